# Optimizing an MI355X kernel written in HIP

```python
import math
import jax
import jax.numpy as jnp
from jax import lax
import numpy as np

D_MODEL = 1024
BATCH = 4
SEQ = 4096
DEPTH = 2

GRID_W = 64
CTX_LEN = 256
EPS = 1e-6
N_MOD = 6

MIX_WIDTH = D_MODEL
SGU_DIM = MIX_WIDTH // 4
SGU_HEADS = 4
SGU_HEAD_DIM = SGU_DIM // SGU_HEADS
SGU_CHUNK = 128

S5_DIM = MIX_WIDTH // 4
S5_GROUP = 16
S5_GROUPS = S5_DIM // S5_GROUP
S5_STATE = 64

GLA_DIM = MIX_WIDTH - SGU_DIM - S5_DIM
GLA_HEADS = 8
GLA_DV = GLA_DIM // GLA_HEADS
GLA_DK = GLA_DV // 2
GLA_KEY_DIM = GLA_HEADS * GLA_DK
GLA_RANK = 16
GLA_GATE_TEMP = 16.0
GLA_CHUNK = 64

PEER_HEADS = 8
PEER_NKEYS = 128
PEER_EXPERTS = PEER_NKEYS * PEER_NKEYS
PEER_QDIM = 256
PEER_HALF = PEER_QDIM // 2
PEER_TOPK = 16
PEER_TOKEN_BLOCK = 128

IN_SPLITS = (SGU_DIM, SGU_DIM, S5_DIM, GLA_KEY_DIM, GLA_KEY_DIM, GLA_DIM, GLA_DIM, GLA_RANK, GLA_RANK)
IN_WIDTH = sum(IN_SPLITS)

kernel_name = 'hybrid_sgu_s5_gla_peer_flow_block'


def rmsnorm(x, g=None):
    xf = x.astype(jnp.float32)
    y = xf * lax.rsqrt(jnp.mean(xf * xf, axis=-1, keepdims=True) + EPS)
    if g is not None:
        y = y * g.astype(jnp.float32)
    return y.astype(x.dtype)


def modulate(h, shift, scale):
    return h * (1 + scale) + shift


def split_cols(p):
    cuts = [int(i) for i in np.cumsum(IN_SPLITS)[:-1]]
    return jnp.split(p, cuts, axis=-1)


def flip_t(t):
    return jnp.flip(t, axis=1)


def to_col_major(t, rows):
    b, n = t.shape[0], t.shape[1]
    rest = t.shape[2:]
    return jnp.swapaxes(t.reshape(b, rows, GRID_W, *rest), 1, 2).reshape(b, n, *rest)


def from_col_major(t, rows):
    b, n = t.shape[0], t.shape[1]
    rest = t.shape[2:]
    return jnp.swapaxes(t.reshape(b, GRID_W, rows, *rest), 1, 2).reshape(b, n, *rest)


def sgu_mixer(u, v, w_s, b_s):
    bsz, length, _ = u.shape
    n = length // SGU_CHUNK
    u = jax.nn.gelu(u)
    v = rmsnorm(jax.nn.gelu(v).reshape(bsz, n, SGU_CHUNK, SGU_HEADS, SGU_HEAD_DIM))
    mixed = jnp.einsum('hts,bnshd->bnthd', w_s, v) + jnp.swapaxes(b_s, 0, 1)[:, :, None]
    return u * mixed.reshape(bsz, length, SGU_DIM)


def s5_discretise(lam_re, lam_im, b_re, b_im, log_step):
    f32 = jnp.float32
    lam_re = jnp.minimum(lam_re.astype(f32), -1e-4)
    lam_im = lam_im.astype(f32)
    dt = jnp.exp(log_step.astype(f32))[:, None]
    mag = jnp.exp(lam_re * dt)
    a_re = mag * jnp.cos(lam_im * dt)
    a_im = mag * jnp.sin(lam_im * dt)
    den = lam_re * lam_re + lam_im * lam_im
    f_re = ((a_re - 1.0) * lam_re + a_im * lam_im) / den
    f_im = (a_im * lam_re - (a_re - 1.0) * lam_im) / den
    b_re = b_re.astype(f32)
    b_im = b_im.astype(f32)
    bb_re = f_re[..., None] * b_re - f_im[..., None] * b_im
    bb_im = f_re[..., None] * b_im + f_im[..., None] * b_re
    return a_re, a_im, bb_re, bb_im


def complex_affine_combine(e1, e2):
    a1r, a1i, b1r, b1i = e1
    a2r, a2i, b2r, b2i = e2
    return (a2r * a1r - a2i * a1i, a2r * a1i + a2i * a1r,
            a2r * b1r - a2i * b1i + b2r, a2r * b1i + a2i * b1r + b2i)


def s5_scan(u, disc, h0):
    a_re, a_im, bb_re, bb_im = disc
    bu_re = jnp.einsum('blgh,gph->blgp', u, bb_re)
    bu_im = jnp.einsum('blgh,gph->blgp', u, bb_im)
    ar = jnp.broadcast_to(a_re, bu_re.shape)
    ai = jnp.broadcast_to(a_im, bu_re.shape)
    cr, ci, hr, hi = lax.associative_scan(complex_affine_combine, (ar, ai, bu_re, bu_im), axis=1)
    if h0 is not None:
        h0r = h0[0][:, None]
        h0i = h0[1][:, None]
        hr = hr + cr * h0r - ci * h0i
        hi = hi + cr * h0i + ci * h0r
    return hr, hi


def s5_readout(h, c_re, c_im):
    return jnp.einsum('blgp,ghp->blgh', h[0], c_re) - jnp.einsum('blgp,ghp->blgh', h[1], c_im)


def s5_glu(y, w_glu):
    y = y.reshape(y.shape[0], y.shape[1], S5_DIM)
    z = jax.nn.gelu(y) @ w_glu.astype(jnp.float32)
    za, zb = jnp.split(z, 2, axis=-1)
    return za * jax.nn.sigmoid(zb)


def s5_mixer(xc, xl, lam_re, lam_im, b_re, b_im, c_re, c_im, log_step, d_skip, w_glu, ctx_out):
    f32 = jnp.float32

    def groups(t):
        return t.astype(f32).reshape(t.shape[0], t.shape[1], S5_GROUPS, S5_GROUP)

    uc, ul = groups(xc), groups(xl)
    ys_c, ys_l = [], []
    for d in range(2):
        disc = s5_discretise(lam_re[d], lam_im[d], b_re[d], b_im[d], log_step[d])
        cre, cim = c_re[d].astype(f32), c_im[d].astype(f32)
        uc_d = uc if d == 0 else flip_t(uc)
        ul_d = ul if d == 0 else flip_t(ul)
        hc = s5_scan(uc_d, disc, None)
        hl = s5_scan(ul_d, disc, (hc[0][:, -1], hc[1][:, -1]))
        y_l = s5_readout(hl, cre, cim)
        ys_l.append(y_l if d == 0 else flip_t(y_l))
        if ctx_out:
            y_c = s5_readout(hc, cre, cim)
            ys_c.append(y_c if d == 0 else flip_t(y_c))
    dd = d_skip.astype(f32).reshape(S5_GROUPS, S5_GROUP)
    out_l = s5_glu(ys_l[0] + ys_l[1] + dd * ul, w_glu)
    out_c = s5_glu(ys_c[0] + ys_c[1] + dd * uc, w_glu) if ctx_out else None
    return out_l, out_c


def gla_scan(q, k, v, log_a, s0, need_out):
    bsz, length, nh, dk = q.shape
    dv = v.shape[-1]
    n = length // GLA_CHUNK

    def chunks(t):
        return t.reshape(bsz, n, GLA_CHUNK, nh, t.shape[-1])

    q, k, v, log_a = chunks(q), chunks(k), chunks(v), chunks(log_a)
    b = jnp.cumsum(log_a, axis=2)
    b_last = b[:, :, -1]
    chunk_kv = jnp.einsum('bnshk,bnshv->bnhkv', k * jnp.exp(b_last[:, :, None] - b), v)
    decay = jnp.exp(b_last)
    if s0 is None:
        s0 = jnp.zeros((bsz, nh, dk, dv), jnp.float32)

    def step(s, inp):
        dec, kv = inp
        return dec[..., None] * s + kv, s

    s_final, s_in = lax.scan(step, s0, (jnp.swapaxes(decay, 0, 1), jnp.swapaxes(chunk_kv, 0, 1)))
    if not need_out:
        return None, s_final
    s_in = jnp.swapaxes(s_in, 0, 1)
    o_inter = jnp.einsum('bnthk,bnhkv->bnthv', q * jnp.exp(b), s_in)
    b_ref = b[:, :, GLA_CHUNK // 2][:, :, None]
    scores = jnp.einsum('bnthk,bnshk->bnhts', q * jnp.exp(b - b_ref), k * jnp.exp(b_ref - b))
    mask = jnp.tril(jnp.ones((GLA_CHUNK, GLA_CHUNK), dtype=bool))
    scores = jnp.where(mask, scores, 0.0)
    o_intra = jnp.einsum('bnhts,bnshv->bnthv', scores, v)
    return (o_inter + o_intra).reshape(bsz, length, nh, dv), s_final


def gla_gates(z, w_up, b_up):
    f32 = jnp.float32
    za = z.astype(f32) @ w_up.astype(f32) + b_up.astype(f32)
    return (jax.nn.log_sigmoid(za) / GLA_GATE_TEMP).reshape(z.shape[0], z.shape[1], GLA_HEADS, GLA_DK)


def gla_out(o, g, norm_g):
    o = rmsnorm(o).reshape(o.shape[0], o.shape[1], GLA_DIM) * norm_g.astype(jnp.float32)
    return o * jax.nn.silu(g.astype(jnp.float32))


def gla_mixer(cols_c, cols_l, w_gate, b_gate, norm_g, rows, ctx_out):
    f32 = jnp.float32

    def prep(cols):
        q, k, v, g, zf, zb = cols
        q = q.astype(f32).reshape(q.shape[0], q.shape[1], GLA_HEADS, GLA_DK) * (GLA_DK ** -0.5)
        k = k.astype(f32).reshape(k.shape[0], k.shape[1], GLA_HEADS, GLA_DK)
        v = v.astype(f32).reshape(v.shape[0], v.shape[1], GLA_HEADS, GLA_DV)
        af = gla_gates(zf, w_gate[0], b_gate[0])
        ab = gla_gates(zb, w_gate[1], b_gate[1])
        return q, k, v, af, ab, g

    qc, kc, vc, afc, abc, gc = prep(cols_c)
    ql, kl, vl, afl, abl, gl = prep(cols_l)
    ql, kl, vl, afl, abl = [to_col_major(t, rows) for t in (ql, kl, vl, afl, abl)]
    oc_f, sc_f = gla_scan(qc, kc, vc, afc, None, ctx_out)
    oc_b, sc_b = gla_scan(flip_t(qc), flip_t(kc), flip_t(vc), flip_t(abc), None, ctx_out)
    ol_f, _ = gla_scan(ql, kl, vl, afl, sc_f, True)
    ol_b, _ = gla_scan(flip_t(ql), flip_t(kl), flip_t(vl), flip_t(abl), sc_b, True)
    out_l = gla_out(from_col_major(ol_f + flip_t(ol_b), rows), gl, norm_g)
    out_c = gla_out(oc_f + flip_t(oc_b), gc, norm_g) if ctx_out else None
    return out_l, out_c


def peer_ffn(h, w_query, sub_keys, expert_u, expert_v):
    bsz, length, dm = h.shape
    blocks = h.reshape(-1, PEER_TOKEN_BLOCK, dm)
    keys = sub_keys.astype(jnp.float32)

    def block(xb):
        q = (xb @ w_query).astype(jnp.float32).reshape(PEER_TOKEN_BLOCK, PEER_HEADS, 2, PEER_HALF)
        s = jnp.einsum('thpd,phkd->thpk', q, keys)
        s1, i1 = lax.top_k(s[:, :, 0], PEER_TOPK)
        s2, i2 = lax.top_k(s[:, :, 1], PEER_TOPK)
        cand_s = (s1[..., :, None] + s2[..., None, :]).reshape(PEER_TOKEN_BLOCK, PEER_HEADS, PEER_TOPK * PEER_TOPK)
        cand_i = (i1[..., :, None] * PEER_NKEYS + i2[..., None, :]).reshape(PEER_TOKEN_BLOCK, PEER_HEADS, PEER_TOPK * PEER_TOPK)
        top_s, pos = lax.top_k(cand_s, PEER_TOPK)
        idx = jnp.take_along_axis(cand_i, pos, axis=-1)
        gate = jax.nn.softmax(top_s, axis=-1)
        act = jax.nn.gelu(jnp.einsum('td,thkd->thk', xb, expert_u[idx]).astype(jnp.float32))
        return jnp.einsum('thk,thkd->td', (gate * act).astype(xb.dtype), expert_v[idx])

    return lax.map(block, blocks).reshape(bsz, length, dm)


def setup_inputs(seed: int = 0) -> dict:
    key = jax.random.key(seed)
    ks = iter(jax.random.split(key, 40))
    f32 = jnp.float32

    def nrm(shape, scale):
        return jax.random.normal(next(ks), shape, f32) * scale

    L, D = DEPTH, D_MODEL
    n_idx = jnp.arange(S5_STATE, dtype=f32)
    return {
        'x': nrm((BATCH, SEQ, D), 1.0),
        'c': nrm((BATCH, D), 1.0),
        'ctx': nrm((BATCH, CTX_LEN, D), 1.0),
        'c_ctx': nrm((D,), 1.0),
        'w_mod': nrm((L, D, N_MOD * D), 0.5 * D ** -0.5),
        'b_mod': nrm((L, N_MOD * D), 0.02),
        'norm1_g': 1.0 + nrm((L, D), 0.02),
        'norm2_g': 1.0 + nrm((L, D), 0.02),
        'w_in': nrm((L, D, IN_WIDTH), D ** -0.5),
        'w_out': nrm((L, MIX_WIDTH, D), MIX_WIDTH ** -0.5),
        'sgu_w': nrm((L, SGU_HEADS, SGU_CHUNK, SGU_CHUNK), SGU_CHUNK ** -0.5),
        'sgu_b': 1.0 + nrm((L, SGU_HEADS, SGU_CHUNK), 0.1),
        's5_lambda_re': -0.5 + nrm((L, 2, S5_GROUPS, S5_STATE), 0.01),
        's5_lambda_im': math.pi * n_idx + nrm((L, 2, S5_GROUPS, S5_STATE), 0.01),
        's5_b_re': nrm((L, 2, S5_GROUPS, S5_STATE, S5_GROUP), (2 * S5_GROUP) ** -0.5),
        's5_b_im': nrm((L, 2, S5_GROUPS, S5_STATE, S5_GROUP), (2 * S5_GROUP) ** -0.5),
        's5_c_re': nrm((L, 2, S5_GROUPS, S5_GROUP, S5_STATE), (2 * S5_STATE) ** -0.5),
        's5_c_im': nrm((L, 2, S5_GROUPS, S5_GROUP, S5_STATE), (2 * S5_STATE) ** -0.5),
        's5_log_step': jax.random.uniform(next(ks), (L, 2, S5_GROUPS), f32, math.log(1e-3), math.log(1e-1)),
        's5_d': nrm((L, S5_DIM), 1.0),
        's5_w_glu': nrm((L, S5_DIM, 2 * S5_DIM), S5_DIM ** -0.5),
        'gla_w_gate': nrm((L, 2, GLA_RANK, GLA_KEY_DIM), GLA_RANK ** -0.5),
        'gla_b_gate': nrm((L, 2, GLA_KEY_DIM), 0.1),
        'gla_norm_g': 1.0 + nrm((L, GLA_DIM), 0.02),
        'peer_w_query': nrm((L, D, PEER_HEADS * PEER_QDIM), D ** -0.5),
        'peer_sub_keys': nrm((L, 2, PEER_HEADS, PEER_NKEYS, PEER_HALF), PEER_HALF ** -0.5),
        'peer_expert_u': nrm((L, PEER_EXPERTS, D), D ** -0.5),
        'peer_expert_v': nrm((L, PEER_EXPERTS, D), PEER_HEADS ** -0.5),
        'final_norm_g': 1.0 + nrm((D,), 0.02),
    }


def reference(x, c, ctx, c_ctx, w_mod, b_mod, norm1_g, norm2_g, w_in, w_out, sgu_w, sgu_b,
              s5_lambda_re, s5_lambda_im, s5_b_re, s5_b_im, s5_c_re, s5_c_im, s5_log_step, s5_d, s5_w_glu,
              gla_w_gate, gla_b_gate, gla_norm_g, peer_w_query, peer_sub_keys, peer_expert_u, peer_expert_v,
              final_norm_g):
    rows = x.shape[1] // GRID_W
    xl, xc = x, ctx
    for l in range(DEPTH):
        ctx_out = l < DEPTH - 1
        mod_l = [m[:, None, :] for m in jnp.split(jax.nn.silu(c) @ w_mod[l] + b_mod[l], N_MOD, axis=-1)]
        mod_c = jnp.split(jax.nn.silu(c_ctx) @ w_mod[l] + b_mod[l], N_MOD, axis=-1)

        cols_l = split_cols(modulate(rmsnorm(xl, norm1_g[l]), mod_l[0], mod_l[1]) @ w_in[l])
        cols_c = split_cols(modulate(rmsnorm(xc, norm1_g[l]), mod_c[0], mod_c[1]) @ w_in[l])
        s5_l, s5_c = s5_mixer(cols_c[2], cols_l[2], s5_lambda_re[l], s5_lambda_im[l], s5_b_re[l], s5_b_im[l],
                              s5_c_re[l], s5_c_im[l], s5_log_step[l], s5_d[l], s5_w_glu[l], ctx_out)
        gla_l, gla_c = gla_mixer(cols_c[3:], cols_l[3:], gla_w_gate[l], gla_b_gate[l], gla_norm_g[l], rows, ctx_out)
        sgu_l = sgu_mixer(cols_l[0], cols_l[1], sgu_w[l], sgu_b[l])
        y_l = jnp.concatenate([sgu_l.astype(xl.dtype), s5_l.astype(xl.dtype), gla_l.astype(xl.dtype)], axis=-1) @ w_out[l]
        xl = xl + mod_l[2] * y_l

        h_l = modulate(rmsnorm(xl, norm2_g[l]), mod_l[3], mod_l[4])
        xl = xl + mod_l[5] * peer_ffn(h_l, peer_w_query[l], peer_sub_keys[l], peer_expert_u[l], peer_expert_v[l])

        if ctx_out:
            sgu_c = sgu_mixer(cols_c[0], cols_c[1], sgu_w[l], sgu_b[l])
            y_c = jnp.concatenate([sgu_c.astype(xc.dtype), s5_c.astype(xc.dtype), gla_c.astype(xc.dtype)], axis=-1) @ w_out[l]
            xc = xc + mod_c[2] * y_c
            h_c = modulate(rmsnorm(xc, norm2_g[l]), mod_c[3], mod_c[4])
            xc = xc + mod_c[5] * peer_ffn(h_c, peer_w_query[l], peer_sub_keys[l], peer_expert_u[l], peer_expert_v[l])
    return rmsnorm(xl, final_norm_g)
```

```cpp
#include <hip/hip_runtime.h>
#include <cstdio>
#include <cstdint>
#include <cmath>

typedef unsigned short bf16_t;
typedef short bf16x8 __attribute__((ext_vector_type(8)));
typedef float f32x4 __attribute__((ext_vector_type(4)));

#define DM 1024
#define NBATCH 4
#define SEQ 4096
#define CTXL 256
#define TL (NBATCH * SEQ)
#define TC (NBATCH * CTXL)
#define TT (TL + TC)
#define INW 2336
#define INWP 2432
#define NMOD 6144
#define NSC 272
#define EPSV 1e-6f

#define C_SGU_U 0
#define C_SGU_V 256
#define C_S5 512
#define C_GQ 768
#define C_GK 1024
#define C_GV 1280
#define C_GG 1792
#define C_ZF 2304

struct Params {
  const float *x, *c, *ctx, *c_ctx, *w_mod, *b_mod, *norm1_g, *norm2_g, *w_in, *w_out, *sgu_w, *sgu_b;
  const float *lam_re, *lam_im, *b_re, *b_im, *c_re, *c_im, *log_step, *s5_d, *w_glu, *gla_wg, *gla_bg, *gla_ng;
  const float *w_query, *sub_keys, *exp_u, *exp_v, *final_g;
  float* out;
  unsigned* bar;
  float* xres;
  float* modv;
  bf16_t* abuf;
  bf16_t* cols;
  bf16_t* mix;
  bf16_t* yg;
  bf16_t *wt_in, *wt_out, *wt_q, *wt_glu, *keysb;
  float *s5a, *s5a64, *s5bb;
  float *s5S, *s5H;
  float *gkv, *gdec, *gSin;
  float* scores;
  int* pidx;
  float* pgate;
};

__device__ __forceinline__ bf16_t f2bf(float f) {
  unsigned u = __float_as_uint(f);
  u += 0x7fffu + ((u >> 16) & 1u);
  return (bf16_t)(u >> 16);
}
__device__ __forceinline__ float bf2f(bf16_t h) { return __uint_as_float(((unsigned)h) << 16); }
__device__ __forceinline__ float gelu_f(float x) {
  const float y = 0.7978845608028654f * (x + 0.044715f * x * x * x);
  const float e = __expf(2.f * y);
  const float th = 1.f - 2.f / (1.f + e);
  return 0.5f * x * (1.f + th);
}
__device__ __forceinline__ float sigmoid_f(float x) { return 1.f / (1.f + __expf(-x)); }
__device__ __forceinline__ float silu_f(float x) { return x * sigmoid_f(x); }
__device__ __forceinline__ float logsigmoid_f(float x) { return fminf(x, 0.f) - log1pf(__expf(-fabsf(x))); }
__device__ __forceinline__ float wave_sum(float v) {
#pragma unroll
  for (int o = 32; o > 0; o >>= 1) v += __shfl_xor(v, o);
  return v;
}
__device__ __forceinline__ int tok_batch(int t) { return t < TL ? (t >> 12) : 4; }
__device__ __forceinline__ int s5_tok(int sc, int i) { return sc < 256 ? ((sc >> 6) * SEQ + (sc & 63) * 64 + i) : (TL + (sc - 256) * 64 + i); }
__device__ __forceinline__ int gla_tok(int sc, int i) { return sc < 256 ? ((sc >> 6) * SEQ + i * 64 + (sc & 63)) : (TL + (sc - 256) * 64 + i); }

__device__ void phase_mod(const Params& p, int bid, int nblk, unsigned char* smem) {
  float* sil = (float*)smem;
  float* red = sil + 5 * 1024;
  const int tid = threadIdx.x;
  for (int i = tid; i < 5 * 1024; i += 256) {
    const int r = i >> 10, k = i & 1023;
    const float v = r < 4 ? p.c[r * 1024 + k] : p.c_ctx[k];
    sil[i] = silu_f(v);
  }
  __syncthreads();
  for (int item = bid; item < 192; item += nblk) {
    const int l = item / 96, j0 = (item % 96) * 64;
    const int cc = tid & 63, kg = tid >> 6;
    float acc[5] = {0.f, 0.f, 0.f, 0.f, 0.f};
    const float* w = p.w_mod + (size_t)l * 1024 * NMOD + j0 + cc;
    for (int k = kg * 256; k < kg * 256 + 256; ++k) {
      const float wv = w[(size_t)k * NMOD];
#pragma unroll
      for (int r = 0; r < 5; ++r) acc[r] += sil[r * 1024 + k] * wv;
    }
#pragma unroll
    for (int r = 0; r < 5; ++r) red[(kg * 5 + r) * 64 + cc] = acc[r];
    __syncthreads();
    if (kg == 0) {
#pragma unroll
      for (int r = 0; r < 5; ++r) {
        float s = red[(0 * 5 + r) * 64 + cc] + red[(1 * 5 + r) * 64 + cc] + red[(2 * 5 + r) * 64 + cc] + red[(3 * 5 + r) * 64 + cc];
        p.modv[((size_t)l * 5 + r) * NMOD + j0 + cc] = s + p.b_mod[l * NMOD + j0 + cc];
      }
    }
    __syncthreads();
  }
}

__device__ void transpose_tile(const float* src, int ldsrc, bf16_t* dst, int lddst, int k0, int r0, int nsrc, int glu, float* tile) {
  const int tid = threadIdx.x;
  const int j = tid & 63;
  const int r = r0 + j;
  int scol;
  if (glu) {
    const int bn = r >> 7, wc = (r >> 6) & 1, hf = (r >> 5) & 1, i = r & 31;
    scol = hf * 256 + bn * 64 + wc * 32 + i;
  } else {
    scol = r < nsrc ? r : -1;
  }
#pragma unroll
  for (int it = 0; it < 16; ++it) {
    const int kk = (tid >> 6) + it * 4;
    tile[kk * 65 + j] = scol >= 0 ? src[(size_t)(k0 + kk) * ldsrc + scol] : 0.f;
  }
  __syncthreads();
  const int kk = tid & 63;
#pragma unroll
  for (int it = 0; it < 16; ++it) {
    const int jj = (tid >> 6) + it * 4;
    dst[(size_t)(r0 + jj) * lddst + k0 + kk] = f2bf(tile[kk * 65 + jj]);
  }
  __syncthreads();
}

__device__ void phase_wprep(const Params& p, int bid, int nblk, unsigned char* smem) {
  float* tile = (float*)smem;
  const int tid = threadIdx.x;
  const int NT_L = 1408;
  const int n_tr = 2 * NT_L;
  const int n_keys = 256;
  const int n_disc = 16;
  const int total = n_tr + n_keys + n_disc;
  for (int item = bid; item < total; item += nblk) {
    if (item < n_tr) {
      const int l = item / NT_L;
      int t = item % NT_L;
      if (t < 608) {
        transpose_tile(p.w_in + (size_t)l * 1024 * INW, INW, p.wt_in + (size_t)l * INWP * 1024, 1024, (t % 16) * 64, (t / 16) * 64, INW, 0, tile);
      } else if (t < 864) {
        t -= 608;
        transpose_tile(p.w_out + (size_t)l * 1024 * 1024, 1024, p.wt_out + (size_t)l * 1024 * 1024, 1024, (t % 16) * 64, (t / 16) * 64, 1024, 0, tile);
      } else if (t < 1376) {
        t -= 864;
        transpose_tile(p.w_query + (size_t)l * 1024 * 2048, 2048, p.wt_q + (size_t)l * 2048 * 1024, 1024, (t % 16) * 64, (t / 16) * 64, 2048, 0, tile);
      } else {
        t -= 1376;
        transpose_tile(p.w_glu + (size_t)l * 256 * 512, 512, p.wt_glu + (size_t)l * 512 * 256, 256, (t % 4) * 64, (t / 4) * 64, 512, 1, tile);
      }
    } else if (item < n_tr + n_keys) {
      const int base = (item - n_tr) * 2048;
      for (int i = tid; i < 2048; i += 256) p.keysb[base + i] = f2bf(p.sub_keys[base + i]);
    } else {
      const int id = (item - n_tr - n_keys) * 256 + tid;
      const int g = (id >> 6) & 15;
      const int ldg = id >> 6;
      double lre = (double)p.lam_re[id];
      if (lre > -1e-4) lre = -1e-4;
      const double lim = (double)p.lam_im[id];
      const double dt = exp((double)p.log_step[ldg]);
      const double mag = exp(lre * dt);
      const double are = mag * cos(lim * dt), aim = mag * sin(lim * dt);
      const double den = lre * lre + lim * lim;
      const double fre = ((are - 1.0) * lre + aim * lim) / den;
      const double fim = (aim * lre - (are - 1.0) * lim) / den;
      p.s5a[id * 2 + 0] = (float)are;
      p.s5a[id * 2 + 1] = (float)aim;
      double pr = are, pi = aim;
      for (int s = 0; s < 6; ++s) { const double nr = pr * pr - pi * pi, ni = 2.0 * pr * pi; pr = nr; pi = ni; }
      p.s5a64[id * 2 + 0] = (float)pr;
      p.s5a64[id * 2 + 1] = (float)pi;
      for (int h = 0; h < 16; ++h) {
        const double br = (double)p.b_re[(size_t)id * 16 + h], bi = (double)p.b_im[(size_t)id * 16 + h];
        p.s5bb[(size_t)id * 32 + h] = (float)(fre * br - fim * bi);
        p.s5bb[(size_t)id * 32 + 16 + h] = (float)(fre * bi + fim * br);
      }
      (void)g;
    }
  }
}

__device__ void phase_normmod(const Params& p, const float* src_l, const float* src_c, const float* gain, const float* modl, int shift_off, int scale_off,
                              int ntok, int copy, int bid, int nblk) {
  const int lane = threadIdx.x & 63, wid = threadIdx.x >> 6;
  for (int t = bid * 4 + wid; t < ntok; t += nblk * 4) {
    const float* row = t < TL ? src_l + (size_t)t * 1024 : src_c + (size_t)(t - TL) * 1024;
    const float* md = modl + (size_t)tok_batch(t) * NMOD;
    f32x4 v[4];
    float ss = 0.f;
#pragma unroll
    for (int j = 0; j < 4; ++j) {
      v[j] = *(const f32x4*)(row + j * 256 + lane * 4);
      ss += v[j][0] * v[j][0] + v[j][1] * v[j][1] + v[j][2] * v[j][2] + v[j][3] * v[j][3];
    }
    ss = wave_sum(ss);
    const float rstd = rsqrtf(ss * (1.f / 1024.f) + EPSV);
#pragma unroll
    for (int j = 0; j < 4; ++j) {
      const int c0 = j * 256 + lane * 4;
      const f32x4 g = *(const f32x4*)(gain + c0);
      const f32x4 sh = *(const f32x4*)(md + shift_off + c0);
      const f32x4 sc = *(const f32x4*)(md + scale_off + c0);
      ushort4 o;
      o.x = f2bf(v[j][0] * rstd * g[0] * (1.f + sc[0]) + sh[0]);
      o.y = f2bf(v[j][1] * rstd * g[1] * (1.f + sc[1]) + sh[1]);
      o.z = f2bf(v[j][2] * rstd * g[2] * (1.f + sc[2]) + sh[2]);
      o.w = f2bf(v[j][3] * rstd * g[3] * (1.f + sc[3]) + sh[3]);
      *(ushort4*)(p.abuf + (size_t)t * 1024 + c0) = o;
      if (copy) *(f32x4*)(p.xres + (size_t)t * 1024 + c0) = v[j];
    }
  }
}

#define G_LDS_STRIDE 72
#define G_TILE_ELEMS (128 * G_LDS_STRIDE)
template <class Epi>
__device__ __forceinline__ void gemm_tile_128(const bf16_t* __restrict__ A, int lda, const bf16_t* __restrict__ Bt, int ldb, int K, int m0, int n0,
                                              const Epi& epi, bf16_t* lds) {
  const int tid = threadIdx.x, lane = tid & 63, wid = tid >> 6;
  const int wr = wid >> 1, wc = wid & 1;
  f32x4 acc[4][4];
#pragma unroll
  for (int m = 0; m < 4; ++m)
#pragma unroll
    for (int n = 0; n < 4; ++n) acc[m][n] = (f32x4){0.f, 0.f, 0.f, 0.f};
  uint4 ra[4], rb[4];
  const int lr = tid >> 3, lc = (tid & 7) * 8;
  const bf16_t* Ag = A + (size_t)(m0 + lr) * lda + lc;
  const bf16_t* Bg = Bt + (size_t)(n0 + lr) * ldb + lc;
#pragma unroll
  for (int i = 0; i < 4; ++i) {
    ra[i] = *(const uint4*)(Ag + (size_t)i * 32 * lda);
    rb[i] = *(const uint4*)(Bg + (size_t)i * 32 * ldb);
  }
#pragma unroll
  for (int i = 0; i < 4; ++i) {
    *(uint4*)(lds + (lr + 32 * i) * G_LDS_STRIDE + lc) = ra[i];
    *(uint4*)(lds + G_TILE_ELEMS + (lr + 32 * i) * G_LDS_STRIDE + lc) = rb[i];
  }
  __syncthreads();
  const int nk = K >> 6;
  const int fr = lane & 15, fq = lane >> 4;
  for (int kt = 0; kt < nk; ++kt) {
    const bf16_t* sA = lds + (kt & 1) * 2 * G_TILE_ELEMS;
    const bf16_t* sB = sA + G_TILE_ELEMS;
    if (kt + 1 < nk) {
#pragma unroll
      for (int i = 0; i < 4; ++i) {
        ra[i] = *(const uint4*)(Ag + (size_t)i * 32 * lda + (kt + 1) * 64);
        rb[i] = *(const uint4*)(Bg + (size_t)i * 32 * ldb + (kt + 1) * 64);
      }
    }
#pragma unroll
    for (int ks = 0; ks < 2; ++ks) {
      bf16x8 a[4], b[4];
#pragma unroll
      for (int m = 0; m < 4; ++m) a[m] = *(const bf16x8*)(sA + (wr * 64 + m * 16 + fr) * G_LDS_STRIDE + ks * 32 + fq * 8);
#pragma unroll
      for (int n = 0; n < 4; ++n) b[n] = *(const bf16x8*)(sB + (wc * 64 + n * 16 + fr) * G_LDS_STRIDE + ks * 32 + fq * 8);
#pragma unroll
      for (int m = 0; m < 4; ++m)
#pragma unroll
        for (int n = 0; n < 4; ++n) acc[m][n] = __builtin_amdgcn_mfma_f32_16x16x32_bf16(a[m], b[n], acc[m][n], 0, 0, 0);
    }
    if (kt + 1 < nk) {
      bf16_t* dA = lds + ((kt + 1) & 1) * 2 * G_TILE_ELEMS;
#pragma unroll
      for (int i = 0; i < 4; ++i) {
        *(uint4*)(dA + (lr + 32 * i) * G_LDS_STRIDE + lc) = ra[i];
        *(uint4*)(dA + G_TILE_ELEMS + (lr + 32 * i) * G_LDS_STRIDE + lc) = rb[i];
      }
    }
    __syncthreads();
  }
  epi(acc, m0 + wr * 64, n0 + wc * 64, wc, lane);
}

struct EpiBf16 {
  bf16_t* out; int ldc; int ncols;
  __device__ __forceinline__ void operator()(const f32x4 (&acc)[4][4], int rb, int cb, int wc, int lane) const {
    const int fr = lane & 15, fq = lane >> 4;
#pragma unroll
    for (int m = 0; m < 4; ++m)
#pragma unroll
      for (int n = 0; n < 4; ++n) {
        const int col = cb + n * 16 + fr;
        if (col < ncols) {
#pragma unroll
          for (int j = 0; j < 4; ++j) out[(size_t)(rb + m * 16 + fq * 4 + j) * ldc + col] = f2bf(acc[m][n][j]);
        }
      }
  }
};
struct EpiF32 {
  float* out; int ldc; int coff;
  __device__ __forceinline__ void operator()(const f32x4 (&acc)[4][4], int rb, int cb, int wc, int lane) const {
    const int fr = lane & 15, fq = lane >> 4;
#pragma unroll
    for (int m = 0; m < 4; ++m)
#pragma unroll
      for (int n = 0; n < 4; ++n) {
        const int col = coff + cb + n * 16 + fr;
#pragma unroll
        for (int j = 0; j < 4; ++j) out[(size_t)(rb + m * 16 + fq * 4 + j) * ldc + col] = acc[m][n][j];
      }
  }
};
struct EpiResid {
  float* xres; const float* modl; int gate_off;
  __device__ __forceinline__ void operator()(const f32x4 (&acc)[4][4], int rb, int cb, int wc, int lane) const {
    const int fr = lane & 15, fq = lane >> 4;
#pragma unroll
    for (int m = 0; m < 4; ++m) {
      const int row0 = rb + m * 16 + fq * 4;
      const float* md = modl + (size_t)tok_batch(row0) * NMOD + gate_off;
#pragma unroll
      for (int n = 0; n < 4; ++n) {
        const int col = cb + n * 16 + fr;
        const float g = md[col];
#pragma unroll
        for (int j = 0; j < 4; ++j) {
          float* px = xres + (size_t)(row0 + j) * 1024 + col;
          *px = *px + g * acc[m][n][j];
        }
      }
    }
  }
};
struct EpiGlu {
  bf16_t* mix;
  __device__ __forceinline__ void operator()(const f32x4 (&acc)[4][4], int rb, int cb, int wc, int lane) const {
    const int fr = lane & 15, fq = lane >> 4;
    const int n0 = cb - wc * 64;
#pragma unroll
    for (int m = 0; m < 4; ++m)
#pragma unroll
      for (int n = 0; n < 2; ++n) {
        const int ocol = (n0 >> 1) + wc * 32 + n * 16 + fr;
#pragma unroll
        for (int j = 0; j < 4; ++j) {
          const float v = acc[m][n][j] * sigmoid_f(acc[m][n + 2][j]);
          mix[(size_t)(rb + m * 16 + fq * 4 + j) * 1024 + 256 + ocol] = f2bf(v);
        }
      }
  }
};

__device__ void phase_sgu(const Params& p, int layer, int nchunks, int bid, int nblk, unsigned char* smem) {
  float* ws = (float*)smem;
  float* vn = ws + 128 * 129;
  const int tid = threadIdx.x;
  for (int item = bid; item < nchunks * 4; item += nblk) {
    const int ch = item >> 2, h = item & 3;
    const int tok0 = ch * 128;
    const float* wsrc = p.sgu_w + ((size_t)layer * 4 + h) * 128 * 128;
    for (int i = tid; i < 128 * 128; i += 256) ws[(i >> 7) * 129 + (i & 127)] = wsrc[i];
    {
      const int s = tid >> 1, half = tid & 1;
      const bf16_t* vrow = p.cols + (size_t)(tok0 + s) * INW + C_SGU_V + h * 64 + half * 32;
      float gv[32];
      float ss = 0.f;
#pragma unroll
      for (int d = 0; d < 32; ++d) { gv[d] = gelu_f(bf2f(vrow[d])); ss += gv[d] * gv[d]; }
      ss += __shfl_xor(ss, 1);
      const float rstd = rsqrtf(ss * (1.f / 64.f) + EPSV);
#pragma unroll
      for (int d = 0; d < 32; ++d) vn[s * 64 + half * 32 + d] = gv[d] * rstd;
    }
    __syncthreads();
    {
      const int t = tid & 127, dh = tid >> 7;
      float acc[32];
#pragma unroll
      for (int d = 0; d < 32; ++d) acc[d] = 0.f;
      for (int s = 0; s < 128; ++s) {
        const float w = ws[t * 129 + s];
        const float* vr = vn + s * 64 + dh * 32;
#pragma unroll
        for (int d = 0; d < 32; ++d) acc[d] += w * vr[d];
      }
      const float bs = p.sgu_b[((size_t)layer * 4 + h) * 128 + t];
      const bf16_t* urow = p.cols + (size_t)(tok0 + t) * INW + C_SGU_U + h * 64 + dh * 32;
      bf16_t* orow = p.mix + (size_t)(tok0 + t) * 1024 + h * 64 + dh * 32;
#pragma unroll
      for (int d = 0; d < 32; ++d) orow[d] = f2bf(gelu_f(bf2f(urow[d])) * (acc[d] + bs));
    }
    __syncthreads();
  }
}

__device__ void phase_s5a(const Params& p, int layer, int bid, int nblk, unsigned char* smem) {
  const int tid = threadIdx.x, lane = tid & 63, wid = tid >> 6;
  float* ul = (float*)smem + wid * 1024;
  const int nitems = NSC * 16 * 2;
  for (int base = bid * 4; base < nitems; base += nblk * 4) {
    const int item = base + wid;
    const bool valid = item < nitems;
    const int dir = valid ? item / (NSC * 16) : 0;
    const int rem = valid ? item % (NSC * 16) : 0;
    const int sc = rem >> 4, g = rem & 15;
    const int pid = ((layer * 2 + dir) * 16 + g) * 64 + lane;
    if (valid) {
#pragma unroll
      for (int j = 0; j < 16; ++j) {
        const int e = lane + 64 * j;
        ul[e] = bf2f(p.cols[(size_t)s5_tok(sc, e >> 4) * INW + C_S5 + g * 16 + (e & 15)]);
      }
    }
    __syncthreads();
    if (valid) {
      const float are = p.s5a[pid * 2], aim = p.s5a[pid * 2 + 1];
      float bre[16], bim[16];
#pragma unroll
      for (int h = 0; h < 16; ++h) { bre[h] = p.s5bb[(size_t)pid * 32 + h]; bim[h] = p.s5bb[(size_t)pid * 32 + 16 + h]; }
      float hr = 0.f, hi = 0.f;
      for (int tau = 0; tau < 64; ++tau) {
        const int i = dir ? 63 - tau : tau;
        float bur = 0.f, bui = 0.f;
#pragma unroll
        for (int h = 0; h < 16; ++h) { const float uv = ul[i * 16 + h]; bur += bre[h] * uv; bui += bim[h] * uv; }
        const float nr = are * hr - aim * hi + bur;
        const float ni = are * hi + aim * hr + bui;
        hr = nr; hi = ni;
      }
      float* dst = p.s5S + ((((size_t)dir * NSC + sc) * 16 + g) * 64 + lane) * 2;
      dst[0] = hr; dst[1] = hi;
    }
    __syncthreads();
  }
}

__device__ void phase_scan(const Params& p, int layer, int bid, int nblk) {
  const int tid = threadIdx.x;
  for (int item = bid; item < 32 + 512; item += nblk) {
    if (item < 32) {
      const int id = item * 256 + tid;
      const int pp = id & 63, g = (id >> 6) & 15, b = (id >> 10) & 3, dir = id >> 12;
      const int pid = ((layer * 2 + dir) * 16 + g) * 64 + pp;
      const float ar = p.s5a64[pid * 2], ai = p.s5a64[pid * 2 + 1];
      float hr = 0.f, hi = 0.f;
      for (int s = 0; s < 68; ++s) {
        int sc;
        if (s < 4) sc = 256 + b * 4 + (dir ? 3 - s : s);
        else sc = b * 64 + (dir ? 63 - (s - 4) : (s - 4));
        const size_t o = ((((size_t)dir * NSC + sc) * 16 + g) * 64 + pp) * 2;
        p.s5H[o] = hr; p.s5H[o + 1] = hi;
        const float sr = p.s5S[o], si = p.s5S[o + 1];
        const float nr = ar * hr - ai * hi + sr;
        const float ni = ar * hi + ai * hr + si;
        hr = nr; hi = ni;
      }
    } else {
      const int id = (item - 32) * 256 + tid;
      const int e = id & 2047, h = (id >> 11) & 7, b = (id >> 14) & 3, dir = id >> 16;
      const int dk = e >> 6;
      float S = 0.f;
      for (int s = 0; s < 68; ++s) {
        int sc;
        if (s < 4) sc = 256 + b * 4 + (dir ? 3 - s : s);
        else sc = b * 64 + (dir ? 63 - (s - 4) : (s - 4));
        const size_t o = (((size_t)dir * NSC + sc) * 8 + h);
        p.gSin[o * 2048 + e] = S;
        S = p.gdec[o * 32 + dk] * S + p.gkv[o * 2048 + e];
      }
    }
  }
}

#define S5C_WAVE_FLOATS (1024 + 2 * 16 * 65 + 2048 + 64 * 17)
__device__ void phase_s5c(const Params& p, int layer, int nsc, int bid, int nblk, unsigned char* smem) {
  const int tid = threadIdx.x, lane = tid & 63, wid = tid >> 6;
  float* ul = (float*)smem + wid * S5C_WAVE_FLOATS;
  float* st_r = ul + 1024;
  float* st_i = st_r + 16 * 65;
  float* Cre = st_i + 16 * 65;
  float* Cim = Cre + 1024;
  float* yb = Cim + 1024;
  const int nitems = nsc * 16;
  for (int base = bid * 4; base < nitems; base += nblk * 4) {
    const int item = base + wid;
    const bool valid = item < nitems;
    const int sc = valid ? item >> 4 : 0, g = item & 15;
    if (valid) {
#pragma unroll
      for (int j = 0; j < 16; ++j) {
        const int e = lane + 64 * j;
        ul[e] = bf2f(p.cols[(size_t)s5_tok(sc, e >> 4) * INW + C_S5 + g * 16 + (e & 15)]);
      }
    }
    for (int dir = 0; dir < 2; ++dir) {
      const int pid = ((layer * 2 + dir) * 16 + g) * 64 + lane;
      __syncthreads();
      if (valid) {
        const float* cr = p.c_re + (size_t)((layer * 2 + dir) * 16 + g) * 16 * 64;
        const float* ci = p.c_im + (size_t)((layer * 2 + dir) * 16 + g) * 16 * 64;
#pragma unroll
        for (int j = 0; j < 16; ++j) { Cre[lane * 16 + j] = cr[j * 64 + lane]; Cim[lane * 16 + j] = ci[j * 64 + lane]; }
      }
      float are = 0.f, aim = 0.f, hr = 0.f, hi = 0.f;
      float bre[16], bim[16];
      if (valid) {
        are = p.s5a[pid * 2]; aim = p.s5a[pid * 2 + 1];
#pragma unroll
        for (int h = 0; h < 16; ++h) { bre[h] = p.s5bb[(size_t)pid * 32 + h]; bim[h] = p.s5bb[(size_t)pid * 32 + 16 + h]; }
        const float* hin = p.s5H + ((((size_t)dir * NSC + sc) * 16 + g) * 64 + lane) * 2;
        hr = hin[0]; hi = hin[1];
      }
      for (int grp = 0; grp < 4; ++grp) {
        __syncthreads();
        if (valid) {
          for (int tl = 0; tl < 16; ++tl) {
            const int tau = grp * 16 + tl;
            const int i = dir ? 63 - tau : tau;
            float bur = 0.f, bui = 0.f;
#pragma unroll
            for (int h = 0; h < 16; ++h) { const float uv = ul[i * 16 + h]; bur += bre[h] * uv; bui += bim[h] * uv; }
            const float nr = are * hr - aim * hi + bur;
            const float ni = are * hi + aim * hr + bui;
            hr = nr; hi = ni;
            st_r[tl * 65 + lane] = hr;
            st_i[tl * 65 + lane] = hi;
          }
        }
        __syncthreads();
        if (valid) {
          const int tl = lane & 15, hg = lane >> 4;
          float a0 = 0.f, a1 = 0.f, a2 = 0.f, a3 = 0.f;
          for (int pp = 0; pp < 64; ++pp) {
            const float sr = st_r[tl * 65 + pp], si = st_i[tl * 65 + pp];
            const f32x4 cr4 = *(const f32x4*)(Cre + pp * 16 + hg * 4);
            const f32x4 ci4 = *(const f32x4*)(Cim + pp * 16 + hg * 4);
            a0 += sr * cr4[0] - si * ci4[0];
            a1 += sr * cr4[1] - si * ci4[1];
            a2 += sr * cr4[2] - si * ci4[2];
            a3 += sr * cr4[3] - si * ci4[3];
          }
          const int tau = grp * 16 + tl;
          const int i = dir ? 63 - tau : tau;
          float* y = yb + i * 17 + hg * 4;
          if (dir == 0) { y[0] = a0; y[1] = a1; y[2] = a2; y[3] = a3; }
          else { y[0] += a0; y[1] += a1; y[2] += a2; y[3] += a3; }
        }
      }
    }
    __syncthreads();
    if (valid) {
#pragma unroll
      for (int j = 0; j < 16; ++j) {
        const int e = lane + 64 * j;
        const int i = e >> 4, hh = e & 15;
        const float v = yb[i * 17 + hh] + p.s5_d[layer * 256 + g * 16 + hh] * ul[e];
        p.yg[(size_t)s5_tok(sc, i) * 256 + g * 16 + hh] = f2bf(gelu_f(v));
      }
    }
    __syncthreads();
  }
}

__device__ __forceinline__ void gla_logdecay(const Params& p, int layer, int sc, int h, int dir, float* lb) {
  const int tid = threadIdx.x;
  {
    const int dk = tid & 31, ig = tid >> 5;
    const float* wg = p.gla_wg + ((size_t)(layer * 2 + dir) * 16) * 256 + h * 32 + dk;
    float w[16];
#pragma unroll
    for (int r = 0; r < 16; ++r) w[r] = wg[r * 256];
    const float bgv = p.gla_bg[(layer * 2 + dir) * 256 + h * 32 + dk];
    for (int ii = 0; ii < 8; ++ii) {
      const int i = ig * 8 + ii;
      const bf16_t* z = p.cols + (size_t)gla_tok(sc, i) * INW + C_ZF + dir * 16;
      float za = bgv;
#pragma unroll
      for (int r = 0; r < 16; ++r) za += bf2f(z[r]) * w[r];
      lb[i * 33 + dk] = logsigmoid_f(za) * (1.f / 16.f);
    }
  }
  __syncthreads();
  if (tid < 32) {
    float run = 0.f;
    for (int tau = 0; tau < 64; ++tau) {
      const int i = dir ? 63 - tau : tau;
      run += lb[i * 33 + tid];
      lb[i * 33 + tid] = run;
    }
  }
  __syncthreads();
}

__device__ void phase_glaa(const Params& p, int layer, int bid, int nblk, unsigned char* smem) {
  float* lb = (float*)smem;
  float* kk = lb + 64 * 33;
  float* vv = kk + 64 * 33;
  const int tid = threadIdx.x;
  const int nitems = NSC * 8 * 2;
  for (int item = bid; item < nitems; item += nblk) {
    const int dir = item / (NSC * 8);
    const int rem = item % (NSC * 8);
    const int sc = rem >> 3, h = rem & 7;
    gla_logdecay(p, layer, sc, h, dir, lb);
    const int ilast = dir ? 0 : 63;
    for (int e = tid; e < 64 * 32; e += 256) {
      const int i = e >> 5, dk = e & 31;
      const float kx = bf2f(p.cols[(size_t)gla_tok(sc, i) * INW + C_GK + h * 32 + dk]);
      kk[i * 33 + dk] = kx * __expf(lb[ilast * 33 + dk] - lb[i * 33 + dk]);
    }
    for (int e = tid; e < 64 * 64; e += 256) {
      const int i = e >> 6, dv = e & 63;
      vv[i * 64 + dv] = bf2f(p.cols[(size_t)gla_tok(sc, i) * INW + C_GV + h * 64 + dv]);
    }
    __syncthreads();
    {
      const int dv = tid & 63, dg = tid >> 6;
      float acc[8];
#pragma unroll
      for (int j = 0; j < 8; ++j) acc[j] = 0.f;
      for (int i = 0; i < 64; ++i) {
        const float v = vv[i * 64 + dv];
#pragma unroll
        for (int j = 0; j < 8; ++j) acc[j] += kk[i * 33 + dg * 8 + j] * v;
      }
      const size_t o = (((size_t)dir * NSC + sc) * 8 + h);
#pragma unroll
      for (int j = 0; j < 8; ++j) p.gkv[o * 2048 + (dg * 8 + j) * 64 + dv] = acc[j];
      if (tid < 32) p.gdec[o * 32 + tid] = __expf(lb[ilast * 33 + tid]);
    }
    __syncthreads();
  }
}

__device__ void phase_glac(const Params& p, int layer, int nsc, int bid, int nblk, unsigned char* smem) {
  float* lb = (float*)smem;
  float* qe = lb + 64 * 33;
  float* qs = qe + 64 * 33;
  float* ks = qs + 64 * 33;
  float* vv = ks + 64 * 33;
  float* Sin = vv + 64 * 64;
  float* scs = Sin + 32 * 64;
  const int tid = threadIdx.x, lane = tid & 63, wid = tid >> 6;
  for (int item = bid; item < nsc * 8; item += nblk) {
    const int sc = item >> 3, h = item & 7;
    float o[16];
#pragma unroll
    for (int j = 0; j < 16; ++j) o[j] = 0.f;
    for (int e = tid; e < 64 * 64; e += 256) {
      const int i = e >> 6, dv = e & 63;
      vv[i * 64 + dv] = bf2f(p.cols[(size_t)gla_tok(sc, i) * INW + C_GV + h * 64 + dv]);
    }
    for (int dir = 0; dir < 2; ++dir) {
      gla_logdecay(p, layer, sc, h, dir, lb);
      const int iref = dir ? 31 : 32;
      for (int e = tid; e < 64 * 32; e += 256) {
        const int i = e >> 5, dk = e & 31;
        const size_t tb = (size_t)gla_tok(sc, i) * INW;
        const float qx = bf2f(p.cols[tb + C_GQ + h * 32 + dk]) * 0.17677669529663687f;
        const float kx = bf2f(p.cols[tb + C_GK + h * 32 + dk]);
        const float bi = lb[i * 33 + dk], br = lb[iref * 33 + dk];
        qe[i * 33 + dk] = qx * __expf(bi);
        qs[i * 33 + dk] = qx * __expf(bi - br);
        ks[i * 33 + dk] = kx * __expf(br - bi);
      }
      {
        const size_t ob = (((size_t)dir * NSC + sc) * 8 + h) * 2048;
        for (int e = tid; e < 2048; e += 256) Sin[e] = p.gSin[ob + e];
      }
      __syncthreads();
      for (int e = tid; e < 64 * 64; e += 256) {
        const int i = e >> 6, i2 = e & 63;
        float s = 0.f;
        const bool ok = dir ? (i2 >= i) : (i2 <= i);
        if (ok) {
#pragma unroll
          for (int dk = 0; dk < 32; ++dk) s += qs[i * 33 + dk] * ks[i2 * 33 + dk];
        }
        scs[i * 65 + i2] = s;
      }
      __syncthreads();
      {
        const int dv = lane;
#pragma unroll
        for (int j = 0; j < 16; ++j) {
          const int i = wid * 16 + j;
          float a = 0.f;
#pragma unroll
          for (int dk = 0; dk < 32; ++dk) a += qe[i * 33 + dk] * Sin[dk * 64 + dv];
          for (int i2 = 0; i2 < 64; ++i2) a += scs[i * 65 + i2] * vv[i2 * 64 + dv];
          o[j] += a;
        }
      }
      __syncthreads();
    }
    {
      const int dv = lane;
      const float ng = p.gla_ng[layer * 512 + h * 64 + dv];
#pragma unroll
      for (int j = 0; j < 16; ++j) {
        const int i = wid * 16 + j;
        const float ss = wave_sum(o[j] * o[j]);
        const float rstd = rsqrtf(ss * (1.f / 64.f) + EPSV);
        const int tok = gla_tok(sc, i);
        const float gg = bf2f(p.cols[(size_t)tok * INW + C_GG + h * 64 + dv]);
        p.mix[(size_t)tok * 1024 + 512 + h * 64 + dv] = f2bf(o[j] * rstd * ng * silu_f(gg));
      }
    }
    __syncthreads();
  }
}

__device__ __forceinline__ void wave_argmax(float& bv, int& bi) {
#pragma unroll
  for (int off = 32; off > 0; off >>= 1) {
    const float ov = __shfl_xor(bv, off);
    const int oi = __shfl_xor(bi, off);
    if (ov > bv || (ov == bv && oi < bi)) { bv = ov; bi = oi; }
  }
}
__device__ void phase_topk(const Params& p, int ntok, int bid, int nblk) {
  const int lane = threadIdx.x & 63, wid = threadIdx.x >> 6;
  const float NEG = -3.0e38f;
  for (int item = bid * 4 + wid; item < ntok * 8; item += nblk * 4) {
    const int t = item >> 3, h = item & 7;
    const float* srow = p.scores + (size_t)t * 2048 + h * 256;
    float tops[2]; int topi[2];
    tops[0] = tops[1] = 0.f; topi[0] = topi[1] = 0;
#pragma unroll
    for (int pp = 0; pp < 2; ++pp) {
      float v0 = srow[pp * 128 + lane], v1 = srow[pp * 128 + 64 + lane];
      float ts = 0.f; int ti = 0;
      for (int r = 0; r < 16; ++r) {
        float bv; int bi;
        if (v0 >= v1) { bv = v0; bi = lane; } else { bv = v1; bi = lane + 64; }
        wave_argmax(bv, bi);
        if (lane == r) { ts = bv; ti = bi; }
        if (bi == lane) v0 = NEG;
        if (bi == lane + 64) v1 = NEG;
      }
      tops[pp] = ts; topi[pp] = ti;
    }
    const float sa = __shfl(tops[0], lane >> 2);
    const int ia = __shfl(topi[0], lane >> 2);
    float cs[4]; int ci[4];
#pragma unroll
    for (int j = 0; j < 4; ++j) {
      const float sb = __shfl(tops[1], (lane & 3) * 4 + j);
      const int ib = __shfl(topi[1], (lane & 3) * 4 + j);
      cs[j] = sa + sb; ci[j] = ia * 128 + ib;
    }
    float fs = 0.f; int fi = 0;
    for (int r = 0; r < 16; ++r) {
      float bv = cs[0]; int bp = lane * 4;
      if (cs[1] > bv) { bv = cs[1]; bp = lane * 4 + 1; }
      if (cs[2] > bv) { bv = cs[2]; bp = lane * 4 + 2; }
      if (cs[3] > bv) { bv = cs[3]; bp = lane * 4 + 3; }
      wave_argmax(bv, bp);
      const int jj = bp & 3;
      const int mine = jj == 0 ? ci[0] : (jj == 1 ? ci[1] : (jj == 2 ? ci[2] : ci[3]));
      const int eidx = __shfl(mine, bp >> 2);
      if (lane == r) { fs = bv; fi = eidx; }
      if ((bp >> 2) == lane) {
        if (jj == 0) cs[0] = NEG; else if (jj == 1) cs[1] = NEG; else if (jj == 2) cs[2] = NEG; else cs[3] = NEG;
      }
    }
    const float mx = __shfl(fs, 0);
    float ex = lane < 16 ? __expf(fs - mx) : 0.f;
    float sum = ex;
#pragma unroll
    for (int off = 8; off > 0; off >>= 1) sum += __shfl_xor(sum, off);
    if (lane < 16) {
      p.pidx[(size_t)t * 128 + h * 16 + lane] = fi;
      p.pgate[(size_t)t * 128 + h * 16 + lane] = ex / sum;
    }
  }
}

__device__ void phase_gather(const Params& p, int layer, int ntok, int bid, int nblk) {
  const int lane = threadIdx.x & 63, wid = threadIdx.x >> 6;
  const float* EU = p.exp_u + (size_t)layer * 16384 * 1024;
  const float* EV = p.exp_v + (size_t)layer * 16384 * 1024;
  for (int t = bid * 4 + wid; t < ntok; t += nblk * 4) {
    float hv[16];
#pragma unroll
    for (int j = 0; j < 4; ++j) {
      const ushort4 hb = *(const ushort4*)(p.abuf + (size_t)t * 1024 + j * 256 + lane * 4);
      hv[j * 4 + 0] = bf2f(hb.x); hv[j * 4 + 1] = bf2f(hb.y); hv[j * 4 + 2] = bf2f(hb.z); hv[j * 4 + 3] = bf2f(hb.w);
    }
    const int i0 = p.pidx[(size_t)t * 128 + lane], i1 = p.pidx[(size_t)t * 128 + 64 + lane];
    const float g0 = p.pgate[(size_t)t * 128 + lane], g1 = p.pgate[(size_t)t * 128 + 64 + lane];
    float w0 = 0.f, w1 = 0.f;
#pragma unroll 4
    for (int s = 0; s < 128; ++s) {
      const int e = __shfl(s < 64 ? i0 : i1, s & 63);
      const float* row = EU + (size_t)e * 1024 + lane * 4;
      float d = 0.f;
#pragma unroll
      for (int j = 0; j < 4; ++j) {
        const f32x4 u = *(const f32x4*)(row + j * 256);
        d += u[0] * hv[j * 4] + u[1] * hv[j * 4 + 1] + u[2] * hv[j * 4 + 2] + u[3] * hv[j * 4 + 3];
      }
      d = wave_sum(d);
      const float a = gelu_f(d);
      if (s < 64) { if (lane == s) w0 = g0 * a; } else { if (lane == s - 64) w1 = g1 * a; }
    }
    float acc[16];
#pragma unroll
    for (int j = 0; j < 16; ++j) acc[j] = 0.f;
#pragma unroll 4
    for (int s = 0; s < 128; ++s) {
      const int e = __shfl(s < 64 ? i0 : i1, s & 63);
      const float w = __shfl(s < 64 ? w0 : w1, s & 63);
      const float* row = EV + (size_t)e * 1024 + lane * 4;
#pragma unroll
      for (int j = 0; j < 4; ++j) {
        const f32x4 v = *(const f32x4*)(row + j * 256);
        acc[j * 4] += w * v[0]; acc[j * 4 + 1] += w * v[1]; acc[j * 4 + 2] += w * v[2]; acc[j * 4 + 3] += w * v[3];
      }
    }
    const float* md = p.modv + ((size_t)layer * 5 + tok_batch(t)) * NMOD + 5120;
#pragma unroll
    for (int j = 0; j < 4; ++j) {
      const int c0 = j * 256 + lane * 4;
      f32x4 xv = *(f32x4*)(p.xres + (size_t)t * 1024 + c0);
      const f32x4 g = *(const f32x4*)(md + c0);
      xv[0] += g[0] * acc[j * 4]; xv[1] += g[1] * acc[j * 4 + 1]; xv[2] += g[2] * acc[j * 4 + 2]; xv[3] += g[3] * acc[j * 4 + 3];
      *(f32x4*)(p.xres + (size_t)t * 1024 + c0) = xv;
    }
  }
}

__device__ void phase_final(const Params& p, int bid, int nblk) {
  const int lane = threadIdx.x & 63, wid = threadIdx.x >> 6;
  for (int t = bid * 4 + wid; t < TL; t += nblk * 4) {
    const float* row = p.xres + (size_t)t * 1024;
    f32x4 v[4];
    float ss = 0.f;
#pragma unroll
    for (int j = 0; j < 4; ++j) {
      v[j] = *(const f32x4*)(row + j * 256 + lane * 4);
      ss += v[j][0] * v[j][0] + v[j][1] * v[j][1] + v[j][2] * v[j][2] + v[j][3] * v[j][3];
    }
    ss = wave_sum(ss);
    const float rstd = rsqrtf(ss * (1.f / 1024.f) + EPSV);
#pragma unroll
    for (int j = 0; j < 4; ++j) {
      const int c0 = j * 256 + lane * 4;
      const f32x4 g = *(const f32x4*)(p.final_g + c0);
      f32x4 o;
      o[0] = v[j][0] * rstd * g[0]; o[1] = v[j][1] * rstd * g[1]; o[2] = v[j][2] * rstd * g[2]; o[3] = v[j][3] * rstd * g[3];
      *(f32x4*)(p.out + (size_t)t * 1024 + c0) = o;
    }
  }
}

__device__ void phase_gemm_in(const Params& p, int layer, int bid, int nblk, unsigned char* smem) {
  EpiBf16 epi{p.cols, INW, INW};
  const int ntn = INWP / 128, ntm = TT / 128;
  for (int item = bid; item < ntm * ntn; item += nblk) {
    const int tm = item / ntn, tn = item % ntn;
    gemm_tile_128(p.abuf, 1024, p.wt_in + (size_t)layer * INWP * 1024, 1024, 1024, tm * 128, tn * 128, epi, (bf16_t*)smem);
  }
}
__device__ void phase_gemm_glu(const Params& p, int layer, int ntok, int bid, int nblk, unsigned char* smem) {
  EpiGlu epi{p.mix};
  const int ntn = 4, ntm = ntok / 128;
  for (int item = bid; item < ntm * ntn; item += nblk) {
    const int tm = item / ntn, tn = item % ntn;
    gemm_tile_128(p.yg, 256, p.wt_glu + (size_t)layer * 512 * 256, 256, 256, tm * 128, tn * 128, epi, (bf16_t*)smem);
  }
}
__device__ void phase_gemm_out(const Params& p, int layer, int ntok, int bid, int nblk, unsigned char* smem) {
  EpiResid epi{p.xres, p.modv + (size_t)layer * 5 * NMOD, 2048};
  const int ntn = 8, ntm = ntok / 128;
  for (int item = bid; item < ntm * ntn; item += nblk) {
    const int tm = item / ntn, tn = item % ntn;
    gemm_tile_128(p.mix, 1024, p.wt_out + (size_t)layer * 1024 * 1024, 1024, 1024, tm * 128, tn * 128, epi, (bf16_t*)smem);
  }
}
__device__ void phase_gemm_q(const Params& p, int layer, int ntok, int bid, int nblk, unsigned char* smem) {
  EpiBf16 epi{p.cols  , 2048, 2048};
  const int ntn = 16, ntm = ntok / 128;
  for (int item = bid; item < ntm * ntn; item += nblk) {
    const int tm = item / ntn, tn = item % ntn;
    gemm_tile_128(p.abuf, 1024, p.wt_q + (size_t)layer * 2048 * 1024, 1024, 1024, tm * 128, tn * 128, epi, (bf16_t*)smem);
  }
}
__device__ void phase_gemm_scores(const Params& p, int layer, int ntok, int bid, int nblk, unsigned char* smem) {
  const int ntm = ntok / 128;
  for (int item = bid; item < ntm * 16; item += nblk) {
    const int tm = item >> 4, z = item & 15;
    const int h = z >> 1, pp = z & 1;
    EpiF32 epi{p.scores, 2048, z * 128};
    gemm_tile_128(p.cols + z * 128, 2048, p.keysb + ((((size_t)layer * 2 + pp) * 8 + h) * 128) * 128, 128, 128, tm * 128, 0, epi, (bf16_t*)smem);
  }
}

#define SMEM_BYTES (100 * 1024)
#define KDEF(name, call)                                                   \
  __global__ void __launch_bounds__(256) name(Params p, int layer, int ntok) { \
    __shared__ __attribute__((aligned(16))) unsigned char smem[SMEM_BYTES]; \
    const int bid = blockIdx.x, nblk = gridDim.x;                          \
    (void)layer; (void)ntok; (void)smem; (void)bid; (void)nblk;            \
    call;                                                                  \
  }
KDEF(k_mod, phase_mod(p, bid, nblk, smem))
KDEF(k_wprep, phase_wprep(p, bid, nblk, smem))
KDEF(k_norm1_first, phase_normmod(p, p.x, p.ctx, p.norm1_g, p.modv, 0, 1024, TT, 1, bid, nblk))
KDEF(k_norm1, phase_normmod(p, p.xres, p.xres + (size_t)TL * 1024, p.norm1_g + layer * 1024, p.modv + (size_t)layer * 5 * NMOD, 0, 1024, TT, 0, bid, nblk))
KDEF(k_norm2, phase_normmod(p, p.xres, p.xres + (size_t)TL * 1024, p.norm2_g + layer * 1024, p.modv + (size_t)layer * 5 * NMOD, 3072, 4096, ntok, 0, bid, nblk))
KDEF(k_gemm_in, phase_gemm_in(p, layer, bid, nblk, smem))
KDEF(k_sgu, phase_sgu(p, layer, ntok / 128, bid, nblk, smem))
KDEF(k_s5a, phase_s5a(p, layer, bid, nblk, smem))
KDEF(k_glaa, phase_glaa(p, layer, bid, nblk, smem))
KDEF(k_scan, phase_scan(p, layer, bid, nblk))
KDEF(k_s5c, phase_s5c(p, layer, ntok / 64, bid, nblk, smem))
KDEF(k_glac, phase_glac(p, layer, ntok / 64, bid, nblk, smem))
KDEF(k_gemm_glu, phase_gemm_glu(p, layer, ntok, bid, nblk, smem))
KDEF(k_gemm_out, phase_gemm_out(p, layer, ntok, bid, nblk, smem))
KDEF(k_gemm_q, phase_gemm_q(p, layer, ntok, bid, nblk, smem))
KDEF(k_gemm_scores, phase_gemm_scores(p, layer, ntok, bid, nblk, smem))
KDEF(k_topk, phase_topk(p, ntok, bid, nblk))
KDEF(k_gather, phase_gather(p, layer, ntok, bid, nblk))
KDEF(k_final, phase_final(p, bid, nblk))

static inline size_t align_up(size_t v, size_t a) { return (v + a - 1) / a * a; }

extern "C" void kernel_launch(void* const* d_in, const int* in_sizes, int n_in, void* d_out, int out_size, void* d_ws, size_t ws_size,
                              hipStream_t stream) {
  Params p{};
  const float* const* in = (const float* const*)d_in;
  p.x = in[0]; p.c = in[1]; p.ctx = in[2]; p.c_ctx = in[3]; p.w_mod = in[4]; p.b_mod = in[5]; p.norm1_g = in[6]; p.norm2_g = in[7];
  p.w_in = in[8]; p.w_out = in[9]; p.sgu_w = in[10]; p.sgu_b = in[11]; p.lam_re = in[12]; p.lam_im = in[13]; p.b_re = in[14]; p.b_im = in[15];
  p.c_re = in[16]; p.c_im = in[17]; p.log_step = in[18]; p.s5_d = in[19]; p.w_glu = in[20]; p.gla_wg = in[21]; p.gla_bg = in[22]; p.gla_ng = in[23];
  p.w_query = in[24]; p.sub_keys = in[25]; p.exp_u = in[26]; p.exp_v = in[27]; p.final_g = in[28];
  p.out = (float*)d_out;
  unsigned char* w = (unsigned char*)d_ws;
  size_t off = 0;
  auto take = [&](size_t bytes) { void* r = w + off; off = align_up(off + bytes, 256); return r; };
  p.bar = (unsigned*)take(16384);
  p.xres = (float*)take((size_t)TT * 1024 * 4);
  p.modv = (float*)take((size_t)2 * 5 * NMOD * 4);
  p.abuf = (bf16_t*)take((size_t)TT * 1024 * 2);
  p.cols = (bf16_t*)take((size_t)TT * INW * 2);
  p.mix = (bf16_t*)take((size_t)TT * 1024 * 2);
  p.yg = (bf16_t*)take((size_t)TT * 256 * 2);
  p.wt_in = (bf16_t*)take((size_t)2 * INWP * 1024 * 2);
  p.wt_out = (bf16_t*)take((size_t)2 * 1024 * 1024 * 2);
  p.wt_q = (bf16_t*)take((size_t)2 * 2048 * 1024 * 2);
  p.wt_glu = (bf16_t*)take((size_t)2 * 512 * 256 * 2);
  p.keysb = (bf16_t*)take((size_t)2 * 2 * 8 * 128 * 128 * 2);
  p.s5a = (float*)take((size_t)4096 * 2 * 4);
  p.s5a64 = (float*)take((size_t)4096 * 2 * 4);
  p.s5bb = (float*)take((size_t)4096 * 32 * 4);
  p.s5S = (float*)take((size_t)2 * NSC * 16 * 64 * 2 * 4);
  p.s5H = (float*)take((size_t)2 * NSC * 16 * 64 * 2 * 4);
  p.gkv = (float*)take((size_t)2 * NSC * 8 * 2048 * 4);
  p.gSin = (float*)take((size_t)2 * NSC * 8 * 2048 * 4);
  p.gdec = (float*)take((size_t)2 * NSC * 8 * 32 * 4);
  p.scores = (float*)take((size_t)TT * 2048 * 4);
  p.pidx = (int*)take((size_t)TT * 128 * 4);
  p.pgate = (float*)take((size_t)TT * 128 * 4);
  if (off > ws_size) { fprintf(stderr, "workspace too small: need %zu have %zu\n", off, ws_size); return; }

  const dim3 blk(256);
  const int G = 1024;
  k_mod<<<192, blk, 0, stream>>>(p, 0, 0);
  k_wprep<<<G, blk, 0, stream>>>(p, 0, 0);
  k_norm1_first<<<G, blk, 0, stream>>>(p, 0, 0);
  for (int l = 0; l < 2; ++l) {
    const int ntok = l == 0 ? TT : TL;
    if (l > 0) k_norm1<<<G, blk, 0, stream>>>(p, l, TT);
    k_gemm_in<<<G, blk, 0, stream>>>(p, l, TT);
    k_sgu<<<G, blk, 0, stream>>>(p, l, ntok);
    k_s5a<<<G, blk, 0, stream>>>(p, l, TT);
    k_glaa<<<G, blk, 0, stream>>>(p, l, TT);
    k_scan<<<544, blk, 0, stream>>>(p, l, TT);
    k_s5c<<<G, blk, 0, stream>>>(p, l, ntok);
    k_glac<<<G, blk, 0, stream>>>(p, l, ntok);
    k_gemm_glu<<<G, blk, 0, stream>>>(p, l, ntok);
    k_gemm_out<<<G, blk, 0, stream>>>(p, l, ntok);
    k_norm2<<<G, blk, 0, stream>>>(p, l, ntok);
    k_gemm_q<<<G, blk, 0, stream>>>(p, l, ntok);
    k_gemm_scores<<<G, blk, 0, stream>>>(p, l, ntok);
    k_topk<<<G, blk, 0, stream>>>(p, l, ntok);
    k_gather<<<G, blk, 0, stream>>>(p, l, ntok);
  }
  k_final<<<G, blk, 0, stream>>>(p, 0, 0);
}
```

```cpp
#include <hip/hip_runtime.h>
#include <cstdio>
#include <cstdint>
#include <cmath>

typedef unsigned short bf16_t;
typedef short bf16x8 __attribute__((ext_vector_type(8)));
typedef float f32x4 __attribute__((ext_vector_type(4)));

#define DM 1024
#define NBATCH 4
#define SEQ 4096
#define CTXL 256
#define TL (NBATCH * SEQ)
#define TC (NBATCH * CTXL)
#define TT (TL + TC)
#define INW 2336
#define INWP 2560
#define NMOD 6144
#define NSC 272
#define EPSV 1e-6f
#define NT 512
#define NW 8
#ifndef REP_GATHER
#define REP_GATHER 1
#endif
#ifndef REP_ROUTE
#define REP_ROUTE 1
#endif
#ifndef REP_GEMM
#define REP_GEMM 1
#endif
#ifndef REP_MIX
#define REP_MIX 1
#endif
#ifndef REP_PRO
#define REP_PRO 1
#endif
#ifndef REP_SGU
#define REP_SGU 1
#endif
#ifndef REP_S5
#define REP_S5 1
#endif
#ifndef REP_GLA
#define REP_GLA 1
#endif

#define C_SGU_U 0
#define C_SGU_V 256
#define C_S5 512
#define C_GQ 768
#define C_GK 1024
#define C_GV 1280
#define C_GG 1792
#define C_ZF 2304

struct Params {
  const float *x, *c, *ctx, *c_ctx, *w_mod, *b_mod, *norm1_g, *norm2_g, *w_in, *w_out, *sgu_w, *sgu_b;
  const float *lam_re, *lam_im, *b_re, *b_im, *c_re, *c_im, *log_step, *s5_d, *w_glu, *gla_wg, *gla_bg, *gla_ng;
  const float *w_query, *sub_keys, *exp_u, *exp_v, *final_g;
  float* out;
  unsigned* bar;
  float* xres;
  float* modv;
  bf16_t* abuf;
  bf16_t* cols;
  bf16_t* mix;
  bf16_t* yg;
  bf16_t *wt_in, *wt_out, *wt_q, *wt_glu, *keysb, *sgu_wb;
  float *s5a, *s5a64, *s5bb;
  bf16_t *s5K, *s5M1, *s5N2;
  float *s5S, *s5H;
  float *gkv, *gdec;
  unsigned char *eu8, *ev8;
  float *su, *sv;
  float* glb;
  float *wbuf, *ssbuf;
  int* pidx;
  float* pgate;
};

__device__ __forceinline__ bf16_t f2bf(float f) {
  unsigned u = __float_as_uint(f);
  u += 0x7fffu + ((u >> 16) & 1u);
  return (bf16_t)(u >> 16);
}
__device__ __forceinline__ float bf2f(bf16_t h) { return __uint_as_float(((unsigned)h) << 16); }
__device__ __forceinline__ bf16x8 pack_bf16x8(const float* v) {
  bf16x8 r;
#pragma unroll
  for (int c = 0; c < 8; ++c) r[c] = (short)f2bf(v[c]);
  return r;
}

__device__ __forceinline__ float bflo(unsigned u) { return __uint_as_float(u << 16); }
__device__ __forceinline__ float bfhi(unsigned u) { return __uint_as_float(u & 0xffff0000u); }
__device__ __forceinline__ float gelu_f(float x) {
  const float y = 0.7978845608028654f * (x + 0.044715f * x * x * x);
  const float e = __expf(2.f * y);
  const float th = 1.f - 2.f / (1.f + e);
  return 0.5f * x * (1.f + th);
}
__device__ __forceinline__ float sigmoid_f(float x) { return 1.f / (1.f + __expf(-x)); }
__device__ __forceinline__ float silu_f(float x) { return x * sigmoid_f(x); }
__device__ __forceinline__ float logsigmoid_f(float x) { return fminf(x, 0.f) - log1pf(__expf(-fabsf(x))); }
__device__ __forceinline__ float wave_sum(float v) {
#pragma unroll
  for (int o = 32; o > 0; o >>= 1) v += __shfl_xor(v, o);
  return v;
}
__device__ __forceinline__ int opaque_tid() { int t = threadIdx.x; asm volatile("" : "+v"(t)); return t; }
__device__ __forceinline__ int tok_batch(int t) { return t < TL ? (t >> 12) : 4; }
__device__ __forceinline__ int s5_tok(int sc, int i) { return sc < 256 ? ((sc >> 6) * SEQ + (sc & 63) * 64 + i) : (TL + (sc - 256) * 64 + i); }
__device__ __forceinline__ int gla_tok(int sc, int i) { return sc < 256 ? ((sc >> 6) * SEQ + i * 64 + (sc & 63)) : (TL + (sc - 256) * 64 + i); }


#define XB_TMO      128
#define XB_XCNT(j)  (256  + 64 * (j))
#define XB_XSUB(j)  (1280 + 64 * (j))
#define XB_XGEN(j)  (2304 + 64 * (j))
#define XB_TOP      3328
#define XB_TOPGEN   3392
#define XCD_BAR_WORDS 3456
#define XB_SPIN_CAP (1u << 22)
#define LAS __attribute__((address_space(3)))
__device__ __forceinline__ unsigned xb_ld(unsigned* p)              { return __hip_atomic_load(p, __ATOMIC_RELAXED, __HIP_MEMORY_SCOPE_AGENT); }
__device__ __forceinline__ unsigned xb_add(unsigned* p, unsigned v) { return __hip_atomic_fetch_add(p, v, __ATOMIC_RELAXED, __HIP_MEMORY_SCOPE_AGENT); }
__device__ __forceinline__ unsigned xb_xcc_id() { return (unsigned)__builtin_amdgcn_s_getreg((3 << 11) | 20) & 0xFu; }
#define XB_SPIN(cond, bar) do { unsigned _sp = 0; while (cond) { __builtin_amdgcn_s_sleep(1); \
    if ((++_sp & 255u) == 0u) { if (xb_ld(&(bar)[XB_TMO])) break; if (_sp > XB_SPIN_CAP) { atomicAdd(&(bar)[XB_TMO], 1u); break; } } } } while (0)
struct XcdBarrier { unsigned* bar; unsigned x; volatile LAS unsigned* st; };
__device__ __forceinline__ XcdBarrier xcd_barrier_post(unsigned* bar, volatile LAS unsigned* st) {
  XcdBarrier b; b.bar = bar; b.x = xb_xcc_id(); b.st = st;
  if (threadIdx.x == 0) st[2] = xb_add(&bar[XB_XCNT(b.x)], 1u);
  return b;
}
__device__ __forceinline__ void xcd_barrier_complete(unsigned* bar, unsigned x, unsigned& nloc, unsigned& nx) {
  const unsigned G = gridDim.x * gridDim.y * gridDim.z;
  unsigned sum, cnt, mine, sp = 0u;
  for (;;) {
    sum = 0u; cnt = 0u; mine = 0u;
#pragma unroll
    for (unsigned j = 0; j < 16; ++j) { const unsigned c = xb_ld(&bar[XB_XCNT(j)]); sum += c; cnt += (c > 0u) ? 1u : 0u; mine = (j == x) ? c : mine; }
    if (sum == G) break;
    __builtin_amdgcn_s_sleep(1);
    if ((++sp & 255u) == 0u) { if (xb_ld(&bar[XB_TMO])) break; if (sp > XB_SPIN_CAP) { atomicAdd(&bar[XB_TMO], 1u); break; } }
  }
  nloc = mine > 0u ? mine : 1u; nx = cnt > 0u ? cnt : 1u;
}
__device__ __forceinline__ void xcd_barrier(const XcdBarrier& b) {
  asm volatile("s_waitcnt vmcnt(0)" ::: "memory");
  __syncthreads();
  if (threadIdx.x == 0) {
    unsigned* bar = b.bar;
    __builtin_amdgcn_s_waitcnt(0);
    unsigned nloc = b.st[0], nx = b.st[1];
    if (nloc == 0u) { xcd_barrier_complete(bar, b.x, nloc, nx); b.st[0] = nloc; b.st[1] = nx; }
    const unsigned old = xb_add(&bar[XB_XSUB(b.x)], 1u);
    const unsigned gen = old / nloc;
    if (old + 1u == (gen + 1u) * nloc) {
      __builtin_amdgcn_fence(__ATOMIC_RELEASE, "agent");
      asm volatile("s_waitcnt vmcnt(0)" ::: "memory");
      const unsigned og = xb_add(&bar[XB_TOP], 1u);
      const unsigned tg = og / nx;
      if (og + 1u == (tg + 1u) * nx) xb_add(&bar[XB_TOPGEN], 1u);
      else XB_SPIN(xb_ld(&bar[XB_TOPGEN]) == tg, bar);
      __builtin_amdgcn_fence(__ATOMIC_ACQUIRE, "agent");
      xb_add(&bar[XB_XGEN(b.x)], 1u);
      asm volatile("s_waitcnt vmcnt(0)" ::: "memory");
    } else {
      XB_SPIN(xb_ld(&bar[XB_XGEN(b.x)]) == gen, bar);
      __builtin_amdgcn_fence(__ATOMIC_ACQUIRE, "agent");
      asm volatile("s_waitcnt vmcnt(0)" ::: "memory");
    }
  }
  __syncthreads();
}

__device__ __forceinline__ void phase_mod(const Params& p, int bid, int nblk, unsigned char* smem) {
  float* sil = (float*)smem;
  float* red = sil + 5 * 1024;
  const int tid = opaque_tid();
  for (int i = tid; i < 5 * 1024; i += NT) {
    const int r = i >> 10, k = i & 1023;
    const float v = r < 4 ? p.c[r * 1024 + k] : p.c_ctx[k];
    sil[i] = silu_f(v);
  }
  __syncthreads();
  for (int item = bid; item < 192; item += nblk) {
    const int l = item / 96, j0 = (item % 96) * 64;
    const int cc = tid & 63, kg = tid >> 6;
    float acc[5] = {0.f, 0.f, 0.f, 0.f, 0.f};
    const float* w = p.w_mod + (size_t)l * 1024 * NMOD + j0 + cc;
#pragma unroll 32
    for (int k = kg * 128; k < kg * 128 + 128; ++k) {
      const float wv = w[(size_t)k * NMOD];
#pragma unroll
      for (int r = 0; r < 5; ++r) acc[r] += sil[r * 1024 + k] * wv;
    }
#pragma unroll
    for (int r = 0; r < 5; ++r) red[(kg * 5 + r) * 64 + cc] = acc[r];
    __syncthreads();
    if (tid < 320) {
      const int r = tid >> 6;
      float s = 0.f;
#pragma unroll
      for (int g = 0; g < 8; ++g) s += red[(g * 5 + r) * 64 + cc];
      p.modv[((size_t)l * 5 + r) * NMOD + j0 + cc] = s + p.b_mod[l * NMOD + j0 + cc];
    }
    __syncthreads();
  }
}

__device__ __forceinline__ void transpose_tile(const float* src, int ldsrc, bf16_t* dst, int lddst, int k0, int r0, int nsrc, int glu, float* tile) {
  const int tid = opaque_tid();
  const int j = tid & 63;
  const int r = r0 + j;
  int scol;
  if (glu) {
    const int pn = r >> 8, bj = (r >> 7) & 1, i = r & 127;
    scol = bj * 256 + pn * 128 + i;
  } else {
    scol = r < nsrc ? r : -1;
  }
  float v[32];
#pragma unroll
  for (int it = 0; it < 32; ++it) {
    const int kk = (tid >> 6) + it * 8;
    v[it] = scol >= 0 ? src[(size_t)(k0 + kk) * ldsrc + scol] : 0.f;
  }
#pragma unroll
  for (int it = 0; it < 32; ++it) {
    const int kk = (tid >> 6) + it * 8;
    tile[(kk >> 6) * 4160 + (kk & 63) * 65 + j] = v[it];
  }
  __syncthreads();
  const int kq = tid & 63;
#pragma unroll
  for (int it = 0; it < 32; ++it) {
    const int jj = (tid >> 6) + (it & 7) * 8, sub = it >> 3;
    dst[(size_t)(r0 + jj) * lddst + k0 + sub * 64 + kq] = f2bf(tile[sub * 4160 + kq * 65 + jj]);
  }
  __syncthreads();
}

__device__ __forceinline__ void s5_tables(const Params& p, int id, int part, unsigned char* smem) {
  const int tid = opaque_tid();
  float2* Apow = (float2*)smem;
  float2* Bbs = Apow + 65 * 64;
  float2* Cs = Bbs + 64 * 16;
  __syncthreads();
  if (tid < 64) {
    const int pid = id * 64 + tid;
    double lre = (double)p.lam_re[pid];
    if (lre > -1e-4) lre = -1e-4;
    const double lim = (double)p.lam_im[pid];
    const double dt = exp((double)p.log_step[id]);
    const double mag = exp(lre * dt);
    const double are = mag * cos(lim * dt), aim = mag * sin(lim * dt);
    {
      double pr = 1.0, pi = 0.0;
      for (int n = 0; n <= 64; ++n) {
        Apow[n * 64 + tid] = make_float2((float)pr, (float)pi);
        const double nr = pr * are - pi * aim, ni = pr * aim + pi * are;
        pr = nr; pi = ni;
      }
    }
    const double den = lre * lre + lim * lim;
    const double fre = ((are - 1.0) * lre + aim * lim) / den;
    const double fim = (aim * lre - (are - 1.0) * lim) / den;
    for (int h = 0; h < 16; ++h) {
      const double br = (double)p.b_re[(size_t)pid * 16 + h], bi = (double)p.b_im[(size_t)pid * 16 + h];
      Bbs[tid * 16 + h] = make_float2((float)(fre * br - fim * bi), (float)(fre * bi + fim * br));
    }
  }
  for (int e = tid; e < 1024; e += NT) Cs[e] = make_float2(p.c_re[(size_t)id * 1024 + e], p.c_im[(size_t)id * 1024 + e]);
  __syncthreads();
  bf16_t* Kt = p.s5K + (size_t)id * 16384;
  for (int e = part * 2048 + tid; e < part * 2048 + 2048; e += NT) {
    const int d = e >> 8, hp = (e >> 4) & 15, h = e & 15;
    float acc = 0.f;
    for (int pp = 0; pp < 64; ++pp) {
      const float2 c = Cs[hp * 64 + pp], a = Apow[d * 64 + pp], b = Bbs[pp * 16 + h];
      const float cr = c.x * a.x - c.y * a.y, ci = c.x * a.y + c.y * a.x;
      acc += cr * b.x - ci * b.y;
    }
    Kt[e] = f2bf(acc);
  }
  bf16_t* M1 = p.s5M1 + (size_t)id * 131072;
  for (int e = part * 16384 + tid; e < part * 16384 + 16384; e += NT) {
    const int c = e >> 10, k = e & 1023, ri = c >> 6, pp = c & 63, tau = k >> 4, h = k & 15;
    const float2 a = Apow[(63 - tau) * 64 + pp], b = Bbs[pp * 16 + h];
    M1[e] = f2bf(ri ? (a.x * b.y + a.y * b.x) : (a.x * b.x - a.y * b.y));
  }
  bf16_t* N2 = p.s5N2 + (size_t)id * 131072;
  for (int e = part * 16384 + tid; e < part * 16384 + 16384; e += NT) {
    const int col = e >> 7, kk = e & 127, tau = col >> 4, hp = col & 15, ri = kk >> 6, pp = kk & 63;
    const float2 c = Cs[hp * 64 + pp], a = Apow[(tau + 1) * 64 + pp];
    N2[e] = f2bf(ri ? -(c.x * a.y + c.y * a.x) : (c.x * a.x - c.y * a.y));
  }
  __syncthreads();
}

__device__ __forceinline__ void convert_rows(const Params& p, int it, int tid) {
      const int lane = tid & 63;
      const int row0 = it * 16 + (tid >> 6) * 2;
      const int tab = row0 >> 15, r0 = row0 & 32767;
      const float* s = (tab ? p.exp_v : p.exp_u) + (size_t)r0 * 1024 + lane * 16;
      f32x4 v[2][4];
#pragma unroll
      for (int rr = 0; rr < 2; ++rr)
#pragma unroll
        for (int q = 0; q < 4; ++q) v[rr][q] = *(const f32x4*)(s + rr * 1024 + q * 4);
#pragma unroll
      for (int rr = 0; rr < 2; ++rr) {
        float m = 0.f;
#pragma unroll
        for (int q = 0; q < 4; ++q) m = fmaxf(m, fmaxf(fmaxf(fabsf(v[rr][q][0]), fabsf(v[rr][q][1])), fmaxf(fabsf(v[rr][q][2]), fabsf(v[rr][q][3]))));
#pragma unroll
        for (int o = 32; o > 0; o >>= 1) m = fmaxf(m, __shfl_xor(m, o));
        const float scale = m > 0.f ? m * (1.f / 400.f) : 1.f;
        const float inv = 1.f / scale;
        unsigned wv[4];
#pragma unroll
        for (int q = 0; q < 4; ++q) {
          unsigned w = 0;
          w = __builtin_amdgcn_cvt_pk_fp8_f32(v[rr][q][0] * inv, v[rr][q][1] * inv, w, false);
          w = __builtin_amdgcn_cvt_pk_fp8_f32(v[rr][q][2] * inv, v[rr][q][3] * inv, w, true);
          wv[q] = w;
        }
        *(uint4*)((tab ? p.ev8 : p.eu8) + (size_t)(r0 + rr) * 1024 + lane * 16) = make_uint4(wv[0], wv[1], wv[2], wv[3]);
        if (lane == 0) (tab ? p.sv : p.su)[r0 + rr] = scale;
      }
}

__device__ __forceinline__ void phase_wprep(const Params& p, int bid, int nblk, unsigned char* smem) {
  float* tile = (float*)smem;
  const int tid = opaque_tid();
  const int NT_L = 360;
  const int n_tr = 2 * NT_L;
  const int n_keys = 256 + 64;
  const int n_disc = 8;
  const int n_exp = 2048;
  const int n_s5t = 512;
  const int total = n_tr + n_keys + n_disc + n_exp + n_s5t;
  for (int item0 = bid; item0 < total; item0 += nblk) {
    const int item = item0 - n_s5t;
    if (item0 < n_s5t) {
      s5_tables(p, item0 >> 3, item0 & 7, smem);
    } else if (item < n_tr) {
      const int l = item / NT_L;
      int t = item % NT_L;
      if (t < 160) {
        transpose_tile(p.w_in + (size_t)l * 1024 * INW, INW, p.wt_in + (size_t)l * INWP * 1024, 1024, (t % 4) * 256, (t / 4) * 64, INW, 0, tile);
      } else if (t < 224) {
        t -= 160;
        transpose_tile(p.w_out + (size_t)l * 1024 * 1024, 1024, p.wt_out + (size_t)l * 1024 * 1024, 1024, (t % 4) * 256, (t / 4) * 64, 1024, 0, tile);
      } else if (t < 352) {
        t -= 224;
        transpose_tile(p.w_query + (size_t)l * 1024 * 2048, 2048, p.wt_q + (size_t)l * 2048 * 1024, 1024, (t % 4) * 256, (t / 4) * 64, 2048, 0, tile);
      } else {
        t -= 352;
        transpose_tile(p.w_glu + (size_t)l * 256 * 512, 512, p.wt_glu + (size_t)l * 512 * 256, 256, 0, t * 64, 512, 1, tile);
      }
    } else if (item < n_tr + n_keys) {
      const int ki = item - n_tr;
      if (ki < 256) {
        const int base = ki * 2048;
        for (int i = tid; i < 2048; i += NT) p.keysb[base + i] = f2bf(p.sub_keys[base + i]);
      } else {
        const int base = (ki - 256) * 2048;
        for (int i = tid; i < 2048; i += NT) p.sgu_wb[base + i] = f2bf(p.sgu_w[base + i]);
      }
    } else if (item >= n_tr + n_keys + n_disc) {
      const int j = item - (n_tr + n_keys + n_disc);
      convert_rows(p, (j >> 10) * 2048 + (j & 1023), tid);
    } else {
      const int id = (item - n_tr - n_keys) * NT + tid;
      const int g = (id >> 6) & 15;
      const int ldg = id >> 6;
      double lre = (double)p.lam_re[id];
      if (lre > -1e-4) lre = -1e-4;
      const double lim = (double)p.lam_im[id];
      const double dt = exp((double)p.log_step[ldg]);
      const double mag = exp(lre * dt);
      const double are = mag * cos(lim * dt), aim = mag * sin(lim * dt);
      const double den = lre * lre + lim * lim;
      const double fre = ((are - 1.0) * lre + aim * lim) / den;
      const double fim = (aim * lre - (are - 1.0) * lim) / den;
      p.s5a[id * 2 + 0] = (float)are;
      p.s5a[id * 2 + 1] = (float)aim;
      double pr = are, pi = aim;
      for (int s = 0; s < 6; ++s) { const double nr = pr * pr - pi * pi, ni = 2.0 * pr * pi; pr = nr; pi = ni; }
      p.s5a64[id * 2 + 0] = (float)pr;
      p.s5a64[id * 2 + 1] = (float)pi;
      for (int h = 0; h < 16; ++h) {
        const double br = (double)p.b_re[(size_t)id * 16 + h], bi = (double)p.b_im[(size_t)id * 16 + h];
        p.s5bb[(size_t)id * 32 + h] = (float)(fre * br - fim * bi);
        p.s5bb[(size_t)id * 32 + 16 + h] = (float)(fre * bi + fim * br);
      }
      (void)g;
    }
  }
}

__device__ __forceinline__ void phase_normmod(const Params& p, const float* src_l, const float* src_c, const float* gain, const float* modl, int shift_off, int scale_off,
                              int ntok, int copy, int bid, int nblk) {
  const int tid = opaque_tid(); const int lane = tid & 63, wid = tid >> 6;
  for (int t = bid * NW + wid; t < ntok; t += nblk * NW) {
    const float* row = t < TL ? src_l + (size_t)t * 1024 : src_c + (size_t)(t - TL) * 1024;
    const float* md = modl + (size_t)tok_batch(t) * NMOD;
    f32x4 v[4];
    float ss = 0.f;
#pragma unroll
    for (int j = 0; j < 4; ++j) {
      v[j] = *(const f32x4*)(row + j * 256 + lane * 4);
      ss += v[j][0] * v[j][0] + v[j][1] * v[j][1] + v[j][2] * v[j][2] + v[j][3] * v[j][3];
    }
    ss = wave_sum(ss);
    const float rstd = rsqrtf(ss * (1.f / 1024.f) + EPSV);
#pragma unroll
    for (int j = 0; j < 4; ++j) {
      const int c0 = j * 256 + lane * 4;
      const f32x4 g = *(const f32x4*)(gain + c0);
      const f32x4 sh = *(const f32x4*)(md + shift_off + c0);
      const f32x4 sc = *(const f32x4*)(md + scale_off + c0);
      ushort4 o;
      o.x = f2bf(v[j][0] * rstd * g[0] * (1.f + sc[0]) + sh[0]);
      o.y = f2bf(v[j][1] * rstd * g[1] * (1.f + sc[1]) + sh[1]);
      o.z = f2bf(v[j][2] * rstd * g[2] * (1.f + sc[2]) + sh[2]);
      o.w = f2bf(v[j][3] * rstd * g[3] * (1.f + sc[3]) + sh[3]);
      *(ushort4*)(p.abuf + (size_t)t * 1024 + c0) = o;
      if (copy) *(f32x4*)(p.xres + (size_t)t * 1024 + c0) = v[j];
    }
  }
}

namespace pg8 {
#define PG8_LAS __attribute__((address_space(3)))
typedef unsigned u32x4 __attribute__((ext_vector_type(4)));
constexpr int BM = 256, BK = 64, HALF = 128, HTB = HALF * BK * 2, STAGE_BYTES = 8 * HTB, NXCD = 8, WGM = 8;
__device__ __forceinline__ int lds_byte(int r, int c) { const int st = (r >> 4) * 2 + (c >> 5), rr = r & 15, cc = c & 31, ob = rr * 64 + cc * 2; return st * 1024 + (ob ^ (((ob >> 9) & 1) << 5)); }
__device__ __forceinline__ void stage_rc(int b, int& R, int& C) { const int st = b / 1024, sb = b % 1024, swz = sb ^ (((sb >> 9) & 1) << 5); R = (st >> 1) * 16 + swz / 64; C = (st & 1) * 32 + (swz % 64) / 2; }
__device__ __forceinline__ int perm32(int rho) { const int n = rho >> 4, i = rho & 15; return 8 * (i >> 2) + 4 * n + (i & 3); }
struct Unit { int pm, pn; };
struct Gemm { const bf16_t* A; const bf16_t* Bt; int M, N, K; };
struct StaticOrder {
  int nM, nN, nwg, G, c;
  __device__ void init(int M, int N, int G_, int c_) { nM = M / BM; nN = N / BM; nwg = nM * nN; G = G_; c = c_; }
  __device__ bool next(int i, Unit& u) const {
    const long L = (long)i * G + c; if (L >= nwg) return false;
    int wgid = (int)L; { const int q = nwg / NXCD, r = nwg % NXCD, xcd = wgid % NXCD, off = wgid / NXCD; wgid = (xcd < r ? xcd * (q + 1) : r * (q + 1) + (xcd - r) * q) + off; }
    const int nig = WGM * nN, gid = wgid / nig, fm = gid * WGM, gsz = (nM - fm) < WGM ? (nM - fm) : WGM;
    u.pm = fm + ((wgid % nig) % gsz); u.pn = (wgid % nig) / gsz; return true;
  }
};
__device__ __forceinline__ unsigned cvt_pk_bf16(float lo, float hi) { unsigned r; asm volatile("v_cvt_pk_bf16_f32 %0, %1, %2" : "=v"(r) : "v"(lo), "v"(hi)); return r; }

template <class Epi>
__device__ __forceinline__ void gemm_phase(PG8_LAS unsigned char* lds, const Gemm g, const StaticOrder& S, const Epi& E) {
  const int tid = opaque_tid(), wid = __builtin_amdgcn_readfirstlane(tid >> 6), lane = tid & 63, wr = wid >> 2, wc = wid & 3, fr = lane & 15, fq = lane >> 4;
  const int K = g.K, nt = K / BK;
  unsigned voffA[2], voffB[2];
#pragma unroll
  for (int i = 0; i < 2; ++i) { int R, C; stage_rc(tid * 16 + i * 8192, R, C); const int Rb = Epi::PERM ? ((R & ~31) + perm32(R & 31)) : R;
    voffA[i] = (unsigned)(R * K + C) * 2u; voffB[i] = (unsigned)(Rb * K + C) * 2u; }
  const size_t kstep = (size_t)(BK * 2);
  const size_t hstep = (size_t)HALF * K * 2;
  const size_t tstep = 2 * hstep;
  const unsigned ldsw = (unsigned)wid * 1024u;
  const int aoff = lds_byte(wr * 64 + fr, fq * 8), boff = lds_byte(wc * 32 + fr, fq * 8);
#define PG8_SA(b, h) (((b) * 2 + (h)) * HTB)
#define PG8_SB(b, h) ((4 + (b) * 2 + (h)) * HTB)
#define PG8_STAGE(bufoff, gbase, voff) do { _Pragma("unroll") for (int _i = 0; _i < 2; ++_i) \
    __builtin_amdgcn_global_load_lds((const unsigned*)((const char*)(gbase) + (voff)[_i]), (PG8_LAS unsigned*)(lds + (bufoff) + ldsw + _i * 8192), 16, 0, 0); } while (0)
#define PG8_LDA(dst, b, h) do { _Pragma("unroll") for (int m = 0; m < 4; ++m) _Pragma("unroll") for (int k = 0; k < 2; ++k) dst[m][k] = *(const PG8_LAS bf16x8*)(lds + PG8_SA(b, h) + aoff + m * 2048 + k * 1024); } while (0)
#define PG8_LDB(dst, b, h) do { _Pragma("unroll") for (int n = 0; n < 2; ++n) _Pragma("unroll") for (int k = 0; k < 2; ++k) dst[n][k] = *(const PG8_LAS bf16x8*)(lds + PG8_SB(b, h) + boff + n * 2048 + k * 1024); } while (0)
#define PG8_MMA(ai, bj, At, Bt) do { __builtin_amdgcn_s_setprio(1); _Pragma("unroll") for (int m = 0; m < 4; ++m) _Pragma("unroll") for (int n = 0; n < 2; ++n) _Pragma("unroll") for (int k = 0; k < 2; ++k) \
    acc[ai][bj][m][n] = __builtin_amdgcn_mfma_f32_16x16x32_bf16(Bt[n][k], At[m][k], acc[ai][bj][m][n], 0, 0, 0); __builtin_amdgcn_s_setprio(0); } while (0)
#define PG8_WAIT_V(n) asm volatile("s_waitcnt vmcnt(" #n ")" ::: "memory")
#define PG8_WAIT_L(n) asm volatile("s_waitcnt lgkmcnt(" #n ")" ::: "memory")
#define PG8_BAR __builtin_amdgcn_s_barrier()
#define PG8_SCHED __builtin_amdgcn_sched_barrier(0)
  Unit cur, nxt; int ui = 0;
  if (!S.next(0, cur)) return;
  f32x4 acc[2][2][4][2];
#pragma unroll
  for (int a = 0; a < 2; ++a)
#pragma unroll
    for (int b = 0; b < 2; ++b)
#pragma unroll
      for (int m = 0; m < 4; ++m)
#pragma unroll
        for (int n = 0; n < 2; ++n) acc[a][b][m][n] = (f32x4){0.f, 0.f, 0.f, 0.f};
  bf16x8 At[4][2], B0[2][2], B1[2][2];
  const char* cA = (const char*)g.A + (size_t)cur.pm * tstep; const char* cB = (const char*)g.Bt + (size_t)cur.pn * tstep;
  PG8_STAGE(PG8_SB(0, 0), cB, voffB); PG8_STAGE(PG8_SA(0, 0), cA, voffA); PG8_STAGE(PG8_SB(0, 1), cB + hstep, voffB); PG8_STAGE(PG8_SA(0, 1), cA + hstep, voffA);
  if (wr == 1) PG8_BAR;
  PG8_WAIT_V(4); PG8_BAR;
  PG8_STAGE(PG8_SB(1, 0), cB + kstep, voffB); PG8_STAGE(PG8_SA(1, 0), cA + kstep, voffA); PG8_STAGE(PG8_SB(1, 1), cB + hstep + kstep, voffB);
  PG8_WAIT_V(6); PG8_BAR;
  for (;;) {
    const bool has_next = S.next(ui + 1, nxt);
    const char* nA = has_next ? (const char*)g.A + (size_t)nxt.pm * tstep : cA; const char* nB = has_next ? (const char*)g.Bt + (size_t)nxt.pn * tstep : cB;
#pragma unroll 1
    for (int t = 0; t < nt; t += 2) {
      const bool last = (t == nt - 2);
      const char* a1 = cA + (size_t)(t + 1) * kstep;
      const char* a2 = last ? nA : cA + (size_t)(t + 2) * kstep; const char* b2 = last ? nB : cB + (size_t)(t + 2) * kstep;
      const char* a3 = a2 + kstep; const char* b3 = b2 + kstep;
      PG8_LDB(B0, 0, 0); PG8_SCHED; PG8_LDA(At, 0, 0); PG8_STAGE(PG8_SA(1, 1), a1 + hstep, voffA);
      PG8_WAIT_L(8); PG8_BAR; PG8_WAIT_L(0); PG8_MMA(0, 0, At, B0); PG8_BAR; PG8_SCHED;
      PG8_LDB(B1, 0, 1); PG8_STAGE(PG8_SB(0, 0), b2, voffB);
      PG8_BAR; PG8_WAIT_L(0); PG8_MMA(0, 1, At, B1); PG8_BAR;
      PG8_LDA(At, 0, 1); PG8_STAGE(PG8_SA(0, 0), a2, voffA);
      PG8_BAR; PG8_WAIT_L(0); PG8_MMA(1, 0, At, B0); PG8_BAR; PG8_SCHED;
      PG8_STAGE(PG8_SB(0, 1), b2 + hstep, voffB);
      PG8_WAIT_V(6); PG8_BAR; PG8_MMA(1, 1, At, B1); PG8_BAR;
      PG8_LDB(B0, 1, 0); PG8_SCHED; PG8_LDA(At, 1, 0); PG8_STAGE(PG8_SA(0, 1), a2 + hstep, voffA);
      PG8_WAIT_L(8); PG8_BAR; PG8_WAIT_L(0); PG8_MMA(0, 0, At, B0); PG8_BAR; PG8_SCHED;
      PG8_LDB(B1, 1, 1); PG8_STAGE(PG8_SB(1, 0), b3, voffB);
      PG8_BAR; PG8_WAIT_L(0); PG8_MMA(0, 1, At, B1); PG8_BAR;
      PG8_LDA(At, 1, 1); PG8_STAGE(PG8_SA(1, 0), a3, voffA);
      PG8_BAR; PG8_WAIT_L(0); PG8_MMA(1, 0, At, B0); PG8_BAR; PG8_SCHED;
      PG8_STAGE(PG8_SB(1, 1), b3 + hstep, voffB);
      PG8_WAIT_V(6); PG8_BAR; PG8_MMA(1, 1, At, B1); PG8_BAR;
    }
    E(acc, cur, wr, wc, fr, fq);
    if (!has_next) break;
#pragma unroll
    for (int a = 0; a < 2; ++a)
#pragma unroll
      for (int b = 0; b < 2; ++b)
#pragma unroll
        for (int m = 0; m < 4; ++m)
#pragma unroll
          for (int n = 0; n < 2; ++n) acc[a][b][m][n] = (f32x4){0.f, 0.f, 0.f, 0.f};
    cur = nxt; cA = nA; cB = nB; ++ui;
  }
  PG8_WAIT_V(0);
  if (wr == 0) PG8_BAR;
  PG8_BAR;
#undef PG8_SA
#undef PG8_SB
#undef PG8_STAGE
#undef PG8_LDA
#undef PG8_LDB
#undef PG8_MMA
#undef PG8_WAIT_V
#undef PG8_WAIT_L
#undef PG8_BAR
#undef PG8_SCHED
}

struct EpiBf16 {
  static constexpr bool PERM = true;
  bf16_t* O; int ldc; int ncols;
  __device__ __forceinline__ void operator()(const f32x4 (&acc)[2][2][4][2], const Unit& u, int wr, int wc, int fr, int fq) const {
    const int row0 = u.pm * BM + wr * 64 + fr, col0 = u.pn * BM + wc * 32 + 8 * fq;
#pragma unroll
    for (int ai = 0; ai < 2; ++ai)
#pragma unroll
      for (int m = 0; m < 4; ++m) {
        bf16_t* rowp = O + (size_t)(row0 + ai * HALF + m * 16) * ldc + col0;
#pragma unroll
        for (int bj = 0; bj < 2; ++bj) {
          if (col0 + bj * HALF < ncols) {
            const f32x4 v0 = acc[ai][bj][m][0], v1 = acc[ai][bj][m][1];
            u32x4 w; w.x = cvt_pk_bf16(v0[0], v0[1]); w.y = cvt_pk_bf16(v0[2], v0[3]); w.z = cvt_pk_bf16(v1[0], v1[1]); w.w = cvt_pk_bf16(v1[2], v1[3]);
            *(u32x4*)(rowp + bj * HALF) = w;
          }
        }
      }
  }
};
struct EpiResid {
  static constexpr bool PERM = false;
  float* xres; const float* modl; int gate_off;
  __device__ __forceinline__ void operator()(const f32x4 (&acc)[2][2][4][2], const Unit& u, int wr, int wc, int fr, int fq) const {
    const int row0 = u.pm * BM + wr * 64 + fr, col0 = u.pn * BM + wc * 32 + 4 * fq;
#pragma unroll
    for (int ai = 0; ai < 2; ++ai)
#pragma unroll
      for (int m = 0; m < 4; ++m) {
        const int row = row0 + ai * HALF + m * 16;
        float* rowp = xres + (size_t)row * 1024 + col0;
        const float* md = modl + (size_t)tok_batch(row) * NMOD + gate_off + col0;
#pragma unroll
        for (int bj = 0; bj < 2; ++bj)
#pragma unroll
          for (int n = 0; n < 2; ++n) {
            const f32x4 g = *(const f32x4*)(md + bj * HALF + n * 16);
            f32x4 x = *(const f32x4*)(rowp + bj * HALF + n * 16);
            x += g * acc[ai][bj][m][n];
            *(f32x4*)(rowp + bj * HALF + n * 16) = x;
          }
      }
  }
};
struct EpiGlu {
  static constexpr bool PERM = true;
  bf16_t* mix;
  __device__ __forceinline__ void operator()(const f32x4 (&acc)[2][2][4][2], const Unit& u, int wr, int wc, int fr, int fq) const {
    const int row0 = u.pm * BM + wr * 64 + fr, col0 = 256 + u.pn * HALF + wc * 32 + 8 * fq;
#pragma unroll
    for (int ai = 0; ai < 2; ++ai)
#pragma unroll
      for (int m = 0; m < 4; ++m) {
        float v[8];
#pragma unroll
        for (int n = 0; n < 2; ++n)
#pragma unroll
          for (int j = 0; j < 4; ++j) v[n * 4 + j] = acc[ai][0][m][n][j] * sigmoid_f(acc[ai][1][m][n][j]);
        u32x4 w; w.x = cvt_pk_bf16(v[0], v[1]); w.y = cvt_pk_bf16(v[2], v[3]); w.z = cvt_pk_bf16(v[4], v[5]); w.w = cvt_pk_bf16(v[6], v[7]);
        *(u32x4*)(mix + (size_t)(row0 + ai * HALF + m * 16) * 1024 + col0) = w;
        __builtin_amdgcn_sched_barrier(0);
      }
  }
};
}

#define VNT_STRIDE 136
__device__ __forceinline__ void phase_sgu(const Params& p, int layer, int nchunks, int bid, int nblk, unsigned char* smem) {
  bf16_t* vnT = (bf16_t*)smem;
  const int tid = opaque_tid(); const int lane = tid & 63, wid = tid >> 6;
  const int fr = lane & 15, fq = lane >> 4;
  for (int item = bid; item < nchunks * 4; item += nblk) {
    const int ch = item >> 2, h = item & 3;
    const int tok0 = ch * 128;
    {
      const int s = tid >> 2, q = tid & 3;
      const bf16_t* vrow = p.cols + (size_t)(tok0 + s) * INW + C_SGU_V + h * 64 + q * 16;
      const uint4 r0 = *(const uint4*)vrow, r1 = *(const uint4*)(vrow + 8);
      float gv[16];
      gv[0] = bflo(r0.x); gv[1] = bfhi(r0.x); gv[2] = bflo(r0.y); gv[3] = bfhi(r0.y); gv[4] = bflo(r0.z); gv[5] = bfhi(r0.z); gv[6] = bflo(r0.w); gv[7] = bfhi(r0.w);
      gv[8] = bflo(r1.x); gv[9] = bfhi(r1.x); gv[10] = bflo(r1.y); gv[11] = bfhi(r1.y); gv[12] = bflo(r1.z); gv[13] = bfhi(r1.z); gv[14] = bflo(r1.w); gv[15] = bfhi(r1.w);
      float ss = 0.f;
#pragma unroll
      for (int d = 0; d < 16; ++d) { gv[d] = gelu_f(gv[d]); ss += gv[d] * gv[d]; }
      ss += __shfl_xor(ss, 1);
      ss += __shfl_xor(ss, 2);
      const float rstd = rsqrtf(ss * (1.f / 64.f) + EPSV);
#pragma unroll
      for (int d = 0; d < 16; ++d) vnT[(q * 16 + d) * VNT_STRIDE + s] = f2bf(gv[d] * rstd);
    }
    __syncthreads();
    {
      const bf16_t* wrow = p.sgu_wb + (((size_t)layer * 4 + h) * 128 + wid * 16 + fr) * 128 + fq * 8;
      f32x4 acc[4];
#pragma unroll
      for (int n = 0; n < 4; ++n) acc[n] = (f32x4){0.f, 0.f, 0.f, 0.f};
#pragma unroll
      for (int ks = 0; ks < 4; ++ks) {
        const bf16x8 a = *(const bf16x8*)(wrow + ks * 32);
#pragma unroll
        for (int n = 0; n < 4; ++n) {
          const bf16x8 b = *(const bf16x8*)(vnT + (n * 16 + fr) * VNT_STRIDE + ks * 32 + fq * 8);
          acc[n] = __builtin_amdgcn_mfma_f32_16x16x32_bf16(a, b, acc[n], 0, 0, 0);
        }
      }
#pragma unroll
      for (int j = 0; j < 4; ++j) {
        const int t = wid * 16 + fq * 4 + j;
        const float bs = p.sgu_b[((size_t)layer * 4 + h) * 128 + t];
        const bf16_t* urow = p.cols + (size_t)(tok0 + t) * INW + C_SGU_U + h * 64;
        bf16_t* orow = p.mix + (size_t)(tok0 + t) * 1024 + h * 64;
#pragma unroll
        for (int n = 0; n < 4; ++n) orow[n * 16 + fr] = f2bf(gelu_f(bf2f(urow[n * 16 + fr])) * (acc[n][j] + bs));
      }
    }
    __syncthreads();
  }
}

__device__ __forceinline__ void phase_s5a(const Params& p, int layer, int bid, int nblk, unsigned char* smem) {
  const int tid = opaque_tid(); const int lane = tid & 63, wid = tid >> 6, fr = lane & 15, fq = lane >> 4;
  const int ntask = 2 * 16 * 17;
  for (int task = bid * NW + wid; task < ntask; task += nblk * NW) {
    const int dir = task / 272, rem = task % 272, g = rem / 17, mt = rem % 17;
    const bf16_t* tab = p.s5M1 + (size_t)((layer * 2 + dir) * 16 + g) * 131072 + (size_t)fr * 1024 + fq * 8;
    const int scr = mt * 16 + fr;
    const bf16_t* ub = p.cols + C_S5 + g * 16 + (fq & 1) * 8;
    f32x4 acc[8];
#pragma unroll
    for (int n = 0; n < 8; ++n) acc[n] = (f32x4){0.f, 0.f, 0.f, 0.f};
#pragma unroll 4
    for (int ks = 0; ks < 32; ++ks) {
      const int tau = 2 * ks + (fq >> 1);
      const int i = dir ? 63 - tau : tau;
      const bf16x8 a = *(const bf16x8*)(ub + (size_t)s5_tok(scr, i) * INW);
#pragma unroll
      for (int n = 0; n < 8; ++n) {
        const bf16x8 b = *(const bf16x8*)(tab + (size_t)n * 16 * 1024 + ks * 32);
        acc[n] = __builtin_amdgcn_mfma_f32_16x16x32_bf16(a, b, acc[n], 0, 0, 0);
      }
    }
#pragma unroll
    for (int n = 0; n < 8; ++n)
#pragma unroll
      for (int j = 0; j < 4; ++j) p.s5S[(((size_t)dir * NSC + mt * 16 + fq * 4 + j) * 16 + g) * 128 + n * 16 + fr] = acc[n][j];
  }
}

__device__ __forceinline__ int scan_sc(int s, int b, int dir) {
  return s < 4 ? 256 + b * 4 + (dir ? 3 - s : s) : b * 64 + (dir ? 63 - (s - 4) : (s - 4));
}
__device__ __forceinline__ void phase_scan(const Params& p, int layer, int bid, int nblk) {
  const int tid = opaque_tid();
  for (int item = bid; item < 16 + 256; item += nblk) {
    if (item < 16) {
      const int id = item * NT + tid;
      const int pp = id & 63, g = (id >> 6) & 15, b = (id >> 10) & 3, dir = id >> 12;
      const int pid = ((layer * 2 + dir) * 16 + g) * 64 + pp;
      const float ar = p.s5a64[pid * 2], ai = p.s5a64[pid * 2 + 1];
      float hr = 0.f, hi = 0.f;
      for (int s0 = 0; s0 < 68; s0 += 17) {
        float sr[17], si[17];
#pragma unroll
        for (int k = 0; k < 17; ++k) {
          const size_t o = (((size_t)dir * NSC + scan_sc(s0 + k, b, dir)) * 16 + g) * 128 + pp;
          sr[k] = p.s5S[o]; si[k] = p.s5S[o + 64];
        }
#pragma unroll
        for (int k = 0; k < 17; ++k) {
          const size_t o = (((size_t)dir * NSC + scan_sc(s0 + k, b, dir)) * 16 + g) * 128 + pp;
          p.s5H[o] = hr; p.s5H[o + 64] = hi;
          const float nr = ar * hr - ai * hi + sr[k];
          const float ni = ar * hi + ai * hr + si[k];
          hr = nr; hi = ni;
        }
      }
    } else {
      const int id = (item - 16) * NT + tid;
      const int e = id & 2047, h = (id >> 11) & 7, b = (id >> 14) & 3, dir = id >> 16;
      const int dk = e & 31;
      float S = 0.f;
      for (int s0 = 0; s0 < 68; s0 += 17) {
        float kv[17], dc[17];
#pragma unroll
        for (int k = 0; k < 17; ++k) {
          const size_t o = (((size_t)dir * NSC + scan_sc(s0 + k, b, dir)) * 8 + h);
          kv[k] = p.gkv[o * 2048 + e]; dc[k] = p.gdec[o * 32 + dk];
        }
#pragma unroll
        for (int k = 0; k < 17; ++k) {
          const size_t o = (((size_t)dir * NSC + scan_sc(s0 + k, b, dir)) * 8 + h);
          p.gkv[o * 2048 + e] = S;
          S = dc[k] * S + kv[k];
        }
      }
    }
  }
}

__device__ __forceinline__ bf16x8 s5_kfrag(const bf16_t* kb, int delta, int sh) {
  const int d = delta - sh;
  bf16x8 r = *(const bf16x8*)(kb + (size_t)(d < 0 ? 0 : d) * 256);
  if (d < 0) r = (bf16x8){0, 0, 0, 0, 0, 0, 0, 0};
  return r;
}
#define S5_UCH 1032
typedef const __attribute__((address_space(3))) bf16_t* lds_bf16_cp;
template <int DIR, bool DIAG>
__device__ __forceinline__ void s5_group8(f32x4 (&acc)[16], bf16x8 (&W)[16], const bf16_t* ul  , const bf16_t* kl  , int ks0, int E, int sh) {
  const bf16x8 zero8 = (bf16x8){0, 0, 0, 0, 0, 0, 0, 0};
#pragma unroll
  for (int j = 0; j < 8; ++j) {
    const int sigma = 2 * (ks0 + j) + sh;
    const bf16x8 a = *(const bf16x8*)(ul + (DIR ? 63 - sigma : sigma) * 16);
    bf16x8 n0 = zero8, n1 = zero8;
    if (!DIAG) {
      if (j + 1 < 8) { n0 = *(const bf16x8*)(kl + (E - 2 * (j + 1) - sh) * 256); n1 = *(const bf16x8*)(kl + (E - 2 * (j + 1) + 1 - sh) * 256); }
      else { n0 = s5_kfrag(kl, E - 16, sh); n1 = s5_kfrag(kl, E - 15, sh); }
    }
#pragma unroll
    for (int i = 0; i < 16; ++i) {
      if (!(DIAG && i < 2 * j)) {
        const int sl = DIR ? 15 - i : i;
        acc[sl] = __builtin_amdgcn_mfma_f32_16x16x32_bf16(a, W[(i - 2 * j) & 15], acc[sl], 0, 0, 0);
      }
    }
    if (!DIAG) { W[(16 - 2 * (j + 1)) & 15] = n0; W[(17 - 2 * (j + 1)) & 15] = n1; }
  }
}
template <int DIR>
__device__ __forceinline__ void s5_dir(f32x4 (&acc)[16], const Params& p, int layer, int g, int scr, int qd, int fr, int fq, const bf16_t* ul, const bf16_t* kl) {
  const int sh = fq >> 1;
  {
    bf16x8 W[16];
#pragma unroll
    for (int i = 0; i < 16; ++i) W[i] = s5_kfrag(kl, 16 * qd + i, sh);
    for (int c = 0; c < qd; ++c) s5_group8<DIR, false>(acc, W, ul, kl, 8 * c, 16 * (qd - c), sh);
    s5_group8<DIR, true>(acc, W, ul, kl, 8 * qd, 0, sh);
  }
  const size_t tb = (size_t)((layer * 2 + DIR) * 16 + g);
  const float* hin = p.s5H + (((size_t)DIR * NSC + scr) * 16 + g) * 128 + fq * 8;
  const bf16_t* n2 = p.s5N2 + tb * 131072 + (size_t)(16 * qd * 16 + fr) * 128 + fq * 8;
  bf16x8 ah[4];
#pragma unroll
  for (int ks = 0; ks < 4; ++ks) {
    const f32x4 h0 = *(const f32x4*)(hin + ks * 32), h1 = *(const f32x4*)(hin + ks * 32 + 4);
    const float h8[8] = {h0[0], h0[1], h0[2], h0[3], h1[0], h1[1], h1[2], h1[3]};
    ah[ks] = pack_bf16x8(h8);
  }
#pragma unroll
  for (int ks = 0; ks < 4; ++ks) {
    bf16x8 b[16];
#pragma unroll
    for (int i = 0; i < 16; ++i) b[i] = *(const bf16x8*)(n2 + (size_t)i * 16 * 128 + ks * 32);
#pragma unroll
    for (int i = 0; i < 16; ++i) {
      const int sl = DIR ? 15 - i : i;
      acc[sl] = __builtin_amdgcn_mfma_f32_16x16x32_bf16(ah[ks], b[i], acc[sl], 0, 0, 0);
    }
    __builtin_amdgcn_sched_barrier(0);
  }
}
__device__ __forceinline__ void phase_s5c(const Params& p, int layer, int nsc, int bid, int nblk, unsigned char* smem) {
  const int tid = opaque_tid(); const int lane = tid & 63, wid = tid >> 6;
  bf16_t* Kl = (bf16_t*)smem;
  bf16_t* Ul = Kl + 2 * 16384;
  const int nmt = nsc / 16, npair = (nmt + 1) / 2;
  const int ntask = 16 * npair;
  for (int task = bid; task < ntask; task += nblk) {
    const int g = task / npair, mt0 = (task % npair) * 2;
    __syncthreads();
    int tid_o = tid; asm volatile("" : "+v"(tid_o));
#pragma unroll
    for (int it = 0; it < 8; ++it) {
      const int e = it * NT + tid_o;
      const int dir = e >> 11, off = (e & 2047) * 8;
      *(uint4*)(Kl + dir * 16384 + off) = *(const uint4*)(p.s5K + (size_t)((layer * 2 + dir) * 16 + g) * 16384 + off);
    }
#pragma unroll
    for (int it = 0; it < 8; ++it) {
      const int e = it * NT + tid_o;
      const int hf = e & 1, tk = (e >> 1) & 63, chk = (e >> 7) & 15, tl = e >> 11;
      const int mt = mt0 + tl;
      uint4 v = make_uint4(0u, 0u, 0u, 0u);
      if (mt < nmt) v = *(const uint4*)(p.cols + (size_t)s5_tok(mt * 16 + chk, tk) * INW + C_S5 + g * 16 + hf * 8);
      *(uint4*)(Ul + (tl * 16 + chk) * S5_UCH + tk * 16 + hf * 8) = v;
    }
    __syncthreads();
    int lane_o = lane; asm volatile("" : "+v"(lane_o));
    const int fr = lane_o & 15, fq = lane_o >> 4;
    const int tl = wid >> 2, q = wid & 3, mt = mt0 + tl;
    if (mt < nmt) {
      const int scr = mt * 16 + fr;
      const bf16_t* ul = Ul + (tl * 16 + fr) * S5_UCH + (fq & 1) * 8;
      f32x4 acc[16];
#pragma unroll
      for (int i = 0; i < 16; ++i) acc[i] = (f32x4){0.f, 0.f, 0.f, 0.f};
      s5_dir<0>(acc, p, layer, g, scr, q, fr, fq, ul, Kl + fr * 16 + (fq & 1) * 8);
      s5_dir<1>(acc, p, layer, g, scr, 3 - q, fr, fq, ul, Kl + 16384 + fr * 16 + (fq & 1) * 8);
      const int ch = g * 16 + fr;
      const float dsk = p.s5_d[layer * 256 + ch];
#pragma unroll
      for (int j = 0; j < 4; ++j) {
        const int chk = fq * 4 + j;
        const size_t tok0 = (size_t)s5_tok(mt * 16 + chk, 16 * q);
        const bf16_t* up = Ul + (tl * 16 + chk) * S5_UCH + (16 * q) * 16 + fr;
        bf16_t* yp = p.yg + tok0 * 256 + ch;
#pragma unroll
        for (int i = 0; i < 16; ++i) {
          const float v = acc[i][j] + dsk * bf2f(up[i * 16]);
          yp[(size_t)i * 256] = f2bf(gelu_f(v));
        }
        __builtin_amdgcn_sched_barrier(0);
      }
    }
  }
  __syncthreads();
}

#define GL_VT_STRIDE 72
#define GL_LB_STRIDE 36
#define GL_HALF_BYTES (64 * 72 * 2 + 64 * 36 * 4 + 64 * 72 * 2)
__device__ __forceinline__ void unpack8(const uint4& r, float* v) {
  v[0] = bflo(r.x); v[1] = bfhi(r.x); v[2] = bflo(r.y); v[3] = bfhi(r.y); v[4] = bflo(r.z); v[5] = bfhi(r.z); v[6] = bflo(r.w); v[7] = bfhi(r.w);
}
__device__ __forceinline__ void gla_store_vT(const uint4& r0, const uint4& r1, bf16_t* vT, int ltid) {
  const int i = ltid & 63, part = ltid >> 6;
  const unsigned w[8] = {r0.x, r0.y, r0.z, r0.w, r1.x, r1.y, r1.z, r1.w};
#pragma unroll
  for (int e = 0; e < 8; ++e) {
    vT[(part * 16 + 2 * e) * GL_VT_STRIDE + i] = (bf16_t)(w[e] & 0xffffu);
    vT[(part * 16 + 2 * e + 1) * GL_VT_STRIDE + i] = (bf16_t)(w[e] >> 16);
  }
}
__device__ __forceinline__ void gla_logdecay(const Params& p, int layer, int sc, int h, int dir, const uint4& z0, const uint4& z1, float* lb, int ltid, float* glb) {
  const int lane = ltid & 63;
  const int wu = __builtin_amdgcn_readfirstlane(ltid >> 6);
  float z[16];
  unpack8(z0, z); unpack8(z1, z + 8);
  const float* wg = p.gla_wg + ((size_t)(layer * 2 + dir) * 16) * 256 + h * 32 + wu * 8;
  const float* bg = p.gla_bg + (layer * 2 + dir) * 256 + h * 32 + wu * 8;
  float la[8];
#pragma unroll
  for (int c = 0; c < 8; ++c) la[c] = bg[c];
#pragma unroll
  for (int r = 0; r < 16; ++r) {
#pragma unroll
    for (int c = 0; c < 8; ++c) la[c] += z[r] * wg[r * 256 + c];
  }
#pragma unroll
  for (int c = 0; c < 8; ++c) la[c] = logsigmoid_f(la[c]) * (1.f / 16.f);
  if (dir == 0) {
#pragma unroll
    for (int off = 1; off < 64; off <<= 1) {
#pragma unroll
      for (int c = 0; c < 8; ++c) { const float nb = __shfl_up(la[c], off); if (lane >= off) la[c] += nb; }
    }
  } else {
#pragma unroll
    for (int off = 1; off < 64; off <<= 1) {
#pragma unroll
      for (int c = 0; c < 8; ++c) { const float nb = __shfl_down(la[c], off); if (lane + off < 64) la[c] += nb; }
    }
  }
  *(f32x4*)(lb + lane * GL_LB_STRIDE + wu * 8) = (f32x4){la[0], la[1], la[2], la[3]};
  *(f32x4*)(lb + lane * GL_LB_STRIDE + wu * 8 + 4) = (f32x4){la[4], la[5], la[6], la[7]};
  float* gp = glb + ((size_t)dir * TT + gla_tok(sc, lane)) * 256 + h * 32 + wu * 8;
  *(f32x4*)gp = (f32x4){la[0], la[1], la[2], la[3]};
  *(f32x4*)(gp + 4) = (f32x4){la[4], la[5], la[6], la[7]};
}

struct GlaAPre { uint4 v0, v1, za0, za1, zb0, zb1, k; };
__device__ __forceinline__ GlaAPre glaa_prefetch(const Params& p, int item, int ltid) {
  const int sc = item >> 3, h = item & 7;
  const int i = ltid & 63, part = ltid >> 6;
  const bf16_t* row = p.cols + (size_t)gla_tok(sc, i) * INW;
  GlaAPre r;
  r.v0 = *(const uint4*)(row + C_GV + h * 64 + part * 16); r.v1 = *(const uint4*)(row + C_GV + h * 64 + part * 16 + 8);
  r.za0 = *(const uint4*)(row + C_ZF); r.za1 = *(const uint4*)(row + C_ZF + 8);
  r.zb0 = *(const uint4*)(row + C_ZF + 16); r.zb1 = *(const uint4*)(row + C_ZF + 24);
  r.k = *(const uint4*)(row + C_GK + h * 32 + part * 8);
  return r;
}
__device__ __forceinline__ void phase_glaa(const Params& p, int layer, int bid, int nblk, unsigned char* smem) {
  const int tid = opaque_tid(); const int half = __builtin_amdgcn_readfirstlane(tid >> 8), ltid = tid & 255;
  const int lane = tid & 63, w = ltid >> 6, fr = lane & 15, fq = lane >> 4;
  bf16_t* vT = (bf16_t*)(smem + half * GL_HALF_BYTES);
  float* lb = (float*)(vT + 64 * GL_VT_STRIDE);
  bf16_t* kT = (bf16_t*)(lb + 64 * GL_LB_STRIDE);
  const int nit = NSC * 8 / 2;
  if (bid >= nit) return;
  GlaAPre cur = glaa_prefetch(p, bid * 2 + half, ltid);
  for (int it = bid; it < nit; it += nblk) {
    const int item = it * 2 + half;
    const int sc = item >> 3, h = item & 7;
    const int itn = it + nblk < nit ? it + nblk : it;
    const GlaAPre nxt = glaa_prefetch(p, itn * 2 + half, ltid);
    gla_store_vT(cur.v0, cur.v1, vT, ltid);
#pragma unroll
    for (int dir = 0; dir < 2; ++dir) {
      gla_logdecay(p, layer, sc, h, dir, dir ? cur.zb0 : cur.za0, dir ? cur.zb1 : cur.za1, lb, ltid, p.glb);
      __syncthreads();
      const int ilast = dir ? 0 : 63;
      {
        const int i = ltid & 63, part = ltid >> 6;
        float kv8[8];
        unpack8(cur.k, kv8);
#pragma unroll
        for (int c = 0; c < 8; ++c) {
          const int dk = part * 8 + c;
          kT[dk * GL_VT_STRIDE + i] = f2bf(kv8[c] * __expf(lb[ilast * GL_LB_STRIDE + dk] - lb[i * GL_LB_STRIDE + dk]));
        }
      }
      const size_t o = (((size_t)dir * NSC + sc) * 8 + h);
      if (ltid < 32) p.gdec[o * 32 + ltid] = __expf(lb[ilast * GL_LB_STRIDE + ltid]);
      __syncthreads();
      {
        f32x4 acc[2];
        acc[0] = (f32x4){0.f, 0.f, 0.f, 0.f}; acc[1] = acc[0];
#pragma unroll
        for (int ks = 0; ks < 2; ++ks) {
          const bf16x8 b = *(const bf16x8*)(vT + (w * 16 + fr) * GL_VT_STRIDE + ks * 32 + fq * 8);
#pragma unroll
          for (int m = 0; m < 2; ++m) {
            const bf16x8 a = *(const bf16x8*)(kT + (m * 16 + fr) * GL_VT_STRIDE + ks * 32 + fq * 8);
            acc[m] = __builtin_amdgcn_mfma_f32_16x16x32_bf16(a, b, acc[m], 0, 0, 0);
          }
        }
#pragma unroll
        for (int m = 0; m < 2; ++m) *(f32x4*)(p.gkv + o * 2048 + (size_t)(w * 16 + fr) * 32 + m * 16 + fq * 4) = acc[m];
      }
      __syncthreads();
    }
    cur = nxt;
  }
}

__device__ __forceinline__ void gl_load8(const float* g, float* v) {
  const f32x4 a = *(const f32x4*)g, b = *(const f32x4*)(g + 4);
  v[0] = a[0]; v[1] = a[1]; v[2] = a[2]; v[3] = a[3]; v[4] = b[0]; v[5] = b[1]; v[6] = b[2]; v[7] = b[3];
}
#define GLC_HALF_BYTES (64 * 72 * 2 + 64 * 72 * 2 + 2 * 64 * 36 * 4 + 2 * 64 * 36 * 4)
struct GlaCPre { uint4 v0, v1, q, k[4], lb[2][2], st[2][2]; };
__device__ __forceinline__ GlaCPre glac_prefetch(const Params& p, int item, int ltid, int w, int fr, int fq) {
  const int sc = item >> 3, h = item & 7;
  GlaCPre r;
  {
    const int i = ltid & 63, part = ltid >> 6;
    const bf16_t* row = p.cols + (size_t)gla_tok(sc, i) * INW + C_GV + h * 64 + part * 16;
    r.v0 = *(const uint4*)row; r.v1 = *(const uint4*)(row + 8);
  }
  r.q = *(const uint4*)(p.cols + (size_t)gla_tok(sc, w * 16 + fr) * INW + C_GQ + h * 32 + fq * 8);
#pragma unroll
  for (int n = 0; n < 4; ++n) r.k[n] = *(const uint4*)(p.cols + (size_t)gla_tok(sc, n * 16 + fr) * INW + C_GK + h * 32 + fq * 8);
  {
    const int i = ltid >> 2, piece = ltid & 3;
#pragma unroll
    for (int dir = 0; dir < 2; ++dir) {
      const float* g = p.glb + ((size_t)dir * TT + gla_tok(sc, i)) * 256 + h * 32 + piece * 8;
      r.lb[dir][0] = *(const uint4*)g; r.lb[dir][1] = *(const uint4*)(g + 4);
      const float* s = p.gkv + (((size_t)dir * NSC + sc) * 8 + h) * 2048 + i * 32 + piece * 8;
      r.st[dir][0] = *(const uint4*)s; r.st[dir][1] = *(const uint4*)(s + 4);
    }
  }
  return r;
}
__device__ __forceinline__ void phase_glac(const Params& p, int layer, int nsc, int bid, int nblk, unsigned char* smem) {
  const int tid = opaque_tid(); const int half = __builtin_amdgcn_readfirstlane(tid >> 8), ltid = tid & 255;
  const int lane = tid & 63, w = ltid >> 6, fr = lane & 15, fq = lane >> 4;
  bf16_t* vT = (bf16_t*)(smem + half * GLC_HALF_BYTES);
  bf16_t* Pw = vT + 64 * GL_VT_STRIDE + w * 16 * GL_VT_STRIDE;
  float* lbT = (float*)(vT + 2 * 64 * GL_VT_STRIDE);
  float* ST = lbT + 2 * 64 * GL_LB_STRIDE;
  const int nit = nsc * 4;
  if (bid >= nit) return;
  GlaCPre cur = glac_prefetch(p, bid * 2 + half, ltid, w, fr, fq);
  for (int it = bid; it < nit; it += nblk) {
    const int item = it * 2 + half;
    const int sc = item >> 3, h = item & 7;
    __syncthreads();
    gla_store_vT(cur.v0, cur.v1, vT, ltid);
    {
      const int i = ltid >> 2, piece = ltid & 3;
#pragma unroll
      for (int dir = 0; dir < 2; ++dir) {
        *(uint4*)(lbT + (dir * 64 + i) * GL_LB_STRIDE + piece * 8) = cur.lb[dir][0]; *(uint4*)(lbT + (dir * 64 + i) * GL_LB_STRIDE + piece * 8 + 4) = cur.lb[dir][1];
        *(uint4*)(ST + (dir * 64 + i) * GL_LB_STRIDE + piece * 8) = cur.st[dir][0]; *(uint4*)(ST + (dir * 64 + i) * GL_LB_STRIDE + piece * 8 + 4) = cur.st[dir][1];
      }
    }
    const int itn = it + nblk < nit ? it + nblk : it;
    const GlaCPre nxt = glac_prefetch(p, itn * 2 + half, ltid, w, fr, fq);
    __syncthreads();
    f32x4 o[4];
#pragma unroll
    for (int n = 0; n < 4; ++n) o[n] = (f32x4){0.f, 0.f, 0.f, 0.f};
#pragma unroll
    for (int dir = 0; dir < 2; ++dir) {
      const float* lbd = lbT + dir * 64 * GL_LB_STRIDE + fq * 8;
      float bref[8], bt[8];
      gl_load8(lbd + (dir ? 31 : 32) * GL_LB_STRIDE, bref);
      gl_load8(lbd + (w * 16 + fr) * GL_LB_STRIDE, bt);
      bf16x8 aqs, aqe;
      {
        float q8[8], s8[8], e8[8];
        unpack8(cur.q, q8);
#pragma unroll
        for (int c = 0; c < 8; ++c) {
          const float qx = q8[c] * 0.17677669529663687f;
          s8[c] = qx * __expf(bt[c] - bref[c]);
          e8[c] = qx * __expf(bt[c]);
        }
        aqs = pack_bf16x8(s8); aqe = pack_bf16x8(e8);
      }
#pragma unroll
      for (int n = 0; n < 4; ++n) {
        const int s = n * 16 + fr;
        float k8[8], bs[8];
        unpack8(cur.k[n], k8);
        gl_load8(lbd + s * GL_LB_STRIDE, bs);
#pragma unroll
        for (int c = 0; c < 8; ++c) k8[c] *= __expf(bref[c] - bs[c]);
        const bf16x8 bks = pack_bf16x8(k8);
        const f32x4 sa = __builtin_amdgcn_mfma_f32_16x16x32_bf16(aqs, bks, (f32x4){0.f, 0.f, 0.f, 0.f}, 0, 0, 0);
#pragma unroll
        for (int j = 0; j < 4; ++j) {
          const int t = w * 16 + fq * 4 + j;
          const bool ok = dir ? (s >= t) : (s <= t);
          Pw[(fq * 4 + j) * GL_VT_STRIDE + s] = f2bf(ok ? sa[j] : 0.f);
        }
      }
      __builtin_amdgcn_wave_barrier();
#pragma unroll
      for (int ks = 0; ks < 2; ++ks) {
        const bf16x8 ap = *(const bf16x8*)(Pw + fr * GL_VT_STRIDE + ks * 32 + fq * 8);
#pragma unroll
        for (int n = 0; n < 4; ++n) {
          const bf16x8 bv = *(const bf16x8*)(vT + (n * 16 + fr) * GL_VT_STRIDE + ks * 32 + fq * 8);
          o[n] = __builtin_amdgcn_mfma_f32_16x16x32_bf16(ap, bv, o[n], 0, 0, 0);
        }
      }
      __builtin_amdgcn_wave_barrier();
      {
        const float* Sg = ST + dir * 64 * GL_LB_STRIDE + fq * 8;
#pragma unroll
        for (int n = 0; n < 4; ++n) {
          float s8[8];
          gl_load8(Sg + (n * 16 + fr) * GL_LB_STRIDE, s8);
          const bf16x8 bS = pack_bf16x8(s8);
          o[n] = __builtin_amdgcn_mfma_f32_16x16x32_bf16(aqe, bS, o[n], 0, 0, 0);
        }
      }
    }
    __builtin_amdgcn_wave_barrier();
#pragma unroll
    for (int j = 0; j < 4; ++j) {
      float ss = o[0][j] * o[0][j] + o[1][j] * o[1][j] + o[2][j] * o[2][j] + o[3][j] * o[3][j];
      ss += __shfl_xor(ss, 1); ss += __shfl_xor(ss, 2); ss += __shfl_xor(ss, 4); ss += __shfl_xor(ss, 8);
      const float rstd = rsqrtf(ss * (1.f / 64.f) + EPSV);
#pragma unroll
      for (int n = 0; n < 4; ++n) Pw[(fq * 4 + j) * GL_VT_STRIDE + n * 16 + fr] = f2bf(o[n][j] * rstd);
    }
    __builtin_amdgcn_wave_barrier();
    {
      const int tl = lane >> 2, dq = (lane & 3) * 16;
      const int tok = gla_tok(sc, w * 16 + tl);
      const bf16_t* grow = p.cols + (size_t)tok * INW + C_GG + h * 64 + dq;
      float ov[16], gv[16];
      unpack8(*(const uint4*)(Pw + tl * GL_VT_STRIDE + dq), ov); unpack8(*(const uint4*)(Pw + tl * GL_VT_STRIDE + dq + 8), ov + 8);
      unpack8(*(const uint4*)grow, gv); unpack8(*(const uint4*)(grow + 8), gv + 8);
      const float* ng = p.gla_ng + layer * 512 + h * 64 + dq;
      unsigned wv[8];
#pragma unroll
      for (int e = 0; e < 8; ++e) {
        const float a = ov[2 * e] * ng[2 * e] * silu_f(gv[2 * e]), b = ov[2 * e + 1] * ng[2 * e + 1] * silu_f(gv[2 * e + 1]);
        wv[e] = (unsigned)f2bf(a) | ((unsigned)f2bf(b) << 16);
      }
      bf16_t* orow = p.mix + (size_t)tok * 1024 + 512 + h * 64 + dq;
      *(uint4*)orow = make_uint4(wv[0], wv[1], wv[2], wv[3]);
      *(uint4*)(orow + 8) = make_uint4(wv[4], wv[5], wv[6], wv[7]);
    }
    __builtin_amdgcn_wave_barrier();
    cur = nxt;
  }
  __syncthreads();
}

__device__ __forceinline__ unsigned fkey(float f) { const unsigned u = __float_as_uint(f); return u ^ ((u >> 31) ? 0xFFFFFFFFu : 0x80000000u); }
__device__ __forceinline__ float funkey(unsigned k) { return __uint_as_float((k >> 31) ? (k ^ 0x80000000u) : ~k); }
__device__ __forceinline__ unsigned umax3(unsigned a, unsigned b) { return a > b ? a : b; }
__device__ __forceinline__ unsigned umin3(unsigned a, unsigned b) { return a < b ? a : b; }
__device__ __forceinline__ unsigned umed3(unsigned a, unsigned b, unsigned c) { return umax3(umin3(a, b), umin3(umax3(a, b), c)); }
__device__ __forceinline__ void top16_insert(unsigned (&L)[16], unsigned x) {
#pragma unroll
  for (int q = 15; q >= 1; --q) L[q] = umed3(L[q - 1], L[q], x);
  L[0] = umax3(L[0], x);
}
template <int XM>
__device__ __forceinline__ void top16_merge(unsigned (&L)[16]) {
  unsigned P[16];
#pragma unroll
  for (int i = 0; i < 16; ++i) P[i] = (unsigned)__shfl_xor((int)L[i], XM);
  unsigned M[16];
#pragma unroll
  for (int i = 0; i < 16; ++i) M[i] = umax3(L[i], P[15 - i]);
#pragma unroll
  for (int d = 8; d >= 1; d >>= 1) {
#pragma unroll
    for (int i = 0; i < 16; ++i) {
      if ((i & d) == 0) { const unsigned hi = umax3(M[i], M[i + d]), lo = umin3(M[i], M[i + d]); M[i] = hi; M[i + d] = lo; }
    }
  }
#pragma unroll
  for (int i = 0; i < 16; ++i) L[i] = M[i];
}
#define RT_SC_STRIDE 132
#define RT_MAX_ITEMS 5
__device__ __forceinline__ void phase_route(const Params& p, int layer, int ntok, int bid, int nblk, unsigned char* smem) {
  const int tid = opaque_tid(); const int lane = tid & 63, wid = tid >> 6;
  float* sc = (float*)smem;
  unsigned* lists_all = (unsigned*)(sc + 128 * RT_SC_STRIDE);
  const int fr = lane & 15, fq = lane >> 4;
  const bf16_t* qb = p.cols;
  const int nitems = ntok / 16;
  for (int item0 = bid; item0 < nitems; item0 += nblk * RT_MAX_ITEMS) {
    for (int ph = 0; ph < 2; ++ph) {
      bf16x8 bk[8][4];
      {
        const bf16_t* kb = p.keysb + ((((size_t)layer * 2 + ph) * 8 + wid) * 128) * 128 + (size_t)fr * 128 + fq * 8;
#pragma unroll
        for (int n = 0; n < 8; ++n)
#pragma unroll
          for (int kt = 0; kt < 4; ++kt) bk[n][kt] = *(const bf16x8*)(kb + (size_t)n * 16 * 128 + kt * 32);
      }
      for (int ii = 0; ii < RT_MAX_ITEMS; ++ii) {
        const int item = item0 + ii * nblk;
        if (item >= nitems) break;
        const int tok0 = item * 16;
        unsigned* lists = lists_all + ii * 4096;
        {
          const bf16_t* qrow = qb + (size_t)(tok0 + fr) * 2048 + wid * 256 + ph * 128 + fq * 8;
          bf16x8 a[4];
#pragma unroll
          for (int kt = 0; kt < 4; ++kt) a[kt] = *(const bf16x8*)(qrow + kt * 32);
#pragma unroll
          for (int n = 0; n < 8; ++n) {
            f32x4 acc = (f32x4){0.f, 0.f, 0.f, 0.f};
#pragma unroll
            for (int kt = 0; kt < 4; ++kt) acc = __builtin_amdgcn_mfma_f32_16x16x32_bf16(a[kt], bk[n][kt], acc, 0, 0, 0);
#pragma unroll
            for (int j = 0; j < 4; ++j) sc[(wid * 16 + fq * 4 + j) * RT_SC_STRIDE + n * 16 + fr] = acc[j];
          }
        }
        __syncthreads();
        {
          const int row = tid >> 2, qr = tid & 3;
          unsigned L[16];
#pragma unroll
          for (int i = 0; i < 16; ++i) L[i] = 0u;
          const float* rp = sc + row * RT_SC_STRIDE + qr * 32;
#pragma unroll
          for (int i = 0; i < 8; ++i) {
            const f32x4 v = *(const f32x4*)(rp + i * 4);
#pragma unroll
            for (int j = 0; j < 4; ++j) top16_insert(L, (fkey(v[j]) & 0xFFFFFF80u) | (unsigned)(qr * 32 + i * 4 + j));
          }
          top16_merge<1>(L);
          top16_merge<2>(L);
          if (qr == 0) {
            unsigned* dst = lists + (((row >> 4) * 2 + ph) * 16 + (row & 15)) * 16;
#pragma unroll
            for (int i = 0; i < 4; ++i) *(uint4*)(dst + i * 4) = make_uint4(L[i * 4], L[i * 4 + 1], L[i * 4 + 2], L[i * 4 + 3]);
          }
        }
        __syncthreads();
      }
    }
    for (int ii = 0; ii < RT_MAX_ITEMS; ++ii) {
      const int item = item0 + ii * nblk;
      if (item >= nitems) break;
      const int tok0 = item * 16;
      const unsigned* lists = lists_all + ii * 4096;
    {
      const int pair = tid >> 2, part = tid & 3;
      const int tk = pair & 15, hd = pair >> 4;
      const unsigned* l1 = lists + ((hd * 2 + 0) * 16 + tk) * 16;
      const unsigned* l2 = lists + ((hd * 2 + 1) * 16 + tk) * 16;
      static const unsigned char STAIR[52] = {0, 1, 2, 3, 4, 5, 6, 7, 8, 9, 10, 11, 12, 13, 14, 15, 16, 17, 18, 19, 20, 21, 22, 23, 32, 33, 34, 35, 36, 48, 49, 50, 51, 64, 65, 66, 80, 81, 96, 97, 112, 113, 128, 144, 160, 176, 192, 208, 224, 240, 255, 255};
      unsigned T[16];
#pragma unroll
      for (int i = 0; i < 16; ++i) T[i] = 0u;
#pragma unroll
      for (int j = 0; j < 13; ++j) {
        const unsigned c = STAIR[part + 4 * j];
        const float sa = funkey(l1[(c >> 4) & 15] & 0xFFFFFF80u), sb = funkey(l2[c & 15] & 0xFFFFFF80u);
        const unsigned key = (fkey(sa + sb) & 0xFFFFFF00u) | c;
        top16_insert(T, c == 255u ? 0u : key);
      }
      top16_merge<1>(T);
      top16_merge<2>(T);
      const float mx = funkey(T[0] & 0xFFFFFF00u);
      float ex[16], sum = 0.f;
#pragma unroll
      for (int r = 0; r < 16; ++r) { ex[r] = __expf(funkey(T[r] & 0xFFFFFF00u) - mx); sum += ex[r]; }
      const float inv = 1.f / sum;
      int eid[4]; float gt[4];
#pragma unroll
      for (int r = 0; r < 16; ++r) {
        if ((r >> 2) == part) {
          const int a = (T[r] >> 4) & 15, b = T[r] & 15;
          eid[r & 3] = (int)(l1[a] & 127u) * 128 + (int)(l2[b] & 127u);
          gt[r & 3] = ex[r] * inv;
        }
      }
      const size_t o = (size_t)(tok0 + tk) * 128 + hd * 16 + part * 4;
      *(int4*)(p.pidx + o) = make_int4(eid[0], eid[1], eid[2], eid[3]);
      *(f32x4*)(p.pgate + o) = (f32x4){gt[0], gt[1], gt[2], gt[3]};
    }
    }
    __syncthreads();
  }
}

typedef float f32x2 __attribute__((ext_vector_type(2)));
__device__ __forceinline__ float dot16_fp8(const uint4& r, const f32x2* h2) {
  const unsigned w[4] = {r.x, r.y, r.z, r.w};
  f32x2 d = {0.f, 0.f};
#pragma unroll
  for (int q = 0; q < 4; ++q) {
    d += __builtin_amdgcn_cvt_pk_f32_fp8(w[q], false) * h2[q * 2];
    d += __builtin_amdgcn_cvt_pk_f32_fp8(w[q], true) * h2[q * 2 + 1];
  }
  return d.x + d.y;
}
__device__ __forceinline__ void fma16_fp8(f32x2* acc2, const uint4& r, float w8) {
  const unsigned w[4] = {r.x, r.y, r.z, r.w};
  const f32x2 ww = {w8, w8};
#pragma unroll
  for (int q = 0; q < 4; ++q) {
    acc2[q * 2] += ww * __builtin_amdgcn_cvt_pk_f32_fp8(w[q], false);
    acc2[q * 2 + 1] += ww * __builtin_amdgcn_cvt_pk_f32_fp8(w[q], true);
  }
}
struct XcdInfo { int rank, nloc, xi, nx; };
__device__ __forceinline__ XcdInfo xcd_info(const XcdBarrier& b) {
  if (threadIdx.x == 0) {
    unsigned xi = 0;
    for (unsigned j = 0; j < 16; ++j) { const unsigned c = xb_ld(&b.bar[XB_XCNT(j)]); if (j < b.x && c > 0u) ++xi; }
    b.st[3] = xi;
  }
  __syncthreads();
  XcdInfo r;
  r.nloc = __builtin_amdgcn_readfirstlane((int)b.st[0]); r.nx = __builtin_amdgcn_readfirstlane((int)b.st[1]);
  r.rank = __builtin_amdgcn_readfirstlane((int)b.st[2]); r.xi = __builtin_amdgcn_readfirstlane((int)b.st[3]);
  return r;
}
__device__ __forceinline__ void gs_issue(uint4 (&buf)[16], const unsigned char* tab, const int* el, int grp) {
#pragma unroll
  for (int k = 0; k < 16; ++k) buf[k] = *(const uint4*)(tab + (size_t)el[k * 8 + grp] * 1024);
}
__device__ __forceinline__ void phase_gather_u(const Params& p, int layer, int ntok, const XcdInfo xin, unsigned char* smem) {
  const int tid = opaque_tid(); const int lane = tid & 63, wid = tid >> 6;
  int* elw = (int*)smem + wid * 256;
  float* pbuf = (float*)p.cols;
  const int sub = lane & 7, grp = lane >> 3;
  const bool b0 = (lane & 1) != 0, b1 = (lane & 2) != 0, b2 = (lane & 4) != 0;
  const int tstep = xin.nloc * NW;
  for (int s = xin.xi; s < 8; s += xin.nx) {
    const unsigned char* EU = p.eu8 + (size_t)layer * 16384 * 1024 + s * 128 + sub * 16;
    const int t0 = xin.rank * NW + wid;
    if (t0 >= ntok) continue;
    const int kslot = ((b0 ? 8 : 0) + (b1 ? 4 : 0) + (b2 ? 2 : 0)) * 8 + grp;
    uint4 bufA[16], bufB[16];
    uint4 hA0, hA1, hB0, hB1;
    int i0n, i1n;
    {
      elw[lane] = p.pidx[(size_t)t0 * 128 + lane]; elw[64 + lane] = p.pidx[(size_t)t0 * 128 + 64 + lane];
      __builtin_amdgcn_wave_barrier();
      gs_issue(bufA, EU, elw, grp);
      hA0 = *(const uint4*)(p.abuf + (size_t)t0 * 1024 + s * 128 + sub * 16); hA1 = *(const uint4*)(p.abuf + (size_t)t0 * 1024 + s * 128 + sub * 16 + 8);
      const int t1 = t0 + tstep < ntok ? t0 + tstep : t0;
      i0n = p.pidx[(size_t)t1 * 128 + lane]; i1n = p.pidx[(size_t)t1 * 128 + 64 + lane];
    }
    int par = 0;
    for (int t = t0; t < ntok; t += 2 * tstep) {
#pragma unroll
      for (int hh = 0; hh < 2; ++hh) {
        const int tc = t + hh * tstep;
        if (tc < ntok) {
          uint4 (&cur)[16] = hh ? bufB : bufA;
          uint4 (&nxt)[16] = hh ? bufA : bufB;
          const uint4 hc0 = hh ? hB0 : hA0, hc1 = hh ? hB1 : hA1;
          const int tn = tc + tstep < ntok ? tc + tstep : tc;
          par ^= 1;
          int* eln = elw + par * 128;
          eln[lane] = i0n; eln[64 + lane] = i1n;
          __builtin_amdgcn_wave_barrier();
          gs_issue(nxt, EU, eln, grp);
          const uint4 hn0 = *(const uint4*)(p.abuf + (size_t)tn * 1024 + s * 128 + sub * 16), hn1 = *(const uint4*)(p.abuf + (size_t)tn * 1024 + s * 128 + sub * 16 + 8);
          const int tnn = tn + tstep < ntok ? tn + tstep : tn;
          i0n = p.pidx[(size_t)tnn * 128 + lane]; i1n = p.pidx[(size_t)tnn * 128 + 64 + lane];
          f32x2 hv2[8];
          {
            float hv[16];
            unpack8(hc0, hv); unpack8(hc1, hv + 8);
#pragma unroll
            for (int q = 0; q < 8; ++q) hv2[q] = (f32x2){hv[2 * q], hv[2 * q + 1]};
          }
          float d[16];
#pragma unroll
          for (int k = 0; k < 16; ++k) d[k] = dot16_fp8(cur[k], hv2);
          float d8[8], d4[4], d2[2];
#pragma unroll
          for (int q = 0; q < 8; ++q) { const float send = b0 ? d[q] : d[q + 8]; const float keep = b0 ? d[q + 8] : d[q]; d8[q] = keep + __shfl_xor(send, 1); }
#pragma unroll
          for (int q = 0; q < 4; ++q) { const float send = b1 ? d8[q] : d8[q + 4]; const float keep = b1 ? d8[q + 4] : d8[q]; d4[q] = keep + __shfl_xor(send, 2); }
#pragma unroll
          for (int q = 0; q < 2; ++q) { const float send = b2 ? d4[q] : d4[q + 2]; const float keep = b2 ? d4[q + 2] : d4[q]; d2[q] = keep + __shfl_xor(send, 4); }
          float* dst = pbuf + ((size_t)s * TT + tc) * 128 + kslot;
          dst[0] = d2[0]; dst[8] = d2[1];
          if (hh) { hA0 = hn0; hA1 = hn1; } else { hB0 = hn0; hB1 = hn1; }
        }
      }
    }
    __builtin_amdgcn_wave_barrier();
  }
}
__device__ __forceinline__ void phase_gather_r(const Params& p, int layer, int ntok, int bid, int nblk) {
  const int tid = opaque_tid();
  const float* pbuf = (const float*)p.cols;
  const size_t n4 = (size_t)ntok * 32;
  for (size_t i = (size_t)bid * NT + tid; i < n4; i += (size_t)nblk * NT) {
    f32x4 z = *(const f32x4*)(pbuf + i * 4);
#pragma unroll
    for (int s = 1; s < 8; ++s) z += *(const f32x4*)(pbuf + (size_t)s * TT * 128 + i * 4);
    const f32x4 g = *(const f32x4*)(p.pgate + i * 4);
    const int4 e = *(const int4*)(p.pidx + i * 4);
    const int ev[4] = {e.x, e.y, e.z, e.w};
    f32x4 w;
#pragma unroll
    for (int j = 0; j < 4; ++j) w[j] = g[j] * gelu_f(z[j] * p.su[layer * 16384 + ev[j]]) * p.sv[layer * 16384 + ev[j]];
    *(f32x4*)(p.wbuf + i * 4) = w;
  }
}
template <bool DUMMY>
__device__ __forceinline__ void phase_gather_v(const Params& p, int layer, int ntok, const XcdInfo xin, unsigned char* smem) {
  float* xout = DUMMY ? (float*)p.cols : p.xres;
  const int tid = opaque_tid(); const int lane = tid & 63, wid = tid >> 6;
  int* elw = (int*)smem + wid * 512;
  float* wlw = (float*)(elw + 256);
  const int sub = lane & 7, grp = lane >> 3;
  const bool b5 = (lane & 32) != 0, b4 = (lane & 16) != 0, b3 = (lane & 8) != 0;
  const int tstep = xin.nloc * NW;
  for (int s = xin.xi; s < 8; s += xin.nx) {
    const unsigned char* EV = p.ev8 + (size_t)layer * 16384 * 1024 + s * 128 + sub * 16;
    const int col = s * 128 + sub * 16 + (b3 ? 8 : 0) + (b4 ? 4 : 0) + (b5 ? 2 : 0);
    const int t0 = xin.rank * NW + wid;
    if (t0 >= ntok) continue;
    uint4 bufA[16], bufB[16];
    int i0n, i1n; float w0n, w1n;
    f32x2 xc, gc, xn, gn;
    {
      elw[lane] = p.pidx[(size_t)t0 * 128 + lane]; elw[64 + lane] = p.pidx[(size_t)t0 * 128 + 64 + lane];
      wlw[lane] = p.wbuf[(size_t)t0 * 128 + lane]; wlw[64 + lane] = p.wbuf[(size_t)t0 * 128 + 64 + lane];
      __builtin_amdgcn_wave_barrier();
      gs_issue(bufA, EV, elw, grp);
      xc = *(const f32x2*)(p.xres + (size_t)t0 * 1024 + col);
      gc = *(const f32x2*)(p.modv + ((size_t)layer * 5 + tok_batch(t0)) * NMOD + 5120 + col);
      const int t1 = t0 + tstep < ntok ? t0 + tstep : t0;
      i0n = p.pidx[(size_t)t1 * 128 + lane]; i1n = p.pidx[(size_t)t1 * 128 + 64 + lane];
      w0n = p.wbuf[(size_t)t1 * 128 + lane]; w1n = p.wbuf[(size_t)t1 * 128 + 64 + lane];
      xn = *(const f32x2*)(p.xres + (size_t)t1 * 1024 + col);
      gn = *(const f32x2*)(p.modv + ((size_t)layer * 5 + tok_batch(t1)) * NMOD + 5120 + col);
    }
    int par = 0;
    for (int t = t0; t < ntok; t += 2 * tstep) {
#pragma unroll
      for (int hh = 0; hh < 2; ++hh) {
        const int tc = t + hh * tstep;
        if (tc < ntok) {
          uint4 (&cur)[16] = hh ? bufB : bufA;
          uint4 (&nxt)[16] = hh ? bufA : bufB;
          const float* wlc = wlw + par * 128;
          const int tn = tc + tstep < ntok ? tc + tstep : tc;
          par ^= 1;
          int* eln = elw + par * 128; float* wln = wlw + par * 128;
          eln[lane] = i0n; eln[64 + lane] = i1n; wln[lane] = w0n; wln[64 + lane] = w1n;
          __builtin_amdgcn_wave_barrier();
          gs_issue(nxt, EV, eln, grp);
          const f32x2 xcur = xc, gcur = gc;
          xc = xn; gc = gn;
          const int tnn = tn + tstep < ntok ? tn + tstep : tn;
          i0n = p.pidx[(size_t)tnn * 128 + lane]; i1n = p.pidx[(size_t)tnn * 128 + 64 + lane];
          w0n = p.wbuf[(size_t)tnn * 128 + lane]; w1n = p.wbuf[(size_t)tnn * 128 + 64 + lane];
          xn = *(const f32x2*)(p.xres + (size_t)tnn * 1024 + col);
          gn = *(const f32x2*)(p.modv + ((size_t)layer * 5 + tok_batch(tnn)) * NMOD + 5120 + col);
          f32x2 acc2[8];
#pragma unroll
          for (int j = 0; j < 8; ++j) acc2[j] = (f32x2){0.f, 0.f};
#pragma unroll
          for (int k = 0; k < 16; ++k) fma16_fp8(acc2, cur[k], wlc[k * 8 + grp]);
          float a16[16];
#pragma unroll
          for (int q = 0; q < 8; ++q) { a16[2 * q] = acc2[q].x; a16[2 * q + 1] = acc2[q].y; }
          float a8[8], a4[4], a2[2];
#pragma unroll
          for (int q = 0; q < 8; ++q) { const float send = b3 ? a16[q] : a16[q + 8]; const float keep = b3 ? a16[q + 8] : a16[q]; a8[q] = keep + __shfl_xor(send, 8); }
#pragma unroll
          for (int q = 0; q < 4; ++q) { const float send = b4 ? a8[q] : a8[q + 4]; const float keep = b4 ? a8[q + 4] : a8[q]; a4[q] = keep + __shfl_xor(send, 16); }
#pragma unroll
          for (int q = 0; q < 2; ++q) { const float send = b5 ? a4[q] : a4[q + 2]; const float keep = b5 ? a4[q + 2] : a4[q]; a2[q] = keep + __shfl_xor(send, 32); }
          f32x2 xv = xcur;
          xv.x += gcur.x * a2[0]; xv.y += gcur.y * a2[1];
          *(f32x2*)(xout + (size_t)tc * 1024 + col) = xv;
          const float ss = wave_sum(xv.x * xv.x + xv.y * xv.y);
          if (lane == 0 && !DUMMY) p.ssbuf[(size_t)tc * 8 + s] = ss;
        }
      }
    }
    __builtin_amdgcn_wave_barrier();
  }
}
__device__ __forceinline__ void phase_gather_norm(const Params& p, int layer, int ntok, int bid, int nblk) {
  const int tid = opaque_tid(); const int lane = tid & 63, wid = tid >> 6;
  for (int t = bid * NW + wid; t < ntok; t += nblk * NW) {
    const f32x4 s0 = *(const f32x4*)(p.ssbuf + (size_t)t * 8), s1 = *(const f32x4*)(p.ssbuf + (size_t)t * 8 + 4);
    const float ss = (s0[0] + s0[1]) + (s0[2] + s0[3]) + (s1[0] + s1[1]) + (s1[2] + s1[3]);
    const float rstd = rsqrtf(ss * (1.f / 1024.f) + EPSV);
    f32x4 xv[4];
#pragma unroll
    for (int q = 0; q < 4; ++q) xv[q] = *(const f32x4*)(p.xres + (size_t)t * 1024 + lane * 16 + q * 4);
    if (layer == 0) {
      const float* md1 = p.modv + ((size_t)5 + tok_batch(t)) * NMOD;
#pragma unroll
      for (int q = 0; q < 4; ++q) {
        const int c0 = lane * 16 + q * 4;
        const f32x4 g = *(const f32x4*)(p.norm1_g + 1024 + c0);
        const f32x4 sh = *(const f32x4*)(md1 + c0);
        const f32x4 sc = *(const f32x4*)(md1 + 1024 + c0);
        ushort4 o;
        o.x = f2bf(xv[q][0] * rstd * g[0] * (1.f + sc[0]) + sh[0]);
        o.y = f2bf(xv[q][1] * rstd * g[1] * (1.f + sc[1]) + sh[1]);
        o.z = f2bf(xv[q][2] * rstd * g[2] * (1.f + sc[2]) + sh[2]);
        o.w = f2bf(xv[q][3] * rstd * g[3] * (1.f + sc[3]) + sh[3]);
        *(ushort4*)(p.abuf + (size_t)t * 1024 + c0) = o;
      }
    } else {
#pragma unroll
      for (int q = 0; q < 4; ++q) {
        const int c0 = lane * 16 + q * 4;
        const f32x4 g = *(const f32x4*)(p.final_g + c0);
        f32x4 o;
        o[0] = xv[q][0] * rstd * g[0]; o[1] = xv[q][1] * rstd * g[1]; o[2] = xv[q][2] * rstd * g[2]; o[3] = xv[q][3] * rstd * g[3];
        *(f32x4*)(p.out + (size_t)t * 1024 + c0) = o;
      }
    }
  }
}

__device__ __forceinline__ void phase_final(const Params& p, int bid, int nblk) {
  const int tid = opaque_tid(); const int lane = tid & 63, wid = tid >> 6;
  for (int t = bid * 4 + wid; t < TL; t += nblk * 4) {
    const float* row = p.xres + (size_t)t * 1024;
    f32x4 v[4];
    float ss = 0.f;
#pragma unroll
    for (int j = 0; j < 4; ++j) {
      v[j] = *(const f32x4*)(row + j * 256 + lane * 4);
      ss += v[j][0] * v[j][0] + v[j][1] * v[j][1] + v[j][2] * v[j][2] + v[j][3] * v[j][3];
    }
    ss = wave_sum(ss);
    const float rstd = rsqrtf(ss * (1.f / 1024.f) + EPSV);
#pragma unroll
    for (int j = 0; j < 4; ++j) {
      const int c0 = j * 256 + lane * 4;
      const f32x4 g = *(const f32x4*)(p.final_g + c0);
      f32x4 o;
      o[0] = v[j][0] * rstd * g[0]; o[1] = v[j][1] * rstd * g[1]; o[2] = v[j][2] * rstd * g[2]; o[3] = v[j][3] * rstd * g[3];
      *(f32x4*)(p.out + (size_t)t * 1024 + c0) = o;
    }
  }
}

template <class Epi>
__device__ __forceinline__ void run_gemm(const bf16_t* A, const bf16_t* Bt, int M, int N, int K, const Epi& epi, int bid, int nblk, unsigned char* smem) {
  pg8::Gemm g{A, Bt, M, N, K};
  pg8::StaticOrder S; S.init(M, N, nblk, bid);
  pg8::gemm_phase(( PG8_LAS unsigned char*)smem, g, S, epi);
}
__device__ __forceinline__ void phase_gemm_in(const Params& p, int layer, int bid, int nblk, unsigned char* smem) {
  pg8::EpiBf16 epi{p.cols, INW, INW};
  run_gemm(p.abuf, p.wt_in + (size_t)layer * INWP * 1024, TT, INWP, 1024, epi, bid, nblk, smem);
}
__device__ __forceinline__ void phase_gemm_glu(const Params& p, int layer, int ntok, int bid, int nblk, unsigned char* smem) {
  pg8::EpiGlu epi{p.mix};
  run_gemm(p.yg, p.wt_glu + (size_t)layer * 512 * 256, ntok, 512, 256, epi, bid, nblk, smem);
}
__device__ __forceinline__ void phase_gemm_out(const Params& p, int layer, int ntok, int bid, int nblk, unsigned char* smem) {
  pg8::EpiResid epi{p.xres, p.modv + (size_t)layer * 5 * NMOD, 2048};
  run_gemm(p.mix, p.wt_out + (size_t)layer * 1024 * 1024, ntok, 1024, 1024, epi, bid, nblk, smem);
}
__device__ __forceinline__ void phase_gemm_q(const Params& p, int layer, int ntok, int bid, int nblk, unsigned char* smem) {
  pg8::EpiBf16 epi{p.cols  , 2048, 2048};
  run_gemm(p.abuf, p.wt_q + (size_t)layer * 2048 * 1024, ntok, 2048, 1024, epi, bid, nblk, smem);
}

template <int L>
__device__ __forceinline__ void layer_body(const Params& p, const XcdBarrier& bar, const XcdInfo xin, int bid, int nblk, unsigned char* smem) {
  constexpr int l = L;
  constexpr int ntok = L == 0 ? TT : TL;
  for (int rep = 0; rep < REP_GEMM; ++rep) phase_gemm_in(p, l, bid, nblk, smem);
  xcd_barrier(bar);
  for (int rep = 0; rep < REP_MIX; ++rep) {
    phase_s5a(p, l, bid, nblk, smem);
    if (REP_S5 > 1) phase_s5a(p, l, bid, nblk, smem);
    for (int r2 = 0; r2 < REP_GLA; ++r2) phase_glaa(p, l, bid, nblk, smem);
  }
  xcd_barrier(bar);
  phase_scan(p, l, bid, nblk);
  for (int r2 = 0; r2 < REP_SGU; ++r2) phase_sgu(p, l, ntok / 128, bid, nblk, smem);
  xcd_barrier(bar);
  for (int rep = 0; rep < REP_MIX; ++rep) {
    phase_s5c(p, l, ntok / 64, bid, nblk, smem);
    if (REP_S5 > 1) phase_s5c(p, l, ntok / 64, bid, nblk, smem);
    for (int r2 = 0; r2 < REP_GLA; ++r2) phase_glac(p, l, ntok / 64, bid, nblk, smem);
  }
  xcd_barrier(bar);
  for (int rep = 0; rep < REP_GEMM; ++rep) phase_gemm_glu(p, l, ntok, bid, nblk, smem);
  xcd_barrier(bar);
  if (REP_GEMM > 1) {
    pg8::EpiBf16 epi{p.abuf, 1024, 1024};
    for (int rep = 1; rep < REP_GEMM; ++rep) run_gemm(p.mix, p.wt_out + (size_t)l * 1024 * 1024, ntok, 1024, 1024, epi, bid, nblk, smem);
  }
  phase_gemm_out(p, l, ntok, bid, nblk, smem);
  if (l == 0 && nblk > 16 && bid >= 16) {
    const int tid = opaque_tid();
    for (int j = bid - 16; j < 2048; j += nblk - 16) convert_rows(p, (j >> 10) * 2048 + 1024 + (j & 1023), tid);
  } else if (l == 0 && nblk <= 16) {
    const int tid = opaque_tid();
    for (int j = bid; j < 2048; j += nblk) convert_rows(p, (j >> 10) * 2048 + 1024 + (j & 1023), tid);
  }
  xcd_barrier(bar);
  for (int rep = 0; rep < REP_PRO; ++rep)
    phase_normmod(p, p.xres, p.xres + (size_t)TL * 1024, p.norm2_g + l * 1024, p.modv + (size_t)l * 5 * NMOD, 3072, 4096, ntok, 0, bid, nblk);
  xcd_barrier(bar);
  for (int rep = 0; rep < REP_GEMM; ++rep) phase_gemm_q(p, l, ntok, bid, nblk, smem);
  xcd_barrier(bar);
  for (int rep = 0; rep < REP_ROUTE; ++rep) phase_route(p, l, ntok, bid, nblk, smem);
  xcd_barrier(bar);
  phase_gather_u(p, l, ntok, xin, smem);
  if (REP_GATHER == 2) phase_gather_u(p, l, ntok, xin, smem);
  xcd_barrier(bar);
  phase_gather_r(p, l, ntok, bid, nblk);
  xcd_barrier(bar);
  if (REP_GATHER > 2) phase_gather_v<true>(p, l, ntok, xin, smem);
  phase_gather_v<false>(p, l, ntok, xin, smem);
  xcd_barrier(bar);
  phase_gather_norm(p, l, ntok, bid, nblk);
  if (l == 0) xcd_barrier(bar);
}

#define SMEM_BYTES (148 * 1024)
__global__ void __launch_bounds__(NT) mega_kernel(Params p) {
  __shared__ __attribute__((aligned(16))) unsigned char smem[SMEM_BYTES + 16];
  const int bid = blockIdx.x, nblk = gridDim.x;
  volatile LAS unsigned* xbw = (volatile LAS unsigned*)(smem + SMEM_BYTES);
  if (threadIdx.x == 0) { xbw[0] = 0u; xbw[1] = 0u; xbw[2] = 0u; xbw[3] = 0u; }
  __syncthreads();
  XcdBarrier bar = xcd_barrier_post(p.bar, xbw);
  for (int rep = 0; rep < REP_PRO; ++rep) {
    phase_mod(p, bid, nblk, smem);
    phase_wprep(p, bid, nblk, smem);
  }
  xcd_barrier(bar);
  for (int rep = 0; rep < REP_PRO; ++rep) phase_normmod(p, p.x, p.ctx, p.norm1_g, p.modv, 0, 1024, TT, 1, bid, nblk);
  xcd_barrier(bar);
  const XcdInfo xin = xcd_info(bar);
  layer_body<0>(p, bar, xin, bid, nblk, smem);
  layer_body<1>(p, bar, xin, bid, nblk, smem);
}

static inline size_t align_up(size_t v, size_t a) { return (v + a - 1) / a * a; }

extern "C" void kernel_launch(void* const* d_in, const int* in_sizes, int n_in, void* d_out, int out_size, void* d_ws, size_t ws_size,
                              hipStream_t stream) {
  Params p{};
  const float* const* in = (const float* const*)d_in;
  p.x = in[0]; p.c = in[1]; p.ctx = in[2]; p.c_ctx = in[3]; p.w_mod = in[4]; p.b_mod = in[5]; p.norm1_g = in[6]; p.norm2_g = in[7];
  p.w_in = in[8]; p.w_out = in[9]; p.sgu_w = in[10]; p.sgu_b = in[11]; p.lam_re = in[12]; p.lam_im = in[13]; p.b_re = in[14]; p.b_im = in[15];
  p.c_re = in[16]; p.c_im = in[17]; p.log_step = in[18]; p.s5_d = in[19]; p.w_glu = in[20]; p.gla_wg = in[21]; p.gla_bg = in[22]; p.gla_ng = in[23];
  p.w_query = in[24]; p.sub_keys = in[25]; p.exp_u = in[26]; p.exp_v = in[27]; p.final_g = in[28];
  p.out = (float*)d_out;
  unsigned char* w = (unsigned char*)d_ws;
  size_t off = 0;
  auto take = [&](size_t bytes) { void* r = w + off; off = align_up(off + bytes, 256); return r; };
  p.bar = (unsigned*)take(16384);
  p.xres = (float*)take((size_t)TT * 1024 * 4);
  p.modv = (float*)take((size_t)2 * 5 * NMOD * 4);
  p.abuf = (bf16_t*)take((size_t)TT * 1024 * 2);
  p.cols = (bf16_t*)take((size_t)TT * INW * 2);
  p.mix = (bf16_t*)take((size_t)TT * 1024 * 2);
  p.yg = (bf16_t*)take((size_t)TT * 256 * 2);
  p.wt_in = (bf16_t*)take((size_t)2 * INWP * 1024 * 2);
  p.wt_out = (bf16_t*)take((size_t)2 * 1024 * 1024 * 2);
  p.wt_q = (bf16_t*)take((size_t)2 * 2048 * 1024 * 2);
  p.wt_glu = (bf16_t*)take((size_t)2 * 512 * 256 * 2);
  p.keysb = (bf16_t*)take((size_t)2 * 2 * 8 * 128 * 128 * 2);
  p.sgu_wb = (bf16_t*)take((size_t)2 * 4 * 128 * 128 * 2);
  p.s5a = (float*)take((size_t)4096 * 2 * 4);
  p.s5a64 = (float*)take((size_t)4096 * 2 * 4);
  p.s5bb = (float*)take((size_t)4096 * 32 * 4);
  p.s5K = (bf16_t*)take((size_t)64 * 16384 * 2);
  p.s5M1 = (bf16_t*)take((size_t)64 * 131072 * 2);
  p.s5N2 = (bf16_t*)take((size_t)64 * 131072 * 2);
  p.s5S = (float*)take((size_t)2 * NSC * 16 * 64 * 2 * 4);
  p.s5H = (float*)take((size_t)2 * NSC * 16 * 64 * 2 * 4);
  p.gkv = (float*)take((size_t)2 * NSC * 8 * 2048 * 4);
  p.gdec = (float*)take((size_t)2 * NSC * 8 * 32 * 4);
  p.eu8 = (unsigned char*)take((size_t)2 * 16384 * 1024);
  p.ev8 = (unsigned char*)take((size_t)2 * 16384 * 1024);
  p.su = (float*)take((size_t)2 * 16384 * 4);
  p.sv = (float*)take((size_t)2 * 16384 * 4);
  p.glb = (float*)take((size_t)2 * TT * 256 * 4);
  p.wbuf = (float*)take((size_t)TT * 128 * 4);
  p.ssbuf = (float*)take((size_t)TT * 8 * 4);
  p.pidx = (int*)take((size_t)TT * 128 * 4);
  p.pgate = (float*)take((size_t)TT * 128 * 4);
  if (off > ws_size) { fprintf(stderr, "workspace too small: need %zu have %zu\n", off, ws_size); return; }

  (void)hipMemsetAsync(p.bar, 0, XCD_BAR_WORDS * 4, stream);
  static int grid_blocks = 0;
  if (!grid_blocks) {
    int dev = 0, cus = 0, per_cu = 0;
    (void)hipGetDevice(&dev);
    (void)hipDeviceGetAttribute(&cus, hipDeviceAttributeMultiprocessorCount, dev);
    (void)hipOccupancyMaxActiveBlocksPerMultiprocessor(&per_cu, (const void*)mega_kernel, NT, 0);
    if (per_cu < 1) { fprintf(stderr, "occupancy query says 0 blocks/CU\n"); per_cu = 1; }
    grid_blocks = cus;
  }
  void* args[] = {&p};
  hipError_t e = hipLaunchCooperativeKernel((const void*)mega_kernel, dim3(grid_blocks), dim3(NT), args, 0, stream);
  if (e != hipSuccess) fprintf(stderr, "cooperative launch failed: %s (grid %d)\n", hipGetErrorString(e), grid_blocks);
}
```

```cpp
#include <hip/hip_runtime.h>
#include <cstdio>
#include <cstdint>
#include <cmath>

typedef unsigned short bf16_t;
typedef short bf16x8 __attribute__((ext_vector_type(8)));
typedef float f32x4 __attribute__((ext_vector_type(4)));

#define DM 1024
#define NBATCH 4
#define SEQ 4096
#define CTXL 256
#define TL (NBATCH * SEQ)
#define TC (NBATCH * CTXL)
#define TT (TL + TC)
#define INW 2336
#define INWP 2560
#define NMOD 6144
#define NSC 272
#define EPSV 1e-6f
#define NT 512
#define NW 8
#ifndef REP_GATHER
#define REP_GATHER 1
#endif
#ifndef REP_ROUTE
#define REP_ROUTE 1
#endif
#ifndef REP_GEMM
#define REP_GEMM 1
#endif
#ifndef REP_MIX
#define REP_MIX 1
#endif
#ifndef REP_PRO
#define REP_PRO 1
#endif
#ifndef REP_SGU
#define REP_SGU 1
#endif
#ifndef REP_S5
#define REP_S5 1
#endif
#ifndef REP_GLA
#define REP_GLA 1
#endif

#define C_SGU_U 0
#define C_SGU_V 256
#define C_S5 512
#define C_GQ 768
#define C_GK 1024
#define C_GV 1280
#define C_GG 1792
#define C_ZF 2304

struct Params {
  const float *x, *c, *ctx, *c_ctx, *w_mod, *b_mod, *norm1_g, *norm2_g, *w_in, *w_out, *sgu_w, *sgu_b;
  const float *lam_re, *lam_im, *b_re, *b_im, *c_re, *c_im, *log_step, *s5_d, *w_glu, *gla_wg, *gla_bg, *gla_ng;
  const float *w_query, *sub_keys, *exp_u, *exp_v, *final_g;
  float* out;
  unsigned* bar;
  float* xres;
  float* modv;
  bf16_t* abuf;
  bf16_t* cols;
  bf16_t* mix;
  bf16_t* yg;
  bf16_t *wt_in, *wt_out, *wt_q, *wt_glu, *keysb, *sgu_wb;
  float *s5a, *s5a64, *s5bb;
  bf16_t *s5K, *s5M1, *s5N2;
  float *s5S, *s5H;
  float *gkv, *gdec;
  unsigned char *eu8, *ev8;
  float *su, *sv;
  float* glb;
  float *wbuf, *ssbuf;
  int* pidx;
  float* pgate;
};

__device__ __forceinline__ bf16_t f2bf(float f) {
  unsigned u = __float_as_uint(f);
  u += 0x7fffu + ((u >> 16) & 1u);
  return (bf16_t)(u >> 16);
}
__device__ __forceinline__ float bf2f(bf16_t h) { return __uint_as_float(((unsigned)h) << 16); }
__device__ __forceinline__ bf16x8 pack_bf16x8(const float* v) {
  bf16x8 r;
#pragma unroll
  for (int c = 0; c < 8; ++c) r[c] = (short)f2bf(v[c]);
  return r;
}

__device__ __forceinline__ float bflo(unsigned u) { return __uint_as_float(u << 16); }
__device__ __forceinline__ float bfhi(unsigned u) { return __uint_as_float(u & 0xffff0000u); }
__device__ __forceinline__ float gelu_f(float x) {
  const float y = 0.7978845608028654f * (x + 0.044715f * x * x * x);
  const float e = __expf(2.f * y);
  const float th = 1.f - 2.f / (1.f + e);
  return 0.5f * x * (1.f + th);
}
__device__ __forceinline__ float sigmoid_f(float x) { return 1.f / (1.f + __expf(-x)); }
__device__ __forceinline__ float silu_f(float x) { return x * sigmoid_f(x); }
__device__ __forceinline__ float logsigmoid_f(float x) { return fminf(x, 0.f) - log1pf(__expf(-fabsf(x))); }
__device__ __forceinline__ float wave_sum(float v) {
#pragma unroll
  for (int o = 32; o > 0; o >>= 1) v += __shfl_xor(v, o);
  return v;
}
__device__ __forceinline__ int opaque_tid() { int t = threadIdx.x; asm volatile("" : "+v"(t)); return t; }
__device__ __forceinline__ int tok_batch(int t) { return t < TL ? (t >> 12) : 4; }
__device__ __forceinline__ int s5_tok(int sc, int i) { return sc < 256 ? ((sc >> 6) * SEQ + (sc & 63) * 64 + i) : (TL + (sc - 256) * 64 + i); }
__device__ __forceinline__ int gla_tok(int sc, int i) { return sc < 256 ? ((sc >> 6) * SEQ + i * 64 + (sc & 63)) : (TL + (sc - 256) * 64 + i); }


#define XB_TMO      128
#define XB_XCNT(j)  (256  + 64 * (j))
#define XB_XSUB(j)  (1280 + 64 * (j))
#define XB_XGEN(j)  (2304 + 64 * (j))
#define XB_TOP      3328
#define XB_TOPGEN   3392
#define XCD_BAR_WORDS 3456
#define XB_SPIN_CAP (1u << 22)
#define LAS __attribute__((address_space(3)))
__device__ __forceinline__ unsigned xb_ld(unsigned* p)              { return __hip_atomic_load(p, __ATOMIC_RELAXED, __HIP_MEMORY_SCOPE_AGENT); }
__device__ __forceinline__ unsigned xb_add(unsigned* p, unsigned v) { return __hip_atomic_fetch_add(p, v, __ATOMIC_RELAXED, __HIP_MEMORY_SCOPE_AGENT); }
__device__ __forceinline__ unsigned xb_xcc_id() { return (unsigned)__builtin_amdgcn_s_getreg((3 << 11) | 20) & 0xFu; }
#define XB_SPIN(cond, bar) do { unsigned _sp = 0; while (cond) { __builtin_amdgcn_s_sleep(1); \
    if ((++_sp & 255u) == 0u) { if (xb_ld(&(bar)[XB_TMO])) break; if (_sp > XB_SPIN_CAP) { atomicAdd(&(bar)[XB_TMO], 1u); break; } } } } while (0)
struct XcdBarrier { unsigned* bar; unsigned x; volatile LAS unsigned* st; };
__device__ __forceinline__ XcdBarrier xcd_barrier_post(unsigned* bar, volatile LAS unsigned* st) {
  XcdBarrier b; b.bar = bar; b.x = xb_xcc_id(); b.st = st;
  if (threadIdx.x == 0) st[2] = xb_add(&bar[XB_XCNT(b.x)], 1u);
  return b;
}
__device__ __forceinline__ void xcd_barrier_complete(unsigned* bar, unsigned x, unsigned& nloc, unsigned& nx) {
  const unsigned G = gridDim.x * gridDim.y * gridDim.z;
  unsigned sum, cnt, mine, sp = 0u;
  for (;;) {
    sum = 0u; cnt = 0u; mine = 0u;
#pragma unroll
    for (unsigned j = 0; j < 16; ++j) { const unsigned c = xb_ld(&bar[XB_XCNT(j)]); sum += c; cnt += (c > 0u) ? 1u : 0u; mine = (j == x) ? c : mine; }
    if (sum == G) break;
    __builtin_amdgcn_s_sleep(1);
    if ((++sp & 255u) == 0u) { if (xb_ld(&bar[XB_TMO])) break; if (sp > XB_SPIN_CAP) { atomicAdd(&bar[XB_TMO], 1u); break; } }
  }
  nloc = mine > 0u ? mine : 1u; nx = cnt > 0u ? cnt : 1u;
}
__device__ __forceinline__ void xcd_barrier(const XcdBarrier& b) {
  asm volatile("s_waitcnt vmcnt(0)" ::: "memory");
  __syncthreads();
  if (threadIdx.x == 0) {
    unsigned* bar = b.bar;
    __builtin_amdgcn_s_waitcnt(0);
    unsigned nloc = b.st[0], nx = b.st[1];
    if (nloc == 0u) { xcd_barrier_complete(bar, b.x, nloc, nx); b.st[0] = nloc; b.st[1] = nx; }
    const unsigned old = xb_add(&bar[XB_XSUB(b.x)], 1u);
    const unsigned gen = old / nloc;
    if (old + 1u == (gen + 1u) * nloc) {
      __builtin_amdgcn_fence(__ATOMIC_RELEASE, "agent");
      asm volatile("s_waitcnt vmcnt(0)" ::: "memory");
      const unsigned og = xb_add(&bar[XB_TOP], 1u);
      const unsigned tg = og / nx;
      if (og + 1u == (tg + 1u) * nx) xb_add(&bar[XB_TOPGEN], 1u);
      else XB_SPIN(xb_ld(&bar[XB_TOPGEN]) == tg, bar);
      __builtin_amdgcn_fence(__ATOMIC_ACQUIRE, "agent");
      xb_add(&bar[XB_XGEN(b.x)], 1u);
      asm volatile("s_waitcnt vmcnt(0)" ::: "memory");
    } else {
      XB_SPIN(xb_ld(&bar[XB_XGEN(b.x)]) == gen, bar);
      __builtin_amdgcn_fence(__ATOMIC_ACQUIRE, "agent");
      asm volatile("s_waitcnt vmcnt(0)" ::: "memory");
    }
  }
  __syncthreads();
}

__device__ __forceinline__ void phase_mod(const Params& p, int bid, int nblk, unsigned char* smem) {
  float* sil = (float*)smem;
  float* red = sil + 5 * 1024;
  const int tid = opaque_tid();
  for (int i = tid; i < 5 * 1024; i += NT) {
    const int r = i >> 10, k = i & 1023;
    const float v = r < 4 ? p.c[r * 1024 + k] : p.c_ctx[k];
    sil[i] = silu_f(v);
  }
  __syncthreads();
  for (int item = bid; item < 192; item += nblk) {
    const int l = item / 96, j0 = (item % 96) * 64;
    const int cc = tid & 63, kg = tid >> 6;
    float acc[5] = {0.f, 0.f, 0.f, 0.f, 0.f};
    const float* w = p.w_mod + (size_t)l * 1024 * NMOD + j0 + cc;
#pragma unroll 32
    for (int k = kg * 128; k < kg * 128 + 128; ++k) {
      const float wv = w[(size_t)k * NMOD];
#pragma unroll
      for (int r = 0; r < 5; ++r) acc[r] += sil[r * 1024 + k] * wv;
    }
#pragma unroll
    for (int r = 0; r < 5; ++r) red[(kg * 5 + r) * 64 + cc] = acc[r];
    __syncthreads();
    if (tid < 320) {
      const int r = tid >> 6;
      float s = 0.f;
#pragma unroll
      for (int g = 0; g < 8; ++g) s += red[(g * 5 + r) * 64 + cc];
      p.modv[((size_t)l * 5 + r) * NMOD + j0 + cc] = s + p.b_mod[l * NMOD + j0 + cc];
    }
    __syncthreads();
  }
}

__device__ __forceinline__ void transpose_tile(const float* src, int ldsrc, bf16_t* dst, int lddst, int k0, int r0, int nsrc, int glu, float* tile) {
  const int tid = opaque_tid();
  const int j = tid & 63;
  const int r = r0 + j;
  int scol;
  if (glu) {
    const int pn = r >> 8, bj = (r >> 7) & 1, i = r & 127;
    scol = bj * 256 + pn * 128 + i;
  } else {
    scol = r < nsrc ? r : -1;
  }
  float v[32];
#pragma unroll
  for (int it = 0; it < 32; ++it) {
    const int kk = (tid >> 6) + it * 8;
    v[it] = scol >= 0 ? src[(size_t)(k0 + kk) * ldsrc + scol] : 0.f;
  }
#pragma unroll
  for (int it = 0; it < 32; ++it) {
    const int kk = (tid >> 6) + it * 8;
    tile[(kk >> 6) * 4160 + (kk & 63) * 65 + j] = v[it];
  }
  __syncthreads();
  const int kq = tid & 63;
#pragma unroll
  for (int it = 0; it < 32; ++it) {
    const int jj = (tid >> 6) + (it & 7) * 8, sub = it >> 3;
    dst[(size_t)(r0 + jj) * lddst + k0 + sub * 64 + kq] = f2bf(tile[sub * 4160 + kq * 65 + jj]);
  }
  __syncthreads();
}

__device__ __forceinline__ void s5_tables(const Params& p, int id, int part, unsigned char* smem) {
  const int tid = opaque_tid();
  float2* Apow = (float2*)smem;
  float2* Bbs = Apow + 65 * 64;
  float2* Cs = Bbs + 64 * 16;
  __syncthreads();
  if (tid < 64) {
    const int pid = id * 64 + tid;
    double lre = (double)p.lam_re[pid];
    if (lre > -1e-4) lre = -1e-4;
    const double lim = (double)p.lam_im[pid];
    const double dt = exp((double)p.log_step[id]);
    const double mag = exp(lre * dt);
    const double are = mag * cos(lim * dt), aim = mag * sin(lim * dt);
    {
      double pr = 1.0, pi = 0.0;
      for (int n = 0; n <= 64; ++n) {
        Apow[n * 64 + tid] = make_float2((float)pr, (float)pi);
        const double nr = pr * are - pi * aim, ni = pr * aim + pi * are;
        pr = nr; pi = ni;
      }
    }
    const double den = lre * lre + lim * lim;
    const double fre = ((are - 1.0) * lre + aim * lim) / den;
    const double fim = (aim * lre - (are - 1.0) * lim) / den;
    for (int h = 0; h < 16; ++h) {
      const double br = (double)p.b_re[(size_t)pid * 16 + h], bi = (double)p.b_im[(size_t)pid * 16 + h];
      Bbs[tid * 16 + h] = make_float2((float)(fre * br - fim * bi), (float)(fre * bi + fim * br));
    }
  }
  for (int e = tid; e < 1024; e += NT) Cs[e] = make_float2(p.c_re[(size_t)id * 1024 + e], p.c_im[(size_t)id * 1024 + e]);
  __syncthreads();
  bf16_t* Kt = p.s5K + (size_t)id * 16384;
  for (int e = part * 2048 + tid; e < part * 2048 + 2048; e += NT) {
    const int d = e >> 8, hp = (e >> 4) & 15, h = e & 15;
    float acc = 0.f;
    for (int pp = 0; pp < 64; ++pp) {
      const float2 c = Cs[hp * 64 + pp], a = Apow[d * 64 + pp], b = Bbs[pp * 16 + h];
      const float cr = c.x * a.x - c.y * a.y, ci = c.x * a.y + c.y * a.x;
      acc += cr * b.x - ci * b.y;
    }
    Kt[e] = f2bf(acc);
  }
  bf16_t* M1 = p.s5M1 + (size_t)id * 131072;
  for (int e = part * 16384 + tid; e < part * 16384 + 16384; e += NT) {
    const int c = e >> 10, k = e & 1023, ri = c >> 6, pp = c & 63, tau = k >> 4, h = k & 15;
    const float2 a = Apow[(63 - tau) * 64 + pp], b = Bbs[pp * 16 + h];
    M1[e] = f2bf(ri ? (a.x * b.y + a.y * b.x) : (a.x * b.x - a.y * b.y));
  }
  bf16_t* N2 = p.s5N2 + (size_t)id * 131072;
  for (int e = part * 16384 + tid; e < part * 16384 + 16384; e += NT) {
    const int col = e >> 7, kk = e & 127, tau = col >> 4, hp = col & 15, ri = kk >> 6, pp = kk & 63;
    const float2 c = Cs[hp * 64 + pp], a = Apow[(tau + 1) * 64 + pp];
    N2[e] = f2bf(ri ? -(c.x * a.y + c.y * a.x) : (c.x * a.x - c.y * a.y));
  }
  __syncthreads();
}

__device__ __forceinline__ void convert_rows(const Params& p, int it, int tid) {
      const int lane = tid & 63;
      const int row0 = it * 16 + (tid >> 6) * 2;
      const int tab = row0 >> 15, r0 = row0 & 32767;
      const float* s = (tab ? p.exp_v : p.exp_u) + (size_t)r0 * 1024 + lane * 16;
      f32x4 v[2][4];
#pragma unroll
      for (int rr = 0; rr < 2; ++rr)
#pragma unroll
        for (int q = 0; q < 4; ++q) v[rr][q] = *(const f32x4*)(s + rr * 1024 + q * 4);
#pragma unroll
      for (int rr = 0; rr < 2; ++rr) {
        float m = 0.f;
#pragma unroll
        for (int q = 0; q < 4; ++q) m = fmaxf(m, fmaxf(fmaxf(fabsf(v[rr][q][0]), fabsf(v[rr][q][1])), fmaxf(fabsf(v[rr][q][2]), fabsf(v[rr][q][3]))));
#pragma unroll
        for (int o = 32; o > 0; o >>= 1) m = fmaxf(m, __shfl_xor(m, o));
        const float scale = m > 0.f ? m * (1.f / 400.f) : 1.f;
        const float inv = 1.f / scale;
        unsigned wv[4];
#pragma unroll
        for (int q = 0; q < 4; ++q) {
          unsigned w = 0;
          w = __builtin_amdgcn_cvt_pk_fp8_f32(v[rr][q][0] * inv, v[rr][q][1] * inv, w, false);
          w = __builtin_amdgcn_cvt_pk_fp8_f32(v[rr][q][2] * inv, v[rr][q][3] * inv, w, true);
          wv[q] = w;
        }
        *(uint4*)((tab ? p.ev8 : p.eu8) + (size_t)(r0 + rr) * 1024 + lane * 16) = make_uint4(wv[0], wv[1], wv[2], wv[3]);
        if (lane == 0) (tab ? p.sv : p.su)[r0 + rr] = scale;
      }
}

__device__ __forceinline__ void phase_wprep(const Params& p, int bid, int nblk, unsigned char* smem) {
  float* tile = (float*)smem;
  const int tid = opaque_tid();
  const int NT_L = 360;
  const int n_tr = 2 * NT_L;
  const int n_keys = 256 + 64;
  const int n_disc = 8;
  const int n_exp = 2048;
  const int n_s5t = 512;
  const int total = n_tr + n_keys + n_disc + n_exp + n_s5t;
  for (int item0 = bid; item0 < total; item0 += nblk) {
    const int item = item0 - n_s5t;
    if (item0 < n_s5t) {
      s5_tables(p, item0 >> 3, item0 & 7, smem);
    } else if (item < n_tr) {
      const int l = item / NT_L;
      int t = item % NT_L;
      if (t < 160) {
        transpose_tile(p.w_in + (size_t)l * 1024 * INW, INW, p.wt_in + (size_t)l * INWP * 1024, 1024, (t % 4) * 256, (t / 4) * 64, INW, 0, tile);
      } else if (t < 224) {
        t -= 160;
        transpose_tile(p.w_out + (size_t)l * 1024 * 1024, 1024, p.wt_out + (size_t)l * 1024 * 1024, 1024, (t % 4) * 256, (t / 4) * 64, 1024, 0, tile);
      } else if (t < 352) {
        t -= 224;
        transpose_tile(p.w_query + (size_t)l * 1024 * 2048, 2048, p.wt_q + (size_t)l * 2048 * 1024, 1024, (t % 4) * 256, (t / 4) * 64, 2048, 0, tile);
      } else {
        t -= 352;
        transpose_tile(p.w_glu + (size_t)l * 256 * 512, 512, p.wt_glu + (size_t)l * 512 * 256, 256, 0, t * 64, 512, 1, tile);
      }
    } else if (item < n_tr + n_keys) {
      const int ki = item - n_tr;
      if (ki < 256) {
        const int base = ki * 2048;
        for (int i = tid; i < 2048; i += NT) p.keysb[base + i] = f2bf(p.sub_keys[base + i]);
      } else {
        const int base = (ki - 256) * 2048;
        for (int i = tid; i < 2048; i += NT) p.sgu_wb[base + i] = f2bf(p.sgu_w[base + i]);
      }
    } else if (item >= n_tr + n_keys + n_disc) {
      const int j = item - (n_tr + n_keys + n_disc);
      convert_rows(p, (j >> 10) * 2048 + (j & 1023), tid);
    } else {
      const int id = (item - n_tr - n_keys) * NT + tid;
      const int g = (id >> 6) & 15;
      const int ldg = id >> 6;
      double lre = (double)p.lam_re[id];
      if (lre > -1e-4) lre = -1e-4;
      const double lim = (double)p.lam_im[id];
      const double dt = exp((double)p.log_step[ldg]);
      const double mag = exp(lre * dt);
      const double are = mag * cos(lim * dt), aim = mag * sin(lim * dt);
      const double den = lre * lre + lim * lim;
      const double fre = ((are - 1.0) * lre + aim * lim) / den;
      const double fim = (aim * lre - (are - 1.0) * lim) / den;
      p.s5a[id * 2 + 0] = (float)are;
      p.s5a[id * 2 + 1] = (float)aim;
      double pr = are, pi = aim;
      for (int s = 0; s < 6; ++s) { const double nr = pr * pr - pi * pi, ni = 2.0 * pr * pi; pr = nr; pi = ni; }
      p.s5a64[id * 2 + 0] = (float)pr;
      p.s5a64[id * 2 + 1] = (float)pi;
      for (int h = 0; h < 16; ++h) {
        const double br = (double)p.b_re[(size_t)id * 16 + h], bi = (double)p.b_im[(size_t)id * 16 + h];
        p.s5bb[(size_t)id * 32 + h] = (float)(fre * br - fim * bi);
        p.s5bb[(size_t)id * 32 + 16 + h] = (float)(fre * bi + fim * br);
      }
      (void)g;
    }
  }
}

__device__ __forceinline__ void phase_normmod(const Params& p, const float* src_l, const float* src_c, const float* gain, const float* modl, int shift_off, int scale_off,
                              int ntok, int copy, int bid, int nblk) {
  const int tid = opaque_tid(); const int lane = tid & 63, wid = tid >> 6;
  for (int t = bid * NW + wid; t < ntok; t += nblk * NW) {
    const float* row = t < TL ? src_l + (size_t)t * 1024 : src_c + (size_t)(t - TL) * 1024;
    const float* md = modl + (size_t)tok_batch(t) * NMOD;
    f32x4 v[4];
    float ss = 0.f;
#pragma unroll
    for (int j = 0; j < 4; ++j) {
      v[j] = *(const f32x4*)(row + j * 256 + lane * 4);
      ss += v[j][0] * v[j][0] + v[j][1] * v[j][1] + v[j][2] * v[j][2] + v[j][3] * v[j][3];
    }
    ss = wave_sum(ss);
    const float rstd = rsqrtf(ss * (1.f / 1024.f) + EPSV);
#pragma unroll
    for (int j = 0; j < 4; ++j) {
      const int c0 = j * 256 + lane * 4;
      const f32x4 g = *(const f32x4*)(gain + c0);
      const f32x4 sh = *(const f32x4*)(md + shift_off + c0);
      const f32x4 sc = *(const f32x4*)(md + scale_off + c0);
      ushort4 o;
      o.x = f2bf(v[j][0] * rstd * g[0] * (1.f + sc[0]) + sh[0]);
      o.y = f2bf(v[j][1] * rstd * g[1] * (1.f + sc[1]) + sh[1]);
      o.z = f2bf(v[j][2] * rstd * g[2] * (1.f + sc[2]) + sh[2]);
      o.w = f2bf(v[j][3] * rstd * g[3] * (1.f + sc[3]) + sh[3]);
      *(ushort4*)(p.abuf + (size_t)t * 1024 + c0) = o;
      if (copy) *(f32x4*)(p.xres + (size_t)t * 1024 + c0) = v[j];
    }
  }
}

namespace pg8 {
#define PG8_LAS __attribute__((address_space(3)))
typedef unsigned u32x4 __attribute__((ext_vector_type(4)));
constexpr int BM = 256, BK = 64, HALF = 128, HTB = HALF * BK * 2, STAGE_BYTES = 8 * HTB, NXCD = 8, WGM = 8;
__device__ __forceinline__ int lds_byte(int r, int c) { const int st = (r >> 4) * 2 + (c >> 5), rr = r & 15, cc = c & 31, ob = rr * 64 + cc * 2; return st * 1024 + (ob ^ (((ob >> 9) & 1) << 5)); }
__device__ __forceinline__ void stage_rc(int b, int& R, int& C) { const int st = b / 1024, sb = b % 1024, swz = sb ^ (((sb >> 9) & 1) << 5); R = (st >> 1) * 16 + swz / 64; C = (st & 1) * 32 + (swz % 64) / 2; }
__device__ __forceinline__ int perm32(int rho) { const int n = rho >> 4, i = rho & 15; return 8 * (i >> 2) + 4 * n + (i & 3); }
struct Unit { int pm, pn; };
struct Gemm { const bf16_t* A; const bf16_t* Bt; int M, N, K; };
struct StaticOrder {
  int nM, nN, nwg, G, c;
  __device__ void init(int M, int N, int G_, int c_) { nM = M / BM; nN = N / BM; nwg = nM * nN; G = G_; c = c_; }
  __device__ bool next(int i, Unit& u) const {
    const long L = (long)i * G + c; if (L >= nwg) return false;
    int wgid = (int)L; { const int q = nwg / NXCD, r = nwg % NXCD, xcd = wgid % NXCD, off = wgid / NXCD; wgid = (xcd < r ? xcd * (q + 1) : r * (q + 1) + (xcd - r) * q) + off; }
    const int nig = WGM * nN, gid = wgid / nig, fm = gid * WGM, gsz = (nM - fm) < WGM ? (nM - fm) : WGM;
    u.pm = fm + ((wgid % nig) % gsz); u.pn = (wgid % nig) / gsz; return true;
  }
};
__device__ __forceinline__ unsigned cvt_pk_bf16(float lo, float hi) { unsigned r; asm volatile("v_cvt_pk_bf16_f32 %0, %1, %2" : "=v"(r) : "v"(lo), "v"(hi)); return r; }

template <class Epi>
__device__ __forceinline__ void gemm_phase(PG8_LAS unsigned char* lds, const Gemm g, const StaticOrder& S, const Epi& E) {
  const int tid = opaque_tid(), wid = __builtin_amdgcn_readfirstlane(tid >> 6), lane = tid & 63, wr = wid >> 2, wc = wid & 3, fr = lane & 15, fq = lane >> 4;
  const int K = g.K, nt = K / BK;
  unsigned voffA[2], voffB[2];
#pragma unroll
  for (int i = 0; i < 2; ++i) { int R, C; stage_rc(tid * 16 + i * 8192, R, C); const int Rb = Epi::PERM ? ((R & ~31) + perm32(R & 31)) : R;
    voffA[i] = (unsigned)(R * K + C) * 2u; voffB[i] = (unsigned)(Rb * K + C) * 2u; }
  const size_t kstep = (size_t)(BK * 2);
  const size_t hstep = (size_t)HALF * K * 2;
  const size_t tstep = 2 * hstep;
  const unsigned ldsw = (unsigned)wid * 1024u;
  const int aoff = lds_byte(wr * 64 + fr, fq * 8), boff = lds_byte(wc * 32 + fr, fq * 8);
#define PG8_SA(b, h) (((b) * 2 + (h)) * HTB)
#define PG8_SB(b, h) ((4 + (b) * 2 + (h)) * HTB)
#define PG8_STAGE(bufoff, gbase, voff) do { _Pragma("unroll") for (int _i = 0; _i < 2; ++_i) \
    __builtin_amdgcn_global_load_lds((const unsigned*)((const char*)(gbase) + (voff)[_i]), (PG8_LAS unsigned*)(lds + (bufoff) + ldsw + _i * 8192), 16, 0, 0); } while (0)
#define PG8_LDA(dst, b, h) do { _Pragma("unroll") for (int m = 0; m < 4; ++m) _Pragma("unroll") for (int k = 0; k < 2; ++k) dst[m][k] = *(const PG8_LAS bf16x8*)(lds + PG8_SA(b, h) + aoff + m * 2048 + k * 1024); } while (0)
#define PG8_LDB(dst, b, h) do { _Pragma("unroll") for (int n = 0; n < 2; ++n) _Pragma("unroll") for (int k = 0; k < 2; ++k) dst[n][k] = *(const PG8_LAS bf16x8*)(lds + PG8_SB(b, h) + boff + n * 2048 + k * 1024); } while (0)
#define PG8_MMA(ai, bj, At, Bt) do { __builtin_amdgcn_s_setprio(1); _Pragma("unroll") for (int m = 0; m < 4; ++m) _Pragma("unroll") for (int n = 0; n < 2; ++n) _Pragma("unroll") for (int k = 0; k < 2; ++k) \
    acc[ai][bj][m][n] = __builtin_amdgcn_mfma_f32_16x16x32_bf16(Bt[n][k], At[m][k], acc[ai][bj][m][n], 0, 0, 0); __builtin_amdgcn_s_setprio(0); } while (0)
#define PG8_WAIT_V(n) asm volatile("s_waitcnt vmcnt(" #n ")" ::: "memory")
#define PG8_WAIT_L(n) asm volatile("s_waitcnt lgkmcnt(" #n ")" ::: "memory")
#define PG8_BAR __builtin_amdgcn_s_barrier()
#define PG8_SCHED __builtin_amdgcn_sched_barrier(0)
  Unit cur, nxt; int ui = 0;
  if (!S.next(0, cur)) return;
  f32x4 acc[2][2][4][2];
#pragma unroll
  for (int a = 0; a < 2; ++a)
#pragma unroll
    for (int b = 0; b < 2; ++b)
#pragma unroll
      for (int m = 0; m < 4; ++m)
#pragma unroll
        for (int n = 0; n < 2; ++n) acc[a][b][m][n] = (f32x4){0.f, 0.f, 0.f, 0.f};
  bf16x8 At[4][2], B0[2][2], B1[2][2];
  const char* cA = (const char*)g.A + (size_t)cur.pm * tstep; const char* cB = (const char*)g.Bt + (size_t)cur.pn * tstep;
  PG8_STAGE(PG8_SB(0, 0), cB, voffB); PG8_STAGE(PG8_SA(0, 0), cA, voffA); PG8_STAGE(PG8_SB(0, 1), cB + hstep, voffB); PG8_STAGE(PG8_SA(0, 1), cA + hstep, voffA);
  if (wr == 1) PG8_BAR;
  PG8_WAIT_V(4); PG8_BAR;
  PG8_STAGE(PG8_SB(1, 0), cB + kstep, voffB); PG8_STAGE(PG8_SA(1, 0), cA + kstep, voffA); PG8_STAGE(PG8_SB(1, 1), cB + hstep + kstep, voffB);
  PG8_WAIT_V(6); PG8_BAR;
  for (;;) {
    const bool has_next = S.next(ui + 1, nxt);
    const char* nA = has_next ? (const char*)g.A + (size_t)nxt.pm * tstep : cA; const char* nB = has_next ? (const char*)g.Bt + (size_t)nxt.pn * tstep : cB;
#pragma unroll 1
    for (int t = 0; t < nt; t += 2) {
      const bool last = (t == nt - 2);
      const char* a1 = cA + (size_t)(t + 1) * kstep;
      const char* a2 = last ? nA : cA + (size_t)(t + 2) * kstep; const char* b2 = last ? nB : cB + (size_t)(t + 2) * kstep;
      const char* a3 = a2 + kstep; const char* b3 = b2 + kstep;
      PG8_LDB(B0, 0, 0); PG8_SCHED; PG8_LDA(At, 0, 0); PG8_STAGE(PG8_SA(1, 1), a1 + hstep, voffA);
      PG8_WAIT_L(8); PG8_BAR; PG8_WAIT_L(0); PG8_MMA(0, 0, At, B0); PG8_BAR; PG8_SCHED;
      PG8_LDB(B1, 0, 1); PG8_STAGE(PG8_SB(0, 0), b2, voffB);
      PG8_BAR; PG8_WAIT_L(0); PG8_MMA(0, 1, At, B1); PG8_BAR;
      PG8_LDA(At, 0, 1); PG8_STAGE(PG8_SA(0, 0), a2, voffA);
      PG8_BAR; PG8_WAIT_L(0); PG8_MMA(1, 0, At, B0); PG8_BAR; PG8_SCHED;
      PG8_STAGE(PG8_SB(0, 1), b2 + hstep, voffB);
      PG8_WAIT_V(6); PG8_BAR; PG8_MMA(1, 1, At, B1); PG8_BAR;
      PG8_LDB(B0, 1, 0); PG8_SCHED; PG8_LDA(At, 1, 0); PG8_STAGE(PG8_SA(0, 1), a2 + hstep, voffA);
      PG8_WAIT_L(8); PG8_BAR; PG8_WAIT_L(0); PG8_MMA(0, 0, At, B0); PG8_BAR; PG8_SCHED;
      PG8_LDB(B1, 1, 1); PG8_STAGE(PG8_SB(1, 0), b3, voffB);
      PG8_BAR; PG8_WAIT_L(0); PG8_MMA(0, 1, At, B1); PG8_BAR;
      PG8_LDA(At, 1, 1); PG8_STAGE(PG8_SA(1, 0), a3, voffA);
      PG8_BAR; PG8_WAIT_L(0); PG8_MMA(1, 0, At, B0); PG8_BAR; PG8_SCHED;
      PG8_STAGE(PG8_SB(1, 1), b3 + hstep, voffB);
      PG8_WAIT_V(6); PG8_BAR; PG8_MMA(1, 1, At, B1); PG8_BAR;
    }
    E(acc, cur, wr, wc, fr, fq);
    if (!has_next) break;
#pragma unroll
    for (int a = 0; a < 2; ++a)
#pragma unroll
      for (int b = 0; b < 2; ++b)
#pragma unroll
        for (int m = 0; m < 4; ++m)
#pragma unroll
          for (int n = 0; n < 2; ++n) acc[a][b][m][n] = (f32x4){0.f, 0.f, 0.f, 0.f};
    cur = nxt; cA = nA; cB = nB; ++ui;
  }
  PG8_WAIT_V(0);
  if (wr == 0) PG8_BAR;
  PG8_BAR;
#undef PG8_SA
#undef PG8_SB
#undef PG8_STAGE
#undef PG8_LDA
#undef PG8_LDB
#undef PG8_MMA
#undef PG8_WAIT_V
#undef PG8_WAIT_L
#undef PG8_BAR
#undef PG8_SCHED
}

struct EpiBf16 {
  static constexpr bool PERM = true;
  bf16_t* O; int ldc; int ncols;
  __device__ __forceinline__ void operator()(const f32x4 (&acc)[2][2][4][2], const Unit& u, int wr, int wc, int fr, int fq) const {
    const int row0 = u.pm * BM + wr * 64 + fr, col0 = u.pn * BM + wc * 32 + 8 * fq;
#pragma unroll
    for (int ai = 0; ai < 2; ++ai)
#pragma unroll
      for (int m = 0; m < 4; ++m) {
        bf16_t* rowp = O + (size_t)(row0 + ai * HALF + m * 16) * ldc + col0;
#pragma unroll
        for (int bj = 0; bj < 2; ++bj) {
          if (col0 + bj * HALF < ncols) {
            const f32x4 v0 = acc[ai][bj][m][0], v1 = acc[ai][bj][m][1];
            u32x4 w; w.x = cvt_pk_bf16(v0[0], v0[1]); w.y = cvt_pk_bf16(v0[2], v0[3]); w.z = cvt_pk_bf16(v1[0], v1[1]); w.w = cvt_pk_bf16(v1[2], v1[3]);
            *(u32x4*)(rowp + bj * HALF) = w;
          }
        }
      }
  }
};
struct EpiResid {
  static constexpr bool PERM = false;
  float* xres; const float* modl; int gate_off;
  __device__ __forceinline__ void operator()(const f32x4 (&acc)[2][2][4][2], const Unit& u, int wr, int wc, int fr, int fq) const {
    const int row0 = u.pm * BM + wr * 64 + fr, col0 = u.pn * BM + wc * 32 + 4 * fq;
#pragma unroll
    for (int ai = 0; ai < 2; ++ai)
#pragma unroll
      for (int m = 0; m < 4; ++m) {
        const int row = row0 + ai * HALF + m * 16;
        float* rowp = xres + (size_t)row * 1024 + col0;
        const float* md = modl + (size_t)tok_batch(row) * NMOD + gate_off + col0;
#pragma unroll
        for (int bj = 0; bj < 2; ++bj)
#pragma unroll
          for (int n = 0; n < 2; ++n) {
            const f32x4 g = *(const f32x4*)(md + bj * HALF + n * 16);
            f32x4 x = *(const f32x4*)(rowp + bj * HALF + n * 16);
            x += g * acc[ai][bj][m][n];
            *(f32x4*)(rowp + bj * HALF + n * 16) = x;
          }
      }
  }
};
struct EpiGlu {
  static constexpr bool PERM = true;
  bf16_t* mix;
  __device__ __forceinline__ void operator()(const f32x4 (&acc)[2][2][4][2], const Unit& u, int wr, int wc, int fr, int fq) const {
    const int row0 = u.pm * BM + wr * 64 + fr, col0 = 256 + u.pn * HALF + wc * 32 + 8 * fq;
#pragma unroll
    for (int ai = 0; ai < 2; ++ai)
#pragma unroll
      for (int m = 0; m < 4; ++m) {
        float v[8];
#pragma unroll
        for (int n = 0; n < 2; ++n)
#pragma unroll
          for (int j = 0; j < 4; ++j) v[n * 4 + j] = acc[ai][0][m][n][j] * sigmoid_f(acc[ai][1][m][n][j]);
        u32x4 w; w.x = cvt_pk_bf16(v[0], v[1]); w.y = cvt_pk_bf16(v[2], v[3]); w.z = cvt_pk_bf16(v[4], v[5]); w.w = cvt_pk_bf16(v[6], v[7]);
        *(u32x4*)(mix + (size_t)(row0 + ai * HALF + m * 16) * 1024 + col0) = w;
        __builtin_amdgcn_sched_barrier(0);
      }
  }
};
}

#define VNT_STRIDE 136
__device__ __forceinline__ void phase_sgu(const Params& p, int layer, int nchunks, int bid, int nblk, unsigned char* smem) {
  bf16_t* vnT = (bf16_t*)smem;
  const int tid = opaque_tid(); const int lane = tid & 63, wid = tid >> 6;
  const int fr = lane & 15, fq = lane >> 4;
  for (int item = bid; item < nchunks * 4; item += nblk) {
    const int ch = item >> 2, h = item & 3;
    const int tok0 = ch * 128;
    {
      const int s = tid >> 2, q = tid & 3;
      const bf16_t* vrow = p.cols + (size_t)(tok0 + s) * INW + C_SGU_V + h * 64 + q * 16;
      const uint4 r0 = *(const uint4*)vrow, r1 = *(const uint4*)(vrow + 8);
      float gv[16];
      gv[0] = bflo(r0.x); gv[1] = bfhi(r0.x); gv[2] = bflo(r0.y); gv[3] = bfhi(r0.y); gv[4] = bflo(r0.z); gv[5] = bfhi(r0.z); gv[6] = bflo(r0.w); gv[7] = bfhi(r0.w);
      gv[8] = bflo(r1.x); gv[9] = bfhi(r1.x); gv[10] = bflo(r1.y); gv[11] = bfhi(r1.y); gv[12] = bflo(r1.z); gv[13] = bfhi(r1.z); gv[14] = bflo(r1.w); gv[15] = bfhi(r1.w);
      float ss = 0.f;
#pragma unroll
      for (int d = 0; d < 16; ++d) { gv[d] = gelu_f(gv[d]); ss += gv[d] * gv[d]; }
      ss += __shfl_xor(ss, 1);
      ss += __shfl_xor(ss, 2);
      const float rstd = rsqrtf(ss * (1.f / 64.f) + EPSV);
#pragma unroll
      for (int d = 0; d < 16; ++d) vnT[(q * 16 + d) * VNT_STRIDE + s] = f2bf(gv[d] * rstd);
    }
    __syncthreads();
    {
      const bf16_t* wrow = p.sgu_wb + (((size_t)layer * 4 + h) * 128 + wid * 16 + fr) * 128 + fq * 8;
      f32x4 acc[4];
#pragma unroll
      for (int n = 0; n < 4; ++n) acc[n] = (f32x4){0.f, 0.f, 0.f, 0.f};
#pragma unroll
      for (int ks = 0; ks < 4; ++ks) {
        const bf16x8 a = *(const bf16x8*)(wrow + ks * 32);
#pragma unroll
        for (int n = 0; n < 4; ++n) {
          const bf16x8 b = *(const bf16x8*)(vnT + (n * 16 + fr) * VNT_STRIDE + ks * 32 + fq * 8);
          acc[n] = __builtin_amdgcn_mfma_f32_16x16x32_bf16(a, b, acc[n], 0, 0, 0);
        }
      }
#pragma unroll
      for (int j = 0; j < 4; ++j) {
        const int t = wid * 16 + fq * 4 + j;
        const float bs = p.sgu_b[((size_t)layer * 4 + h) * 128 + t];
        const bf16_t* urow = p.cols + (size_t)(tok0 + t) * INW + C_SGU_U + h * 64;
        bf16_t* orow = p.mix + (size_t)(tok0 + t) * 1024 + h * 64;
#pragma unroll
        for (int n = 0; n < 4; ++n) orow[n * 16 + fr] = f2bf(gelu_f(bf2f(urow[n * 16 + fr])) * (acc[n][j] + bs));
      }
    }
    __syncthreads();
  }
}

__device__ __forceinline__ void phase_s5a(const Params& p, int layer, int bid, int nblk, unsigned char* smem) {
  const int tid = opaque_tid(); const int lane = tid & 63, wid = tid >> 6, fr = lane & 15, fq = lane >> 4;
  const int ntask = 2 * 16 * 17;
  for (int task = bid * NW + wid; task < ntask; task += nblk * NW) {
    const int dir = task / 272, rem = task % 272, g = rem / 17, mt = rem % 17;
    const bf16_t* tab = p.s5M1 + (size_t)((layer * 2 + dir) * 16 + g) * 131072 + (size_t)fr * 1024 + fq * 8;
    const int scr = mt * 16 + fr;
    const bf16_t* ub = p.cols + C_S5 + g * 16 + (fq & 1) * 8;
    f32x4 acc[8];
#pragma unroll
    for (int n = 0; n < 8; ++n) acc[n] = (f32x4){0.f, 0.f, 0.f, 0.f};
#pragma unroll 4
    for (int ks = 0; ks < 32; ++ks) {
      const int tau = 2 * ks + (fq >> 1);
      const int i = dir ? 63 - tau : tau;
      const bf16x8 a = *(const bf16x8*)(ub + (size_t)s5_tok(scr, i) * INW);
#pragma unroll
      for (int n = 0; n < 8; ++n) {
        const bf16x8 b = *(const bf16x8*)(tab + (size_t)n * 16 * 1024 + ks * 32);
        acc[n] = __builtin_amdgcn_mfma_f32_16x16x32_bf16(a, b, acc[n], 0, 0, 0);
      }
    }
#pragma unroll
    for (int n = 0; n < 8; ++n)
#pragma unroll
      for (int j = 0; j < 4; ++j) p.s5S[(((size_t)dir * NSC + mt * 16 + fq * 4 + j) * 16 + g) * 128 + n * 16 + fr] = acc[n][j];
  }
}

__device__ __forceinline__ int scan_sc(int s, int b, int dir) {
  return s < 4 ? 256 + b * 4 + (dir ? 3 - s : s) : b * 64 + (dir ? 63 - (s - 4) : (s - 4));
}
__device__ __forceinline__ void phase_scan(const Params& p, int layer, int bid, int nblk) {
  const int tid = opaque_tid();
  for (int item = bid; item < 16 + 256; item += nblk) {
    if (item < 16) {
      const int id = item * NT + tid;
      const int pp = id & 63, g = (id >> 6) & 15, b = (id >> 10) & 3, dir = id >> 12;
      const int pid = ((layer * 2 + dir) * 16 + g) * 64 + pp;
      const float ar = p.s5a64[pid * 2], ai = p.s5a64[pid * 2 + 1];
      float hr = 0.f, hi = 0.f;
      for (int s0 = 0; s0 < 68; s0 += 17) {
        float sr[17], si[17];
#pragma unroll
        for (int k = 0; k < 17; ++k) {
          const size_t o = (((size_t)dir * NSC + scan_sc(s0 + k, b, dir)) * 16 + g) * 128 + pp;
          sr[k] = p.s5S[o]; si[k] = p.s5S[o + 64];
        }
#pragma unroll
        for (int k = 0; k < 17; ++k) {
          const size_t o = (((size_t)dir * NSC + scan_sc(s0 + k, b, dir)) * 16 + g) * 128 + pp;
          p.s5H[o] = hr; p.s5H[o + 64] = hi;
          const float nr = ar * hr - ai * hi + sr[k];
          const float ni = ar * hi + ai * hr + si[k];
          hr = nr; hi = ni;
        }
      }
    } else {
      const int id = (item - 16) * NT + tid;
      const int e = id & 2047, h = (id >> 11) & 7, b = (id >> 14) & 3, dir = id >> 16;
      const int dk = e & 31;
      float S = 0.f;
      for (int s0 = 0; s0 < 68; s0 += 17) {
        float kv[17], dc[17];
#pragma unroll
        for (int k = 0; k < 17; ++k) {
          const size_t o = (((size_t)dir * NSC + scan_sc(s0 + k, b, dir)) * 8 + h);
          kv[k] = p.gkv[o * 2048 + e]; dc[k] = p.gdec[o * 32 + dk];
        }
#pragma unroll
        for (int k = 0; k < 17; ++k) {
          const size_t o = (((size_t)dir * NSC + scan_sc(s0 + k, b, dir)) * 8 + h);
          p.gkv[o * 2048 + e] = S;
          S = dc[k] * S + kv[k];
        }
      }
    }
  }
}

__device__ __forceinline__ bf16x8 s5_kfrag(const bf16_t* kb, int delta, int sh) {
  const int d = delta - sh;
  bf16x8 r = *(const bf16x8*)(kb + (size_t)(d < 0 ? 0 : d) * 256);
  if (d < 0) r = (bf16x8){0, 0, 0, 0, 0, 0, 0, 0};
  return r;
}
#define S5_UCH 1032
typedef const __attribute__((address_space(3))) bf16_t* lds_bf16_cp;
template <int DIR, bool DIAG>
__device__ __forceinline__ void s5_group8(f32x4 (&acc)[16], bf16x8 (&W)[16], const bf16_t* ul  , const bf16_t* kl  , int ks0, int E, int sh) {
  const bf16x8 zero8 = (bf16x8){0, 0, 0, 0, 0, 0, 0, 0};
#pragma unroll
  for (int j = 0; j < 8; ++j) {
    const int sigma = 2 * (ks0 + j) + sh;
    const bf16x8 a = *(const bf16x8*)(ul + (DIR ? 63 - sigma : sigma) * 16);
    bf16x8 n0 = zero8, n1 = zero8;
    if (!DIAG) {
      if (j + 1 < 8) { n0 = *(const bf16x8*)(kl + (E - 2 * (j + 1) - sh) * 256); n1 = *(const bf16x8*)(kl + (E - 2 * (j + 1) + 1 - sh) * 256); }
      else { n0 = s5_kfrag(kl, E - 16, sh); n1 = s5_kfrag(kl, E - 15, sh); }
    }
#pragma unroll
    for (int i = 0; i < 16; ++i) {
      if (!(DIAG && i < 2 * j)) {
        const int sl = DIR ? 15 - i : i;
        acc[sl] = __builtin_amdgcn_mfma_f32_16x16x32_bf16(a, W[(i - 2 * j) & 15], acc[sl], 0, 0, 0);
      }
    }
    if (!DIAG) { W[(16 - 2 * (j + 1)) & 15] = n0; W[(17 - 2 * (j + 1)) & 15] = n1; }
  }
}
template <int DIR>
__device__ __forceinline__ void s5_dir(f32x4 (&acc)[16], const Params& p, int layer, int g, int scr, int qd, int fr, int fq, const bf16_t* ul, const bf16_t* kl) {
  const int sh = fq >> 1;
  {
    bf16x8 W[16];
#pragma unroll
    for (int i = 0; i < 16; ++i) W[i] = s5_kfrag(kl, 16 * qd + i, sh);
    for (int c = 0; c < qd; ++c) s5_group8<DIR, false>(acc, W, ul, kl, 8 * c, 16 * (qd - c), sh);
    s5_group8<DIR, true>(acc, W, ul, kl, 8 * qd, 0, sh);
  }
  const size_t tb = (size_t)((layer * 2 + DIR) * 16 + g);
  const float* hin = p.s5H + (((size_t)DIR * NSC + scr) * 16 + g) * 128 + fq * 8;
  const bf16_t* n2 = p.s5N2 + tb * 131072 + (size_t)(16 * qd * 16 + fr) * 128 + fq * 8;
  bf16x8 ah[4];
#pragma unroll
  for (int ks = 0; ks < 4; ++ks) {
    const f32x4 h0 = *(const f32x4*)(hin + ks * 32), h1 = *(const f32x4*)(hin + ks * 32 + 4);
    const float h8[8] = {h0[0], h0[1], h0[2], h0[3], h1[0], h1[1], h1[2], h1[3]};
    ah[ks] = pack_bf16x8(h8);
  }
#pragma unroll
  for (int ks = 0; ks < 4; ++ks) {
    bf16x8 b[16];
#pragma unroll
    for (int i = 0; i < 16; ++i) b[i] = *(const bf16x8*)(n2 + (size_t)i * 16 * 128 + ks * 32);
#pragma unroll
    for (int i = 0; i < 16; ++i) {
      const int sl = DIR ? 15 - i : i;
      acc[sl] = __builtin_amdgcn_mfma_f32_16x16x32_bf16(ah[ks], b[i], acc[sl], 0, 0, 0);
    }
    __builtin_amdgcn_sched_barrier(0);
  }
}
__device__ __forceinline__ void phase_s5c(const Params& p, int layer, int nsc, int bid, int nblk, unsigned char* smem) {
  const int tid = opaque_tid(); const int lane = tid & 63, wid = tid >> 6;
  bf16_t* Kl = (bf16_t*)smem;
  bf16_t* Ul = Kl + 2 * 16384;
  const int nmt = nsc / 16, npair = (nmt + 1) / 2;
  const int ntask = 16 * npair;
  for (int task = bid; task < ntask; task += nblk) {
    const int g = task / npair, mt0 = (task % npair) * 2;
    __syncthreads();
    int tid_o = tid; asm volatile("" : "+v"(tid_o));
#pragma unroll
    for (int it = 0; it < 8; ++it) {
      const int e = it * NT + tid_o;
      const int dir = e >> 11, off = (e & 2047) * 8;
      *(uint4*)(Kl + dir * 16384 + off) = *(const uint4*)(p.s5K + (size_t)((layer * 2 + dir) * 16 + g) * 16384 + off);
    }
#pragma unroll
    for (int it = 0; it < 8; ++it) {
      const int e = it * NT + tid_o;
      const int hf = e & 1, tk = (e >> 1) & 63, chk = (e >> 7) & 15, tl = e >> 11;
      const int mt = mt0 + tl;
      uint4 v = make_uint4(0u, 0u, 0u, 0u);
      if (mt < nmt) v = *(const uint4*)(p.cols + (size_t)s5_tok(mt * 16 + chk, tk) * INW + C_S5 + g * 16 + hf * 8);
      *(uint4*)(Ul + (tl * 16 + chk) * S5_UCH + tk * 16 + hf * 8) = v;
    }
    __syncthreads();
    int lane_o = lane; asm volatile("" : "+v"(lane_o));
    const int fr = lane_o & 15, fq = lane_o >> 4;
    const int tl = wid >> 2, q = wid & 3, mt = mt0 + tl;
    if (mt < nmt) {
      const int scr = mt * 16 + fr;
      const bf16_t* ul = Ul + (tl * 16 + fr) * S5_UCH + (fq & 1) * 8;
      f32x4 acc[16];
#pragma unroll
      for (int i = 0; i < 16; ++i) acc[i] = (f32x4){0.f, 0.f, 0.f, 0.f};
      s5_dir<0>(acc, p, layer, g, scr, q, fr, fq, ul, Kl + fr * 16 + (fq & 1) * 8);
      s5_dir<1>(acc, p, layer, g, scr, 3 - q, fr, fq, ul, Kl + 16384 + fr * 16 + (fq & 1) * 8);
      const int ch = g * 16 + fr;
      const float dsk = p.s5_d[layer * 256 + ch];
#pragma unroll
      for (int j = 0; j < 4; ++j) {
        const int chk = fq * 4 + j;
        const size_t tok0 = (size_t)s5_tok(mt * 16 + chk, 16 * q);
        const bf16_t* up = Ul + (tl * 16 + chk) * S5_UCH + (16 * q) * 16 + fr;
        bf16_t* yp = p.yg + tok0 * 256 + ch;
#pragma unroll
        for (int i = 0; i < 16; ++i) {
          const float v = acc[i][j] + dsk * bf2f(up[i * 16]);
          yp[(size_t)i * 256] = f2bf(gelu_f(v));
        }
        __builtin_amdgcn_sched_barrier(0);
      }
    }
  }
  __syncthreads();
}

#define GL_VT_STRIDE 72
#define GL_LB_STRIDE 36
#define GL_HALF_BYTES (64 * 72 * 2 + 64 * 36 * 4 + 64 * 72 * 2)
__device__ __forceinline__ void unpack8(const uint4& r, float* v) {
  v[0] = bflo(r.x); v[1] = bfhi(r.x); v[2] = bflo(r.y); v[3] = bfhi(r.y); v[4] = bflo(r.z); v[5] = bfhi(r.z); v[6] = bflo(r.w); v[7] = bfhi(r.w);
}
__device__ __forceinline__ void gla_store_vT(const uint4& r0, const uint4& r1, bf16_t* vT, int ltid) {
  const int i = ltid & 63, part = ltid >> 6;
  const unsigned w[8] = {r0.x, r0.y, r0.z, r0.w, r1.x, r1.y, r1.z, r1.w};
#pragma unroll
  for (int e = 0; e < 8; ++e) {
    vT[(part * 16 + 2 * e) * GL_VT_STRIDE + i] = (bf16_t)(w[e] & 0xffffu);
    vT[(part * 16 + 2 * e + 1) * GL_VT_STRIDE + i] = (bf16_t)(w[e] >> 16);
  }
}
__device__ __forceinline__ void gla_logdecay(const Params& p, int layer, int sc, int h, int dir, const uint4& z0, const uint4& z1, float* lb, int ltid, float* glb) {
  const int lane = ltid & 63;
  const int wu = __builtin_amdgcn_readfirstlane(ltid >> 6);
  float z[16];
  unpack8(z0, z); unpack8(z1, z + 8);
  const float* wg = p.gla_wg + ((size_t)(layer * 2 + dir) * 16) * 256 + h * 32 + wu * 8;
  const float* bg = p.gla_bg + (layer * 2 + dir) * 256 + h * 32 + wu * 8;
  float la[8];
#pragma unroll
  for (int c = 0; c < 8; ++c) la[c] = bg[c];
#pragma unroll
  for (int r = 0; r < 16; ++r) {
#pragma unroll
    for (int c = 0; c < 8; ++c) la[c] += z[r] * wg[r * 256 + c];
  }
#pragma unroll
  for (int c = 0; c < 8; ++c) la[c] = logsigmoid_f(la[c]) * (1.f / 16.f);
  if (dir == 0) {
#pragma unroll
    for (int off = 1; off < 64; off <<= 1) {
#pragma unroll
      for (int c = 0; c < 8; ++c) { const float nb = __shfl_up(la[c], off); if (lane >= off) la[c] += nb; }
    }
  } else {
#pragma unroll
    for (int off = 1; off < 64; off <<= 1) {
#pragma unroll
      for (int c = 0; c < 8; ++c) { const float nb = __shfl_down(la[c], off); if (lane + off < 64) la[c] += nb; }
    }
  }
  *(f32x4*)(lb + lane * GL_LB_STRIDE + wu * 8) = (f32x4){la[0], la[1], la[2], la[3]};
  *(f32x4*)(lb + lane * GL_LB_STRIDE + wu * 8 + 4) = (f32x4){la[4], la[5], la[6], la[7]};
  float* gp = glb + ((size_t)dir * TT + gla_tok(sc, lane)) * 256 + h * 32 + wu * 8;
  *(f32x4*)gp = (f32x4){la[0], la[1], la[2], la[3]};
  *(f32x4*)(gp + 4) = (f32x4){la[4], la[5], la[6], la[7]};
}

struct GlaAPre { uint4 v0, v1, za0, za1, zb0, zb1, k; };
__device__ __forceinline__ GlaAPre glaa_prefetch(const Params& p, int item, int ltid) {
  const int sc = item >> 3, h = item & 7;
  const int i = ltid & 63, part = ltid >> 6;
  const bf16_t* row = p.cols + (size_t)gla_tok(sc, i) * INW;
  GlaAPre r;
  r.v0 = *(const uint4*)(row + C_GV + h * 64 + part * 16); r.v1 = *(const uint4*)(row + C_GV + h * 64 + part * 16 + 8);
  r.za0 = *(const uint4*)(row + C_ZF); r.za1 = *(const uint4*)(row + C_ZF + 8);
  r.zb0 = *(const uint4*)(row + C_ZF + 16); r.zb1 = *(const uint4*)(row + C_ZF + 24);
  r.k = *(const uint4*)(row + C_GK + h * 32 + part * 8);
  return r;
}
__device__ __forceinline__ void phase_glaa(const Params& p, int layer, int bid, int nblk, unsigned char* smem) {
  const int tid = opaque_tid(); const int half = __builtin_amdgcn_readfirstlane(tid >> 8), ltid = tid & 255;
  const int lane = tid & 63, w = ltid >> 6, fr = lane & 15, fq = lane >> 4;
  bf16_t* vT = (bf16_t*)(smem + half * GL_HALF_BYTES);
  float* lb = (float*)(vT + 64 * GL_VT_STRIDE);
  bf16_t* kT = (bf16_t*)(lb + 64 * GL_LB_STRIDE);
  const int nit = NSC * 8 / 2;
  if (bid >= nit) return;
  GlaAPre cur = glaa_prefetch(p, bid * 2 + half, ltid);
  for (int it = bid; it < nit; it += nblk) {
    const int item = it * 2 + half;
    const int sc = item >> 3, h = item & 7;
    const int itn = it + nblk < nit ? it + nblk : it;
    const GlaAPre nxt = glaa_prefetch(p, itn * 2 + half, ltid);
    gla_store_vT(cur.v0, cur.v1, vT, ltid);
#pragma unroll
    for (int dir = 0; dir < 2; ++dir) {
      gla_logdecay(p, layer, sc, h, dir, dir ? cur.zb0 : cur.za0, dir ? cur.zb1 : cur.za1, lb, ltid, p.glb);
      __syncthreads();
      const int ilast = dir ? 0 : 63;
      {
        const int i = ltid & 63, part = ltid >> 6;
        float kv8[8];
        unpack8(cur.k, kv8);
#pragma unroll
        for (int c = 0; c < 8; ++c) {
          const int dk = part * 8 + c;
          kT[dk * GL_VT_STRIDE + i] = f2bf(kv8[c] * __expf(lb[ilast * GL_LB_STRIDE + dk] - lb[i * GL_LB_STRIDE + dk]));
        }
      }
      const size_t o = (((size_t)dir * NSC + sc) * 8 + h);
      if (ltid < 32) p.gdec[o * 32 + ltid] = __expf(lb[ilast * GL_LB_STRIDE + ltid]);
      __syncthreads();
      {
        f32x4 acc[2];
        acc[0] = (f32x4){0.f, 0.f, 0.f, 0.f}; acc[1] = acc[0];
#pragma unroll
        for (int ks = 0; ks < 2; ++ks) {
          const bf16x8 b = *(const bf16x8*)(vT + (w * 16 + fr) * GL_VT_STRIDE + ks * 32 + fq * 8);
#pragma unroll
          for (int m = 0; m < 2; ++m) {
            const bf16x8 a = *(const bf16x8*)(kT + (m * 16 + fr) * GL_VT_STRIDE + ks * 32 + fq * 8);
            acc[m] = __builtin_amdgcn_mfma_f32_16x16x32_bf16(a, b, acc[m], 0, 0, 0);
          }
        }
#pragma unroll
        for (int m = 0; m < 2; ++m) *(f32x4*)(p.gkv + o * 2048 + (size_t)(w * 16 + fr) * 32 + m * 16 + fq * 4) = acc[m];
      }
      __syncthreads();
    }
    cur = nxt;
  }
}

__device__ __forceinline__ void gl_load8(const float* g, float* v) {
  const f32x4 a = *(const f32x4*)g, b = *(const f32x4*)(g + 4);
  v[0] = a[0]; v[1] = a[1]; v[2] = a[2]; v[3] = a[3]; v[4] = b[0]; v[5] = b[1]; v[6] = b[2]; v[7] = b[3];
}
#define GLC_HALF_BYTES (64 * 72 * 2 + 64 * 72 * 2 + 2 * 64 * 36 * 4 + 2 * 64 * 36 * 4)
struct GlaCPre { uint4 v0, v1, q, k[4], lb[2][2], st[2][2]; };
__device__ __forceinline__ GlaCPre glac_prefetch(const Params& p, int item, int ltid, int w, int fr, int fq) {
  const int sc = item >> 3, h = item & 7;
  GlaCPre r;
  {
    const int i = ltid & 63, part = ltid >> 6;
    const bf16_t* row = p.cols + (size_t)gla_tok(sc, i) * INW + C_GV + h * 64 + part * 16;
    r.v0 = *(const uint4*)row; r.v1 = *(const uint4*)(row + 8);
  }
  r.q = *(const uint4*)(p.cols + (size_t)gla_tok(sc, w * 16 + fr) * INW + C_GQ + h * 32 + fq * 8);
#pragma unroll
  for (int n = 0; n < 4; ++n) r.k[n] = *(const uint4*)(p.cols + (size_t)gla_tok(sc, n * 16 + fr) * INW + C_GK + h * 32 + fq * 8);
  {
    const int i = ltid >> 2, piece = ltid & 3;
#pragma unroll
    for (int dir = 0; dir < 2; ++dir) {
      const float* g = p.glb + ((size_t)dir * TT + gla_tok(sc, i)) * 256 + h * 32 + piece * 8;
      r.lb[dir][0] = *(const uint4*)g; r.lb[dir][1] = *(const uint4*)(g + 4);
      const float* s = p.gkv + (((size_t)dir * NSC + sc) * 8 + h) * 2048 + i * 32 + piece * 8;
      r.st[dir][0] = *(const uint4*)s; r.st[dir][1] = *(const uint4*)(s + 4);
    }
  }
  return r;
}
__device__ __forceinline__ void phase_glac(const Params& p, int layer, int nsc, int bid, int nblk, unsigned char* smem) {
  const int tid = opaque_tid(); const int half = __builtin_amdgcn_readfirstlane(tid >> 8), ltid = tid & 255;
  const int lane = tid & 63, w = ltid >> 6, fr = lane & 15, fq = lane >> 4;
  bf16_t* vT = (bf16_t*)(smem + half * GLC_HALF_BYTES);
  bf16_t* Pw = vT + 64 * GL_VT_STRIDE + w * 16 * GL_VT_STRIDE;
  float* lbT = (float*)(vT + 2 * 64 * GL_VT_STRIDE);
  float* ST = lbT + 2 * 64 * GL_LB_STRIDE;
  const int nit = nsc * 4;
  if (bid >= nit) return;
  GlaCPre cur = glac_prefetch(p, bid * 2 + half, ltid, w, fr, fq);
  for (int it = bid; it < nit; it += nblk) {
    const int item = it * 2 + half;
    const int sc = item >> 3, h = item & 7;
    __syncthreads();
    gla_store_vT(cur.v0, cur.v1, vT, ltid);
    {
      const int i = ltid >> 2, piece = ltid & 3;
#pragma unroll
      for (int dir = 0; dir < 2; ++dir) {
        *(uint4*)(lbT + (dir * 64 + i) * GL_LB_STRIDE + piece * 8) = cur.lb[dir][0]; *(uint4*)(lbT + (dir * 64 + i) * GL_LB_STRIDE + piece * 8 + 4) = cur.lb[dir][1];
        *(uint4*)(ST + (dir * 64 + i) * GL_LB_STRIDE + piece * 8) = cur.st[dir][0]; *(uint4*)(ST + (dir * 64 + i) * GL_LB_STRIDE + piece * 8 + 4) = cur.st[dir][1];
      }
    }
    const int itn = it + nblk < nit ? it + nblk : it;
    const GlaCPre nxt = glac_prefetch(p, itn * 2 + half, ltid, w, fr, fq);
    __syncthreads();
    f32x4 o[4];
#pragma unroll
    for (int n = 0; n < 4; ++n) o[n] = (f32x4){0.f, 0.f, 0.f, 0.f};
#pragma unroll
    for (int dir = 0; dir < 2; ++dir) {
      const float* lbd = lbT + dir * 64 * GL_LB_STRIDE + fq * 8;
      float bref[8], bt[8];
      gl_load8(lbd + (dir ? 31 : 32) * GL_LB_STRIDE, bref);
      gl_load8(lbd + (w * 16 + fr) * GL_LB_STRIDE, bt);
      bf16x8 aqs, aqe;
      {
        float q8[8], s8[8], e8[8];
        unpack8(cur.q, q8);
#pragma unroll
        for (int c = 0; c < 8; ++c) {
          const float qx = q8[c] * 0.17677669529663687f;
          s8[c] = qx * __expf(bt[c] - bref[c]);
          e8[c] = qx * __expf(bt[c]);
        }
        aqs = pack_bf16x8(s8); aqe = pack_bf16x8(e8);
      }
#pragma unroll
      for (int n = 0; n < 4; ++n) {
        const int s = n * 16 + fr;
        float k8[8], bs[8];
        unpack8(cur.k[n], k8);
        gl_load8(lbd + s * GL_LB_STRIDE, bs);
#pragma unroll
        for (int c = 0; c < 8; ++c) k8[c] *= __expf(bref[c] - bs[c]);
        const bf16x8 bks = pack_bf16x8(k8);
        const f32x4 sa = __builtin_amdgcn_mfma_f32_16x16x32_bf16(aqs, bks, (f32x4){0.f, 0.f, 0.f, 0.f}, 0, 0, 0);
#pragma unroll
        for (int j = 0; j < 4; ++j) {
          const int t = w * 16 + fq * 4 + j;
          const bool ok = dir ? (s >= t) : (s <= t);
          Pw[(fq * 4 + j) * GL_VT_STRIDE + s] = f2bf(ok ? sa[j] : 0.f);
        }
      }
      __builtin_amdgcn_wave_barrier();
#pragma unroll
      for (int ks = 0; ks < 2; ++ks) {
        const bf16x8 ap = *(const bf16x8*)(Pw + fr * GL_VT_STRIDE + ks * 32 + fq * 8);
#pragma unroll
        for (int n = 0; n < 4; ++n) {
          const bf16x8 bv = *(const bf16x8*)(vT + (n * 16 + fr) * GL_VT_STRIDE + ks * 32 + fq * 8);
          o[n] = __builtin_amdgcn_mfma_f32_16x16x32_bf16(ap, bv, o[n], 0, 0, 0);
        }
      }
      __builtin_amdgcn_wave_barrier();
      {
        const float* Sg = ST + dir * 64 * GL_LB_STRIDE + fq * 8;
#pragma unroll
        for (int n = 0; n < 4; ++n) {
          float s8[8];
          gl_load8(Sg + (n * 16 + fr) * GL_LB_STRIDE, s8);
          const bf16x8 bS = pack_bf16x8(s8);
          o[n] = __builtin_amdgcn_mfma_f32_16x16x32_bf16(aqe, bS, o[n], 0, 0, 0);
        }
      }
    }
    __builtin_amdgcn_wave_barrier();
#pragma unroll
    for (int j = 0; j < 4; ++j) {
      float ss = o[0][j] * o[0][j] + o[1][j] * o[1][j] + o[2][j] * o[2][j] + o[3][j] * o[3][j];
      ss += __shfl_xor(ss, 1); ss += __shfl_xor(ss, 2); ss += __shfl_xor(ss, 4); ss += __shfl_xor(ss, 8);
      const float rstd = rsqrtf(ss * (1.f / 64.f) + EPSV);
#pragma unroll
      for (int n = 0; n < 4; ++n) Pw[(fq * 4 + j) * GL_VT_STRIDE + n * 16 + fr] = f2bf(o[n][j] * rstd);
    }
    __builtin_amdgcn_wave_barrier();
    {
      const int tl = lane >> 2, dq = (lane & 3) * 16;
      const int tok = gla_tok(sc, w * 16 + tl);
      const bf16_t* grow = p.cols + (size_t)tok * INW + C_GG + h * 64 + dq;
      float ov[16], gv[16];
      unpack8(*(const uint4*)(Pw + tl * GL_VT_STRIDE + dq), ov); unpack8(*(const uint4*)(Pw + tl * GL_VT_STRIDE + dq + 8), ov + 8);
      unpack8(*(const uint4*)grow, gv); unpack8(*(const uint4*)(grow + 8), gv + 8);
      const float* ng = p.gla_ng + layer * 512 + h * 64 + dq;
      unsigned wv[8];
#pragma unroll
      for (int e = 0; e < 8; ++e) {
        const float a = ov[2 * e] * ng[2 * e] * silu_f(gv[2 * e]), b = ov[2 * e + 1] * ng[2 * e + 1] * silu_f(gv[2 * e + 1]);
        wv[e] = (unsigned)f2bf(a) | ((unsigned)f2bf(b) << 16);
      }
      bf16_t* orow = p.mix + (size_t)tok * 1024 + 512 + h * 64 + dq;
      *(uint4*)orow = make_uint4(wv[0], wv[1], wv[2], wv[3]);
      *(uint4*)(orow + 8) = make_uint4(wv[4], wv[5], wv[6], wv[7]);
    }
    __builtin_amdgcn_wave_barrier();
    cur = nxt;
  }
  __syncthreads();
}

__device__ __forceinline__ unsigned fkey(float f) { const unsigned u = __float_as_uint(f); return u ^ ((u >> 31) ? 0xFFFFFFFFu : 0x80000000u); }
__device__ __forceinline__ float funkey(unsigned k) { return __uint_as_float((k >> 31) ? (k ^ 0x80000000u) : ~k); }
__device__ __forceinline__ unsigned umax3(unsigned a, unsigned b) { return a > b ? a : b; }
__device__ __forceinline__ unsigned umin3(unsigned a, unsigned b) { return a < b ? a : b; }
__device__ __forceinline__ unsigned umed3(unsigned a, unsigned b, unsigned c) { return umax3(umin3(a, b), umin3(umax3(a, b), c)); }
__device__ __forceinline__ void top16_insert(unsigned (&L)[16], unsigned x) {
#pragma unroll
  for (int q = 15; q >= 1; --q) L[q] = umed3(L[q - 1], L[q], x);
  L[0] = umax3(L[0], x);
}
template <int XM>
__device__ __forceinline__ void top16_merge(unsigned (&L)[16]) {
  unsigned P[16];
#pragma unroll
  for (int i = 0; i < 16; ++i) P[i] = (unsigned)__shfl_xor((int)L[i], XM);
  unsigned M[16];
#pragma unroll
  for (int i = 0; i < 16; ++i) M[i] = umax3(L[i], P[15 - i]);
#pragma unroll
  for (int d = 8; d >= 1; d >>= 1) {
#pragma unroll
    for (int i = 0; i < 16; ++i) {
      if ((i & d) == 0) { const unsigned hi = umax3(M[i], M[i + d]), lo = umin3(M[i], M[i + d]); M[i] = hi; M[i + d] = lo; }
    }
  }
#pragma unroll
  for (int i = 0; i < 16; ++i) L[i] = M[i];
}
#define RT_SC_STRIDE 132
#define RT_MAX_ITEMS 5
__device__ __forceinline__ void phase_route(const Params& p, int layer, int ntok, int bid, int nblk, unsigned char* smem) {
  const int tid = opaque_tid(); const int lane = tid & 63, wid = tid >> 6;
  float* sc = (float*)smem;
  unsigned* lists_all = (unsigned*)(sc + 128 * RT_SC_STRIDE);
  const int fr = lane & 15, fq = lane >> 4;
  const bf16_t* qb = p.cols;
  const int nitems = ntok / 16;
  for (int item0 = bid; item0 < nitems; item0 += nblk * RT_MAX_ITEMS) {
    for (int ph = 0; ph < 2; ++ph) {
      bf16x8 bk[8][4];
      {
        const bf16_t* kb = p.keysb + ((((size_t)layer * 2 + ph) * 8 + wid) * 128) * 128 + (size_t)fr * 128 + fq * 8;
#pragma unroll
        for (int n = 0; n < 8; ++n)
#pragma unroll
          for (int kt = 0; kt < 4; ++kt) bk[n][kt] = *(const bf16x8*)(kb + (size_t)n * 16 * 128 + kt * 32);
      }
      for (int ii = 0; ii < RT_MAX_ITEMS; ++ii) {
        const int item = item0 + ii * nblk;
        if (item >= nitems) break;
        const int tok0 = item * 16;
        unsigned* lists = lists_all + ii * 4096;
        {
          const bf16_t* qrow = qb + (size_t)(tok0 + fr) * 2048 + wid * 256 + ph * 128 + fq * 8;
          bf16x8 a[4];
#pragma unroll
          for (int kt = 0; kt < 4; ++kt) a[kt] = *(const bf16x8*)(qrow + kt * 32);
#pragma unroll
          for (int n = 0; n < 8; ++n) {
            f32x4 acc = (f32x4){0.f, 0.f, 0.f, 0.f};
#pragma unroll
            for (int kt = 0; kt < 4; ++kt) acc = __builtin_amdgcn_mfma_f32_16x16x32_bf16(a[kt], bk[n][kt], acc, 0, 0, 0);
#pragma unroll
            for (int j = 0; j < 4; ++j) sc[(wid * 16 + fq * 4 + j) * RT_SC_STRIDE + n * 16 + fr] = acc[j];
          }
        }
        __syncthreads();
        {
          const int row = tid >> 2, qr = tid & 3;
          unsigned L[16];
#pragma unroll
          for (int i = 0; i < 16; ++i) L[i] = 0u;
          const float* rp = sc + row * RT_SC_STRIDE + qr * 32;
#pragma unroll
          for (int i = 0; i < 8; ++i) {
            const f32x4 v = *(const f32x4*)(rp + i * 4);
#pragma unroll
            for (int j = 0; j < 4; ++j) top16_insert(L, (fkey(v[j]) & 0xFFFFFF80u) | (unsigned)(qr * 32 + i * 4 + j));
          }
          top16_merge<1>(L);
          top16_merge<2>(L);
          if (qr == 0) {
            unsigned* dst = lists + (((row >> 4) * 2 + ph) * 16 + (row & 15)) * 16;
#pragma unroll
            for (int i = 0; i < 4; ++i) *(uint4*)(dst + i * 4) = make_uint4(L[i * 4], L[i * 4 + 1], L[i * 4 + 2], L[i * 4 + 3]);
          }
        }
        __syncthreads();
      }
    }
    for (int ii = 0; ii < RT_MAX_ITEMS; ++ii) {
      const int item = item0 + ii * nblk;
      if (item >= nitems) break;
      const int tok0 = item * 16;
      const unsigned* lists = lists_all + ii * 4096;
    {
      const int pair = tid >> 2, part = tid & 3;
      const int tk = pair & 15, hd = pair >> 4;
      const unsigned* l1 = lists + ((hd * 2 + 0) * 16 + tk) * 16;
      const unsigned* l2 = lists + ((hd * 2 + 1) * 16 + tk) * 16;
      static const unsigned char STAIR[52] = {0, 1, 2, 3, 4, 5, 6, 7, 8, 9, 10, 11, 12, 13, 14, 15, 16, 17, 18, 19, 20, 21, 22, 23, 32, 33, 34, 35, 36, 48, 49, 50, 51, 64, 65, 66, 80, 81, 96, 97, 112, 113, 128, 144, 160, 176, 192, 208, 224, 240, 255, 255};
      unsigned T[16];
#pragma unroll
      for (int i = 0; i < 16; ++i) T[i] = 0u;
#pragma unroll
      for (int j = 0; j < 13; ++j) {
        const unsigned c = STAIR[part + 4 * j];
        const float sa = funkey(l1[(c >> 4) & 15] & 0xFFFFFF80u), sb = funkey(l2[c & 15] & 0xFFFFFF80u);
        const unsigned key = (fkey(sa + sb) & 0xFFFFFF00u) | c;
        top16_insert(T, c == 255u ? 0u : key);
      }
      top16_merge<1>(T);
      top16_merge<2>(T);
      const float mx = funkey(T[0] & 0xFFFFFF00u);
      float ex[16], sum = 0.f;
#pragma unroll
      for (int r = 0; r < 16; ++r) { ex[r] = __expf(funkey(T[r] & 0xFFFFFF00u) - mx); sum += ex[r]; }
      const float inv = 1.f / sum;
      int eid[4]; float gt[4];
#pragma unroll
      for (int r = 0; r < 16; ++r) {
        if ((r >> 2) == part) {
          const int a = (T[r] >> 4) & 15, b = T[r] & 15;
          eid[r & 3] = (int)(l1[a] & 127u) * 128 + (int)(l2[b] & 127u);
          gt[r & 3] = ex[r] * inv;
        }
      }
      const size_t o = (size_t)(tok0 + tk) * 128 + hd * 16 + part * 4;
      *(int4*)(p.pidx + o) = make_int4(eid[0], eid[1], eid[2], eid[3]);
      *(f32x4*)(p.pgate + o) = (f32x4){gt[0], gt[1], gt[2], gt[3]};
    }
    }
    __syncthreads();
  }
}

typedef float f32x2 __attribute__((ext_vector_type(2)));
__device__ __forceinline__ float dot16_fp8(const uint4& r, const f32x2* h2) {
  const unsigned w[4] = {r.x, r.y, r.z, r.w};
  f32x2 d = {0.f, 0.f};
#pragma unroll
  for (int q = 0; q < 4; ++q) {
    d += __builtin_amdgcn_cvt_pk_f32_fp8(w[q], false) * h2[q * 2];
    d += __builtin_amdgcn_cvt_pk_f32_fp8(w[q], true) * h2[q * 2 + 1];
  }
  return d.x + d.y;
}
__device__ __forceinline__ void fma16_fp8(f32x2* acc2, const uint4& r, float w8) {
  const unsigned w[4] = {r.x, r.y, r.z, r.w};
  const f32x2 ww = {w8, w8};
#pragma unroll
  for (int q = 0; q < 4; ++q) {
    acc2[q * 2] += ww * __builtin_amdgcn_cvt_pk_f32_fp8(w[q], false);
    acc2[q * 2 + 1] += ww * __builtin_amdgcn_cvt_pk_f32_fp8(w[q], true);
  }
}
struct XcdInfo { int rank, nloc, xi, nx; };
__device__ __forceinline__ XcdInfo xcd_info(const XcdBarrier& b) {
  if (threadIdx.x == 0) {
    unsigned xi = 0;
    for (unsigned j = 0; j < 16; ++j) { const unsigned c = xb_ld(&b.bar[XB_XCNT(j)]); if (j < b.x && c > 0u) ++xi; }
    b.st[3] = xi;
  }
  __syncthreads();
  XcdInfo r;
  r.nloc = __builtin_amdgcn_readfirstlane((int)b.st[0]); r.nx = __builtin_amdgcn_readfirstlane((int)b.st[1]);
  r.rank = __builtin_amdgcn_readfirstlane((int)b.st[2]); r.xi = __builtin_amdgcn_readfirstlane((int)b.st[3]);
  return r;
}
__device__ __forceinline__ void gs_issue(uint4 (&buf)[16], const unsigned char* tab, const int* el, int grp) {
#pragma unroll
  for (int k = 0; k < 16; ++k) buf[k] = *(const uint4*)(tab + (size_t)el[k * 8 + grp] * 1024);
}
__device__ __forceinline__ void phase_gather_u(const Params& p, int layer, int ntok, const XcdInfo xin, unsigned char* smem) {
  const int tid = opaque_tid(); const int lane = tid & 63, wid = tid >> 6;
  int* elw = (int*)smem + wid * 256;
  float* pbuf = (float*)p.cols;
  const int sub = lane & 7, grp = lane >> 3;
  const bool b0 = (lane & 1) != 0, b1 = (lane & 2) != 0, b2 = (lane & 4) != 0;
  const int tstep = xin.nloc * NW;
  for (int s = xin.xi; s < 8; s += xin.nx) {
    const unsigned char* EU = p.eu8 + (size_t)layer * 16384 * 1024 + s * 128 + sub * 16;
    const int t0 = xin.rank * NW + wid;
    if (t0 >= ntok) continue;
    const int kslot = ((b0 ? 8 : 0) + (b1 ? 4 : 0) + (b2 ? 2 : 0)) * 8 + grp;
    uint4 bufA[16], bufB[16];
    uint4 hA0, hA1, hB0, hB1;
    int i0n, i1n;
    {
      elw[lane] = p.pidx[(size_t)t0 * 128 + lane]; elw[64 + lane] = p.pidx[(size_t)t0 * 128 + 64 + lane];
      __builtin_amdgcn_wave_barrier();
      gs_issue(bufA, EU, elw, grp);
      hA0 = *(const uint4*)(p.abuf + (size_t)t0 * 1024 + s * 128 + sub * 16); hA1 = *(const uint4*)(p.abuf + (size_t)t0 * 1024 + s * 128 + sub * 16 + 8);
      const int t1 = t0 + tstep < ntok ? t0 + tstep : t0;
      i0n = p.pidx[(size_t)t1 * 128 + lane]; i1n = p.pidx[(size_t)t1 * 128 + 64 + lane];
    }
    int par = 0;
    for (int t = t0; t < ntok; t += 2 * tstep) {
#pragma unroll
      for (int hh = 0; hh < 2; ++hh) {
        const int tc = t + hh * tstep;
        if (tc < ntok) {
          uint4 (&cur)[16] = hh ? bufB : bufA;
          uint4 (&nxt)[16] = hh ? bufA : bufB;
          const uint4 hc0 = hh ? hB0 : hA0, hc1 = hh ? hB1 : hA1;
          const int tn = tc + tstep < ntok ? tc + tstep : tc;
          par ^= 1;
          int* eln = elw + par * 128;
          eln[lane] = i0n; eln[64 + lane] = i1n;
          __builtin_amdgcn_wave_barrier();
          gs_issue(nxt, EU, eln, grp);
          const uint4 hn0 = *(const uint4*)(p.abuf + (size_t)tn * 1024 + s * 128 + sub * 16), hn1 = *(const uint4*)(p.abuf + (size_t)tn * 1024 + s * 128 + sub * 16 + 8);
          const int tnn = tn + tstep < ntok ? tn + tstep : tn;
          i0n = p.pidx[(size_t)tnn * 128 + lane]; i1n = p.pidx[(size_t)tnn * 128 + 64 + lane];
          f32x2 hv2[8];
          {
            float hv[16];
            unpack8(hc0, hv); unpack8(hc1, hv + 8);
#pragma unroll
            for (int q = 0; q < 8; ++q) hv2[q] = (f32x2){hv[2 * q], hv[2 * q + 1]};
          }
          float d[16];
#pragma unroll
          for (int k = 0; k < 16; ++k) d[k] = dot16_fp8(cur[k], hv2);
          float d8[8], d4[4], d2[2];
#pragma unroll
          for (int q = 0; q < 8; ++q) { const float send = b0 ? d[q] : d[q + 8]; const float keep = b0 ? d[q + 8] : d[q]; d8[q] = keep + __shfl_xor(send, 1); }
#pragma unroll
          for (int q = 0; q < 4; ++q) { const float send = b1 ? d8[q] : d8[q + 4]; const float keep = b1 ? d8[q + 4] : d8[q]; d4[q] = keep + __shfl_xor(send, 2); }
#pragma unroll
          for (int q = 0; q < 2; ++q) { const float send = b2 ? d4[q] : d4[q + 2]; const float keep = b2 ? d4[q + 2] : d4[q]; d2[q] = keep + __shfl_xor(send, 4); }
          float* dst = pbuf + ((size_t)s * TT + tc) * 128 + kslot;
          dst[0] = d2[0]; dst[8] = d2[1];
          if (hh) { hA0 = hn0; hA1 = hn1; } else { hB0 = hn0; hB1 = hn1; }
        }
      }
    }
    __builtin_amdgcn_wave_barrier();
  }
}
__device__ __forceinline__ void phase_gather_r(const Params& p, int layer, int ntok, int bid, int nblk) {
  const int tid = opaque_tid();
  const float* pbuf = (const float*)p.cols;
  const size_t n4 = (size_t)ntok * 32;
  for (size_t i = (size_t)bid * NT + tid; i < n4; i += (size_t)nblk * NT) {
    f32x4 z = *(const f32x4*)(pbuf + i * 4);
#pragma unroll
    for (int s = 1; s < 8; ++s) z += *(const f32x4*)(pbuf + (size_t)s * TT * 128 + i * 4);
    const f32x4 g = *(const f32x4*)(p.pgate + i * 4);
    const int4 e = *(const int4*)(p.pidx + i * 4);
    const int ev[4] = {e.x, e.y, e.z, e.w};
    f32x4 w;
#pragma unroll
    for (int j = 0; j < 4; ++j) w[j] = g[j] * gelu_f(z[j] * p.su[layer * 16384 + ev[j]]) * p.sv[layer * 16384 + ev[j]];
    *(f32x4*)(p.wbuf + i * 4) = w;
  }
}
template <bool DUMMY>
__device__ __forceinline__ void phase_gather_v(const Params& p, int layer, int ntok, const XcdInfo xin, unsigned char* smem) {
  float* xout = DUMMY ? (float*)p.cols : p.xres;
  const int tid = opaque_tid(); const int lane = tid & 63, wid = tid >> 6;
  int* elw = (int*)smem + wid * 512;
  float* wlw = (float*)(elw + 256);
  const int sub = lane & 7, grp = lane >> 3;
  const bool b5 = (lane & 32) != 0, b4 = (lane & 16) != 0, b3 = (lane & 8) != 0;
  const int tstep = xin.nloc * NW;
  for (int s = xin.xi; s < 8; s += xin.nx) {
    const unsigned char* EV = p.ev8 + (size_t)layer * 16384 * 1024 + s * 128 + sub * 16;
    const int col = s * 128 + sub * 16 + (b3 ? 8 : 0) + (b4 ? 4 : 0) + (b5 ? 2 : 0);
    const int t0 = xin.rank * NW + wid;
    if (t0 >= ntok) continue;
    uint4 bufA[16], bufB[16];
    int i0n, i1n; float w0n, w1n;
    f32x2 xc, gc, xn, gn;
    {
      elw[lane] = p.pidx[(size_t)t0 * 128 + lane]; elw[64 + lane] = p.pidx[(size_t)t0 * 128 + 64 + lane];
      wlw[lane] = p.wbuf[(size_t)t0 * 128 + lane]; wlw[64 + lane] = p.wbuf[(size_t)t0 * 128 + 64 + lane];
      __builtin_amdgcn_wave_barrier();
      gs_issue(bufA, EV, elw, grp);
      xc = *(const f32x2*)(p.xres + (size_t)t0 * 1024 + col);
      gc = *(const f32x2*)(p.modv + ((size_t)layer * 5 + tok_batch(t0)) * NMOD + 5120 + col);
      const int t1 = t0 + tstep < ntok ? t0 + tstep : t0;
      i0n = p.pidx[(size_t)t1 * 128 + lane]; i1n = p.pidx[(size_t)t1 * 128 + 64 + lane];
      w0n = p.wbuf[(size_t)t1 * 128 + lane]; w1n = p.wbuf[(size_t)t1 * 128 + 64 + lane];
      xn = *(const f32x2*)(p.xres + (size_t)t1 * 1024 + col);
      gn = *(const f32x2*)(p.modv + ((size_t)layer * 5 + tok_batch(t1)) * NMOD + 5120 + col);
    }
    int par = 0;
    for (int t = t0; t < ntok; t += 2 * tstep) {
#pragma unroll
      for (int hh = 0; hh < 2; ++hh) {
        const int tc = t + hh * tstep;
        if (tc < ntok) {
          uint4 (&cur)[16] = hh ? bufB : bufA;
          uint4 (&nxt)[16] = hh ? bufA : bufB;
          const float* wlc = wlw + par * 128;
          const int tn = tc + tstep < ntok ? tc + tstep : tc;
          par ^= 1;
          int* eln = elw + par * 128; float* wln = wlw + par * 128;
          eln[lane] = i0n; eln[64 + lane] = i1n; wln[lane] = w0n; wln[64 + lane] = w1n;
          __builtin_amdgcn_wave_barrier();
          gs_issue(nxt, EV, eln, grp);
          const f32x2 xcur = xc, gcur = gc;
          xc = xn; gc = gn;
          const int tnn = tn + tstep < ntok ? tn + tstep : tn;
          i0n = p.pidx[(size_t)tnn * 128 + lane]; i1n = p.pidx[(size_t)tnn * 128 + 64 + lane];
          w0n = p.wbuf[(size_t)tnn * 128 + lane]; w1n = p.wbuf[(size_t)tnn * 128 + 64 + lane];
          xn = *(const f32x2*)(p.xres + (size_t)tnn * 1024 + col);
          gn = *(const f32x2*)(p.modv + ((size_t)layer * 5 + tok_batch(tnn)) * NMOD + 5120 + col);
          f32x2 acc2[8];
#pragma unroll
          for (int j = 0; j < 8; ++j) acc2[j] = (f32x2){0.f, 0.f};
#pragma unroll
          for (int k = 0; k < 16; ++k) fma16_fp8(acc2, cur[k], wlc[k * 8 + grp]);
          float a16[16];
#pragma unroll
          for (int q = 0; q < 8; ++q) { a16[2 * q] = acc2[q].x; a16[2 * q + 1] = acc2[q].y; }
          float a8[8], a4[4], a2[2];
#pragma unroll
          for (int q = 0; q < 8; ++q) { const float send = b3 ? a16[q] : a16[q + 8]; const float keep = b3 ? a16[q + 8] : a16[q]; a8[q] = keep + __shfl_xor(send, 8); }
#pragma unroll
          for (int q = 0; q < 4; ++q) { const float send = b4 ? a8[q] : a8[q + 4]; const float keep = b4 ? a8[q + 4] : a8[q]; a4[q] = keep + __shfl_xor(send, 16); }
#pragma unroll
          for (int q = 0; q < 2; ++q) { const float send = b5 ? a4[q] : a4[q + 2]; const float keep = b5 ? a4[q + 2] : a4[q]; a2[q] = keep + __shfl_xor(send, 32); }
          f32x2 xv = xcur;
          xv.x += gcur.x * a2[0]; xv.y += gcur.y * a2[1];
          *(f32x2*)(xout + (size_t)tc * 1024 + col) = xv;
        }
      }
    }
    __builtin_amdgcn_wave_barrier();
  }
}
__device__ __forceinline__ void phase_gather_norm(const Params& p, int layer, int ntok, int bid, int nblk) {
  const int tid = opaque_tid(); const int lane = tid & 63, wid = tid >> 6;
  for (int t = bid * NW + wid; t < ntok; t += nblk * NW) {
    f32x4 xv[4];
    float ss = 0.f;
#pragma unroll
    for (int q = 0; q < 4; ++q) {
      xv[q] = *(const f32x4*)(p.xres + (size_t)t * 1024 + lane * 16 + q * 4);
      ss += xv[q][0] * xv[q][0] + xv[q][1] * xv[q][1] + xv[q][2] * xv[q][2] + xv[q][3] * xv[q][3];
    }
    ss = wave_sum(ss);
    const float rstd = rsqrtf(ss * (1.f / 1024.f) + EPSV);
    if (layer == 0) {
      const float* md1 = p.modv + ((size_t)5 + tok_batch(t)) * NMOD;
#pragma unroll
      for (int q = 0; q < 4; ++q) {
        const int c0 = lane * 16 + q * 4;
        const f32x4 g = *(const f32x4*)(p.norm1_g + 1024 + c0);
        const f32x4 sh = *(const f32x4*)(md1 + c0);
        const f32x4 sc = *(const f32x4*)(md1 + 1024 + c0);
        ushort4 o;
        o.x = f2bf(xv[q][0] * rstd * g[0] * (1.f + sc[0]) + sh[0]);
        o.y = f2bf(xv[q][1] * rstd * g[1] * (1.f + sc[1]) + sh[1]);
        o.z = f2bf(xv[q][2] * rstd * g[2] * (1.f + sc[2]) + sh[2]);
        o.w = f2bf(xv[q][3] * rstd * g[3] * (1.f + sc[3]) + sh[3]);
        *(ushort4*)(p.abuf + (size_t)t * 1024 + c0) = o;
      }
    } else {
#pragma unroll
      for (int q = 0; q < 4; ++q) {
        const int c0 = lane * 16 + q * 4;
        const f32x4 g = *(const f32x4*)(p.final_g + c0);
        f32x4 o;
        o[0] = xv[q][0] * rstd * g[0]; o[1] = xv[q][1] * rstd * g[1]; o[2] = xv[q][2] * rstd * g[2]; o[3] = xv[q][3] * rstd * g[3];
        *(f32x4*)(p.out + (size_t)t * 1024 + c0) = o;
      }
    }
  }
}

__device__ __forceinline__ void phase_final(const Params& p, int bid, int nblk) {
  const int tid = opaque_tid(); const int lane = tid & 63, wid = tid >> 6;
  for (int t = bid * 4 + wid; t < TL; t += nblk * 4) {
    const float* row = p.xres + (size_t)t * 1024;
    f32x4 v[4];
    float ss = 0.f;
#pragma unroll
    for (int j = 0; j < 4; ++j) {
      v[j] = *(const f32x4*)(row + j * 256 + lane * 4);
      ss += v[j][0] * v[j][0] + v[j][1] * v[j][1] + v[j][2] * v[j][2] + v[j][3] * v[j][3];
    }
    ss = wave_sum(ss);
    const float rstd = rsqrtf(ss * (1.f / 1024.f) + EPSV);
#pragma unroll
    for (int j = 0; j < 4; ++j) {
      const int c0 = j * 256 + lane * 4;
      const f32x4 g = *(const f32x4*)(p.final_g + c0);
      f32x4 o;
      o[0] = v[j][0] * rstd * g[0]; o[1] = v[j][1] * rstd * g[1]; o[2] = v[j][2] * rstd * g[2]; o[3] = v[j][3] * rstd * g[3];
      *(f32x4*)(p.out + (size_t)t * 1024 + c0) = o;
    }
  }
}

template <class Epi>
__device__ __forceinline__ void run_gemm(const bf16_t* A, const bf16_t* Bt, int M, int N, int K, const Epi& epi, int bid, int nblk, unsigned char* smem) {
  pg8::Gemm g{A, Bt, M, N, K};
  pg8::StaticOrder S; S.init(M, N, nblk, bid);
  pg8::gemm_phase(( PG8_LAS unsigned char*)smem, g, S, epi);
}
__device__ __forceinline__ void phase_gemm_in(const Params& p, int layer, int bid, int nblk, unsigned char* smem) {
  pg8::EpiBf16 epi{p.cols, INW, INW};
  run_gemm(p.abuf, p.wt_in + (size_t)layer * INWP * 1024, TT, INWP, 1024, epi, bid, nblk, smem);
}
__device__ __forceinline__ void phase_gemm_glu(const Params& p, int layer, int ntok, int bid, int nblk, unsigned char* smem) {
  pg8::EpiGlu epi{p.mix};
  run_gemm(p.yg, p.wt_glu + (size_t)layer * 512 * 256, ntok, 512, 256, epi, bid, nblk, smem);
}
__device__ __forceinline__ void phase_gemm_out(const Params& p, int layer, int ntok, int bid, int nblk, unsigned char* smem) {
  pg8::EpiResid epi{p.xres, p.modv + (size_t)layer * 5 * NMOD, 2048};
  run_gemm(p.mix, p.wt_out + (size_t)layer * 1024 * 1024, ntok, 1024, 1024, epi, bid, nblk, smem);
}
__device__ __forceinline__ void phase_gemm_q(const Params& p, int layer, int ntok, int bid, int nblk, unsigned char* smem) {
  pg8::EpiBf16 epi{p.cols  , 2048, 2048};
  run_gemm(p.abuf, p.wt_q + (size_t)layer * 2048 * 1024, ntok, 2048, 1024, epi, bid, nblk, smem);
}

template <int L>
__device__ __forceinline__ void layer_body(const Params& p, const XcdBarrier& bar, const XcdInfo xin, int bid, int nblk, unsigned char* smem) {
  constexpr int l = L;
  constexpr int ntok = L == 0 ? TT : TL;
  for (int rep = 0; rep < REP_GEMM; ++rep) phase_gemm_in(p, l, bid, nblk, smem);
  xcd_barrier(bar);
  for (int rep = 0; rep < REP_MIX; ++rep) {
    phase_s5a(p, l, bid, nblk, smem);
    if (REP_S5 > 1) phase_s5a(p, l, bid, nblk, smem);
    for (int r2 = 0; r2 < REP_GLA; ++r2) phase_glaa(p, l, bid, nblk, smem);
  }
  xcd_barrier(bar);
  phase_scan(p, l, bid, nblk);
  for (int r2 = 0; r2 < REP_SGU; ++r2) phase_sgu(p, l, ntok / 128, bid, nblk, smem);
  xcd_barrier(bar);
  for (int rep = 0; rep < REP_MIX; ++rep) {
    phase_s5c(p, l, ntok / 64, bid, nblk, smem);
    if (REP_S5 > 1) phase_s5c(p, l, ntok / 64, bid, nblk, smem);
    for (int r2 = 0; r2 < REP_GLA; ++r2) phase_glac(p, l, ntok / 64, bid, nblk, smem);
  }
  xcd_barrier(bar);
  for (int rep = 0; rep < REP_GEMM; ++rep) phase_gemm_glu(p, l, ntok, bid, nblk, smem);
  xcd_barrier(bar);
  if (REP_GEMM > 1) {
    pg8::EpiBf16 epi{p.abuf, 1024, 1024};
    for (int rep = 1; rep < REP_GEMM; ++rep) run_gemm(p.mix, p.wt_out + (size_t)l * 1024 * 1024, ntok, 1024, 1024, epi, bid, nblk, smem);
  }
  phase_gemm_out(p, l, ntok, bid, nblk, smem);
  if (l == 0 && nblk > 16 && bid >= 16) {
    const int tid = opaque_tid();
    for (int j = bid - 16; j < 2048; j += nblk - 16) convert_rows(p, (j >> 10) * 2048 + 1024 + (j & 1023), tid);
  } else if (l == 0 && nblk <= 16) {
    const int tid = opaque_tid();
    for (int j = bid; j < 2048; j += nblk) convert_rows(p, (j >> 10) * 2048 + 1024 + (j & 1023), tid);
  }
  xcd_barrier(bar);
  for (int rep = 0; rep < REP_PRO; ++rep)
    phase_normmod(p, p.xres, p.xres + (size_t)TL * 1024, p.norm2_g + l * 1024, p.modv + (size_t)l * 5 * NMOD, 3072, 4096, ntok, 0, bid, nblk);
  xcd_barrier(bar);
  for (int rep = 0; rep < REP_GEMM; ++rep) phase_gemm_q(p, l, ntok, bid, nblk, smem);
  xcd_barrier(bar);
  for (int rep = 0; rep < REP_ROUTE; ++rep) phase_route(p, l, ntok, bid, nblk, smem);
  xcd_barrier(bar);
  phase_gather_u(p, l, ntok, xin, smem);
  if (REP_GATHER == 2) phase_gather_u(p, l, ntok, xin, smem);
  xcd_barrier(bar);
  phase_gather_r(p, l, ntok, bid, nblk);
  xcd_barrier(bar);
  if (REP_GATHER > 2) phase_gather_v<true>(p, l, ntok, xin, smem);
  phase_gather_v<false>(p, l, ntok, xin, smem);
  xcd_barrier(bar);
  phase_gather_norm(p, l, ntok, bid, nblk);
  if (l == 0) xcd_barrier(bar);
}

#define SMEM_BYTES (148 * 1024)
__global__ void __launch_bounds__(NT) mega_kernel(Params p) {
  __shared__ __attribute__((aligned(16))) unsigned char smem[SMEM_BYTES + 16];
  const int bid = blockIdx.x, nblk = gridDim.x;
  volatile LAS unsigned* xbw = (volatile LAS unsigned*)(smem + SMEM_BYTES);
  if (threadIdx.x == 0) { xbw[0] = 0u; xbw[1] = 0u; xbw[2] = 0u; xbw[3] = 0u; }
  __syncthreads();
  XcdBarrier bar = xcd_barrier_post(p.bar, xbw);
  for (int rep = 0; rep < REP_PRO; ++rep) {
    phase_mod(p, bid, nblk, smem);
    phase_wprep(p, bid, nblk, smem);
  }
  xcd_barrier(bar);
  for (int rep = 0; rep < REP_PRO; ++rep) phase_normmod(p, p.x, p.ctx, p.norm1_g, p.modv, 0, 1024, TT, 1, bid, nblk);
  xcd_barrier(bar);
  const XcdInfo xin = xcd_info(bar);
  layer_body<0>(p, bar, xin, bid, nblk, smem);
  layer_body<1>(p, bar, xin, bid, nblk, smem);
}

static inline size_t align_up(size_t v, size_t a) { return (v + a - 1) / a * a; }

extern "C" void kernel_launch(void* const* d_in, const int* in_sizes, int n_in, void* d_out, int out_size, void* d_ws, size_t ws_size,
                              hipStream_t stream) {
  Params p{};
  const float* const* in = (const float* const*)d_in;
  p.x = in[0]; p.c = in[1]; p.ctx = in[2]; p.c_ctx = in[3]; p.w_mod = in[4]; p.b_mod = in[5]; p.norm1_g = in[6]; p.norm2_g = in[7];
  p.w_in = in[8]; p.w_out = in[9]; p.sgu_w = in[10]; p.sgu_b = in[11]; p.lam_re = in[12]; p.lam_im = in[13]; p.b_re = in[14]; p.b_im = in[15];
  p.c_re = in[16]; p.c_im = in[17]; p.log_step = in[18]; p.s5_d = in[19]; p.w_glu = in[20]; p.gla_wg = in[21]; p.gla_bg = in[22]; p.gla_ng = in[23];
  p.w_query = in[24]; p.sub_keys = in[25]; p.exp_u = in[26]; p.exp_v = in[27]; p.final_g = in[28];
  p.out = (float*)d_out;
  unsigned char* w = (unsigned char*)d_ws;
  size_t off = 0;
  auto take = [&](size_t bytes) { void* r = w + off; off = align_up(off + bytes, 256); return r; };
  p.bar = (unsigned*)take(16384);
  p.xres = (float*)take((size_t)TT * 1024 * 4);
  p.modv = (float*)take((size_t)2 * 5 * NMOD * 4);
  p.abuf = (bf16_t*)take((size_t)TT * 1024 * 2);
  p.cols = (bf16_t*)take((size_t)TT * INW * 2);
  p.mix = (bf16_t*)take((size_t)TT * 1024 * 2);
  p.yg = (bf16_t*)take((size_t)TT * 256 * 2);
  p.wt_in = (bf16_t*)take((size_t)2 * INWP * 1024 * 2);
  p.wt_out = (bf16_t*)take((size_t)2 * 1024 * 1024 * 2);
  p.wt_q = (bf16_t*)take((size_t)2 * 2048 * 1024 * 2);
  p.wt_glu = (bf16_t*)take((size_t)2 * 512 * 256 * 2);
  p.keysb = (bf16_t*)take((size_t)2 * 2 * 8 * 128 * 128 * 2);
  p.sgu_wb = (bf16_t*)take((size_t)2 * 4 * 128 * 128 * 2);
  p.s5a = (float*)take((size_t)4096 * 2 * 4);
  p.s5a64 = (float*)take((size_t)4096 * 2 * 4);
  p.s5bb = (float*)take((size_t)4096 * 32 * 4);
  p.s5K = (bf16_t*)take((size_t)64 * 16384 * 2);
  p.s5M1 = (bf16_t*)take((size_t)64 * 131072 * 2);
  p.s5N2 = (bf16_t*)take((size_t)64 * 131072 * 2);
  p.s5S = (float*)take((size_t)2 * NSC * 16 * 64 * 2 * 4);
  p.s5H = (float*)take((size_t)2 * NSC * 16 * 64 * 2 * 4);
  p.gkv = (float*)take((size_t)2 * NSC * 8 * 2048 * 4);
  p.gdec = (float*)take((size_t)2 * NSC * 8 * 32 * 4);
  p.eu8 = (unsigned char*)take((size_t)2 * 16384 * 1024);
  p.ev8 = (unsigned char*)take((size_t)2 * 16384 * 1024);
  p.su = (float*)take((size_t)2 * 16384 * 4);
  p.sv = (float*)take((size_t)2 * 16384 * 4);
  p.glb = (float*)take((size_t)2 * TT * 256 * 4);
  p.wbuf = (float*)take((size_t)TT * 128 * 4);
  p.ssbuf = (float*)take((size_t)TT * 8 * 4);
  p.pidx = (int*)take((size_t)TT * 128 * 4);
  p.pgate = (float*)take((size_t)TT * 128 * 4);
  if (off > ws_size) { fprintf(stderr, "workspace too small: need %zu have %zu\n", off, ws_size); return; }

  (void)hipMemsetAsync(p.bar, 0, XCD_BAR_WORDS * 4, stream);
  static int grid_blocks = 0;
  if (!grid_blocks) {
    int dev = 0, cus = 0, per_cu = 0;
    (void)hipGetDevice(&dev);
    (void)hipDeviceGetAttribute(&cus, hipDeviceAttributeMultiprocessorCount, dev);
    (void)hipOccupancyMaxActiveBlocksPerMultiprocessor(&per_cu, (const void*)mega_kernel, NT, 0);
    if (per_cu < 1) { fprintf(stderr, "occupancy query says 0 blocks/CU\n"); per_cu = 1; }
    grid_blocks = cus;
  }
  void* args[] = {&p};
  hipError_t e = hipLaunchCooperativeKernel((const void*)mega_kernel, dim3(grid_blocks), dim3(NT), args, 0, stream);
  if (e != hipSuccess) fprintf(stderr, "cooperative launch failed: %s (grid %d)\n", hipGetErrorString(e), grid_blocks);
}
```

```cpp
#include <hip/hip_runtime.h>
#include <cstdio>
#include <cstdint>
#include <cmath>

typedef unsigned short bf16_t;
typedef short bf16x8 __attribute__((ext_vector_type(8)));
typedef float f32x4 __attribute__((ext_vector_type(4)));

#define DM 1024
#define NBATCH 4
#define SEQ 4096
#define CTXL 256
#define TL (NBATCH * SEQ)
#define TC (NBATCH * CTXL)
#define TT (TL + TC)
#define INW 2336
#define INWP 2560
#define NMOD 6144
#define NSC 272
#define EPSV 1e-6f
#define NT 512
#define NW 8
#ifndef REP_GATHER
#define REP_GATHER 1
#endif
#ifndef REP_ROUTE
#define REP_ROUTE 1
#endif
#ifndef REP_GEMM
#define REP_GEMM 1
#endif
#ifndef REP_MIX
#define REP_MIX 1
#endif
#ifndef REP_PRO
#define REP_PRO 1
#endif
#ifndef REP_SGU
#define REP_SGU 1
#endif
#ifndef REP_S5
#define REP_S5 1
#endif
#ifndef REP_GLA
#define REP_GLA 1
#endif

#define C_SGU_U 0
#define C_SGU_V 256
#define C_S5 512
#define C_GQ 768
#define C_GK 1024
#define C_GV 1280
#define C_GG 1792
#define C_ZF 2304

struct Params {
  const float *x, *c, *ctx, *c_ctx, *w_mod, *b_mod, *norm1_g, *norm2_g, *w_in, *w_out, *sgu_w, *sgu_b;
  const float *lam_re, *lam_im, *b_re, *b_im, *c_re, *c_im, *log_step, *s5_d, *w_glu, *gla_wg, *gla_bg, *gla_ng;
  const float *w_query, *sub_keys, *exp_u, *exp_v, *final_g;
  float* out;
  unsigned* bar;
  float* xres;
  float* modv;
  bf16_t* abuf;
  bf16_t* cols;
  bf16_t* mix;
  bf16_t* yg;
  bf16_t *wt_in, *wt_out, *wt_q, *wt_glu, *keysb, *sgu_wb;
  float *s5a, *s5a64, *s5bb;
  bf16_t *s5K, *s5M1, *s5N2;
  float *s5S, *s5H;
  float *gkv, *gdec;
  unsigned char *eu8, *ev8;
  float *su, *sv;
  float* glb;
  float *wbuf, *ssbuf;
  int* pidx;
  float* pgate;
};

__device__ __forceinline__ bf16_t f2bf(float f) {
  unsigned u = __float_as_uint(f);
  u += 0x7fffu + ((u >> 16) & 1u);
  return (bf16_t)(u >> 16);
}
__device__ __forceinline__ float bf2f(bf16_t h) { return __uint_as_float(((unsigned)h) << 16); }
__device__ __forceinline__ bf16x8 pack_bf16x8(const float* v) {
  bf16x8 r;
#pragma unroll
  for (int c = 0; c < 8; ++c) r[c] = (short)f2bf(v[c]);
  return r;
}

__device__ __forceinline__ float bflo(unsigned u) { return __uint_as_float(u << 16); }
__device__ __forceinline__ float bfhi(unsigned u) { return __uint_as_float(u & 0xffff0000u); }
__device__ __forceinline__ float gelu_f(float x) {
  const float y = 0.7978845608028654f * (x + 0.044715f * x * x * x);
  const float e = __expf(2.f * y);
  const float th = 1.f - 2.f / (1.f + e);
  return 0.5f * x * (1.f + th);
}
__device__ __forceinline__ float sigmoid_f(float x) { return 1.f / (1.f + __expf(-x)); }
__device__ __forceinline__ float silu_f(float x) { return x * sigmoid_f(x); }
__device__ __forceinline__ float logsigmoid_f(float x) { return fminf(x, 0.f) - log1pf(__expf(-fabsf(x))); }
__device__ __forceinline__ float wave_sum(float v) {
#pragma unroll
  for (int o = 32; o > 0; o >>= 1) v += __shfl_xor(v, o);
  return v;
}
__device__ __forceinline__ void lds_barrier() {
  asm volatile("s_waitcnt lgkmcnt(0)" ::: "memory");
  __builtin_amdgcn_s_barrier();
  asm volatile("" ::: "memory");
}
__device__ __forceinline__ int opaque_tid() { int t = threadIdx.x; asm volatile("" : "+v"(t)); return t; }
__device__ __forceinline__ int tok_batch(int t) { return t < TL ? (t >> 12) : 4; }
__device__ __forceinline__ int s5_tok(int sc, int i) { return sc < 256 ? ((sc >> 6) * SEQ + (sc & 63) * 64 + i) : (TL + (sc - 256) * 64 + i); }
__device__ __forceinline__ int gla_tok(int sc, int i) { return sc < 256 ? ((sc >> 6) * SEQ + i * 64 + (sc & 63)) : (TL + (sc - 256) * 64 + i); }


#define XB_TMO      128
#define XB_XCNT(j)  (256  + 64 * (j))
#define XB_XSUB(j)  (1280 + 64 * (j))
#define XB_XGEN(j)  (2304 + 64 * (j))
#define XB_TOP      3328
#define XB_TOPGEN   3392
#define XCD_BAR_WORDS 3456
#define XB_SPIN_CAP (1u << 22)
#define LAS __attribute__((address_space(3)))
__device__ __forceinline__ unsigned xb_ld(unsigned* p)              { return __hip_atomic_load(p, __ATOMIC_RELAXED, __HIP_MEMORY_SCOPE_AGENT); }
__device__ __forceinline__ unsigned xb_add(unsigned* p, unsigned v) { return __hip_atomic_fetch_add(p, v, __ATOMIC_RELAXED, __HIP_MEMORY_SCOPE_AGENT); }
__device__ __forceinline__ unsigned xb_xcc_id() { return (unsigned)__builtin_amdgcn_s_getreg((3 << 11) | 20) & 0xFu; }
#define XB_SPIN(cond, bar) do { unsigned _sp = 0; while (cond) { __builtin_amdgcn_s_sleep(1); \
    if ((++_sp & 255u) == 0u) { if (xb_ld(&(bar)[XB_TMO])) break; if (_sp > XB_SPIN_CAP) { atomicAdd(&(bar)[XB_TMO], 1u); break; } } } } while (0)
struct XcdBarrier { unsigned* bar; unsigned x; volatile LAS unsigned* st; };
__device__ __forceinline__ XcdBarrier xcd_barrier_post(unsigned* bar, volatile LAS unsigned* st) {
  XcdBarrier b; b.bar = bar; b.x = xb_xcc_id(); b.st = st;
  if (threadIdx.x == 0) st[2] = xb_add(&bar[XB_XCNT(b.x)], 1u);
  return b;
}
__device__ __forceinline__ void xcd_barrier_complete(unsigned* bar, unsigned x, unsigned& nloc, unsigned& nx) {
  const unsigned G = gridDim.x * gridDim.y * gridDim.z;
  unsigned sum, cnt, mine, sp = 0u;
  for (;;) {
    sum = 0u; cnt = 0u; mine = 0u;
#pragma unroll
    for (unsigned j = 0; j < 16; ++j) { const unsigned c = xb_ld(&bar[XB_XCNT(j)]); sum += c; cnt += (c > 0u) ? 1u : 0u; mine = (j == x) ? c : mine; }
    if (sum == G) break;
    __builtin_amdgcn_s_sleep(1);
    if ((++sp & 255u) == 0u) { if (xb_ld(&bar[XB_TMO])) break; if (sp > XB_SPIN_CAP) { atomicAdd(&bar[XB_TMO], 1u); break; } }
  }
  nloc = mine > 0u ? mine : 1u; nx = cnt > 0u ? cnt : 1u;
}
__device__ __forceinline__ void xcd_barrier(const XcdBarrier& b) {
  asm volatile("s_waitcnt vmcnt(0)" ::: "memory");
  __syncthreads();
  if (threadIdx.x == 0) {
    unsigned* bar = b.bar;
    __builtin_amdgcn_s_waitcnt(0);
    unsigned nloc = b.st[0], nx = b.st[1];
    if (nloc == 0u) { xcd_barrier_complete(bar, b.x, nloc, nx); b.st[0] = nloc; b.st[1] = nx; }
    const unsigned old = xb_add(&bar[XB_XSUB(b.x)], 1u);
    const unsigned gen = old / nloc;
    if (old + 1u == (gen + 1u) * nloc) {
      __builtin_amdgcn_fence(__ATOMIC_RELEASE, "agent");
      asm volatile("s_waitcnt vmcnt(0)" ::: "memory");
      const unsigned og = xb_add(&bar[XB_TOP], 1u);
      const unsigned tg = og / nx;
      if (og + 1u == (tg + 1u) * nx) xb_add(&bar[XB_TOPGEN], 1u);
      else XB_SPIN(xb_ld(&bar[XB_TOPGEN]) == tg, bar);
      __builtin_amdgcn_fence(__ATOMIC_ACQUIRE, "agent");
      xb_add(&bar[XB_XGEN(b.x)], 1u);
      asm volatile("s_waitcnt vmcnt(0)" ::: "memory");
    } else {
      XB_SPIN(xb_ld(&bar[XB_XGEN(b.x)]) == gen, bar);
      __builtin_amdgcn_fence(__ATOMIC_ACQUIRE, "agent");
      asm volatile("s_waitcnt vmcnt(0)" ::: "memory");
    }
  }
  __syncthreads();
}

__device__ __forceinline__ void phase_mod(const Params& p, int bid, int nblk, unsigned char* smem) {
  float* sil = (float*)smem;
  float* red = sil + 5 * 1024;
  const int tid = opaque_tid();
  for (int i = tid; i < 5 * 1024; i += NT) {
    const int r = i >> 10, k = i & 1023;
    const float v = r < 4 ? p.c[r * 1024 + k] : p.c_ctx[k];
    sil[i] = silu_f(v);
  }
  __syncthreads();
  for (int item = bid; item < 192; item += nblk) {
    const int l = item / 96, j0 = (item % 96) * 64;
    const int cc = tid & 63, kg = tid >> 6;
    float acc[5] = {0.f, 0.f, 0.f, 0.f, 0.f};
    const float* w = p.w_mod + (size_t)l * 1024 * NMOD + j0 + cc;
#pragma unroll 32
    for (int k = kg * 128; k < kg * 128 + 128; ++k) {
      const float wv = w[(size_t)k * NMOD];
#pragma unroll
      for (int r = 0; r < 5; ++r) acc[r] += sil[r * 1024 + k] * wv;
    }
#pragma unroll
    for (int r = 0; r < 5; ++r) red[(kg * 5 + r) * 64 + cc] = acc[r];
    __syncthreads();
    if (tid < 320) {
      const int r = tid >> 6;
      float s = 0.f;
#pragma unroll
      for (int g = 0; g < 8; ++g) s += red[(g * 5 + r) * 64 + cc];
      p.modv[((size_t)l * 5 + r) * NMOD + j0 + cc] = s + p.b_mod[l * NMOD + j0 + cc];
    }
    __syncthreads();
  }
}

__device__ __forceinline__ void transpose_tile(const float* src, int ldsrc, bf16_t* dst, int lddst, int k0, int r0, int nsrc, int glu, float* tile) {
  const int tid = opaque_tid();
  const int j = tid & 63;
  const int r = r0 + j;
  int scol;
  if (glu) {
    const int pn = r >> 8, bj = (r >> 7) & 1, i = r & 127;
    scol = bj * 256 + pn * 128 + i;
  } else {
    scol = r < nsrc ? r : -1;
  }
  float v[32];
#pragma unroll
  for (int it = 0; it < 32; ++it) {
    const int kk = (tid >> 6) + it * 8;
    v[it] = scol >= 0 ? src[(size_t)(k0 + kk) * ldsrc + scol] : 0.f;
  }
#pragma unroll
  for (int it = 0; it < 32; ++it) {
    const int kk = (tid >> 6) + it * 8;
    tile[(kk >> 6) * 4160 + (kk & 63) * 65 + j] = v[it];
  }
  __syncthreads();
  const int kq = tid & 63;
#pragma unroll
  for (int it = 0; it < 32; ++it) {
    const int jj = (tid >> 6) + (it & 7) * 8, sub = it >> 3;
    dst[(size_t)(r0 + jj) * lddst + k0 + sub * 64 + kq] = f2bf(tile[sub * 4160 + kq * 65 + jj]);
  }
  __syncthreads();
}

__device__ __forceinline__ void s5_tables(const Params& p, int id, int part, unsigned char* smem) {
  const int tid = opaque_tid();
  float2* Apow = (float2*)smem;
  float2* Bbs = Apow + 65 * 64;
  float2* Cs = Bbs + 64 * 16;
  __syncthreads();
  if (tid < 64) {
    const int pid = id * 64 + tid;
    double lre = (double)p.lam_re[pid];
    if (lre > -1e-4) lre = -1e-4;
    const double lim = (double)p.lam_im[pid];
    const double dt = exp((double)p.log_step[id]);
    const double mag = exp(lre * dt);
    const double are = mag * cos(lim * dt), aim = mag * sin(lim * dt);
    {
      double pr = 1.0, pi = 0.0;
      for (int n = 0; n <= 64; ++n) {
        Apow[n * 64 + tid] = make_float2((float)pr, (float)pi);
        const double nr = pr * are - pi * aim, ni = pr * aim + pi * are;
        pr = nr; pi = ni;
      }
    }
    const double den = lre * lre + lim * lim;
    const double fre = ((are - 1.0) * lre + aim * lim) / den;
    const double fim = (aim * lre - (are - 1.0) * lim) / den;
    for (int h = 0; h < 16; ++h) {
      const double br = (double)p.b_re[(size_t)pid * 16 + h], bi = (double)p.b_im[(size_t)pid * 16 + h];
      Bbs[tid * 16 + h] = make_float2((float)(fre * br - fim * bi), (float)(fre * bi + fim * br));
    }
  }
  for (int e = tid; e < 1024; e += NT) Cs[e] = make_float2(p.c_re[(size_t)id * 1024 + e], p.c_im[(size_t)id * 1024 + e]);
  __syncthreads();
  bf16_t* Kt = p.s5K + (size_t)id * 16384;
  for (int e = part * 2048 + tid; e < part * 2048 + 2048; e += NT) {
    const int d = e >> 8, hp = (e >> 4) & 15, h = e & 15;
    float acc = 0.f;
    for (int pp = 0; pp < 64; ++pp) {
      const float2 c = Cs[hp * 64 + pp], a = Apow[d * 64 + pp], b = Bbs[pp * 16 + h];
      const float cr = c.x * a.x - c.y * a.y, ci = c.x * a.y + c.y * a.x;
      acc += cr * b.x - ci * b.y;
    }
    Kt[e] = f2bf(acc);
  }
  bf16_t* M1 = p.s5M1 + (size_t)id * 131072;
  for (int e = part * 16384 + tid; e < part * 16384 + 16384; e += NT) {
    const int c = e >> 10, k = e & 1023, ri = c >> 6, pp = c & 63, tau = k >> 4, h = k & 15;
    const float2 a = Apow[(63 - tau) * 64 + pp], b = Bbs[pp * 16 + h];
    M1[e] = f2bf(ri ? (a.x * b.y + a.y * b.x) : (a.x * b.x - a.y * b.y));
  }
  bf16_t* N2 = p.s5N2 + (size_t)id * 131072;
  for (int e = part * 16384 + tid; e < part * 16384 + 16384; e += NT) {
    const int col = e >> 7, kk = e & 127, tau = col >> 4, hp = col & 15, ri = kk >> 6, pp = kk & 63;
    const float2 c = Cs[hp * 64 + pp], a = Apow[(tau + 1) * 64 + pp];
    N2[e] = f2bf(ri ? -(c.x * a.y + c.y * a.x) : (c.x * a.x - c.y * a.y));
  }
  __syncthreads();
}

__device__ __forceinline__ void convert_rows(const Params& p, int it, int tid) {
      const int lane = tid & 63;
      const int row0 = it * 16 + (tid >> 6) * 2;
      const int tab = row0 >> 15, r0 = row0 & 32767;
      const float* s = (tab ? p.exp_v : p.exp_u) + (size_t)r0 * 1024 + lane * 16;
      f32x4 v[2][4];
#pragma unroll
      for (int rr = 0; rr < 2; ++rr)
#pragma unroll
        for (int q = 0; q < 4; ++q) v[rr][q] = *(const f32x4*)(s + rr * 1024 + q * 4);
#pragma unroll
      for (int rr = 0; rr < 2; ++rr) {
        float m = 0.f;
#pragma unroll
        for (int q = 0; q < 4; ++q) m = fmaxf(m, fmaxf(fmaxf(fabsf(v[rr][q][0]), fabsf(v[rr][q][1])), fmaxf(fabsf(v[rr][q][2]), fabsf(v[rr][q][3]))));
#pragma unroll
        for (int o = 32; o > 0; o >>= 1) m = fmaxf(m, __shfl_xor(m, o));
        const float scale = m > 0.f ? m * (1.f / 400.f) : 1.f;
        const float inv = 1.f / scale;
        unsigned wv[4];
#pragma unroll
        for (int q = 0; q < 4; ++q) {
          unsigned w = 0;
          w = __builtin_amdgcn_cvt_pk_fp8_f32(v[rr][q][0] * inv, v[rr][q][1] * inv, w, false);
          w = __builtin_amdgcn_cvt_pk_fp8_f32(v[rr][q][2] * inv, v[rr][q][3] * inv, w, true);
          wv[q] = w;
        }
        *(uint4*)((tab ? p.ev8 : p.eu8) + (size_t)(r0 + rr) * 1024 + lane * 16) = make_uint4(wv[0], wv[1], wv[2], wv[3]);
        if (lane == 0) (tab ? p.sv : p.su)[r0 + rr] = scale;
      }
}

__device__ __forceinline__ void phase_wprep(const Params& p, int bid, int nblk, unsigned char* smem) {
  float* tile = (float*)smem;
  const int tid = opaque_tid();
  const int NT_L = 360;
  const int n_tr = 2 * NT_L;
  const int n_keys = 256 + 64;
  const int n_disc = 8;
  const int n_exp = 2048;
  const int n_s5t = 512;
  const int total = n_tr + n_keys + n_disc + n_exp + n_s5t;
  for (int item0 = bid; item0 < total; item0 += nblk) {
    const int item = item0 - n_s5t;
    if (item0 < n_s5t) {
      s5_tables(p, item0 >> 3, item0 & 7, smem);
    } else if (item < n_tr) {
      const int l = item / NT_L;
      int t = item % NT_L;
      if (t < 160) {
        transpose_tile(p.w_in + (size_t)l * 1024 * INW, INW, p.wt_in + (size_t)l * INWP * 1024, 1024, (t % 4) * 256, (t / 4) * 64, INW, 0, tile);
      } else if (t < 224) {
        t -= 160;
        transpose_tile(p.w_out + (size_t)l * 1024 * 1024, 1024, p.wt_out + (size_t)l * 1024 * 1024, 1024, (t % 4) * 256, (t / 4) * 64, 1024, 0, tile);
      } else if (t < 352) {
        t -= 224;
        transpose_tile(p.w_query + (size_t)l * 1024 * 2048, 2048, p.wt_q + (size_t)l * 2048 * 1024, 1024, (t % 4) * 256, (t / 4) * 64, 2048, 0, tile);
      } else {
        t -= 352;
        transpose_tile(p.w_glu + (size_t)l * 256 * 512, 512, p.wt_glu + (size_t)l * 512 * 256, 256, 0, t * 64, 512, 1, tile);
      }
    } else if (item < n_tr + n_keys) {
      const int ki = item - n_tr;
      if (ki < 256) {
        const int base = ki * 2048;
        for (int i = tid; i < 2048; i += NT) p.keysb[base + i] = f2bf(p.sub_keys[base + i]);
      } else {
        const int base = (ki - 256) * 2048;
        for (int i = tid; i < 2048; i += NT) p.sgu_wb[base + i] = f2bf(p.sgu_w[base + i]);
      }
    } else if (item >= n_tr + n_keys + n_disc) {
      const int j = item - (n_tr + n_keys + n_disc);
      convert_rows(p, (j >> 10) * 2048 + (j & 1023), tid);
    } else {
      const int id = (item - n_tr - n_keys) * NT + tid;
      const int g = (id >> 6) & 15;
      const int ldg = id >> 6;
      double lre = (double)p.lam_re[id];
      if (lre > -1e-4) lre = -1e-4;
      const double lim = (double)p.lam_im[id];
      const double dt = exp((double)p.log_step[ldg]);
      const double mag = exp(lre * dt);
      const double are = mag * cos(lim * dt), aim = mag * sin(lim * dt);
      const double den = lre * lre + lim * lim;
      const double fre = ((are - 1.0) * lre + aim * lim) / den;
      const double fim = (aim * lre - (are - 1.0) * lim) / den;
      p.s5a[id * 2 + 0] = (float)are;
      p.s5a[id * 2 + 1] = (float)aim;
      double pr = are, pi = aim;
      for (int s = 0; s < 6; ++s) { const double nr = pr * pr - pi * pi, ni = 2.0 * pr * pi; pr = nr; pi = ni; }
      p.s5a64[id * 2 + 0] = (float)pr;
      p.s5a64[id * 2 + 1] = (float)pi;
      for (int h = 0; h < 16; ++h) {
        const double br = (double)p.b_re[(size_t)id * 16 + h], bi = (double)p.b_im[(size_t)id * 16 + h];
        p.s5bb[(size_t)id * 32 + h] = (float)(fre * br - fim * bi);
        p.s5bb[(size_t)id * 32 + 16 + h] = (float)(fre * bi + fim * br);
      }
      (void)g;
    }
  }
}

__device__ __forceinline__ void phase_normmod(const Params& p, const float* src_l, const float* src_c, const float* gain, const float* modl, int shift_off, int scale_off,
                              int ntok, int copy, int bid, int nblk) {
  const int tid = opaque_tid(); const int lane = tid & 63, wid = tid >> 6;
  for (int t = bid * NW + wid; t < ntok; t += nblk * NW) {
    const float* row = t < TL ? src_l + (size_t)t * 1024 : src_c + (size_t)(t - TL) * 1024;
    const float* md = modl + (size_t)tok_batch(t) * NMOD;
    f32x4 v[4];
    float ss = 0.f;
#pragma unroll
    for (int j = 0; j < 4; ++j) {
      v[j] = *(const f32x4*)(row + j * 256 + lane * 4);
      ss += v[j][0] * v[j][0] + v[j][1] * v[j][1] + v[j][2] * v[j][2] + v[j][3] * v[j][3];
    }
    ss = wave_sum(ss);
    const float rstd = rsqrtf(ss * (1.f / 1024.f) + EPSV);
#pragma unroll
    for (int j = 0; j < 4; ++j) {
      const int c0 = j * 256 + lane * 4;
      const f32x4 g = *(const f32x4*)(gain + c0);
      const f32x4 sh = *(const f32x4*)(md + shift_off + c0);
      const f32x4 sc = *(const f32x4*)(md + scale_off + c0);
      ushort4 o;
      o.x = f2bf(v[j][0] * rstd * g[0] * (1.f + sc[0]) + sh[0]);
      o.y = f2bf(v[j][1] * rstd * g[1] * (1.f + sc[1]) + sh[1]);
      o.z = f2bf(v[j][2] * rstd * g[2] * (1.f + sc[2]) + sh[2]);
      o.w = f2bf(v[j][3] * rstd * g[3] * (1.f + sc[3]) + sh[3]);
      *(ushort4*)(p.abuf + (size_t)t * 1024 + c0) = o;
      if (copy) *(f32x4*)(p.xres + (size_t)t * 1024 + c0) = v[j];
    }
  }
}

namespace pg8 {
#define PG8_LAS __attribute__((address_space(3)))
typedef unsigned u32x4 __attribute__((ext_vector_type(4)));
constexpr int BM = 256, BK = 64, HALF = 128, HTB = HALF * BK * 2, STAGE_BYTES = 8 * HTB, NXCD = 8, WGM = 8;
__device__ __forceinline__ int lds_byte(int r, int c) { const int st = (r >> 4) * 2 + (c >> 5), rr = r & 15, cc = c & 31, ob = rr * 64 + cc * 2; return st * 1024 + (ob ^ (((ob >> 9) & 1) << 5)); }
__device__ __forceinline__ void stage_rc(int b, int& R, int& C) { const int st = b / 1024, sb = b % 1024, swz = sb ^ (((sb >> 9) & 1) << 5); R = (st >> 1) * 16 + swz / 64; C = (st & 1) * 32 + (swz % 64) / 2; }
__device__ __forceinline__ int perm32(int rho) { const int n = rho >> 4, i = rho & 15; return 8 * (i >> 2) + 4 * n + (i & 3); }
struct Unit { int pm, pn; };
struct Gemm { const bf16_t* A; const bf16_t* Bt; int M, N, K; };
struct StaticOrder {
  int nM, nN, nwg, G, c;
  __device__ void init(int M, int N, int G_, int c_) { nM = M / BM; nN = N / BM; nwg = nM * nN; G = G_; c = c_; }
  __device__ bool next(int i, Unit& u) const {
    const long L = (long)i * G + c; if (L >= nwg) return false;
    int wgid = (int)L; { const int q = nwg / NXCD, r = nwg % NXCD, xcd = wgid % NXCD, off = wgid / NXCD; wgid = (xcd < r ? xcd * (q + 1) : r * (q + 1) + (xcd - r) * q) + off; }
    const int nig = WGM * nN, gid = wgid / nig, fm = gid * WGM, gsz = (nM - fm) < WGM ? (nM - fm) : WGM;
    u.pm = fm + ((wgid % nig) % gsz); u.pn = (wgid % nig) / gsz; return true;
  }
};
__device__ __forceinline__ unsigned cvt_pk_bf16(float lo, float hi) { unsigned r; asm volatile("v_cvt_pk_bf16_f32 %0, %1, %2" : "=v"(r) : "v"(lo), "v"(hi)); return r; }

template <class Epi>
__device__ __forceinline__ void gemm_phase(PG8_LAS unsigned char* lds, const Gemm g, const StaticOrder& S, const Epi& E) {
  const int tid = opaque_tid(), wid = __builtin_amdgcn_readfirstlane(tid >> 6), lane = tid & 63, wr = wid >> 2, wc = wid & 3, fr = lane & 15, fq = lane >> 4;
  const int K = g.K, nt = K / BK;
  unsigned voffA[2], voffB[2];
#pragma unroll
  for (int i = 0; i < 2; ++i) { int R, C; stage_rc(tid * 16 + i * 8192, R, C); const int Rb = Epi::PERM ? ((R & ~31) + perm32(R & 31)) : R;
    voffA[i] = (unsigned)(R * K + C) * 2u; voffB[i] = (unsigned)(Rb * K + C) * 2u; }
  const size_t kstep = (size_t)(BK * 2);
  const size_t hstep = (size_t)HALF * K * 2;
  const size_t tstep = 2 * hstep;
  const unsigned ldsw = (unsigned)wid * 1024u;
  const int aoff = lds_byte(wr * 64 + fr, fq * 8), boff = lds_byte(wc * 32 + fr, fq * 8);
#define PG8_SA(b, h) (((b) * 2 + (h)) * HTB)
#define PG8_SB(b, h) ((4 + (b) * 2 + (h)) * HTB)
#define PG8_STAGE(bufoff, gbase, voff) do { _Pragma("unroll") for (int _i = 0; _i < 2; ++_i) \
    __builtin_amdgcn_global_load_lds((const unsigned*)((const char*)(gbase) + (voff)[_i]), (PG8_LAS unsigned*)(lds + (bufoff) + ldsw + _i * 8192), 16, 0, 0); } while (0)
#define PG8_LDA(dst, b, h) do { _Pragma("unroll") for (int m = 0; m < 4; ++m) _Pragma("unroll") for (int k = 0; k < 2; ++k) dst[m][k] = *(const PG8_LAS bf16x8*)(lds + PG8_SA(b, h) + aoff + m * 2048 + k * 1024); } while (0)
#define PG8_LDB(dst, b, h) do { _Pragma("unroll") for (int n = 0; n < 2; ++n) _Pragma("unroll") for (int k = 0; k < 2; ++k) dst[n][k] = *(const PG8_LAS bf16x8*)(lds + PG8_SB(b, h) + boff + n * 2048 + k * 1024); } while (0)
#define PG8_MMA(ai, bj, At, Bt) do { __builtin_amdgcn_s_setprio(1); _Pragma("unroll") for (int m = 0; m < 4; ++m) _Pragma("unroll") for (int n = 0; n < 2; ++n) _Pragma("unroll") for (int k = 0; k < 2; ++k) \
    acc[ai][bj][m][n] = __builtin_amdgcn_mfma_f32_16x16x32_bf16(Bt[n][k], At[m][k], acc[ai][bj][m][n], 0, 0, 0); __builtin_amdgcn_s_setprio(0); } while (0)
#define PG8_WAIT_V(n) asm volatile("s_waitcnt vmcnt(" #n ")" ::: "memory")
#define PG8_WAIT_L(n) asm volatile("s_waitcnt lgkmcnt(" #n ")" ::: "memory")
#define PG8_BAR __builtin_amdgcn_s_barrier()
#define PG8_SCHED __builtin_amdgcn_sched_barrier(0)
  Unit cur, nxt; int ui = 0;
  if (!S.next(0, cur)) return;
  f32x4 acc[2][2][4][2];
#pragma unroll
  for (int a = 0; a < 2; ++a)
#pragma unroll
    for (int b = 0; b < 2; ++b)
#pragma unroll
      for (int m = 0; m < 4; ++m)
#pragma unroll
        for (int n = 0; n < 2; ++n) acc[a][b][m][n] = (f32x4){0.f, 0.f, 0.f, 0.f};
  bf16x8 At[4][2], B0[2][2], B1[2][2];
  const char* cA = (const char*)g.A + (size_t)cur.pm * tstep; const char* cB = (const char*)g.Bt + (size_t)cur.pn * tstep;
  PG8_STAGE(PG8_SB(0, 0), cB, voffB); PG8_STAGE(PG8_SA(0, 0), cA, voffA); PG8_STAGE(PG8_SB(0, 1), cB + hstep, voffB); PG8_STAGE(PG8_SA(0, 1), cA + hstep, voffA);
  if (wr == 1) PG8_BAR;
  PG8_WAIT_V(4); PG8_BAR;
  PG8_STAGE(PG8_SB(1, 0), cB + kstep, voffB); PG8_STAGE(PG8_SA(1, 0), cA + kstep, voffA); PG8_STAGE(PG8_SB(1, 1), cB + hstep + kstep, voffB);
  PG8_WAIT_V(6); PG8_BAR;
  for (;;) {
    const bool has_next = S.next(ui + 1, nxt);
    const char* nA = has_next ? (const char*)g.A + (size_t)nxt.pm * tstep : cA; const char* nB = has_next ? (const char*)g.Bt + (size_t)nxt.pn * tstep : cB;
#pragma unroll 1
    for (int t = 0; t < nt; t += 2) {
      const bool last = (t == nt - 2);
      const char* a1 = cA + (size_t)(t + 1) * kstep;
      const char* a2 = last ? nA : cA + (size_t)(t + 2) * kstep; const char* b2 = last ? nB : cB + (size_t)(t + 2) * kstep;
      const char* a3 = a2 + kstep; const char* b3 = b2 + kstep;
      PG8_LDB(B0, 0, 0); PG8_SCHED; PG8_LDA(At, 0, 0); PG8_STAGE(PG8_SA(1, 1), a1 + hstep, voffA);
      PG8_WAIT_L(8); PG8_BAR; PG8_WAIT_L(0); PG8_MMA(0, 0, At, B0); PG8_BAR; PG8_SCHED;
      PG8_LDB(B1, 0, 1); PG8_STAGE(PG8_SB(0, 0), b2, voffB);
      PG8_BAR; PG8_WAIT_L(0); PG8_MMA(0, 1, At, B1); PG8_BAR;
      PG8_LDA(At, 0, 1); PG8_STAGE(PG8_SA(0, 0), a2, voffA);
      PG8_BAR; PG8_WAIT_L(0); PG8_MMA(1, 0, At, B0); PG8_BAR; PG8_SCHED;
      PG8_STAGE(PG8_SB(0, 1), b2 + hstep, voffB);
      PG8_WAIT_V(6); PG8_BAR; PG8_MMA(1, 1, At, B1); PG8_BAR;
      PG8_LDB(B0, 1, 0); PG8_SCHED; PG8_LDA(At, 1, 0); PG8_STAGE(PG8_SA(0, 1), a2 + hstep, voffA);
      PG8_WAIT_L(8); PG8_BAR; PG8_WAIT_L(0); PG8_MMA(0, 0, At, B0); PG8_BAR; PG8_SCHED;
      PG8_LDB(B1, 1, 1); PG8_STAGE(PG8_SB(1, 0), b3, voffB);
      PG8_BAR; PG8_WAIT_L(0); PG8_MMA(0, 1, At, B1); PG8_BAR;
      PG8_LDA(At, 1, 1); PG8_STAGE(PG8_SA(1, 0), a3, voffA);
      PG8_BAR; PG8_WAIT_L(0); PG8_MMA(1, 0, At, B0); PG8_BAR; PG8_SCHED;
      PG8_STAGE(PG8_SB(1, 1), b3 + hstep, voffB);
      PG8_WAIT_V(6); PG8_BAR; PG8_MMA(1, 1, At, B1); PG8_BAR;
    }
    E(acc, cur, wr, wc, fr, fq);
    if (!has_next) break;
#pragma unroll
    for (int a = 0; a < 2; ++a)
#pragma unroll
      for (int b = 0; b < 2; ++b)
#pragma unroll
        for (int m = 0; m < 4; ++m)
#pragma unroll
          for (int n = 0; n < 2; ++n) acc[a][b][m][n] = (f32x4){0.f, 0.f, 0.f, 0.f};
    cur = nxt; cA = nA; cB = nB; ++ui;
  }
  PG8_WAIT_V(0);
  if (wr == 0) PG8_BAR;
  PG8_BAR;
#undef PG8_SA
#undef PG8_SB
#undef PG8_STAGE
#undef PG8_LDA
#undef PG8_LDB
#undef PG8_MMA
#undef PG8_WAIT_V
#undef PG8_WAIT_L
#undef PG8_BAR
#undef PG8_SCHED
}

struct EpiBf16 {
  static constexpr bool PERM = true;
  bf16_t* O; int ldc; int ncols;
  __device__ __forceinline__ void operator()(const f32x4 (&acc)[2][2][4][2], const Unit& u, int wr, int wc, int fr, int fq) const {
    const int row0 = u.pm * BM + wr * 64 + fr, col0 = u.pn * BM + wc * 32 + 8 * fq;
#pragma unroll
    for (int ai = 0; ai < 2; ++ai)
#pragma unroll
      for (int m = 0; m < 4; ++m) {
        bf16_t* rowp = O + (size_t)(row0 + ai * HALF + m * 16) * ldc + col0;
#pragma unroll
        for (int bj = 0; bj < 2; ++bj) {
          if (col0 + bj * HALF < ncols) {
            const f32x4 v0 = acc[ai][bj][m][0], v1 = acc[ai][bj][m][1];
            u32x4 w; w.x = cvt_pk_bf16(v0[0], v0[1]); w.y = cvt_pk_bf16(v0[2], v0[3]); w.z = cvt_pk_bf16(v1[0], v1[1]); w.w = cvt_pk_bf16(v1[2], v1[3]);
            *(u32x4*)(rowp + bj * HALF) = w;
          }
        }
      }
  }
};
struct EpiResid {
  static constexpr bool PERM = false;
  float* xres; const float* modl; int gate_off;
  __device__ __forceinline__ void operator()(const f32x4 (&acc)[2][2][4][2], const Unit& u, int wr, int wc, int fr, int fq) const {
    const int row0 = u.pm * BM + wr * 64 + fr, col0 = u.pn * BM + wc * 32 + 4 * fq;
#pragma unroll
    for (int ai = 0; ai < 2; ++ai)
#pragma unroll
      for (int m = 0; m < 4; ++m) {
        const int row = row0 + ai * HALF + m * 16;
        float* rowp = xres + (size_t)row * 1024 + col0;
        const float* md = modl + (size_t)tok_batch(row) * NMOD + gate_off + col0;
#pragma unroll
        for (int bj = 0; bj < 2; ++bj)
#pragma unroll
          for (int n = 0; n < 2; ++n) {
            const f32x4 g = *(const f32x4*)(md + bj * HALF + n * 16);
            f32x4 x = *(const f32x4*)(rowp + bj * HALF + n * 16);
            x += g * acc[ai][bj][m][n];
            *(f32x4*)(rowp + bj * HALF + n * 16) = x;
          }
      }
  }
};
struct EpiGlu {
  static constexpr bool PERM = true;
  bf16_t* mix;
  __device__ __forceinline__ void operator()(const f32x4 (&acc)[2][2][4][2], const Unit& u, int wr, int wc, int fr, int fq) const {
    const int row0 = u.pm * BM + wr * 64 + fr, col0 = 256 + u.pn * HALF + wc * 32 + 8 * fq;
#pragma unroll
    for (int ai = 0; ai < 2; ++ai)
#pragma unroll
      for (int m = 0; m < 4; ++m) {
        float v[8];
#pragma unroll
        for (int n = 0; n < 2; ++n)
#pragma unroll
          for (int j = 0; j < 4; ++j) v[n * 4 + j] = acc[ai][0][m][n][j] * sigmoid_f(acc[ai][1][m][n][j]);
        u32x4 w; w.x = cvt_pk_bf16(v[0], v[1]); w.y = cvt_pk_bf16(v[2], v[3]); w.z = cvt_pk_bf16(v[4], v[5]); w.w = cvt_pk_bf16(v[6], v[7]);
        *(u32x4*)(mix + (size_t)(row0 + ai * HALF + m * 16) * 1024 + col0) = w;
        __builtin_amdgcn_sched_barrier(0);
      }
  }
};
}

#define VNT_STRIDE 136
__device__ __forceinline__ void phase_sgu(const Params& p, int layer, int nchunks, int bid, int nblk, unsigned char* smem) {
  bf16_t* vnT = (bf16_t*)smem;
  const int tid = opaque_tid(); const int lane = tid & 63, wid = tid >> 6;
  const int fr = lane & 15, fq = lane >> 4;
  for (int item = bid; item < nchunks * 4; item += nblk) {
    const int ch = item >> 2, h = item & 3;
    const int tok0 = ch * 128;
    {
      const int s = tid >> 2, q = tid & 3;
      const bf16_t* vrow = p.cols + (size_t)(tok0 + s) * INW + C_SGU_V + h * 64 + q * 16;
      const uint4 r0 = *(const uint4*)vrow, r1 = *(const uint4*)(vrow + 8);
      float gv[16];
      gv[0] = bflo(r0.x); gv[1] = bfhi(r0.x); gv[2] = bflo(r0.y); gv[3] = bfhi(r0.y); gv[4] = bflo(r0.z); gv[5] = bfhi(r0.z); gv[6] = bflo(r0.w); gv[7] = bfhi(r0.w);
      gv[8] = bflo(r1.x); gv[9] = bfhi(r1.x); gv[10] = bflo(r1.y); gv[11] = bfhi(r1.y); gv[12] = bflo(r1.z); gv[13] = bfhi(r1.z); gv[14] = bflo(r1.w); gv[15] = bfhi(r1.w);
      float ss = 0.f;
#pragma unroll
      for (int d = 0; d < 16; ++d) { gv[d] = gelu_f(gv[d]); ss += gv[d] * gv[d]; }
      ss += __shfl_xor(ss, 1);
      ss += __shfl_xor(ss, 2);
      const float rstd = rsqrtf(ss * (1.f / 64.f) + EPSV);
#pragma unroll
      for (int d = 0; d < 16; ++d) vnT[(q * 16 + d) * VNT_STRIDE + s] = f2bf(gv[d] * rstd);
    }
    __syncthreads();
    {
      const bf16_t* wrow = p.sgu_wb + (((size_t)layer * 4 + h) * 128 + wid * 16 + fr) * 128 + fq * 8;
      f32x4 acc[4];
#pragma unroll
      for (int n = 0; n < 4; ++n) acc[n] = (f32x4){0.f, 0.f, 0.f, 0.f};
#pragma unroll
      for (int ks = 0; ks < 4; ++ks) {
        const bf16x8 a = *(const bf16x8*)(wrow + ks * 32);
#pragma unroll
        for (int n = 0; n < 4; ++n) {
          const bf16x8 b = *(const bf16x8*)(vnT + (n * 16 + fr) * VNT_STRIDE + ks * 32 + fq * 8);
          acc[n] = __builtin_amdgcn_mfma_f32_16x16x32_bf16(a, b, acc[n], 0, 0, 0);
        }
      }
#pragma unroll
      for (int j = 0; j < 4; ++j) {
        const int t = wid * 16 + fq * 4 + j;
        const float bs = p.sgu_b[((size_t)layer * 4 + h) * 128 + t];
        const bf16_t* urow = p.cols + (size_t)(tok0 + t) * INW + C_SGU_U + h * 64;
        bf16_t* orow = p.mix + (size_t)(tok0 + t) * 1024 + h * 64;
#pragma unroll
        for (int n = 0; n < 4; ++n) orow[n * 16 + fr] = f2bf(gelu_f(bf2f(urow[n * 16 + fr])) * (acc[n][j] + bs));
      }
    }
    __syncthreads();
  }
}

__device__ __forceinline__ void phase_s5a(const Params& p, int layer, int bid, int nblk, unsigned char* smem) {
  const int tid = opaque_tid(); const int lane = tid & 63, wid = tid >> 6, fr = lane & 15, fq = lane >> 4;
  const int ntask = 2 * 16 * 17 * 2;
  for (int task = wid * nblk + bid; task < ntask; task += nblk * NW) {
    const int nh = task & 1, t2 = task >> 1;
    const int dir = t2 / 272, rem = t2 % 272, g = rem / 17, mt = rem % 17;
    const bf16_t* tab = p.s5M1 + (size_t)((layer * 2 + dir) * 16 + g) * 131072 + (size_t)(nh * 64 + fr) * 1024 + fq * 8;
    const int scr = mt * 16 + fr;
    const bf16_t* ub = p.cols + C_S5 + g * 16 + (fq & 1) * 8;
    f32x4 acc[4];
#pragma unroll
    for (int n = 0; n < 4; ++n) acc[n] = (f32x4){0.f, 0.f, 0.f, 0.f};
#pragma unroll 8
    for (int ks = 0; ks < 32; ++ks) {
      const int tau = 2 * ks + (fq >> 1);
      const int i = dir ? 63 - tau : tau;
      const bf16x8 a = *(const bf16x8*)(ub + (size_t)s5_tok(scr, i) * INW);
#pragma unroll
      for (int n = 0; n < 4; ++n) {
        const bf16x8 b = *(const bf16x8*)(tab + (size_t)n * 16 * 1024 + ks * 32);
        acc[n] = __builtin_amdgcn_mfma_f32_16x16x32_bf16(a, b, acc[n], 0, 0, 0);
      }
    }
#pragma unroll
    for (int n = 0; n < 4; ++n)
#pragma unroll
      for (int j = 0; j < 4; ++j) p.s5S[(((size_t)dir * NSC + mt * 16 + fq * 4 + j) * 16 + g) * 128 + nh * 64 + n * 16 + fr] = acc[n][j];
  }
}

__device__ __forceinline__ int scan_sc(int s, int b, int dir) {
  return s < 4 ? 256 + b * 4 + (dir ? 3 - s : s) : b * 64 + (dir ? 63 - (s - 4) : (s - 4));
}
__device__ __forceinline__ void phase_scan(const Params& p, int layer, int bid, int nblk) {
  const int tid = opaque_tid();
  for (int item = bid; item < 16 + 256; item += nblk) {
    if (item < 16) {
      const int id = item * NT + tid;
      const int pp = id & 63, g = (id >> 6) & 15, b = (id >> 10) & 3, dir = id >> 12;
      const int pid = ((layer * 2 + dir) * 16 + g) * 64 + pp;
      const float ar = p.s5a64[pid * 2], ai = p.s5a64[pid * 2 + 1];
      float hr = 0.f, hi = 0.f;
      for (int s0 = 0; s0 < 68; s0 += 17) {
        float sr[17], si[17];
#pragma unroll
        for (int k = 0; k < 17; ++k) {
          const size_t o = (((size_t)dir * NSC + scan_sc(s0 + k, b, dir)) * 16 + g) * 128 + pp;
          sr[k] = p.s5S[o]; si[k] = p.s5S[o + 64];
        }
#pragma unroll
        for (int k = 0; k < 17; ++k) {
          const size_t o = (((size_t)dir * NSC + scan_sc(s0 + k, b, dir)) * 16 + g) * 128 + pp;
          p.s5H[o] = hr; p.s5H[o + 64] = hi;
          const float nr = ar * hr - ai * hi + sr[k];
          const float ni = ar * hi + ai * hr + si[k];
          hr = nr; hi = ni;
        }
      }
    } else {
      const int id = (item - 16) * NT + tid;
      const int e = id & 2047, h = (id >> 11) & 7, b = (id >> 14) & 3, dir = id >> 16;
      const int dk = e & 31;
      float S = 0.f;
      for (int s0 = 0; s0 < 68; s0 += 17) {
        float kv[17], dc[17];
#pragma unroll
        for (int k = 0; k < 17; ++k) {
          const size_t o = (((size_t)dir * NSC + scan_sc(s0 + k, b, dir)) * 8 + h);
          kv[k] = p.gkv[o * 2048 + e]; dc[k] = p.gdec[o * 32 + dk];
        }
#pragma unroll
        for (int k = 0; k < 17; ++k) {
          const size_t o = (((size_t)dir * NSC + scan_sc(s0 + k, b, dir)) * 8 + h);
          p.gkv[o * 2048 + e] = S;
          S = dc[k] * S + kv[k];
        }
      }
    }
  }
}

__device__ __forceinline__ bf16x8 s5_kfrag(const bf16_t* kb, int delta, int sh) {
  const int d = delta - sh;
  bf16x8 r = *(const bf16x8*)(kb + (size_t)(d < 0 ? 0 : d) * 256);
  if (d < 0) r = (bf16x8){0, 0, 0, 0, 0, 0, 0, 0};
  return r;
}
#define S5_UCH 1032
typedef const __attribute__((address_space(3))) bf16_t* lds_bf16_cp;
template <int DIR, bool DIAG>
__device__ __forceinline__ void s5_group8(f32x4 (&acc)[16], bf16x8 (&W)[16], const bf16_t* ul  , const bf16_t* kl  , int ks0, int E, int sh) {
  const bf16x8 zero8 = (bf16x8){0, 0, 0, 0, 0, 0, 0, 0};
#pragma unroll
  for (int j = 0; j < 8; ++j) {
    const int sigma = 2 * (ks0 + j) + sh;
    const bf16x8 a = *(const bf16x8*)(ul + (DIR ? 63 - sigma : sigma) * 16);
    bf16x8 n0 = zero8, n1 = zero8;
    if (!DIAG) {
      if (j + 1 < 8) { n0 = *(const bf16x8*)(kl + (E - 2 * (j + 1) - sh) * 256); n1 = *(const bf16x8*)(kl + (E - 2 * (j + 1) + 1 - sh) * 256); }
      else { n0 = s5_kfrag(kl, E - 16, sh); n1 = s5_kfrag(kl, E - 15, sh); }
    }
#pragma unroll
    for (int i = 0; i < 16; ++i) {
      if (!(DIAG && i < 2 * j)) {
        const int sl = DIR ? 15 - i : i;
        acc[sl] = __builtin_amdgcn_mfma_f32_16x16x32_bf16(a, W[(i - 2 * j) & 15], acc[sl], 0, 0, 0);
      }
    }
    if (!DIAG) { W[(16 - 2 * (j + 1)) & 15] = n0; W[(17 - 2 * (j + 1)) & 15] = n1; }
  }
}
template <int DIR>
__device__ __forceinline__ void s5_dir(f32x4 (&acc)[16], const Params& p, int layer, int g, int scr, int qd, int fr, int fq, const bf16_t* ul, const bf16_t* kl) {
  const int sh = fq >> 1;
  {
    bf16x8 W[16];
#pragma unroll
    for (int i = 0; i < 16; ++i) W[i] = s5_kfrag(kl, 16 * qd + i, sh);
    for (int c = 0; c < qd; ++c) s5_group8<DIR, false>(acc, W, ul, kl, 8 * c, 16 * (qd - c), sh);
    s5_group8<DIR, true>(acc, W, ul, kl, 8 * qd, 0, sh);
  }
  const size_t tb = (size_t)((layer * 2 + DIR) * 16 + g);
  const float* hin = p.s5H + (((size_t)DIR * NSC + scr) * 16 + g) * 128 + fq * 8;
  const bf16_t* n2 = p.s5N2 + tb * 131072 + (size_t)(16 * qd * 16 + fr) * 128 + fq * 8;
  bf16x8 ah[4];
#pragma unroll
  for (int ks = 0; ks < 4; ++ks) {
    const f32x4 h0 = *(const f32x4*)(hin + ks * 32), h1 = *(const f32x4*)(hin + ks * 32 + 4);
    const float h8[8] = {h0[0], h0[1], h0[2], h0[3], h1[0], h1[1], h1[2], h1[3]};
    ah[ks] = pack_bf16x8(h8);
  }
#pragma unroll
  for (int ks = 0; ks < 4; ++ks) {
    bf16x8 b[16];
#pragma unroll
    for (int i = 0; i < 16; ++i) b[i] = *(const bf16x8*)(n2 + (size_t)i * 16 * 128 + ks * 32);
#pragma unroll
    for (int i = 0; i < 16; ++i) {
      const int sl = DIR ? 15 - i : i;
      acc[sl] = __builtin_amdgcn_mfma_f32_16x16x32_bf16(ah[ks], b[i], acc[sl], 0, 0, 0);
    }
    __builtin_amdgcn_sched_barrier(0);
  }
}
__device__ __forceinline__ void phase_s5c(const Params& p, int layer, int nsc, int bid, int nblk, unsigned char* smem) {
  const int tid = opaque_tid(); const int lane = tid & 63, wid = tid >> 6;
  bf16_t* Kl = (bf16_t*)smem;
  bf16_t* Ul = Kl + 2 * 16384;
  const int nmt = nsc / 16, npair = (nmt + 1) / 2;
  const int ntask = 16 * npair;
  for (int task = bid; task < ntask; task += nblk) {
    const int g = task / npair, mt0 = (task % npair) * 2;
    __syncthreads();
    int tid_o = tid; asm volatile("" : "+v"(tid_o));
#pragma unroll
    for (int it = 0; it < 8; ++it) {
      const int e = it * NT + tid_o;
      const int dir = e >> 11, off = (e & 2047) * 8;
      *(uint4*)(Kl + dir * 16384 + off) = *(const uint4*)(p.s5K + (size_t)((layer * 2 + dir) * 16 + g) * 16384 + off);
    }
#pragma unroll
    for (int it = 0; it < 8; ++it) {
      const int e = it * NT + tid_o;
      const int hf = e & 1, tk = (e >> 1) & 63, chk = (e >> 7) & 15, tl = e >> 11;
      const int mt = mt0 + tl;
      uint4 v = make_uint4(0u, 0u, 0u, 0u);
      if (mt < nmt) v = *(const uint4*)(p.cols + (size_t)s5_tok(mt * 16 + chk, tk) * INW + C_S5 + g * 16 + hf * 8);
      *(uint4*)(Ul + (tl * 16 + chk) * S5_UCH + tk * 16 + hf * 8) = v;
    }
    __syncthreads();
    int lane_o = lane; asm volatile("" : "+v"(lane_o));
    const int fr = lane_o & 15, fq = lane_o >> 4;
    const int tl = wid >> 2, q = wid & 3, mt = mt0 + tl;
    if (mt < nmt) {
      const int scr = mt * 16 + fr;
      const bf16_t* ul = Ul + (tl * 16 + fr) * S5_UCH + (fq & 1) * 8;
      f32x4 acc[16];
#pragma unroll
      for (int i = 0; i < 16; ++i) acc[i] = (f32x4){0.f, 0.f, 0.f, 0.f};
      s5_dir<0>(acc, p, layer, g, scr, q, fr, fq, ul, Kl + fr * 16 + (fq & 1) * 8);
      s5_dir<1>(acc, p, layer, g, scr, 3 - q, fr, fq, ul, Kl + 16384 + fr * 16 + (fq & 1) * 8);
      const int ch = g * 16 + fr;
      const float dsk = p.s5_d[layer * 256 + ch];
#pragma unroll
      for (int j = 0; j < 4; ++j) {
        const int chk = fq * 4 + j;
        const size_t tok0 = (size_t)s5_tok(mt * 16 + chk, 16 * q);
        const bf16_t* up = Ul + (tl * 16 + chk) * S5_UCH + (16 * q) * 16 + fr;
        bf16_t* yp = p.yg + tok0 * 256 + ch;
#pragma unroll
        for (int i = 0; i < 16; ++i) {
          const float v = acc[i][j] + dsk * bf2f(up[i * 16]);
          yp[(size_t)i * 256] = f2bf(gelu_f(v));
        }
        __builtin_amdgcn_sched_barrier(0);
      }
    }
  }
  __syncthreads();
}

#define GL_VT_STRIDE 72
#define GL_LB_STRIDE 36
#define GL_HALF_BYTES (64 * 72 * 2 + 64 * 36 * 4 + 64 * 72 * 2)
__device__ __forceinline__ void unpack8(const uint4& r, float* v) {
  v[0] = bflo(r.x); v[1] = bfhi(r.x); v[2] = bflo(r.y); v[3] = bfhi(r.y); v[4] = bflo(r.z); v[5] = bfhi(r.z); v[6] = bflo(r.w); v[7] = bfhi(r.w);
}
__device__ __forceinline__ void gla_store_vT(const uint4& r0, const uint4& r1, bf16_t* vT, int ltid) {
  const int i = ltid & 63, part = ltid >> 6;
  const unsigned w[8] = {r0.x, r0.y, r0.z, r0.w, r1.x, r1.y, r1.z, r1.w};
#pragma unroll
  for (int e = 0; e < 8; ++e) {
    vT[(part * 16 + 2 * e) * GL_VT_STRIDE + i] = (bf16_t)(w[e] & 0xffffu);
    vT[(part * 16 + 2 * e + 1) * GL_VT_STRIDE + i] = (bf16_t)(w[e] >> 16);
  }
}
__device__ __forceinline__ void gla_logdecay(const Params& p, int layer, int sc, int h, int dir, const uint4& z0, const uint4& z1, float* lb, int ltid, float* glb) {
  const int lane = ltid & 63;
  const int wu = __builtin_amdgcn_readfirstlane(ltid >> 6);
  float z[16];
  unpack8(z0, z); unpack8(z1, z + 8);
  const float* wg = p.gla_wg + ((size_t)(layer * 2 + dir) * 16) * 256 + h * 32 + wu * 8;
  const float* bg = p.gla_bg + (layer * 2 + dir) * 256 + h * 32 + wu * 8;
  float la[8];
#pragma unroll
  for (int c = 0; c < 8; ++c) la[c] = bg[c];
#pragma unroll
  for (int r = 0; r < 16; ++r) {
#pragma unroll
    for (int c = 0; c < 8; ++c) la[c] += z[r] * wg[r * 256 + c];
  }
#pragma unroll
  for (int c = 0; c < 8; ++c) la[c] = logsigmoid_f(la[c]) * (1.f / 16.f);
  if (dir == 0) {
#pragma unroll
    for (int off = 1; off < 64; off <<= 1) {
#pragma unroll
      for (int c = 0; c < 8; ++c) { const float nb = __shfl_up(la[c], off); if (lane >= off) la[c] += nb; }
    }
  } else {
#pragma unroll
    for (int off = 1; off < 64; off <<= 1) {
#pragma unroll
      for (int c = 0; c < 8; ++c) { const float nb = __shfl_down(la[c], off); if (lane + off < 64) la[c] += nb; }
    }
  }
  *(f32x4*)(lb + lane * GL_LB_STRIDE + wu * 8) = (f32x4){la[0], la[1], la[2], la[3]};
  *(f32x4*)(lb + lane * GL_LB_STRIDE + wu * 8 + 4) = (f32x4){la[4], la[5], la[6], la[7]};
  float* gp = glb + ((size_t)dir * TT + gla_tok(sc, lane)) * 256 + h * 32 + wu * 8;
  *(f32x4*)gp = (f32x4){la[0], la[1], la[2], la[3]};
  *(f32x4*)(gp + 4) = (f32x4){la[4], la[5], la[6], la[7]};
}

struct GlaAPre { uint4 v0, v1, za0, za1, zb0, zb1, k; };
__device__ __forceinline__ GlaAPre glaa_prefetch(const Params& p, int item, int ltid) {
  const int sc = item >> 3, h = item & 7;
  const int i = ltid & 63, part = ltid >> 6;
  const bf16_t* row = p.cols + (size_t)gla_tok(sc, i) * INW;
  GlaAPre r;
  r.v0 = *(const uint4*)(row + C_GV + h * 64 + part * 16); r.v1 = *(const uint4*)(row + C_GV + h * 64 + part * 16 + 8);
  r.za0 = *(const uint4*)(row + C_ZF); r.za1 = *(const uint4*)(row + C_ZF + 8);
  r.zb0 = *(const uint4*)(row + C_ZF + 16); r.zb1 = *(const uint4*)(row + C_ZF + 24);
  r.k = *(const uint4*)(row + C_GK + h * 32 + part * 8);
  return r;
}
__device__ __forceinline__ void phase_glaa(const Params& p, int layer, int bid, int nblk, unsigned char* smem) {
  const int tid = opaque_tid(); const int half = __builtin_amdgcn_readfirstlane(tid >> 8), ltid = tid & 255;
  const int lane = tid & 63, w = ltid >> 6, fr = lane & 15, fq = lane >> 4;
  bf16_t* vT = (bf16_t*)(smem + half * GL_HALF_BYTES);
  float* lb = (float*)(vT + 64 * GL_VT_STRIDE);
  bf16_t* kT = (bf16_t*)(lb + 64 * GL_LB_STRIDE);
  const int nit = NSC * 8 / 2;
  if (bid >= nit) return;
  GlaAPre cur = glaa_prefetch(p, bid * 2 + half, ltid);
  for (int it = bid; it < nit; it += nblk) {
    const int item = it * 2 + half;
    const int sc = item >> 3, h = item & 7;
    const int itn = it + nblk < nit ? it + nblk : it;
    const GlaAPre nxt = glaa_prefetch(p, itn * 2 + half, ltid);
    gla_store_vT(cur.v0, cur.v1, vT, ltid);
#pragma unroll
    for (int dir = 0; dir < 2; ++dir) {
      gla_logdecay(p, layer, sc, h, dir, dir ? cur.zb0 : cur.za0, dir ? cur.zb1 : cur.za1, lb, ltid, p.glb);
      __syncthreads();
      const int ilast = dir ? 0 : 63;
      {
        const int i = ltid & 63, part = ltid >> 6;
        float kv8[8];
        unpack8(cur.k, kv8);
#pragma unroll
        for (int c = 0; c < 8; ++c) {
          const int dk = part * 8 + c;
          kT[dk * GL_VT_STRIDE + i] = f2bf(kv8[c] * __expf(lb[ilast * GL_LB_STRIDE + dk] - lb[i * GL_LB_STRIDE + dk]));
        }
      }
      const size_t o = (((size_t)dir * NSC + sc) * 8 + h);
      if (ltid < 32) p.gdec[o * 32 + ltid] = __expf(lb[ilast * GL_LB_STRIDE + ltid]);
      __syncthreads();
      {
        f32x4 acc[2];
        acc[0] = (f32x4){0.f, 0.f, 0.f, 0.f}; acc[1] = acc[0];
#pragma unroll
        for (int ks = 0; ks < 2; ++ks) {
          const bf16x8 b = *(const bf16x8*)(vT + (w * 16 + fr) * GL_VT_STRIDE + ks * 32 + fq * 8);
#pragma unroll
          for (int m = 0; m < 2; ++m) {
            const bf16x8 a = *(const bf16x8*)(kT + (m * 16 + fr) * GL_VT_STRIDE + ks * 32 + fq * 8);
            acc[m] = __builtin_amdgcn_mfma_f32_16x16x32_bf16(a, b, acc[m], 0, 0, 0);
          }
        }
#pragma unroll
        for (int m = 0; m < 2; ++m) *(f32x4*)(p.gkv + o * 2048 + (size_t)(w * 16 + fr) * 32 + m * 16 + fq * 4) = acc[m];
      }
      __syncthreads();
    }
    cur = nxt;
  }
}

__device__ __forceinline__ void gl_load8(const float* g, float* v) {
  const f32x4 a = *(const f32x4*)g, b = *(const f32x4*)(g + 4);
  v[0] = a[0]; v[1] = a[1]; v[2] = a[2]; v[3] = a[3]; v[4] = b[0]; v[5] = b[1]; v[6] = b[2]; v[7] = b[3];
}
#define GLC_HALF_BYTES (64 * 72 * 2 + 64 * 72 * 2 + 2 * 64 * 36 * 4 + 2 * 64 * 36 * 4)
struct GlaCPre { uint4 v0, v1, q, k[4], lb[2][2], st[2][2]; };
__device__ __forceinline__ GlaCPre glac_prefetch(const Params& p, int item, int ltid, int w, int fr, int fq) {
  const int sc = item >> 3, h = item & 7;
  GlaCPre r;
  {
    const int i = ltid & 63, part = ltid >> 6;
    const bf16_t* row = p.cols + (size_t)gla_tok(sc, i) * INW + C_GV + h * 64 + part * 16;
    r.v0 = *(const uint4*)row; r.v1 = *(const uint4*)(row + 8);
  }
  r.q = *(const uint4*)(p.cols + (size_t)gla_tok(sc, w * 16 + fr) * INW + C_GQ + h * 32 + fq * 8);
#pragma unroll
  for (int n = 0; n < 4; ++n) r.k[n] = *(const uint4*)(p.cols + (size_t)gla_tok(sc, n * 16 + fr) * INW + C_GK + h * 32 + fq * 8);
  {
    const int i = ltid >> 2, piece = ltid & 3;
#pragma unroll
    for (int dir = 0; dir < 2; ++dir) {
      const float* g = p.glb + ((size_t)dir * TT + gla_tok(sc, i)) * 256 + h * 32 + piece * 8;
      r.lb[dir][0] = *(const uint4*)g; r.lb[dir][1] = *(const uint4*)(g + 4);
      const float* s = p.gkv + (((size_t)dir * NSC + sc) * 8 + h) * 2048 + i * 32 + piece * 8;
      r.st[dir][0] = *(const uint4*)s; r.st[dir][1] = *(const uint4*)(s + 4);
    }
  }
  return r;
}
#define GLC_BONUS 4
__device__ __forceinline__ void phase_glac(const Params& p, int layer, int nsc, int nbusy, int bid, int nblk, unsigned char* smem) {
  const int tid = opaque_tid(); const int half = __builtin_amdgcn_readfirstlane(tid >> 8), ltid = tid & 255;
  const int lane = tid & 63, w = ltid >> 6, fr = lane & 15, fq = lane >> 4;
  bf16_t* vT = (bf16_t*)(smem + half * GLC_HALF_BYTES);
  bf16_t* Pw = vT + 64 * GL_VT_STRIDE + w * 16 * GL_VT_STRIDE;
  float* lbT = (float*)(vT + 2 * 64 * GL_VT_STRIDE);
  float* ST = lbT + 2 * 64 * GL_LB_STRIDE;
  const int nit = nsc * 4;
  const int nfree = nblk - nbusy;
  const int nbonus = (nbusy > 0 && nfree > 0 && nfree * GLC_BONUS < nit) ? nfree * GLC_BONUS : 0;
  auto itof = [&](int k) -> int {
    if (nbonus == 0) return bid + k * nblk;
    if (bid >= nbusy) return k < GLC_BONUS ? k * nfree + (bid - nbusy) : nbonus + bid + (k - GLC_BONUS) * nblk;
    return nbonus + bid + k * nblk;
  };
  if (itof(0) >= nit) return;
  GlaCPre cur = glac_prefetch(p, itof(0) * 2 + half, ltid, w, fr, fq);
  for (int kk = 0; itof(kk) < nit; ++kk) {
    const int it = itof(kk);
    const int item = it * 2 + half;
    const int sc = item >> 3, h = item & 7;
    __syncthreads();
    gla_store_vT(cur.v0, cur.v1, vT, ltid);
    {
      const int i = ltid >> 2, piece = ltid & 3;
#pragma unroll
      for (int dir = 0; dir < 2; ++dir) {
        *(uint4*)(lbT + (dir * 64 + i) * GL_LB_STRIDE + piece * 8) = cur.lb[dir][0]; *(uint4*)(lbT + (dir * 64 + i) * GL_LB_STRIDE + piece * 8 + 4) = cur.lb[dir][1];
        *(uint4*)(ST + (dir * 64 + i) * GL_LB_STRIDE + piece * 8) = cur.st[dir][0]; *(uint4*)(ST + (dir * 64 + i) * GL_LB_STRIDE + piece * 8 + 4) = cur.st[dir][1];
      }
    }
    const int itn = itof(kk + 1) < nit ? itof(kk + 1) : it;
    const GlaCPre nxt = glac_prefetch(p, itn * 2 + half, ltid, w, fr, fq);
    __syncthreads();
    f32x4 o[4];
#pragma unroll
    for (int n = 0; n < 4; ++n) o[n] = (f32x4){0.f, 0.f, 0.f, 0.f};
#pragma unroll
    for (int dir = 0; dir < 2; ++dir) {
      const float* lbd = lbT + dir * 64 * GL_LB_STRIDE + fq * 8;
      float bref[8], bt[8];
      gl_load8(lbd + (dir ? 31 : 32) * GL_LB_STRIDE, bref);
      gl_load8(lbd + (w * 16 + fr) * GL_LB_STRIDE, bt);
      bf16x8 aqs, aqe;
      {
        float q8[8], s8[8], e8[8];
        unpack8(cur.q, q8);
#pragma unroll
        for (int c = 0; c < 8; ++c) {
          const float qx = q8[c] * 0.17677669529663687f;
          s8[c] = qx * __expf(bt[c] - bref[c]);
          e8[c] = qx * __expf(bt[c]);
        }
        aqs = pack_bf16x8(s8); aqe = pack_bf16x8(e8);
      }
#pragma unroll
      for (int n = 0; n < 4; ++n) {
        const int s = n * 16 + fr;
        float k8[8], bs[8];
        unpack8(cur.k[n], k8);
        gl_load8(lbd + s * GL_LB_STRIDE, bs);
#pragma unroll
        for (int c = 0; c < 8; ++c) k8[c] *= __expf(bref[c] - bs[c]);
        const bf16x8 bks = pack_bf16x8(k8);
        const f32x4 sa = __builtin_amdgcn_mfma_f32_16x16x32_bf16(aqs, bks, (f32x4){0.f, 0.f, 0.f, 0.f}, 0, 0, 0);
#pragma unroll
        for (int j = 0; j < 4; ++j) {
          const int t = w * 16 + fq * 4 + j;
          const bool ok = dir ? (s >= t) : (s <= t);
          Pw[(fq * 4 + j) * GL_VT_STRIDE + s] = f2bf(ok ? sa[j] : 0.f);
        }
      }
      __builtin_amdgcn_wave_barrier();
#pragma unroll
      for (int ks = 0; ks < 2; ++ks) {
        const bf16x8 ap = *(const bf16x8*)(Pw + fr * GL_VT_STRIDE + ks * 32 + fq * 8);
#pragma unroll
        for (int n = 0; n < 4; ++n) {
          const bf16x8 bv = *(const bf16x8*)(vT + (n * 16 + fr) * GL_VT_STRIDE + ks * 32 + fq * 8);
          o[n] = __builtin_amdgcn_mfma_f32_16x16x32_bf16(ap, bv, o[n], 0, 0, 0);
        }
      }
      __builtin_amdgcn_wave_barrier();
      {
        const float* Sg = ST + dir * 64 * GL_LB_STRIDE + fq * 8;
#pragma unroll
        for (int n = 0; n < 4; ++n) {
          float s8[8];
          gl_load8(Sg + (n * 16 + fr) * GL_LB_STRIDE, s8);
          const bf16x8 bS = pack_bf16x8(s8);
          o[n] = __builtin_amdgcn_mfma_f32_16x16x32_bf16(aqe, bS, o[n], 0, 0, 0);
        }
      }
    }
    __builtin_amdgcn_wave_barrier();
#pragma unroll
    for (int j = 0; j < 4; ++j) {
      float ss = o[0][j] * o[0][j] + o[1][j] * o[1][j] + o[2][j] * o[2][j] + o[3][j] * o[3][j];
      ss += __shfl_xor(ss, 1); ss += __shfl_xor(ss, 2); ss += __shfl_xor(ss, 4); ss += __shfl_xor(ss, 8);
      const float rstd = rsqrtf(ss * (1.f / 64.f) + EPSV);
#pragma unroll
      for (int n = 0; n < 4; ++n) Pw[(fq * 4 + j) * GL_VT_STRIDE + n * 16 + fr] = f2bf(o[n][j] * rstd);
    }
    __builtin_amdgcn_wave_barrier();
    {
      const int tl = lane >> 2, dq = (lane & 3) * 16;
      const int tok = gla_tok(sc, w * 16 + tl);
      const bf16_t* grow = p.cols + (size_t)tok * INW + C_GG + h * 64 + dq;
      float ov[16], gv[16];
      unpack8(*(const uint4*)(Pw + tl * GL_VT_STRIDE + dq), ov); unpack8(*(const uint4*)(Pw + tl * GL_VT_STRIDE + dq + 8), ov + 8);
      unpack8(*(const uint4*)grow, gv); unpack8(*(const uint4*)(grow + 8), gv + 8);
      const float* ng = p.gla_ng + layer * 512 + h * 64 + dq;
      unsigned wv[8];
#pragma unroll
      for (int e = 0; e < 8; ++e) {
        const float a = ov[2 * e] * ng[2 * e] * silu_f(gv[2 * e]), b = ov[2 * e + 1] * ng[2 * e + 1] * silu_f(gv[2 * e + 1]);
        wv[e] = (unsigned)f2bf(a) | ((unsigned)f2bf(b) << 16);
      }
      bf16_t* orow = p.mix + (size_t)tok * 1024 + 512 + h * 64 + dq;
      *(uint4*)orow = make_uint4(wv[0], wv[1], wv[2], wv[3]);
      *(uint4*)(orow + 8) = make_uint4(wv[4], wv[5], wv[6], wv[7]);
    }
    __builtin_amdgcn_wave_barrier();
    cur = nxt;
  }
  __syncthreads();
}

__device__ __forceinline__ unsigned fkey(float f) { const unsigned u = __float_as_uint(f); return u ^ ((u >> 31) ? 0xFFFFFFFFu : 0x80000000u); }
__device__ __forceinline__ float funkey(unsigned k) { return __uint_as_float((k >> 31) ? (k ^ 0x80000000u) : ~k); }
__device__ __forceinline__ unsigned umax3(unsigned a, unsigned b) { return a > b ? a : b; }
__device__ __forceinline__ unsigned umin3(unsigned a, unsigned b) { return a < b ? a : b; }
__device__ __forceinline__ unsigned umed3(unsigned a, unsigned b, unsigned c) { return umax3(umin3(a, b), umin3(umax3(a, b), c)); }
__device__ __forceinline__ void top16_insert(unsigned (&L)[16], unsigned x) {
#pragma unroll
  for (int q = 15; q >= 1; --q) L[q] = umed3(L[q - 1], L[q], x);
  L[0] = umax3(L[0], x);
}
template <int XM>
__device__ __forceinline__ void top16_merge(unsigned (&L)[16]) {
  unsigned P[16];
#pragma unroll
  for (int i = 0; i < 16; ++i) P[i] = (unsigned)__shfl_xor((int)L[i], XM);
  unsigned M[16];
#pragma unroll
  for (int i = 0; i < 16; ++i) M[i] = umax3(L[i], P[15 - i]);
#pragma unroll
  for (int d = 8; d >= 1; d >>= 1) {
#pragma unroll
    for (int i = 0; i < 16; ++i) {
      if ((i & d) == 0) { const unsigned hi = umax3(M[i], M[i + d]), lo = umin3(M[i], M[i + d]); M[i] = hi; M[i + d] = lo; }
    }
  }
#pragma unroll
  for (int i = 0; i < 16; ++i) L[i] = M[i];
}
#define RT_SC_STRIDE 132
#define RT_MAX_ITEMS 5
__device__ __forceinline__ void phase_route(const Params& p, int layer, int ntok, int bid, int nblk, unsigned char* smem) {
  const int tid = opaque_tid(); const int lane = tid & 63, wid = tid >> 6;
  float* sc = (float*)smem;
  unsigned* lists_all = (unsigned*)(sc + 128 * RT_SC_STRIDE);
  const int fr = lane & 15, fq = lane >> 4;
  const bf16_t* qb = p.cols;
  const int nitems = ntok / 16;
  for (int item0 = bid; item0 < nitems; item0 += nblk * RT_MAX_ITEMS) {
    for (int ph = 0; ph < 2; ++ph) {
      bf16x8 bk[8][4];
      {
        const bf16_t* kb = p.keysb + ((((size_t)layer * 2 + ph) * 8 + wid) * 128) * 128 + (size_t)fr * 128 + fq * 8;
#pragma unroll
        for (int n = 0; n < 8; ++n)
#pragma unroll
          for (int kt = 0; kt < 4; ++kt) bk[n][kt] = *(const bf16x8*)(kb + (size_t)n * 16 * 128 + kt * 32);
      }
      bf16x8 an[4];
      {
        const bf16_t* qrow = qb + (size_t)(item0 * 16 + fr) * 2048 + wid * 256 + ph * 128 + fq * 8;
#pragma unroll
        for (int kt = 0; kt < 4; ++kt) an[kt] = *(const bf16x8*)(qrow + kt * 32);
      }
      for (int ii = 0; ii < RT_MAX_ITEMS; ++ii) {
        const int item = item0 + ii * nblk;
        if (item >= nitems) break;
        const int tok0 = item * 16;
        unsigned* lists = lists_all + ii * 4096;
        {
          bf16x8 a[4];
#pragma unroll
          for (int kt = 0; kt < 4; ++kt) a[kt] = an[kt];
          {
            const int itn = item0 + (ii + 1) * nblk;
            const int tokn = (ii + 1 < RT_MAX_ITEMS && itn < nitems) ? itn * 16 : tok0;
            const bf16_t* qrow = qb + (size_t)(tokn + fr) * 2048 + wid * 256 + ph * 128 + fq * 8;
#pragma unroll
            for (int kt = 0; kt < 4; ++kt) an[kt] = *(const bf16x8*)(qrow + kt * 32);
          }
#pragma unroll
          for (int n = 0; n < 8; ++n) {
            f32x4 acc = (f32x4){0.f, 0.f, 0.f, 0.f};
#pragma unroll
            for (int kt = 0; kt < 4; ++kt) acc = __builtin_amdgcn_mfma_f32_16x16x32_bf16(a[kt], bk[n][kt], acc, 0, 0, 0);
#pragma unroll
            for (int j = 0; j < 4; ++j) sc[(wid * 16 + fq * 4 + j) * RT_SC_STRIDE + n * 16 + fr] = acc[j];
          }
        }
        lds_barrier();
        {
          const int row = tid >> 2, qr = tid & 3;
          unsigned L[16];
#pragma unroll
          for (int i = 0; i < 16; ++i) L[i] = 0u;
          const float* rp = sc + row * RT_SC_STRIDE + qr * 32;
#pragma unroll
          for (int i = 0; i < 8; ++i) {
            const f32x4 v = *(const f32x4*)(rp + i * 4);
#pragma unroll
            for (int j = 0; j < 4; ++j) top16_insert(L, (fkey(v[j]) & 0xFFFFFF80u) | (unsigned)(qr * 32 + i * 4 + j));
          }
          top16_merge<1>(L);
          top16_merge<2>(L);
          if (qr == 0) {
            unsigned* dst = lists + (((row >> 4) * 2 + ph) * 16 + (row & 15)) * 16;
#pragma unroll
            for (int i = 0; i < 4; ++i) *(uint4*)(dst + i * 4) = make_uint4(L[i * 4], L[i * 4 + 1], L[i * 4 + 2], L[i * 4 + 3]);
          }
        }
        lds_barrier();
      }
    }
    for (int ii = 0; ii < RT_MAX_ITEMS; ++ii) {
      const int item = item0 + ii * nblk;
      if (item >= nitems) break;
      const int tok0 = item * 16;
      const unsigned* lists = lists_all + ii * 4096;
    {
      const int pair = tid >> 2, part = tid & 3;
      const int tk = pair & 15, hd = pair >> 4;
      const unsigned* l1 = lists + ((hd * 2 + 0) * 16 + tk) * 16;
      const unsigned* l2 = lists + ((hd * 2 + 1) * 16 + tk) * 16;
      static const unsigned char STAIR[52] = {0, 1, 2, 3, 4, 5, 6, 7, 8, 9, 10, 11, 12, 13, 14, 15, 16, 17, 18, 19, 20, 21, 22, 23, 32, 33, 34, 35, 36, 48, 49, 50, 51, 64, 65, 66, 80, 81, 96, 97, 112, 113, 128, 144, 160, 176, 192, 208, 224, 240, 255, 255};
      unsigned T[16];
#pragma unroll
      for (int i = 0; i < 16; ++i) T[i] = 0u;
#pragma unroll
      for (int j = 0; j < 13; ++j) {
        const unsigned c = STAIR[part + 4 * j];
        const float sa = funkey(l1[(c >> 4) & 15] & 0xFFFFFF80u), sb = funkey(l2[c & 15] & 0xFFFFFF80u);
        const unsigned key = (fkey(sa + sb) & 0xFFFFFF00u) | c;
        top16_insert(T, c == 255u ? 0u : key);
      }
      top16_merge<1>(T);
      top16_merge<2>(T);
      const float mx = funkey(T[0] & 0xFFFFFF00u);
      float ex[16], sum = 0.f;
#pragma unroll
      for (int r = 0; r < 16; ++r) { ex[r] = __expf(funkey(T[r] & 0xFFFFFF00u) - mx); sum += ex[r]; }
      const float inv = 1.f / sum;
      int eid[4]; float gt[4];
#pragma unroll
      for (int r = 0; r < 16; ++r) {
        if ((r >> 2) == part) {
          const int a = (T[r] >> 4) & 15, b = T[r] & 15;
          eid[r & 3] = (int)(l1[a] & 127u) * 128 + (int)(l2[b] & 127u);
          gt[r & 3] = ex[r] * inv;
        }
      }
      const size_t o = (size_t)(tok0 + tk) * 128 + hd * 16 + part * 4;
      *(int4*)(p.pidx + o) = make_int4(eid[0], eid[1], eid[2], eid[3]);
      *(f32x4*)(p.pgate + o) = (f32x4){gt[0], gt[1], gt[2], gt[3]};
    }
    }
    lds_barrier();
  }
}

typedef float f32x2 __attribute__((ext_vector_type(2)));
__device__ __forceinline__ float dot16_fp8(const uint4& r, const f32x2* h2) {
  const unsigned w[4] = {r.x, r.y, r.z, r.w};
  f32x2 d = {0.f, 0.f};
#pragma unroll
  for (int q = 0; q < 4; ++q) {
    d += __builtin_amdgcn_cvt_pk_f32_fp8(w[q], false) * h2[q * 2];
    d += __builtin_amdgcn_cvt_pk_f32_fp8(w[q], true) * h2[q * 2 + 1];
  }
  return d.x + d.y;
}
__device__ __forceinline__ void fma16_fp8(f32x2* acc2, const uint4& r, float w8) {
  const unsigned w[4] = {r.x, r.y, r.z, r.w};
  const f32x2 ww = {w8, w8};
#pragma unroll
  for (int q = 0; q < 4; ++q) {
    acc2[q * 2] += ww * __builtin_amdgcn_cvt_pk_f32_fp8(w[q], false);
    acc2[q * 2 + 1] += ww * __builtin_amdgcn_cvt_pk_f32_fp8(w[q], true);
  }
}
struct XcdInfo { int rank, nloc, xi, nx; };
__device__ __forceinline__ XcdInfo xcd_info(const XcdBarrier& b) {
  if (threadIdx.x == 0) {
    unsigned xi = 0;
    for (unsigned j = 0; j < 16; ++j) { const unsigned c = xb_ld(&b.bar[XB_XCNT(j)]); if (j < b.x && c > 0u) ++xi; }
    b.st[3] = xi;
  }
  __syncthreads();
  XcdInfo r;
  r.nloc = __builtin_amdgcn_readfirstlane((int)b.st[0]); r.nx = __builtin_amdgcn_readfirstlane((int)b.st[1]);
  r.rank = __builtin_amdgcn_readfirstlane((int)b.st[2]); r.xi = __builtin_amdgcn_readfirstlane((int)b.st[3]);
  return r;
}
__device__ __forceinline__ void gs_issue(uint4 (&buf)[16], const unsigned char* tab, const int* el, int grp) {
#pragma unroll
  for (int k = 0; k < 16; ++k) buf[k] = *(const uint4*)(tab + (size_t)el[k * 8 + grp] * 1024);
}
__device__ __forceinline__ void phase_gather_u(const Params& p, int layer, int ntok, const XcdInfo xin, unsigned char* smem) {
  const int tid = opaque_tid(); const int lane = tid & 63, wid = tid >> 6;
  int* elw = (int*)smem + wid * 256;
  float* pbuf = (float*)p.cols;
  const int sub = lane & 7, grp = lane >> 3;
  const bool b0 = (lane & 1) != 0, b1 = (lane & 2) != 0, b2 = (lane & 4) != 0;
  const int tstep = xin.nloc * NW;
  for (int s = xin.xi; s < 8; s += xin.nx) {
    const unsigned char* EU = p.eu8 + (size_t)layer * 16384 * 1024 + s * 128 + sub * 16;
    const int t0 = xin.rank * NW + wid;
    if (t0 >= ntok) continue;
    const int kslot = ((b0 ? 8 : 0) + (b1 ? 4 : 0) + (b2 ? 2 : 0)) * 8 + grp;
    uint4 bufA[16], bufB[16];
    uint4 hA0, hA1, hB0, hB1;
    int i0n, i1n;
    {
      elw[lane] = p.pidx[(size_t)t0 * 128 + lane]; elw[64 + lane] = p.pidx[(size_t)t0 * 128 + 64 + lane];
      __builtin_amdgcn_wave_barrier();
      gs_issue(bufA, EU, elw, grp);
      hA0 = *(const uint4*)(p.abuf + (size_t)t0 * 1024 + s * 128 + sub * 16); hA1 = *(const uint4*)(p.abuf + (size_t)t0 * 1024 + s * 128 + sub * 16 + 8);
      const int t1 = t0 + tstep < ntok ? t0 + tstep : t0;
      i0n = p.pidx[(size_t)t1 * 128 + lane]; i1n = p.pidx[(size_t)t1 * 128 + 64 + lane];
    }
    int par = 0;
    for (int t = t0; t < ntok; t += 2 * tstep) {
#pragma unroll
      for (int hh = 0; hh < 2; ++hh) {
        const int tc = t + hh * tstep;
        if (tc < ntok) {
          uint4 (&cur)[16] = hh ? bufB : bufA;
          uint4 (&nxt)[16] = hh ? bufA : bufB;
          const uint4 hc0 = hh ? hB0 : hA0, hc1 = hh ? hB1 : hA1;
          const int tn = tc + tstep < ntok ? tc + tstep : tc;
          par ^= 1;
          int* eln = elw + par * 128;
          eln[lane] = i0n; eln[64 + lane] = i1n;
          __builtin_amdgcn_wave_barrier();
          gs_issue(nxt, EU, eln, grp);
          const uint4 hn0 = *(const uint4*)(p.abuf + (size_t)tn * 1024 + s * 128 + sub * 16), hn1 = *(const uint4*)(p.abuf + (size_t)tn * 1024 + s * 128 + sub * 16 + 8);
          const int tnn = tn + tstep < ntok ? tn + tstep : tn;
          i0n = p.pidx[(size_t)tnn * 128 + lane]; i1n = p.pidx[(size_t)tnn * 128 + 64 + lane];
          f32x2 hv2[8];
          {
            float hv[16];
            unpack8(hc0, hv); unpack8(hc1, hv + 8);
#pragma unroll
            for (int q = 0; q < 8; ++q) hv2[q] = (f32x2){hv[2 * q], hv[2 * q + 1]};
          }
          float d[16];
#pragma unroll
          for (int k = 0; k < 16; ++k) d[k] = dot16_fp8(cur[k], hv2);
          float d8[8], d4[4], d2[2];
#pragma unroll
          for (int q = 0; q < 8; ++q) { const float send = b0 ? d[q] : d[q + 8]; const float keep = b0 ? d[q + 8] : d[q]; d8[q] = keep + __shfl_xor(send, 1); }
#pragma unroll
          for (int q = 0; q < 4; ++q) { const float send = b1 ? d8[q] : d8[q + 4]; const float keep = b1 ? d8[q + 4] : d8[q]; d4[q] = keep + __shfl_xor(send, 2); }
#pragma unroll
          for (int q = 0; q < 2; ++q) { const float send = b2 ? d4[q] : d4[q + 2]; const float keep = b2 ? d4[q + 2] : d4[q]; d2[q] = keep + __shfl_xor(send, 4); }
          float* dst = pbuf + ((size_t)s * TT + tc) * 128 + kslot;
          dst[0] = d2[0]; dst[8] = d2[1];
          if (hh) { hA0 = hn0; hA1 = hn1; } else { hB0 = hn0; hB1 = hn1; }
        }
      }
    }
    __builtin_amdgcn_wave_barrier();
  }
}
__device__ __forceinline__ void phase_gather_r(const Params& p, int layer, int ntok, int bid, int nblk) {
  const int tid = opaque_tid();
  const float* pbuf = (const float*)p.cols;
  const size_t n4 = (size_t)ntok * 32;
  for (size_t i = (size_t)bid * NT + tid; i < n4; i += (size_t)nblk * NT) {
    f32x4 z = *(const f32x4*)(pbuf + i * 4);
#pragma unroll
    for (int s = 1; s < 8; ++s) z += *(const f32x4*)(pbuf + (size_t)s * TT * 128 + i * 4);
    const f32x4 g = *(const f32x4*)(p.pgate + i * 4);
    const int4 e = *(const int4*)(p.pidx + i * 4);
    const int ev[4] = {e.x, e.y, e.z, e.w};
    f32x4 w;
#pragma unroll
    for (int j = 0; j < 4; ++j) w[j] = g[j] * gelu_f(z[j] * p.su[layer * 16384 + ev[j]]) * p.sv[layer * 16384 + ev[j]];
    *(f32x4*)(p.wbuf + i * 4) = w;
  }
}
template <bool DUMMY>
__device__ __forceinline__ void phase_gather_v(const Params& p, int layer, int ntok, const XcdInfo xin, unsigned char* smem) {
  float* xout = DUMMY ? (float*)p.cols : p.xres;
  const int tid = opaque_tid(); const int lane = tid & 63, wid = tid >> 6;
  int* elw = (int*)smem + wid * 512;
  float* wlw = (float*)(elw + 256);
  const int sub = lane & 7, grp = lane >> 3;
  const bool b5 = (lane & 32) != 0, b4 = (lane & 16) != 0, b3 = (lane & 8) != 0;
  const int tstep = xin.nloc * NW;
  for (int s = xin.xi; s < 8; s += xin.nx) {
    const unsigned char* EV = p.ev8 + (size_t)layer * 16384 * 1024 + s * 128 + sub * 16;
    const int col = s * 128 + sub * 16 + (b3 ? 8 : 0) + (b4 ? 4 : 0) + (b5 ? 2 : 0);
    const int t0 = xin.rank * NW + wid;
    if (t0 >= ntok) continue;
    uint4 bufA[16], bufB[16];
    int i0n, i1n; float w0n, w1n;
    f32x2 xc, gc, xn, gn;
    {
      elw[lane] = p.pidx[(size_t)t0 * 128 + lane]; elw[64 + lane] = p.pidx[(size_t)t0 * 128 + 64 + lane];
      wlw[lane] = p.wbuf[(size_t)t0 * 128 + lane]; wlw[64 + lane] = p.wbuf[(size_t)t0 * 128 + 64 + lane];
      __builtin_amdgcn_wave_barrier();
      gs_issue(bufA, EV, elw, grp);
      xc = *(const f32x2*)(p.xres + (size_t)t0 * 1024 + col);
      gc = *(const f32x2*)(p.modv + ((size_t)layer * 5 + tok_batch(t0)) * NMOD + 5120 + col);
      const int t1 = t0 + tstep < ntok ? t0 + tstep : t0;
      i0n = p.pidx[(size_t)t1 * 128 + lane]; i1n = p.pidx[(size_t)t1 * 128 + 64 + lane];
      w0n = p.wbuf[(size_t)t1 * 128 + lane]; w1n = p.wbuf[(size_t)t1 * 128 + 64 + lane];
      xn = *(const f32x2*)(p.xres + (size_t)t1 * 1024 + col);
      gn = *(const f32x2*)(p.modv + ((size_t)layer * 5 + tok_batch(t1)) * NMOD + 5120 + col);
    }
    int par = 0;
    for (int t = t0; t < ntok; t += 2 * tstep) {
#pragma unroll
      for (int hh = 0; hh < 2; ++hh) {
        const int tc = t + hh * tstep;
        if (tc < ntok) {
          uint4 (&cur)[16] = hh ? bufB : bufA;
          uint4 (&nxt)[16] = hh ? bufA : bufB;
          const float* wlc = wlw + par * 128;
          const int tn = tc + tstep < ntok ? tc + tstep : tc;
          par ^= 1;
          int* eln = elw + par * 128; float* wln = wlw + par * 128;
          eln[lane] = i0n; eln[64 + lane] = i1n; wln[lane] = w0n; wln[64 + lane] = w1n;
          __builtin_amdgcn_wave_barrier();
          gs_issue(nxt, EV, eln, grp);
          const f32x2 xcur = xc, gcur = gc;
          xc = xn; gc = gn;
          const int tnn = tn + tstep < ntok ? tn + tstep : tn;
          i0n = p.pidx[(size_t)tnn * 128 + lane]; i1n = p.pidx[(size_t)tnn * 128 + 64 + lane];
          w0n = p.wbuf[(size_t)tnn * 128 + lane]; w1n = p.wbuf[(size_t)tnn * 128 + 64 + lane];
          xn = *(const f32x2*)(p.xres + (size_t)tnn * 1024 + col);
          gn = *(const f32x2*)(p.modv + ((size_t)layer * 5 + tok_batch(tnn)) * NMOD + 5120 + col);
          f32x2 acc2[8];
#pragma unroll
          for (int j = 0; j < 8; ++j) acc2[j] = (f32x2){0.f, 0.f};
#pragma unroll
          for (int k = 0; k < 16; ++k) fma16_fp8(acc2, cur[k], wlc[k * 8 + grp]);
          float a16[16];
#pragma unroll
          for (int q = 0; q < 8; ++q) { a16[2 * q] = acc2[q].x; a16[2 * q + 1] = acc2[q].y; }
          float a8[8], a4[4], a2[2];
#pragma unroll
          for (int q = 0; q < 8; ++q) { const float send = b3 ? a16[q] : a16[q + 8]; const float keep = b3 ? a16[q + 8] : a16[q]; a8[q] = keep + __shfl_xor(send, 8); }
#pragma unroll
          for (int q = 0; q < 4; ++q) { const float send = b4 ? a8[q] : a8[q + 4]; const float keep = b4 ? a8[q + 4] : a8[q]; a4[q] = keep + __shfl_xor(send, 16); }
#pragma unroll
          for (int q = 0; q < 2; ++q) { const float send = b5 ? a4[q] : a4[q + 2]; const float keep = b5 ? a4[q + 2] : a4[q]; a2[q] = keep + __shfl_xor(send, 32); }
          f32x2 xv = xcur;
          xv.x += gcur.x * a2[0]; xv.y += gcur.y * a2[1];
          *(f32x2*)(xout + (size_t)tc * 1024 + col) = xv;
        }
      }
    }
    __builtin_amdgcn_wave_barrier();
  }
}
__device__ __forceinline__ void phase_gather_norm(const Params& p, int layer, int ntok, int bid, int nblk) {
  const int tid = opaque_tid(); const int lane = tid & 63, wid = tid >> 6;
  for (int t = bid * NW + wid; t < ntok; t += nblk * NW) {
    f32x4 xv[4];
    float ss = 0.f;
#pragma unroll
    for (int q = 0; q < 4; ++q) {
      xv[q] = *(const f32x4*)(p.xres + (size_t)t * 1024 + lane * 16 + q * 4);
      ss += xv[q][0] * xv[q][0] + xv[q][1] * xv[q][1] + xv[q][2] * xv[q][2] + xv[q][3] * xv[q][3];
    }
    ss = wave_sum(ss);
    const float rstd = rsqrtf(ss * (1.f / 1024.f) + EPSV);
    if (layer == 0) {
      const float* md1 = p.modv + ((size_t)5 + tok_batch(t)) * NMOD;
#pragma unroll
      for (int q = 0; q < 4; ++q) {
        const int c0 = lane * 16 + q * 4;
        const f32x4 g = *(const f32x4*)(p.norm1_g + 1024 + c0);
        const f32x4 sh = *(const f32x4*)(md1 + c0);
        const f32x4 sc = *(const f32x4*)(md1 + 1024 + c0);
        ushort4 o;
        o.x = f2bf(xv[q][0] * rstd * g[0] * (1.f + sc[0]) + sh[0]);
        o.y = f2bf(xv[q][1] * rstd * g[1] * (1.f + sc[1]) + sh[1]);
        o.z = f2bf(xv[q][2] * rstd * g[2] * (1.f + sc[2]) + sh[2]);
        o.w = f2bf(xv[q][3] * rstd * g[3] * (1.f + sc[3]) + sh[3]);
        *(ushort4*)(p.abuf + (size_t)t * 1024 + c0) = o;
      }
    } else {
#pragma unroll
      for (int q = 0; q < 4; ++q) {
        const int c0 = lane * 16 + q * 4;
        const f32x4 g = *(const f32x4*)(p.final_g + c0);
        f32x4 o;
        o[0] = xv[q][0] * rstd * g[0]; o[1] = xv[q][1] * rstd * g[1]; o[2] = xv[q][2] * rstd * g[2]; o[3] = xv[q][3] * rstd * g[3];
        *(f32x4*)(p.out + (size_t)t * 1024 + c0) = o;
      }
    }
  }
}

__device__ __forceinline__ void phase_final(const Params& p, int bid, int nblk) {
  const int tid = opaque_tid(); const int lane = tid & 63, wid = tid >> 6;
  for (int t = bid * 4 + wid; t < TL; t += nblk * 4) {
    const float* row = p.xres + (size_t)t * 1024;
    f32x4 v[4];
    float ss = 0.f;
#pragma unroll
    for (int j = 0; j < 4; ++j) {
      v[j] = *(const f32x4*)(row + j * 256 + lane * 4);
      ss += v[j][0] * v[j][0] + v[j][1] * v[j][1] + v[j][2] * v[j][2] + v[j][3] * v[j][3];
    }
    ss = wave_sum(ss);
    const float rstd = rsqrtf(ss * (1.f / 1024.f) + EPSV);
#pragma unroll
    for (int j = 0; j < 4; ++j) {
      const int c0 = j * 256 + lane * 4;
      const f32x4 g = *(const f32x4*)(p.final_g + c0);
      f32x4 o;
      o[0] = v[j][0] * rstd * g[0]; o[1] = v[j][1] * rstd * g[1]; o[2] = v[j][2] * rstd * g[2]; o[3] = v[j][3] * rstd * g[3];
      *(f32x4*)(p.out + (size_t)t * 1024 + c0) = o;
    }
  }
}

template <class Epi>
__device__ __forceinline__ void run_gemm(const bf16_t* A, const bf16_t* Bt, int M, int N, int K, const Epi& epi, int bid, int nblk, unsigned char* smem) {
  pg8::Gemm g{A, Bt, M, N, K};
  pg8::StaticOrder S; S.init(M, N, nblk, bid);
  pg8::gemm_phase(( PG8_LAS unsigned char*)smem, g, S, epi);
}
__device__ __forceinline__ void phase_gemm_in(const Params& p, int layer, int bid, int nblk, unsigned char* smem) {
  pg8::EpiBf16 epi{p.cols, INW, INW};
  run_gemm(p.abuf, p.wt_in + (size_t)layer * INWP * 1024, TT, INWP, 1024, epi, bid, nblk, smem);
}
__device__ __forceinline__ void phase_gemm_glu(const Params& p, int layer, int ntok, int bid, int nblk, unsigned char* smem) {
  pg8::EpiGlu epi{p.mix};
  run_gemm(p.yg, p.wt_glu + (size_t)layer * 512 * 256, ntok, 512, 256, epi, bid, nblk, smem);
}
__device__ __forceinline__ void phase_gemm_out(const Params& p, int layer, int ntok, int bid, int nblk, unsigned char* smem) {
  pg8::EpiResid epi{p.xres, p.modv + (size_t)layer * 5 * NMOD, 2048};
  run_gemm(p.mix, p.wt_out + (size_t)layer * 1024 * 1024, ntok, 1024, 1024, epi, bid, nblk, smem);
}
__device__ __forceinline__ void phase_gemm_q(const Params& p, int layer, int ntok, int bid, int nblk, unsigned char* smem) {
  pg8::EpiBf16 epi{p.cols  , 2048, 2048};
  run_gemm(p.abuf, p.wt_q + (size_t)layer * 2048 * 1024, ntok, 2048, 1024, epi, bid, nblk, smem);
}

template <int L>
__device__ __forceinline__ void layer_body(const Params& p, const XcdBarrier& bar, const XcdInfo xin, int bid, int nblk, unsigned char* smem) {
  constexpr int l = L;
  constexpr int ntok = L == 0 ? TT : TL;
  for (int rep = 0; rep < REP_GEMM; ++rep) phase_gemm_in(p, l, bid, nblk, smem);
  xcd_barrier(bar);
  for (int rep = 0; rep < REP_MIX; ++rep) {
    phase_s5a(p, l, bid, nblk, smem);
    if (REP_S5 > 1) phase_s5a(p, l, bid, nblk, smem);
    for (int r2 = 0; r2 < REP_GLA; ++r2) phase_glaa(p, l, bid, nblk, smem);
  }
  xcd_barrier(bar);
  phase_scan(p, l, bid, nblk);
  for (int r2 = 0; r2 < REP_SGU; ++r2) phase_sgu(p, l, ntok / 128, bid, nblk, smem);
  xcd_barrier(bar);
  for (int rep = 0; rep < REP_MIX; ++rep) {
    phase_s5c(p, l, ntok / 64, bid, nblk, smem);
    if (REP_S5 > 1) phase_s5c(p, l, ntok / 64, bid, nblk, smem);
    for (int r2 = 0; r2 < REP_GLA; ++r2) phase_glac(p, l, ntok / 64, 16 * ((ntok / 64 / 16 + 1) / 2), bid, nblk, smem);
  }
  xcd_barrier(bar);
  for (int rep = 0; rep < REP_GEMM; ++rep) phase_gemm_glu(p, l, ntok, bid, nblk, smem);
  xcd_barrier(bar);
  if (REP_GEMM > 1) {
    pg8::EpiBf16 epi{p.abuf, 1024, 1024};
    for (int rep = 1; rep < REP_GEMM; ++rep) run_gemm(p.mix, p.wt_out + (size_t)l * 1024 * 1024, ntok, 1024, 1024, epi, bid, nblk, smem);
  }
  phase_gemm_out(p, l, ntok, bid, nblk, smem);
  if (l == 0 && nblk > 16 && bid >= 16) {
    const int tid = opaque_tid();
    for (int j = bid - 16; j < 2048; j += nblk - 16) convert_rows(p, (j >> 10) * 2048 + 1024 + (j & 1023), tid);
  } else if (l == 0 && nblk <= 16) {
    const int tid = opaque_tid();
    for (int j = bid; j < 2048; j += nblk) convert_rows(p, (j >> 10) * 2048 + 1024 + (j & 1023), tid);
  }
  xcd_barrier(bar);
  for (int rep = 0; rep < REP_PRO; ++rep)
    phase_normmod(p, p.xres, p.xres + (size_t)TL * 1024, p.norm2_g + l * 1024, p.modv + (size_t)l * 5 * NMOD, 3072, 4096, ntok, 0, bid, nblk);
  xcd_barrier(bar);
  for (int rep = 0; rep < REP_GEMM; ++rep) phase_gemm_q(p, l, ntok, bid, nblk, smem);
  xcd_barrier(bar);
  for (int rep = 0; rep < REP_ROUTE; ++rep) phase_route(p, l, ntok, bid, nblk, smem);
  xcd_barrier(bar);
  phase_gather_u(p, l, ntok, xin, smem);
  if (REP_GATHER == 2) phase_gather_u(p, l, ntok, xin, smem);
  xcd_barrier(bar);
  phase_gather_r(p, l, ntok, bid, nblk);
  xcd_barrier(bar);
  if (REP_GATHER > 2) phase_gather_v<true>(p, l, ntok, xin, smem);
  phase_gather_v<false>(p, l, ntok, xin, smem);
  xcd_barrier(bar);
  phase_gather_norm(p, l, ntok, bid, nblk);
  if (l == 0) xcd_barrier(bar);
}

#define SMEM_BYTES (148 * 1024)
__global__ void __launch_bounds__(NT) mega_kernel(Params p) {
  __shared__ __attribute__((aligned(16))) unsigned char smem[SMEM_BYTES + 16];
  const int bid = blockIdx.x, nblk = gridDim.x;
  volatile LAS unsigned* xbw = (volatile LAS unsigned*)(smem + SMEM_BYTES);
  if (threadIdx.x == 0) { xbw[0] = 0u; xbw[1] = 0u; xbw[2] = 0u; xbw[3] = 0u; }
  __syncthreads();
  XcdBarrier bar = xcd_barrier_post(p.bar, xbw);
  for (int rep = 0; rep < REP_PRO; ++rep) {
    phase_mod(p, bid, nblk, smem);
    phase_wprep(p, bid, nblk, smem);
  }
  xcd_barrier(bar);
  for (int rep = 0; rep < REP_PRO; ++rep) phase_normmod(p, p.x, p.ctx, p.norm1_g, p.modv, 0, 1024, TT, 1, bid, nblk);
  xcd_barrier(bar);
  const XcdInfo xin = xcd_info(bar);
  layer_body<0>(p, bar, xin, bid, nblk, smem);
  layer_body<1>(p, bar, xin, bid, nblk, smem);
}

static inline size_t align_up(size_t v, size_t a) { return (v + a - 1) / a * a; }

extern "C" void kernel_launch(void* const* d_in, const int* in_sizes, int n_in, void* d_out, int out_size, void* d_ws, size_t ws_size,
                              hipStream_t stream) {
  Params p{};
  const float* const* in = (const float* const*)d_in;
  p.x = in[0]; p.c = in[1]; p.ctx = in[2]; p.c_ctx = in[3]; p.w_mod = in[4]; p.b_mod = in[5]; p.norm1_g = in[6]; p.norm2_g = in[7];
  p.w_in = in[8]; p.w_out = in[9]; p.sgu_w = in[10]; p.sgu_b = in[11]; p.lam_re = in[12]; p.lam_im = in[13]; p.b_re = in[14]; p.b_im = in[15];
  p.c_re = in[16]; p.c_im = in[17]; p.log_step = in[18]; p.s5_d = in[19]; p.w_glu = in[20]; p.gla_wg = in[21]; p.gla_bg = in[22]; p.gla_ng = in[23];
  p.w_query = in[24]; p.sub_keys = in[25]; p.exp_u = in[26]; p.exp_v = in[27]; p.final_g = in[28];
  p.out = (float*)d_out;
  unsigned char* w = (unsigned char*)d_ws;
  size_t off = 0;
  auto take = [&](size_t bytes) { void* r = w + off; off = align_up(off + bytes, 256); return r; };
  p.bar = (unsigned*)take(16384);
  p.xres = (float*)take((size_t)TT * 1024 * 4);
  p.modv = (float*)take((size_t)2 * 5 * NMOD * 4);
  p.abuf = (bf16_t*)take((size_t)TT * 1024 * 2);
  p.cols = (bf16_t*)take((size_t)TT * INW * 2);
  p.mix = (bf16_t*)take((size_t)TT * 1024 * 2);
  p.yg = (bf16_t*)take((size_t)TT * 256 * 2);
  p.wt_in = (bf16_t*)take((size_t)2 * INWP * 1024 * 2);
  p.wt_out = (bf16_t*)take((size_t)2 * 1024 * 1024 * 2);
  p.wt_q = (bf16_t*)take((size_t)2 * 2048 * 1024 * 2);
  p.wt_glu = (bf16_t*)take((size_t)2 * 512 * 256 * 2);
  p.keysb = (bf16_t*)take((size_t)2 * 2 * 8 * 128 * 128 * 2);
  p.sgu_wb = (bf16_t*)take((size_t)2 * 4 * 128 * 128 * 2);
  p.s5a = (float*)take((size_t)4096 * 2 * 4);
  p.s5a64 = (float*)take((size_t)4096 * 2 * 4);
  p.s5bb = (float*)take((size_t)4096 * 32 * 4);
  p.s5K = (bf16_t*)take((size_t)64 * 16384 * 2);
  p.s5M1 = (bf16_t*)take((size_t)64 * 131072 * 2);
  p.s5N2 = (bf16_t*)take((size_t)64 * 131072 * 2);
  p.s5S = (float*)take((size_t)2 * NSC * 16 * 64 * 2 * 4);
  p.s5H = (float*)take((size_t)2 * NSC * 16 * 64 * 2 * 4);
  p.gkv = (float*)take((size_t)2 * NSC * 8 * 2048 * 4);
  p.gdec = (float*)take((size_t)2 * NSC * 8 * 32 * 4);
  p.eu8 = (unsigned char*)take((size_t)2 * 16384 * 1024);
  p.ev8 = (unsigned char*)take((size_t)2 * 16384 * 1024);
  p.su = (float*)take((size_t)2 * 16384 * 4);
  p.sv = (float*)take((size_t)2 * 16384 * 4);
  p.glb = (float*)take((size_t)2 * TT * 256 * 4);
  p.wbuf = (float*)take((size_t)TT * 128 * 4);
  p.ssbuf = (float*)take((size_t)TT * 8 * 4);
  p.pidx = (int*)take((size_t)TT * 128 * 4);
  p.pgate = (float*)take((size_t)TT * 128 * 4);
  if (off > ws_size) { fprintf(stderr, "workspace too small: need %zu have %zu\n", off, ws_size); return; }

  (void)hipMemsetAsync(p.bar, 0, XCD_BAR_WORDS * 4, stream);
  static int grid_blocks = 0;
  if (!grid_blocks) {
    int dev = 0, cus = 0, per_cu = 0;
    (void)hipGetDevice(&dev);
    (void)hipDeviceGetAttribute(&cus, hipDeviceAttributeMultiprocessorCount, dev);
    (void)hipOccupancyMaxActiveBlocksPerMultiprocessor(&per_cu, (const void*)mega_kernel, NT, 0);
    if (per_cu < 1) { fprintf(stderr, "occupancy query says 0 blocks/CU\n"); per_cu = 1; }
    grid_blocks = cus;
  }
  void* args[] = {&p};
  hipError_t e = hipLaunchCooperativeKernel((const void*)mega_kernel, dim3(grid_blocks), dim3(NT), args, 0, stream);
  if (e != hipSuccess) fprintf(stderr, "cooperative launch failed: %s (grid %d)\n", hipGetErrorString(e), grid_blocks);
}
```

```cpp
#include <hip/hip_runtime.h>
#include <cstdio>
#include <cstdint>
#include <cmath>

typedef unsigned short bf16_t;
typedef short bf16x8 __attribute__((ext_vector_type(8)));
typedef float f32x4 __attribute__((ext_vector_type(4)));

#define DM 1024
#define NBATCH 4
#define SEQ 4096
#define CTXL 256
#define TL (NBATCH * SEQ)
#define TC (NBATCH * CTXL)
#define TT (TL + TC)
#define INW 2336
#define INWP 2560
#define NMOD 6144
#define NSC 272
#define EPSV 1e-6f
#define NT 512
#define NW 8
#ifndef REP_GATHER
#define REP_GATHER 1
#endif
#ifndef REP_ROUTE
#define REP_ROUTE 1
#endif
#ifndef REP_GEMM
#define REP_GEMM 1
#endif
#ifndef REP_MIX
#define REP_MIX 1
#endif
#ifndef REP_PRO
#define REP_PRO 1
#endif
#ifndef REP_SGU
#define REP_SGU 1
#endif
#ifndef REP_S5
#define REP_S5 1
#endif
#ifndef REP_GLA
#define REP_GLA 1
#endif

#define C_SGU_U 0
#define C_SGU_V 256
#define C_S5 512
#define C_GQ 768
#define C_GK 1024
#define C_GV 1280
#define C_GG 1792
#define C_ZF 2304

struct Params {
  const float *x, *c, *ctx, *c_ctx, *w_mod, *b_mod, *norm1_g, *norm2_g, *w_in, *w_out, *sgu_w, *sgu_b;
  const float *lam_re, *lam_im, *b_re, *b_im, *c_re, *c_im, *log_step, *s5_d, *w_glu, *gla_wg, *gla_bg, *gla_ng;
  const float *w_query, *sub_keys, *exp_u, *exp_v, *final_g;
  float* out;
  unsigned* bar;
  float* xres;
  float* modv;
  bf16_t* abuf;
  bf16_t* cols;
  bf16_t* mix;
  bf16_t* yg;
  bf16_t *wt_in, *wt_out, *wt_q, *wt_glu, *keysb, *sgu_wb;
  float *s5a, *s5a64, *s5bb;
  bf16_t *s5K, *s5M1, *s5N2;
  float *s5S, *s5H;
  float *gkv, *gdec;
  unsigned char *eu8, *ev8;
  float *su, *sv;
  float* glb;
  float *wbuf, *ssbuf;
  int* pidx;
  float* pgate;
};

__device__ __forceinline__ bf16_t f2bf(float f) {
  unsigned u = __float_as_uint(f);
  u += 0x7fffu + ((u >> 16) & 1u);
  return (bf16_t)(u >> 16);
}
__device__ __forceinline__ float bf2f(bf16_t h) { return __uint_as_float(((unsigned)h) << 16); }
__device__ __forceinline__ bf16x8 pack_bf16x8(const float* v) {
  bf16x8 r;
#pragma unroll
  for (int c = 0; c < 8; ++c) r[c] = (short)f2bf(v[c]);
  return r;
}

__device__ __forceinline__ float bflo(unsigned u) { return __uint_as_float(u << 16); }
__device__ __forceinline__ float bfhi(unsigned u) { return __uint_as_float(u & 0xffff0000u); }
__device__ __forceinline__ float gelu_f(float x) {
  const float y = 0.7978845608028654f * (x + 0.044715f * x * x * x);
  const float e = __expf(2.f * y);
  const float th = 1.f - 2.f / (1.f + e);
  return 0.5f * x * (1.f + th);
}
__device__ __forceinline__ float sigmoid_f(float x) { return 1.f / (1.f + __expf(-x)); }
__device__ __forceinline__ float silu_f(float x) { return x * sigmoid_f(x); }
__device__ __forceinline__ float logsigmoid_f(float x) { return fminf(x, 0.f) - log1pf(__expf(-fabsf(x))); }
__device__ __forceinline__ float wave_sum(float v) {
#pragma unroll
  for (int o = 32; o > 0; o >>= 1) v += __shfl_xor(v, o);
  return v;
}
__device__ __forceinline__ void lds_barrier() {
  asm volatile("s_waitcnt lgkmcnt(0)" ::: "memory");
  __builtin_amdgcn_s_barrier();
  asm volatile("" ::: "memory");
}
__device__ __forceinline__ int opaque_tid() { int t = threadIdx.x; asm volatile("" : "+v"(t)); return t; }
__device__ __forceinline__ int tok_batch(int t) { return t < TL ? (t >> 12) : 4; }
__device__ __forceinline__ int s5_tok(int sc, int i) { return sc < 256 ? ((sc >> 6) * SEQ + (sc & 63) * 64 + i) : (TL + (sc - 256) * 64 + i); }
__device__ __forceinline__ int gla_tok(int sc, int i) { return sc < 256 ? ((sc >> 6) * SEQ + i * 64 + (sc & 63)) : (TL + (sc - 256) * 64 + i); }


#define XB_TMO      128
#define XB_XCNT(j)  (256  + 64 * (j))
#define XB_XSUB(j)  (1280 + 64 * (j))
#define XB_XGEN(j)  (2304 + 64 * (j))
#define XB_TOP      3328
#define XB_TOPGEN   3392
#define XCD_BAR_WORDS 3456
#define XB_SPIN_CAP (1u << 22)
#define LAS __attribute__((address_space(3)))
__device__ __forceinline__ unsigned xb_ld(unsigned* p)              { return __hip_atomic_load(p, __ATOMIC_RELAXED, __HIP_MEMORY_SCOPE_AGENT); }
__device__ __forceinline__ unsigned xb_add(unsigned* p, unsigned v) { return __hip_atomic_fetch_add(p, v, __ATOMIC_RELAXED, __HIP_MEMORY_SCOPE_AGENT); }
__device__ __forceinline__ unsigned xb_xcc_id() { return (unsigned)__builtin_amdgcn_s_getreg((3 << 11) | 20) & 0xFu; }
#define XB_SPIN(cond, bar) do { unsigned _sp = 0; while (cond) { __builtin_amdgcn_s_sleep(1); \
    if ((++_sp & 255u) == 0u) { if (xb_ld(&(bar)[XB_TMO])) break; if (_sp > XB_SPIN_CAP) { atomicAdd(&(bar)[XB_TMO], 1u); break; } } } } while (0)
struct XcdBarrier { unsigned* bar; unsigned x; volatile LAS unsigned* st; };
__device__ __forceinline__ XcdBarrier xcd_barrier_post(unsigned* bar, volatile LAS unsigned* st) {
  XcdBarrier b; b.bar = bar; b.x = xb_xcc_id(); b.st = st;
  if (threadIdx.x == 0) st[2] = xb_add(&bar[XB_XCNT(b.x)], 1u);
  return b;
}
__device__ __forceinline__ void xcd_barrier_complete(unsigned* bar, unsigned x, unsigned& nloc, unsigned& nx) {
  const unsigned G = gridDim.x * gridDim.y * gridDim.z;
  unsigned sum, cnt, mine, sp = 0u;
  for (;;) {
    sum = 0u; cnt = 0u; mine = 0u;
#pragma unroll
    for (unsigned j = 0; j < 16; ++j) { const unsigned c = xb_ld(&bar[XB_XCNT(j)]); sum += c; cnt += (c > 0u) ? 1u : 0u; mine = (j == x) ? c : mine; }
    if (sum == G) break;
    __builtin_amdgcn_s_sleep(1);
    if ((++sp & 255u) == 0u) { if (xb_ld(&bar[XB_TMO])) break; if (sp > XB_SPIN_CAP) { atomicAdd(&bar[XB_TMO], 1u); break; } }
  }
  nloc = mine > 0u ? mine : 1u; nx = cnt > 0u ? cnt : 1u;
}
__device__ __forceinline__ void xcd_barrier(const XcdBarrier& b) {
  asm volatile("s_waitcnt vmcnt(0)" ::: "memory");
  __syncthreads();
  if (threadIdx.x == 0) {
    unsigned* bar = b.bar;
    __builtin_amdgcn_s_waitcnt(0);
    unsigned nloc = b.st[0], nx = b.st[1];
    if (nloc == 0u) { xcd_barrier_complete(bar, b.x, nloc, nx); b.st[0] = nloc; b.st[1] = nx; }
    const unsigned old = xb_add(&bar[XB_XSUB(b.x)], 1u);
    const unsigned gen = old / nloc;
    if (old + 1u == (gen + 1u) * nloc) {
      __builtin_amdgcn_fence(__ATOMIC_RELEASE, "agent");
      asm volatile("s_waitcnt vmcnt(0)" ::: "memory");
      const unsigned og = xb_add(&bar[XB_TOP], 1u);
      const unsigned tg = og / nx;
      if (og + 1u == (tg + 1u) * nx) xb_add(&bar[XB_TOPGEN], 1u);
      else XB_SPIN(xb_ld(&bar[XB_TOPGEN]) == tg, bar);
      __builtin_amdgcn_fence(__ATOMIC_ACQUIRE, "agent");
      xb_add(&bar[XB_XGEN(b.x)], 1u);
      asm volatile("s_waitcnt vmcnt(0)" ::: "memory");
    } else {
      XB_SPIN(xb_ld(&bar[XB_XGEN(b.x)]) == gen, bar);
      __builtin_amdgcn_fence(__ATOMIC_ACQUIRE, "agent");
      asm volatile("s_waitcnt vmcnt(0)" ::: "memory");
    }
  }
  __syncthreads();
}

__device__ __forceinline__ void phase_mod(const Params& p, int bid, int nblk, unsigned char* smem) {
  float* sil = (float*)smem;
  float* red = sil + 5 * 1024;
  const int tid = opaque_tid();
  for (int i = tid; i < 5 * 1024; i += NT) {
    const int r = i >> 10, k = i & 1023;
    const float v = r < 4 ? p.c[r * 1024 + k] : p.c_ctx[k];
    sil[i] = silu_f(v);
  }
  __syncthreads();
  for (int item = bid; item < 192; item += nblk) {
    const int l = item / 96, j0 = (item % 96) * 64;
    const int cc = tid & 63, kg = tid >> 6;
    float acc[5] = {0.f, 0.f, 0.f, 0.f, 0.f};
    const float* w = p.w_mod + (size_t)l * 1024 * NMOD + j0 + cc;
#pragma unroll 32
    for (int k = kg * 128; k < kg * 128 + 128; ++k) {
      const float wv = w[(size_t)k * NMOD];
#pragma unroll
      for (int r = 0; r < 5; ++r) acc[r] += sil[r * 1024 + k] * wv;
    }
#pragma unroll
    for (int r = 0; r < 5; ++r) red[(kg * 5 + r) * 64 + cc] = acc[r];
    __syncthreads();
    if (tid < 320) {
      const int r = tid >> 6;
      float s = 0.f;
#pragma unroll
      for (int g = 0; g < 8; ++g) s += red[(g * 5 + r) * 64 + cc];
      p.modv[((size_t)l * 5 + r) * NMOD + j0 + cc] = s + p.b_mod[l * NMOD + j0 + cc];
    }
    __syncthreads();
  }
}

__device__ __forceinline__ void transpose_tile(const float* src, int ldsrc, bf16_t* dst, int lddst, int k0, int r0, int nsrc, int glu, float* tile) {
  const int tid = opaque_tid();
  const int j = tid & 63;
  const int r = r0 + j;
  int scol;
  if (glu) {
    const int pn = r >> 8, bj = (r >> 7) & 1, i = r & 127;
    scol = bj * 256 + pn * 128 + i;
  } else {
    scol = r < nsrc ? r : -1;
  }
  float v[32];
#pragma unroll
  for (int it = 0; it < 32; ++it) {
    const int kk = (tid >> 6) + it * 8;
    v[it] = scol >= 0 ? src[(size_t)(k0 + kk) * ldsrc + scol] : 0.f;
  }
#pragma unroll
  for (int it = 0; it < 32; ++it) {
    const int kk = (tid >> 6) + it * 8;
    tile[(kk >> 6) * 4160 + (kk & 63) * 65 + j] = v[it];
  }
  __syncthreads();
  const int kq = tid & 63;
#pragma unroll
  for (int it = 0; it < 32; ++it) {
    const int jj = (tid >> 6) + (it & 7) * 8, sub = it >> 3;
    dst[(size_t)(r0 + jj) * lddst + k0 + sub * 64 + kq] = f2bf(tile[sub * 4160 + kq * 65 + jj]);
  }
  __syncthreads();
}

__device__ __forceinline__ void s5_tables(const Params& p, int id, int part, unsigned char* smem) {
  const int tid = opaque_tid();
  float2* Apow = (float2*)smem;
  float2* Bbs = Apow + 65 * 64;
  float2* Cs = Bbs + 64 * 16;
  __syncthreads();
  if (tid < 64) {
    const int pid = id * 64 + tid;
    double lre = (double)p.lam_re[pid];
    if (lre > -1e-4) lre = -1e-4;
    const double lim = (double)p.lam_im[pid];
    const double dt = exp((double)p.log_step[id]);
    const double mag = exp(lre * dt);
    const double are = mag * cos(lim * dt), aim = mag * sin(lim * dt);
    {
      double pr = 1.0, pi = 0.0;
      for (int n = 0; n <= 64; ++n) {
        Apow[n * 64 + tid] = make_float2((float)pr, (float)pi);
        const double nr = pr * are - pi * aim, ni = pr * aim + pi * are;
        pr = nr; pi = ni;
      }
    }
    const double den = lre * lre + lim * lim;
    const double fre = ((are - 1.0) * lre + aim * lim) / den;
    const double fim = (aim * lre - (are - 1.0) * lim) / den;
    for (int h = 0; h < 16; ++h) {
      const double br = (double)p.b_re[(size_t)pid * 16 + h], bi = (double)p.b_im[(size_t)pid * 16 + h];
      Bbs[tid * 16 + h] = make_float2((float)(fre * br - fim * bi), (float)(fre * bi + fim * br));
    }
  }
  for (int e = tid; e < 1024; e += NT) Cs[e] = make_float2(p.c_re[(size_t)id * 1024 + e], p.c_im[(size_t)id * 1024 + e]);
  __syncthreads();
  bf16_t* Kt = p.s5K + (size_t)id * 16384;
  for (int e = part * 2048 + tid; e < part * 2048 + 2048; e += NT) {
    const int d = e >> 8, hp = (e >> 4) & 15, h = e & 15;
    float acc = 0.f;
    for (int pp = 0; pp < 64; ++pp) {
      const float2 c = Cs[hp * 64 + pp], a = Apow[d * 64 + pp], b = Bbs[pp * 16 + h];
      const float cr = c.x * a.x - c.y * a.y, ci = c.x * a.y + c.y * a.x;
      acc += cr * b.x - ci * b.y;
    }
    Kt[e] = f2bf(acc);
  }
  bf16_t* M1 = p.s5M1 + (size_t)id * 131072;
  for (int e = part * 16384 + tid; e < part * 16384 + 16384; e += NT) {
    const int c = e >> 10, k = e & 1023, ri = c >> 6, pp = c & 63, tau = k >> 4, h = k & 15;
    const float2 a = Apow[(63 - tau) * 64 + pp], b = Bbs[pp * 16 + h];
    M1[e] = f2bf(ri ? (a.x * b.y + a.y * b.x) : (a.x * b.x - a.y * b.y));
  }
  bf16_t* N2 = p.s5N2 + (size_t)id * 131072;
  for (int e = part * 16384 + tid; e < part * 16384 + 16384; e += NT) {
    const int col = e >> 7, kk = e & 127, tau = col >> 4, hp = col & 15, ri = kk >> 6, pp = kk & 63;
    const float2 c = Cs[hp * 64 + pp], a = Apow[(tau + 1) * 64 + pp];
    N2[e] = f2bf(ri ? -(c.x * a.y + c.y * a.x) : (c.x * a.x - c.y * a.y));
  }
  __syncthreads();
}

__device__ __forceinline__ void convert_rows(const Params& p, int it, int tid) {
      const int lane = tid & 63;
      const int row0 = it * 16 + (tid >> 6) * 2;
      const int tab = row0 >> 15, r0 = row0 & 32767;
      const float* s = (tab ? p.exp_v : p.exp_u) + (size_t)r0 * 1024 + lane * 16;
      f32x4 v[2][4];
#pragma unroll
      for (int rr = 0; rr < 2; ++rr)
#pragma unroll
        for (int q = 0; q < 4; ++q) v[rr][q] = *(const f32x4*)(s + rr * 1024 + q * 4);
#pragma unroll
      for (int rr = 0; rr < 2; ++rr) {
        float m = 0.f;
#pragma unroll
        for (int q = 0; q < 4; ++q) m = fmaxf(m, fmaxf(fmaxf(fabsf(v[rr][q][0]), fabsf(v[rr][q][1])), fmaxf(fabsf(v[rr][q][2]), fabsf(v[rr][q][3]))));
#pragma unroll
        for (int o = 32; o > 0; o >>= 1) m = fmaxf(m, __shfl_xor(m, o));
        const float scale = m > 0.f ? m * (1.f / 400.f) : 1.f;
        const float inv = 1.f / scale;
        unsigned wv[4];
#pragma unroll
        for (int q = 0; q < 4; ++q) {
          unsigned w = 0;
          w = __builtin_amdgcn_cvt_pk_fp8_f32(v[rr][q][0] * inv, v[rr][q][1] * inv, w, false);
          w = __builtin_amdgcn_cvt_pk_fp8_f32(v[rr][q][2] * inv, v[rr][q][3] * inv, w, true);
          wv[q] = w;
        }
        *(uint4*)((tab ? p.ev8 : p.eu8) + (size_t)(r0 + rr) * 1024 + lane * 16) = make_uint4(wv[0], wv[1], wv[2], wv[3]);
        if (lane == 0) (tab ? p.sv : p.su)[r0 + rr] = scale;
      }
}

__device__ __forceinline__ void phase_wprep(const Params& p, int bid, int nblk, unsigned char* smem) {
  float* tile = (float*)smem;
  const int tid = opaque_tid();
  const int NT_L = 360;
  const int n_tr = 2 * NT_L;
  const int n_keys = 256 + 64;
  const int n_disc = 8;
  const int n_exp = 2048;
  const int n_s5t = 512;
  const int total = n_tr + n_keys + n_disc + n_exp + n_s5t;
  for (int item0 = bid; item0 < total; item0 += nblk) {
    const int item = item0 - n_s5t;
    if (item0 < n_s5t) {
      s5_tables(p, item0 >> 3, item0 & 7, smem);
    } else if (item < n_tr) {
      const int l = item / NT_L;
      int t = item % NT_L;
      if (t < 160) {
        transpose_tile(p.w_in + (size_t)l * 1024 * INW, INW, p.wt_in + (size_t)l * INWP * 1024, 1024, (t % 4) * 256, (t / 4) * 64, INW, 0, tile);
      } else if (t < 224) {
        t -= 160;
        transpose_tile(p.w_out + (size_t)l * 1024 * 1024, 1024, p.wt_out + (size_t)l * 1024 * 1024, 1024, (t % 4) * 256, (t / 4) * 64, 1024, 0, tile);
      } else if (t < 352) {
        t -= 224;
        transpose_tile(p.w_query + (size_t)l * 1024 * 2048, 2048, p.wt_q + (size_t)l * 2048 * 1024, 1024, (t % 4) * 256, (t / 4) * 64, 2048, 0, tile);
      } else {
        t -= 352;
        transpose_tile(p.w_glu + (size_t)l * 256 * 512, 512, p.wt_glu + (size_t)l * 512 * 256, 256, 0, t * 64, 512, 1, tile);
      }
    } else if (item < n_tr + n_keys) {
      const int ki = item - n_tr;
      if (ki < 256) {
        const int base = ki * 2048;
        for (int i = tid; i < 2048; i += NT) p.keysb[base + i] = f2bf(p.sub_keys[base + i]);
      } else {
        const int base = (ki - 256) * 2048;
        for (int i = tid; i < 2048; i += NT) p.sgu_wb[base + i] = f2bf(p.sgu_w[base + i]);
      }
    } else if (item >= n_tr + n_keys + n_disc) {
      const int j = item - (n_tr + n_keys + n_disc);
      convert_rows(p, (j >> 10) * 2048 + (j & 1023), tid);
    } else {
      const int id = (item - n_tr - n_keys) * NT + tid;
      const int g = (id >> 6) & 15;
      const int ldg = id >> 6;
      double lre = (double)p.lam_re[id];
      if (lre > -1e-4) lre = -1e-4;
      const double lim = (double)p.lam_im[id];
      const double dt = exp((double)p.log_step[ldg]);
      const double mag = exp(lre * dt);
      const double are = mag * cos(lim * dt), aim = mag * sin(lim * dt);
      const double den = lre * lre + lim * lim;
      const double fre = ((are - 1.0) * lre + aim * lim) / den;
      const double fim = (aim * lre - (are - 1.0) * lim) / den;
      p.s5a[id * 2 + 0] = (float)are;
      p.s5a[id * 2 + 1] = (float)aim;
      double pr = are, pi = aim;
      for (int s = 0; s < 6; ++s) { const double nr = pr * pr - pi * pi, ni = 2.0 * pr * pi; pr = nr; pi = ni; }
      p.s5a64[id * 2 + 0] = (float)pr;
      p.s5a64[id * 2 + 1] = (float)pi;
      for (int h = 0; h < 16; ++h) {
        const double br = (double)p.b_re[(size_t)id * 16 + h], bi = (double)p.b_im[(size_t)id * 16 + h];
        p.s5bb[(size_t)id * 32 + h] = (float)(fre * br - fim * bi);
        p.s5bb[(size_t)id * 32 + 16 + h] = (float)(fre * bi + fim * br);
      }
      (void)g;
    }
  }
}

__device__ __forceinline__ void phase_normmod(const Params& p, const float* src_l, const float* src_c, const float* gain, const float* modl, int shift_off, int scale_off,
                              int ntok, int copy, int bid, int nblk) {
  const int tid = opaque_tid(); const int lane = tid & 63, wid = tid >> 6;
  for (int t = bid * NW + wid; t < ntok; t += nblk * NW) {
    const float* row = t < TL ? src_l + (size_t)t * 1024 : src_c + (size_t)(t - TL) * 1024;
    const float* md = modl + (size_t)tok_batch(t) * NMOD;
    f32x4 v[4];
    float ss = 0.f;
#pragma unroll
    for (int j = 0; j < 4; ++j) {
      v[j] = *(const f32x4*)(row + j * 256 + lane * 4);
      ss += v[j][0] * v[j][0] + v[j][1] * v[j][1] + v[j][2] * v[j][2] + v[j][3] * v[j][3];
    }
    ss = wave_sum(ss);
    const float rstd = rsqrtf(ss * (1.f / 1024.f) + EPSV);
#pragma unroll
    for (int j = 0; j < 4; ++j) {
      const int c0 = j * 256 + lane * 4;
      const f32x4 g = *(const f32x4*)(gain + c0);
      const f32x4 sh = *(const f32x4*)(md + shift_off + c0);
      const f32x4 sc = *(const f32x4*)(md + scale_off + c0);
      ushort4 o;
      o.x = f2bf(v[j][0] * rstd * g[0] * (1.f + sc[0]) + sh[0]);
      o.y = f2bf(v[j][1] * rstd * g[1] * (1.f + sc[1]) + sh[1]);
      o.z = f2bf(v[j][2] * rstd * g[2] * (1.f + sc[2]) + sh[2]);
      o.w = f2bf(v[j][3] * rstd * g[3] * (1.f + sc[3]) + sh[3]);
      *(ushort4*)(p.abuf + (size_t)t * 1024 + c0) = o;
      if (copy) *(f32x4*)(p.xres + (size_t)t * 1024 + c0) = v[j];
    }
  }
}

namespace pg8 {
#define PG8_LAS __attribute__((address_space(3)))
typedef unsigned u32x4 __attribute__((ext_vector_type(4)));
constexpr int BM = 256, BK = 64, HALF = 128, HTB = HALF * BK * 2, STAGE_BYTES = 8 * HTB, NXCD = 8, WGM = 8;
__device__ __forceinline__ int lds_byte(int r, int c) { const int st = (r >> 4) * 2 + (c >> 5), rr = r & 15, cc = c & 31, ob = rr * 64 + cc * 2; return st * 1024 + (ob ^ (((ob >> 9) & 1) << 5)); }
__device__ __forceinline__ void stage_rc(int b, int& R, int& C) { const int st = b / 1024, sb = b % 1024, swz = sb ^ (((sb >> 9) & 1) << 5); R = (st >> 1) * 16 + swz / 64; C = (st & 1) * 32 + (swz % 64) / 2; }
__device__ __forceinline__ int perm32(int rho) { const int n = rho >> 4, i = rho & 15; return 8 * (i >> 2) + 4 * n + (i & 3); }
struct Unit { int pm, pn; };
struct Gemm { const bf16_t* A; const bf16_t* Bt; int M, N, K; };
struct StaticOrder {
  int nM, nN, nwg, G, c;
  __device__ void init(int M, int N, int G_, int c_) { nM = M / BM; nN = N / BM; nwg = nM * nN; G = G_; c = c_; }
  __device__ bool next(int i, Unit& u) const {
    const long L = (long)i * G + c; if (L >= nwg) return false;
    int wgid = (int)L; { const int q = nwg / NXCD, r = nwg % NXCD, xcd = wgid % NXCD, off = wgid / NXCD; wgid = (xcd < r ? xcd * (q + 1) : r * (q + 1) + (xcd - r) * q) + off; }
    const int nig = WGM * nN, gid = wgid / nig, fm = gid * WGM, gsz = (nM - fm) < WGM ? (nM - fm) : WGM;
    u.pm = fm + ((wgid % nig) % gsz); u.pn = (wgid % nig) / gsz; return true;
  }
};
__device__ __forceinline__ unsigned cvt_pk_bf16(float lo, float hi) { unsigned r; asm volatile("v_cvt_pk_bf16_f32 %0, %1, %2" : "=v"(r) : "v"(lo), "v"(hi)); return r; }

template <class Epi>
__device__ __forceinline__ void gemm_phase(PG8_LAS unsigned char* lds, const Gemm g, const StaticOrder& S, const Epi& E) {
  const int tid = opaque_tid(), wid = __builtin_amdgcn_readfirstlane(tid >> 6), lane = tid & 63, wr = wid >> 2, wc = wid & 3, fr = lane & 15, fq = lane >> 4;
  const int K = g.K, nt = K / BK;
  unsigned voffA[2], voffB[2];
#pragma unroll
  for (int i = 0; i < 2; ++i) { int R, C; stage_rc(tid * 16 + i * 8192, R, C); const int Rb = Epi::PERM ? ((R & ~31) + perm32(R & 31)) : R;
    voffA[i] = (unsigned)(R * K + C) * 2u; voffB[i] = (unsigned)(Rb * K + C) * 2u; }
  const size_t kstep = (size_t)(BK * 2);
  const size_t hstep = (size_t)HALF * K * 2;
  const size_t tstep = 2 * hstep;
  const unsigned ldsw = (unsigned)wid * 1024u;
  const int aoff = lds_byte(wr * 64 + fr, fq * 8), boff = lds_byte(wc * 32 + fr, fq * 8);
#define PG8_SA(b, h) (((b) * 2 + (h)) * HTB)
#define PG8_SB(b, h) ((4 + (b) * 2 + (h)) * HTB)
#define PG8_STAGE(bufoff, gbase, voff) do { _Pragma("unroll") for (int _i = 0; _i < 2; ++_i) \
    __builtin_amdgcn_global_load_lds((const unsigned*)((const char*)(gbase) + (voff)[_i]), (PG8_LAS unsigned*)(lds + (bufoff) + ldsw + _i * 8192), 16, 0, 0); } while (0)
#define PG8_LDA(dst, b, h) do { _Pragma("unroll") for (int m = 0; m < 4; ++m) _Pragma("unroll") for (int k = 0; k < 2; ++k) dst[m][k] = *(const PG8_LAS bf16x8*)(lds + PG8_SA(b, h) + aoff + m * 2048 + k * 1024); } while (0)
#define PG8_LDB(dst, b, h) do { _Pragma("unroll") for (int n = 0; n < 2; ++n) _Pragma("unroll") for (int k = 0; k < 2; ++k) dst[n][k] = *(const PG8_LAS bf16x8*)(lds + PG8_SB(b, h) + boff + n * 2048 + k * 1024); } while (0)
#define PG8_MMA(ai, bj, At, Bt) do { __builtin_amdgcn_s_setprio(1); _Pragma("unroll") for (int m = 0; m < 4; ++m) _Pragma("unroll") for (int n = 0; n < 2; ++n) _Pragma("unroll") for (int k = 0; k < 2; ++k) \
    acc[ai][bj][m][n] = __builtin_amdgcn_mfma_f32_16x16x32_bf16(Bt[n][k], At[m][k], acc[ai][bj][m][n], 0, 0, 0); __builtin_amdgcn_s_setprio(0); } while (0)
#define PG8_WAIT_V(n) asm volatile("s_waitcnt vmcnt(" #n ")" ::: "memory")
#define PG8_WAIT_L(n) asm volatile("s_waitcnt lgkmcnt(" #n ")" ::: "memory")
#define PG8_BAR __builtin_amdgcn_s_barrier()
#define PG8_SCHED __builtin_amdgcn_sched_barrier(0)
  Unit cur, nxt; int ui = 0;
  if (!S.next(0, cur)) return;
  f32x4 acc[2][2][4][2];
#pragma unroll
  for (int a = 0; a < 2; ++a)
#pragma unroll
    for (int b = 0; b < 2; ++b)
#pragma unroll
      for (int m = 0; m < 4; ++m)
#pragma unroll
        for (int n = 0; n < 2; ++n) acc[a][b][m][n] = (f32x4){0.f, 0.f, 0.f, 0.f};
  bf16x8 At[4][2], B0[2][2], B1[2][2];
  const char* cA = (const char*)g.A + (size_t)cur.pm * tstep; const char* cB = (const char*)g.Bt + (size_t)cur.pn * tstep;
  PG8_STAGE(PG8_SB(0, 0), cB, voffB); PG8_STAGE(PG8_SA(0, 0), cA, voffA); PG8_STAGE(PG8_SB(0, 1), cB + hstep, voffB); PG8_STAGE(PG8_SA(0, 1), cA + hstep, voffA);
  if (wr == 1) PG8_BAR;
  PG8_WAIT_V(4); PG8_BAR;
  PG8_STAGE(PG8_SB(1, 0), cB + kstep, voffB); PG8_STAGE(PG8_SA(1, 0), cA + kstep, voffA); PG8_STAGE(PG8_SB(1, 1), cB + hstep + kstep, voffB);
  PG8_WAIT_V(6); PG8_BAR;
  for (;;) {
    const bool has_next = S.next(ui + 1, nxt);
    const char* nA = has_next ? (const char*)g.A + (size_t)nxt.pm * tstep : cA; const char* nB = has_next ? (const char*)g.Bt + (size_t)nxt.pn * tstep : cB;
#pragma unroll 1
    for (int t = 0; t < nt; t += 2) {
      const bool last = (t == nt - 2);
      const char* a1 = cA + (size_t)(t + 1) * kstep;
      const char* a2 = last ? nA : cA + (size_t)(t + 2) * kstep; const char* b2 = last ? nB : cB + (size_t)(t + 2) * kstep;
      const char* a3 = a2 + kstep; const char* b3 = b2 + kstep;
      PG8_LDB(B0, 0, 0); PG8_SCHED; PG8_LDA(At, 0, 0); PG8_STAGE(PG8_SA(1, 1), a1 + hstep, voffA);
      PG8_WAIT_L(8); PG8_BAR; PG8_WAIT_L(0); PG8_MMA(0, 0, At, B0); PG8_BAR; PG8_SCHED;
      PG8_LDB(B1, 0, 1); PG8_STAGE(PG8_SB(0, 0), b2, voffB);
      PG8_BAR; PG8_WAIT_L(0); PG8_MMA(0, 1, At, B1); PG8_BAR;
      PG8_LDA(At, 0, 1); PG8_STAGE(PG8_SA(0, 0), a2, voffA);
      PG8_BAR; PG8_WAIT_L(0); PG8_MMA(1, 0, At, B0); PG8_BAR; PG8_SCHED;
      PG8_STAGE(PG8_SB(0, 1), b2 + hstep, voffB);
      PG8_WAIT_V(6); PG8_BAR; PG8_MMA(1, 1, At, B1); PG8_BAR;
      PG8_LDB(B0, 1, 0); PG8_SCHED; PG8_LDA(At, 1, 0); PG8_STAGE(PG8_SA(0, 1), a2 + hstep, voffA);
      PG8_WAIT_L(8); PG8_BAR; PG8_WAIT_L(0); PG8_MMA(0, 0, At, B0); PG8_BAR; PG8_SCHED;
      PG8_LDB(B1, 1, 1); PG8_STAGE(PG8_SB(1, 0), b3, voffB);
      PG8_BAR; PG8_WAIT_L(0); PG8_MMA(0, 1, At, B1); PG8_BAR;
      PG8_LDA(At, 1, 1); PG8_STAGE(PG8_SA(1, 0), a3, voffA);
      PG8_BAR; PG8_WAIT_L(0); PG8_MMA(1, 0, At, B0); PG8_BAR; PG8_SCHED;
      PG8_STAGE(PG8_SB(1, 1), b3 + hstep, voffB);
      PG8_WAIT_V(6); PG8_BAR; PG8_MMA(1, 1, At, B1); PG8_BAR;
    }
    E(acc, cur, wr, wc, fr, fq);
    if (!has_next) break;
#pragma unroll
    for (int a = 0; a < 2; ++a)
#pragma unroll
      for (int b = 0; b < 2; ++b)
#pragma unroll
        for (int m = 0; m < 4; ++m)
#pragma unroll
          for (int n = 0; n < 2; ++n) acc[a][b][m][n] = (f32x4){0.f, 0.f, 0.f, 0.f};
    cur = nxt; cA = nA; cB = nB; ++ui;
  }
  PG8_WAIT_V(0);
  if (wr == 0) PG8_BAR;
  PG8_BAR;
#undef PG8_SA
#undef PG8_SB
#undef PG8_STAGE
#undef PG8_LDA
#undef PG8_LDB
#undef PG8_MMA
#undef PG8_WAIT_V
#undef PG8_WAIT_L
#undef PG8_BAR
#undef PG8_SCHED
}

struct EpiBf16 {
  static constexpr bool PERM = true;
  bf16_t* O; int ldc; int ncols;
  __device__ __forceinline__ void operator()(const f32x4 (&acc)[2][2][4][2], const Unit& u, int wr, int wc, int fr, int fq) const {
    const int row0 = u.pm * BM + wr * 64 + fr, col0 = u.pn * BM + wc * 32 + 8 * fq;
#pragma unroll
    for (int ai = 0; ai < 2; ++ai)
#pragma unroll
      for (int m = 0; m < 4; ++m) {
        bf16_t* rowp = O + (size_t)(row0 + ai * HALF + m * 16) * ldc + col0;
#pragma unroll
        for (int bj = 0; bj < 2; ++bj) {
          if (col0 + bj * HALF < ncols) {
            const f32x4 v0 = acc[ai][bj][m][0], v1 = acc[ai][bj][m][1];
            u32x4 w; w.x = cvt_pk_bf16(v0[0], v0[1]); w.y = cvt_pk_bf16(v0[2], v0[3]); w.z = cvt_pk_bf16(v1[0], v1[1]); w.w = cvt_pk_bf16(v1[2], v1[3]);
            *(u32x4*)(rowp + bj * HALF) = w;
          }
        }
      }
  }
};
struct EpiResid {
  static constexpr bool PERM = false;
  float* xres; const float* modl; int gate_off;
  __device__ __forceinline__ void operator()(const f32x4 (&acc)[2][2][4][2], const Unit& u, int wr, int wc, int fr, int fq) const {
    const int row0 = u.pm * BM + wr * 64 + fr, col0 = u.pn * BM + wc * 32 + 4 * fq;
#pragma unroll
    for (int ai = 0; ai < 2; ++ai)
#pragma unroll
      for (int m = 0; m < 4; ++m) {
        const int row = row0 + ai * HALF + m * 16;
        float* rowp = xres + (size_t)row * 1024 + col0;
        const float* md = modl + (size_t)tok_batch(row) * NMOD + gate_off + col0;
#pragma unroll
        for (int bj = 0; bj < 2; ++bj)
#pragma unroll
          for (int n = 0; n < 2; ++n) {
            const f32x4 g = *(const f32x4*)(md + bj * HALF + n * 16);
            f32x4 x = *(const f32x4*)(rowp + bj * HALF + n * 16);
            x += g * acc[ai][bj][m][n];
            *(f32x4*)(rowp + bj * HALF + n * 16) = x;
          }
      }
  }
};
struct EpiGlu {
  static constexpr bool PERM = true;
  bf16_t* mix;
  __device__ __forceinline__ void operator()(const f32x4 (&acc)[2][2][4][2], const Unit& u, int wr, int wc, int fr, int fq) const {
    const int row0 = u.pm * BM + wr * 64 + fr, col0 = 256 + u.pn * HALF + wc * 32 + 8 * fq;
#pragma unroll
    for (int ai = 0; ai < 2; ++ai)
#pragma unroll
      for (int m = 0; m < 4; ++m) {
        float v[8];
#pragma unroll
        for (int n = 0; n < 2; ++n)
#pragma unroll
          for (int j = 0; j < 4; ++j) v[n * 4 + j] = acc[ai][0][m][n][j] * sigmoid_f(acc[ai][1][m][n][j]);
        u32x4 w; w.x = cvt_pk_bf16(v[0], v[1]); w.y = cvt_pk_bf16(v[2], v[3]); w.z = cvt_pk_bf16(v[4], v[5]); w.w = cvt_pk_bf16(v[6], v[7]);
        *(u32x4*)(mix + (size_t)(row0 + ai * HALF + m * 16) * 1024 + col0) = w;
        __builtin_amdgcn_sched_barrier(0);
      }
  }
};
}

#define VNT_STRIDE 136
__device__ __forceinline__ void phase_sgu(const Params& p, int layer, int nchunks, int bid, int nblk, unsigned char* smem) {
  bf16_t* vnT = (bf16_t*)smem;
  const int tid = opaque_tid(); const int lane = tid & 63, wid = tid >> 6;
  const int fr = lane & 15, fq = lane >> 4;
  for (int item = bid; item < nchunks * 4; item += nblk) {
    const int ch = item >> 2, h = item & 3;
    const int tok0 = ch * 128;
    {
      const int s = tid >> 2, q = tid & 3;
      const bf16_t* vrow = p.cols + (size_t)(tok0 + s) * INW + C_SGU_V + h * 64 + q * 16;
      const uint4 r0 = *(const uint4*)vrow, r1 = *(const uint4*)(vrow + 8);
      float gv[16];
      gv[0] = bflo(r0.x); gv[1] = bfhi(r0.x); gv[2] = bflo(r0.y); gv[3] = bfhi(r0.y); gv[4] = bflo(r0.z); gv[5] = bfhi(r0.z); gv[6] = bflo(r0.w); gv[7] = bfhi(r0.w);
      gv[8] = bflo(r1.x); gv[9] = bfhi(r1.x); gv[10] = bflo(r1.y); gv[11] = bfhi(r1.y); gv[12] = bflo(r1.z); gv[13] = bfhi(r1.z); gv[14] = bflo(r1.w); gv[15] = bfhi(r1.w);
      float ss = 0.f;
#pragma unroll
      for (int d = 0; d < 16; ++d) { gv[d] = gelu_f(gv[d]); ss += gv[d] * gv[d]; }
      ss += __shfl_xor(ss, 1);
      ss += __shfl_xor(ss, 2);
      const float rstd = rsqrtf(ss * (1.f / 64.f) + EPSV);
#pragma unroll
      for (int d = 0; d < 16; ++d) vnT[(q * 16 + d) * VNT_STRIDE + s] = f2bf(gv[d] * rstd);
    }
    __syncthreads();
    {
      const bf16_t* wrow = p.sgu_wb + (((size_t)layer * 4 + h) * 128 + wid * 16 + fr) * 128 + fq * 8;
      f32x4 acc[4];
#pragma unroll
      for (int n = 0; n < 4; ++n) acc[n] = (f32x4){0.f, 0.f, 0.f, 0.f};
#pragma unroll
      for (int ks = 0; ks < 4; ++ks) {
        const bf16x8 a = *(const bf16x8*)(wrow + ks * 32);
#pragma unroll
        for (int n = 0; n < 4; ++n) {
          const bf16x8 b = *(const bf16x8*)(vnT + (n * 16 + fr) * VNT_STRIDE + ks * 32 + fq * 8);
          acc[n] = __builtin_amdgcn_mfma_f32_16x16x32_bf16(a, b, acc[n], 0, 0, 0);
        }
      }
#pragma unroll
      for (int j = 0; j < 4; ++j) {
        const int t = wid * 16 + fq * 4 + j;
        const float bs = p.sgu_b[((size_t)layer * 4 + h) * 128 + t];
        const bf16_t* urow = p.cols + (size_t)(tok0 + t) * INW + C_SGU_U + h * 64;
        bf16_t* orow = p.mix + (size_t)(tok0 + t) * 1024 + h * 64;
#pragma unroll
        for (int n = 0; n < 4; ++n) orow[n * 16 + fr] = f2bf(gelu_f(bf2f(urow[n * 16 + fr])) * (acc[n][j] + bs));
      }
    }
    __syncthreads();
  }
}

__device__ __forceinline__ void phase_s5a(const Params& p, int layer, int bid, int nblk, unsigned char* smem) {
  const int tid = opaque_tid(); const int lane = tid & 63, wid = tid >> 6, fr = lane & 15, fq = lane >> 4;
  const int ntask = 2 * 16 * 17 * 2;
  for (int task = wid * nblk + bid; task < ntask; task += nblk * NW) {
    const int nh = task & 1, t2 = task >> 1;
    const int dir = t2 / 272, rem = t2 % 272, g = rem / 17, mt = rem % 17;
    const bf16_t* tab = p.s5M1 + (size_t)((layer * 2 + dir) * 16 + g) * 131072 + (size_t)(nh * 64 + fr) * 1024 + fq * 8;
    const int scr = mt * 16 + fr;
    const bf16_t* ub = p.cols + C_S5 + g * 16 + (fq & 1) * 8;
    f32x4 acc[4];
#pragma unroll
    for (int n = 0; n < 4; ++n) acc[n] = (f32x4){0.f, 0.f, 0.f, 0.f};
#pragma unroll 8
    for (int ks = 0; ks < 32; ++ks) {
      const int tau = 2 * ks + (fq >> 1);
      const int i = dir ? 63 - tau : tau;
      const bf16x8 a = *(const bf16x8*)(ub + (size_t)s5_tok(scr, i) * INW);
#pragma unroll
      for (int n = 0; n < 4; ++n) {
        const bf16x8 b = *(const bf16x8*)(tab + (size_t)n * 16 * 1024 + ks * 32);
        acc[n] = __builtin_amdgcn_mfma_f32_16x16x32_bf16(a, b, acc[n], 0, 0, 0);
      }
    }
#pragma unroll
    for (int n = 0; n < 4; ++n)
#pragma unroll
      for (int j = 0; j < 4; ++j) p.s5S[(((size_t)dir * NSC + mt * 16 + fq * 4 + j) * 16 + g) * 128 + nh * 64 + n * 16 + fr] = acc[n][j];
  }
}

__device__ __forceinline__ int scan_sc(int s, int b, int dir) {
  return s < 4 ? 256 + b * 4 + (dir ? 3 - s : s) : b * 64 + (dir ? 63 - (s - 4) : (s - 4));
}
__device__ __forceinline__ void phase_scan(const Params& p, int layer, int bid, int nblk) {
  const int tid = opaque_tid();
  for (int item = bid; item < 16 + 256; item += nblk) {
    if (item < 16) {
      const int id = item * NT + tid;
      const int pp = id & 63, g = (id >> 6) & 15, b = (id >> 10) & 3, dir = id >> 12;
      const int pid = ((layer * 2 + dir) * 16 + g) * 64 + pp;
      const float ar = p.s5a64[pid * 2], ai = p.s5a64[pid * 2 + 1];
      float hr = 0.f, hi = 0.f;
      for (int s0 = 0; s0 < 68; s0 += 17) {
        float sr[17], si[17];
#pragma unroll
        for (int k = 0; k < 17; ++k) {
          const size_t o = (((size_t)dir * NSC + scan_sc(s0 + k, b, dir)) * 16 + g) * 128 + pp;
          sr[k] = p.s5S[o]; si[k] = p.s5S[o + 64];
        }
#pragma unroll
        for (int k = 0; k < 17; ++k) {
          const size_t o = (((size_t)dir * NSC + scan_sc(s0 + k, b, dir)) * 16 + g) * 128 + pp;
          p.s5H[o] = hr; p.s5H[o + 64] = hi;
          const float nr = ar * hr - ai * hi + sr[k];
          const float ni = ar * hi + ai * hr + si[k];
          hr = nr; hi = ni;
        }
      }
    } else {
      const int id = (item - 16) * NT + tid;
      const int e = id & 2047, h = (id >> 11) & 7, b = (id >> 14) & 3, dir = id >> 16;
      const int dk = e & 31;
      float S = 0.f;
      for (int s0 = 0; s0 < 68; s0 += 17) {
        float kv[17], dc[17];
#pragma unroll
        for (int k = 0; k < 17; ++k) {
          const size_t o = (((size_t)dir * NSC + scan_sc(s0 + k, b, dir)) * 8 + h);
          kv[k] = p.gkv[o * 2048 + e]; dc[k] = p.gdec[o * 32 + dk];
        }
#pragma unroll
        for (int k = 0; k < 17; ++k) {
          const size_t o = (((size_t)dir * NSC + scan_sc(s0 + k, b, dir)) * 8 + h);
          p.gkv[o * 2048 + e] = S;
          S = dc[k] * S + kv[k];
        }
      }
    }
  }
}

__device__ __forceinline__ bf16x8 s5_kfrag(const bf16_t* kb, int delta, int sh) {
  const int d = delta - sh;
  bf16x8 r = *(const bf16x8*)(kb + (size_t)(d < 0 ? 0 : d) * 256);
  if (d < 0) r = (bf16x8){0, 0, 0, 0, 0, 0, 0, 0};
  return r;
}
#define S5_UCH 1032
typedef const __attribute__((address_space(3))) bf16_t* lds_bf16_cp;
template <int DIR, bool DIAG>
__device__ __forceinline__ void s5_group8(f32x4 (&acc)[16], bf16x8 (&W)[16], const bf16_t* ul  , const bf16_t* kl  , int ks0, int E, int sh) {
  const bf16x8 zero8 = (bf16x8){0, 0, 0, 0, 0, 0, 0, 0};
#pragma unroll
  for (int j = 0; j < 8; ++j) {
    const int sigma = 2 * (ks0 + j) + sh;
    const bf16x8 a = *(const bf16x8*)(ul + (DIR ? 63 - sigma : sigma) * 16);
    bf16x8 n0 = zero8, n1 = zero8;
    if (!DIAG) {
      if (j + 1 < 8) { n0 = *(const bf16x8*)(kl + (E - 2 * (j + 1) - sh) * 256); n1 = *(const bf16x8*)(kl + (E - 2 * (j + 1) + 1 - sh) * 256); }
      else { n0 = s5_kfrag(kl, E - 16, sh); n1 = s5_kfrag(kl, E - 15, sh); }
    }
#pragma unroll
    for (int i = 0; i < 16; ++i) {
      if (!(DIAG && i < 2 * j)) {
        const int sl = DIR ? 15 - i : i;
        acc[sl] = __builtin_amdgcn_mfma_f32_16x16x32_bf16(a, W[(i - 2 * j) & 15], acc[sl], 0, 0, 0);
      }
    }
    if (!DIAG) { W[(16 - 2 * (j + 1)) & 15] = n0; W[(17 - 2 * (j + 1)) & 15] = n1; }
  }
}
template <int DIR>
__device__ __forceinline__ void s5_dir(f32x4 (&acc)[16], const Params& p, int layer, int g, int scr, int qd, int fr, int fq, const bf16_t* ul, const bf16_t* kl) {
  const int sh = fq >> 1;
  {
    bf16x8 W[16];
#pragma unroll
    for (int i = 0; i < 16; ++i) W[i] = s5_kfrag(kl, 16 * qd + i, sh);
    for (int c = 0; c < qd; ++c) s5_group8<DIR, false>(acc, W, ul, kl, 8 * c, 16 * (qd - c), sh);
    s5_group8<DIR, true>(acc, W, ul, kl, 8 * qd, 0, sh);
  }
  const size_t tb = (size_t)((layer * 2 + DIR) * 16 + g);
  const float* hin = p.s5H + (((size_t)DIR * NSC + scr) * 16 + g) * 128 + fq * 8;
  const bf16_t* n2 = p.s5N2 + tb * 131072 + (size_t)(16 * qd * 16 + fr) * 128 + fq * 8;
  bf16x8 ah[4];
#pragma unroll
  for (int ks = 0; ks < 4; ++ks) {
    const f32x4 h0 = *(const f32x4*)(hin + ks * 32), h1 = *(const f32x4*)(hin + ks * 32 + 4);
    const float h8[8] = {h0[0], h0[1], h0[2], h0[3], h1[0], h1[1], h1[2], h1[3]};
    ah[ks] = pack_bf16x8(h8);
  }
#pragma unroll
  for (int ks = 0; ks < 4; ++ks) {
    bf16x8 b[16];
#pragma unroll
    for (int i = 0; i < 16; ++i) b[i] = *(const bf16x8*)(n2 + (size_t)i * 16 * 128 + ks * 32);
#pragma unroll
    for (int i = 0; i < 16; ++i) {
      const int sl = DIR ? 15 - i : i;
      acc[sl] = __builtin_amdgcn_mfma_f32_16x16x32_bf16(ah[ks], b[i], acc[sl], 0, 0, 0);
    }
    __builtin_amdgcn_sched_barrier(0);
  }
}
__device__ __forceinline__ void phase_s5c(const Params& p, int layer, int nsc, int bid, int nblk, unsigned char* smem) {
  const int tid = opaque_tid(); const int lane = tid & 63, wid = tid >> 6;
  bf16_t* Kl = (bf16_t*)smem;
  bf16_t* Ul = Kl + 2 * 16384;
  const int nmt = nsc / 16, npair = (nmt + 1) / 2;
  const int ntask = 16 * npair;
  for (int task = bid; task < ntask; task += nblk) {
    const int g = task / npair, mt0 = (task % npair) * 2;
    __syncthreads();
    int tid_o = tid; asm volatile("" : "+v"(tid_o));
#pragma unroll
    for (int it = 0; it < 8; ++it) {
      const int e = it * NT + tid_o;
      const int dir = e >> 11, off = (e & 2047) * 8;
      *(uint4*)(Kl + dir * 16384 + off) = *(const uint4*)(p.s5K + (size_t)((layer * 2 + dir) * 16 + g) * 16384 + off);
    }
#pragma unroll
    for (int it = 0; it < 8; ++it) {
      const int e = it * NT + tid_o;
      const int hf = e & 1, tk = (e >> 1) & 63, chk = (e >> 7) & 15, tl = e >> 11;
      const int mt = mt0 + tl;
      uint4 v = make_uint4(0u, 0u, 0u, 0u);
      if (mt < nmt) v = *(const uint4*)(p.cols + (size_t)s5_tok(mt * 16 + chk, tk) * INW + C_S5 + g * 16 + hf * 8);
      *(uint4*)(Ul + (tl * 16 + chk) * S5_UCH + tk * 16 + hf * 8) = v;
    }
    __syncthreads();
    int lane_o = lane; asm volatile("" : "+v"(lane_o));
    const int fr = lane_o & 15, fq = lane_o >> 4;
    const int tl = wid >> 2, q = wid & 3, mt = mt0 + tl;
    if (mt < nmt) {
      const int scr = mt * 16 + fr;
      const bf16_t* ul = Ul + (tl * 16 + fr) * S5_UCH + (fq & 1) * 8;
      f32x4 acc[16];
#pragma unroll
      for (int i = 0; i < 16; ++i) acc[i] = (f32x4){0.f, 0.f, 0.f, 0.f};
      s5_dir<0>(acc, p, layer, g, scr, q, fr, fq, ul, Kl + fr * 16 + (fq & 1) * 8);
      s5_dir<1>(acc, p, layer, g, scr, 3 - q, fr, fq, ul, Kl + 16384 + fr * 16 + (fq & 1) * 8);
      const int ch = g * 16 + fr;
      const float dsk = p.s5_d[layer * 256 + ch];
#pragma unroll
      for (int j = 0; j < 4; ++j) {
        const int chk = fq * 4 + j;
        const size_t tok0 = (size_t)s5_tok(mt * 16 + chk, 16 * q);
        const bf16_t* up = Ul + (tl * 16 + chk) * S5_UCH + (16 * q) * 16 + fr;
        bf16_t* yp = p.yg + tok0 * 256 + ch;
#pragma unroll
        for (int i = 0; i < 16; ++i) {
          const float v = acc[i][j] + dsk * bf2f(up[i * 16]);
          yp[(size_t)i * 256] = f2bf(gelu_f(v));
        }
        __builtin_amdgcn_sched_barrier(0);
      }
    }
  }
  __syncthreads();
}

#define GL_VT_STRIDE 72
#define GL_LB_STRIDE 36
#define GL_HALF_BYTES (64 * 72 * 2 + 64 * 36 * 4 + 64 * 72 * 2)
__device__ __forceinline__ void unpack8(const uint4& r, float* v) {
  v[0] = bflo(r.x); v[1] = bfhi(r.x); v[2] = bflo(r.y); v[3] = bfhi(r.y); v[4] = bflo(r.z); v[5] = bfhi(r.z); v[6] = bflo(r.w); v[7] = bfhi(r.w);
}
__device__ __forceinline__ void gla_store_vT(const uint4& r0, const uint4& r1, bf16_t* vT, int ltid) {
  const int i = ltid & 63, part = ltid >> 6;
  const unsigned w[8] = {r0.x, r0.y, r0.z, r0.w, r1.x, r1.y, r1.z, r1.w};
#pragma unroll
  for (int e = 0; e < 8; ++e) {
    vT[(part * 16 + 2 * e) * GL_VT_STRIDE + i] = (bf16_t)(w[e] & 0xffffu);
    vT[(part * 16 + 2 * e + 1) * GL_VT_STRIDE + i] = (bf16_t)(w[e] >> 16);
  }
}
__device__ __forceinline__ void gla_logdecay(const Params& p, int layer, int sc, int h, int dir, const uint4& z0, const uint4& z1, float* lb, int ltid, float* glb) {
  const int lane = ltid & 63;
  const int wu = __builtin_amdgcn_readfirstlane(ltid >> 6);
  float z[16];
  unpack8(z0, z); unpack8(z1, z + 8);
  const float* wg = p.gla_wg + ((size_t)(layer * 2 + dir) * 16) * 256 + h * 32 + wu * 8;
  const float* bg = p.gla_bg + (layer * 2 + dir) * 256 + h * 32 + wu * 8;
  float la[8];
#pragma unroll
  for (int c = 0; c < 8; ++c) la[c] = bg[c];
#pragma unroll
  for (int r = 0; r < 16; ++r) {
#pragma unroll
    for (int c = 0; c < 8; ++c) la[c] += z[r] * wg[r * 256 + c];
  }
#pragma unroll
  for (int c = 0; c < 8; ++c) la[c] = (fminf(la[c], 0.f) - __logf(1.f + __expf(-fabsf(la[c])))) * (1.f / 16.f);
#pragma unroll
  for (int c = 0; c < 8; ++c) {
    float v = la[c];
    if (dir == 0) {
      v += __builtin_bit_cast(float, __builtin_amdgcn_update_dpp(0, __builtin_bit_cast(int, v), 0x111, 0xf, 0xf, true));
      v += __builtin_bit_cast(float, __builtin_amdgcn_update_dpp(0, __builtin_bit_cast(int, v), 0x112, 0xf, 0xf, true));
      v += __builtin_bit_cast(float, __builtin_amdgcn_update_dpp(0, __builtin_bit_cast(int, v), 0x114, 0xf, 0xf, true));
      v += __builtin_bit_cast(float, __builtin_amdgcn_update_dpp(0, __builtin_bit_cast(int, v), 0x118, 0xf, 0xf, true));
      const float t0 = __builtin_bit_cast(float, __builtin_amdgcn_readlane(__builtin_bit_cast(int, v), 15));
      const float t1 = __builtin_bit_cast(float, __builtin_amdgcn_readlane(__builtin_bit_cast(int, v), 31));
      const float t2 = __builtin_bit_cast(float, __builtin_amdgcn_readlane(__builtin_bit_cast(int, v), 47));
      const int row = lane >> 4;
      v += row == 0 ? 0.f : (row == 1 ? t0 : (row == 2 ? t0 + t1 : (t0 + t1) + t2));
    } else {
      v += __builtin_bit_cast(float, __builtin_amdgcn_update_dpp(0, __builtin_bit_cast(int, v), 0x101, 0xf, 0xf, true));
      v += __builtin_bit_cast(float, __builtin_amdgcn_update_dpp(0, __builtin_bit_cast(int, v), 0x102, 0xf, 0xf, true));
      v += __builtin_bit_cast(float, __builtin_amdgcn_update_dpp(0, __builtin_bit_cast(int, v), 0x104, 0xf, 0xf, true));
      v += __builtin_bit_cast(float, __builtin_amdgcn_update_dpp(0, __builtin_bit_cast(int, v), 0x108, 0xf, 0xf, true));
      const float t1 = __builtin_bit_cast(float, __builtin_amdgcn_readlane(__builtin_bit_cast(int, v), 16));
      const float t2 = __builtin_bit_cast(float, __builtin_amdgcn_readlane(__builtin_bit_cast(int, v), 32));
      const float t3 = __builtin_bit_cast(float, __builtin_amdgcn_readlane(__builtin_bit_cast(int, v), 48));
      const int row = lane >> 4;
      v += row == 3 ? 0.f : (row == 2 ? t3 : (row == 1 ? t3 + t2 : (t3 + t2) + t1));
    }
    la[c] = v;
  }
  *(f32x4*)(lb + lane * GL_LB_STRIDE + wu * 8) = (f32x4){la[0], la[1], la[2], la[3]};
  *(f32x4*)(lb + lane * GL_LB_STRIDE + wu * 8 + 4) = (f32x4){la[4], la[5], la[6], la[7]};
  float* gp = glb + ((size_t)dir * TT + gla_tok(sc, lane)) * 256 + h * 32 + wu * 8;
  *(f32x4*)gp = (f32x4){la[0], la[1], la[2], la[3]};
  *(f32x4*)(gp + 4) = (f32x4){la[4], la[5], la[6], la[7]};
}

struct GlaAPre { uint4 v0, v1, za0, za1, zb0, zb1, k; };
__device__ __forceinline__ GlaAPre glaa_prefetch(const Params& p, int item, int ltid) {
  const int sc = item >> 3, h = item & 7;
  const int i = ltid & 63, part = ltid >> 6;
  const bf16_t* row = p.cols + (size_t)gla_tok(sc, i) * INW;
  GlaAPre r;
  r.v0 = *(const uint4*)(row + C_GV + h * 64 + part * 16); r.v1 = *(const uint4*)(row + C_GV + h * 64 + part * 16 + 8);
  r.za0 = *(const uint4*)(row + C_ZF); r.za1 = *(const uint4*)(row + C_ZF + 8);
  r.zb0 = *(const uint4*)(row + C_ZF + 16); r.zb1 = *(const uint4*)(row + C_ZF + 24);
  r.k = *(const uint4*)(row + C_GK + h * 32 + part * 8);
  return r;
}
__device__ __forceinline__ void phase_glaa(const Params& p, int layer, int bid, int nblk, unsigned char* smem) {
  const int tid = opaque_tid(); const int half = __builtin_amdgcn_readfirstlane(tid >> 8), ltid = tid & 255;
  const int lane = tid & 63, w = ltid >> 6, fr = lane & 15, fq = lane >> 4;
  bf16_t* vT = (bf16_t*)(smem + half * GL_HALF_BYTES);
  float* lb = (float*)(vT + 64 * GL_VT_STRIDE);
  bf16_t* kT = (bf16_t*)(lb + 64 * GL_LB_STRIDE);
  const int nit = NSC * 8 / 2;
  if (bid >= nit) return;
  GlaAPre cur = glaa_prefetch(p, bid * 2 + half, ltid);
  for (int it = bid; it < nit; it += nblk) {
    const int item = it * 2 + half;
    const int sc = item >> 3, h = item & 7;
    const int itn = it + nblk < nit ? it + nblk : it;
    const GlaAPre nxt = glaa_prefetch(p, itn * 2 + half, ltid);
    gla_store_vT(cur.v0, cur.v1, vT, ltid);
#pragma unroll
    for (int dir = 0; dir < 2; ++dir) {
      gla_logdecay(p, layer, sc, h, dir, dir ? cur.zb0 : cur.za0, dir ? cur.zb1 : cur.za1, lb, ltid, p.glb);
      __syncthreads();
      const int ilast = dir ? 0 : 63;
      {
        const int i = ltid & 63, part = ltid >> 6;
        float kv8[8];
        unpack8(cur.k, kv8);
#pragma unroll
        for (int c = 0; c < 8; ++c) {
          const int dk = part * 8 + c;
          kT[dk * GL_VT_STRIDE + i] = f2bf(kv8[c] * __expf(lb[ilast * GL_LB_STRIDE + dk] - lb[i * GL_LB_STRIDE + dk]));
        }
      }
      const size_t o = (((size_t)dir * NSC + sc) * 8 + h);
      if (ltid < 32) p.gdec[o * 32 + ltid] = __expf(lb[ilast * GL_LB_STRIDE + ltid]);
      __syncthreads();
      {
        f32x4 acc[2];
        acc[0] = (f32x4){0.f, 0.f, 0.f, 0.f}; acc[1] = acc[0];
#pragma unroll
        for (int ks = 0; ks < 2; ++ks) {
          const bf16x8 b = *(const bf16x8*)(vT + (w * 16 + fr) * GL_VT_STRIDE + ks * 32 + fq * 8);
#pragma unroll
          for (int m = 0; m < 2; ++m) {
            const bf16x8 a = *(const bf16x8*)(kT + (m * 16 + fr) * GL_VT_STRIDE + ks * 32 + fq * 8);
            acc[m] = __builtin_amdgcn_mfma_f32_16x16x32_bf16(a, b, acc[m], 0, 0, 0);
          }
        }
#pragma unroll
        for (int m = 0; m < 2; ++m) *(f32x4*)(p.gkv + o * 2048 + (size_t)(w * 16 + fr) * 32 + m * 16 + fq * 4) = acc[m];
      }
      __syncthreads();
    }
    cur = nxt;
  }
}

__device__ __forceinline__ void gl_load8(const float* g, float* v) {
  const f32x4 a = *(const f32x4*)g, b = *(const f32x4*)(g + 4);
  v[0] = a[0]; v[1] = a[1]; v[2] = a[2]; v[3] = a[3]; v[4] = b[0]; v[5] = b[1]; v[6] = b[2]; v[7] = b[3];
}
#define GLC_HALF_BYTES (64 * 72 * 2 + 64 * 72 * 2 + 2 * 64 * 36 * 4 + 2 * 64 * 36 * 4)
struct GlaCPre { uint4 v0, v1, q, k[4], lb[2][2], st[2][2]; };
__device__ __forceinline__ GlaCPre glac_prefetch(const Params& p, int item, int ltid, int w, int fr, int fq) {
  const int sc = item >> 3, h = item & 7;
  GlaCPre r;
  {
    const int i = ltid & 63, part = ltid >> 6;
    const bf16_t* row = p.cols + (size_t)gla_tok(sc, i) * INW + C_GV + h * 64 + part * 16;
    r.v0 = *(const uint4*)row; r.v1 = *(const uint4*)(row + 8);
  }
  r.q = *(const uint4*)(p.cols + (size_t)gla_tok(sc, w * 16 + fr) * INW + C_GQ + h * 32 + fq * 8);
#pragma unroll
  for (int n = 0; n < 4; ++n) r.k[n] = *(const uint4*)(p.cols + (size_t)gla_tok(sc, n * 16 + fr) * INW + C_GK + h * 32 + fq * 8);
  {
    const int i = ltid >> 2, piece = ltid & 3;
#pragma unroll
    for (int dir = 0; dir < 2; ++dir) {
      const float* g = p.glb + ((size_t)dir * TT + gla_tok(sc, i)) * 256 + h * 32 + piece * 8;
      r.lb[dir][0] = *(const uint4*)g; r.lb[dir][1] = *(const uint4*)(g + 4);
      const float* s = p.gkv + (((size_t)dir * NSC + sc) * 8 + h) * 2048 + i * 32 + piece * 8;
      r.st[dir][0] = *(const uint4*)s; r.st[dir][1] = *(const uint4*)(s + 4);
    }
  }
  return r;
}
#define GLC_BONUS 4
__device__ __forceinline__ void phase_glac(const Params& p, int layer, int nsc, int nbusy, int bid, int nblk, unsigned char* smem) {
  const int tid = opaque_tid(); const int half = __builtin_amdgcn_readfirstlane(tid >> 8), ltid = tid & 255;
  const int lane = tid & 63, w = ltid >> 6, fr = lane & 15, fq = lane >> 4;
  bf16_t* vT = (bf16_t*)(smem + half * GLC_HALF_BYTES);
  bf16_t* Pw = vT + 64 * GL_VT_STRIDE + w * 16 * GL_VT_STRIDE;
  float* lbT = (float*)(vT + 2 * 64 * GL_VT_STRIDE);
  float* ST = lbT + 2 * 64 * GL_LB_STRIDE;
  const int nit = nsc * 4;
  const int nfree = nblk - nbusy;
  const int nbonus = (nbusy > 0 && nfree > 0 && nfree * GLC_BONUS < nit) ? nfree * GLC_BONUS : 0;
  auto itof = [&](int k) -> int {
    if (nbonus == 0) return bid + k * nblk;
    if (bid >= nbusy) return k < GLC_BONUS ? k * nfree + (bid - nbusy) : nbonus + bid + (k - GLC_BONUS) * nblk;
    return nbonus + bid + k * nblk;
  };
  if (itof(0) >= nit) return;
  GlaCPre cur = glac_prefetch(p, itof(0) * 2 + half, ltid, w, fr, fq);
  for (int kk = 0; itof(kk) < nit; ++kk) {
    const int it = itof(kk);
    const int item = it * 2 + half;
    const int sc = item >> 3, h = item & 7;
    __syncthreads();
    gla_store_vT(cur.v0, cur.v1, vT, ltid);
    {
      const int i = ltid >> 2, piece = ltid & 3;
#pragma unroll
      for (int dir = 0; dir < 2; ++dir) {
        *(uint4*)(lbT + (dir * 64 + i) * GL_LB_STRIDE + piece * 8) = cur.lb[dir][0]; *(uint4*)(lbT + (dir * 64 + i) * GL_LB_STRIDE + piece * 8 + 4) = cur.lb[dir][1];
        *(uint4*)(ST + (dir * 64 + i) * GL_LB_STRIDE + piece * 8) = cur.st[dir][0]; *(uint4*)(ST + (dir * 64 + i) * GL_LB_STRIDE + piece * 8 + 4) = cur.st[dir][1];
      }
    }
    const int itn = itof(kk + 1) < nit ? itof(kk + 1) : it;
    const GlaCPre nxt = glac_prefetch(p, itn * 2 + half, ltid, w, fr, fq);
    __syncthreads();
    f32x4 o[4];
#pragma unroll
    for (int n = 0; n < 4; ++n) o[n] = (f32x4){0.f, 0.f, 0.f, 0.f};
#pragma unroll
    for (int dir = 0; dir < 2; ++dir) {
      const float* lbd = lbT + dir * 64 * GL_LB_STRIDE + fq * 8;
      float bref[8], bt[8];
      gl_load8(lbd + (dir ? 31 : 32) * GL_LB_STRIDE, bref);
      gl_load8(lbd + (w * 16 + fr) * GL_LB_STRIDE, bt);
      bf16x8 aqs, aqe;
      {
        float q8[8], s8[8], e8[8];
        unpack8(cur.q, q8);
#pragma unroll
        for (int c = 0; c < 8; ++c) {
          const float qx = q8[c] * 0.17677669529663687f;
          s8[c] = qx * __expf(bt[c] - bref[c]);
          e8[c] = qx * __expf(bt[c]);
        }
        aqs = pack_bf16x8(s8); aqe = pack_bf16x8(e8);
      }
#pragma unroll
      for (int n = 0; n < 4; ++n) {
        const int s = n * 16 + fr;
        float k8[8], bs[8];
        unpack8(cur.k[n], k8);
        gl_load8(lbd + s * GL_LB_STRIDE, bs);
#pragma unroll
        for (int c = 0; c < 8; ++c) k8[c] *= __expf(bref[c] - bs[c]);
        const bf16x8 bks = pack_bf16x8(k8);
        const f32x4 sa = __builtin_amdgcn_mfma_f32_16x16x32_bf16(aqs, bks, (f32x4){0.f, 0.f, 0.f, 0.f}, 0, 0, 0);
#pragma unroll
        for (int j = 0; j < 4; ++j) {
          const int t = w * 16 + fq * 4 + j;
          const bool ok = dir ? (s >= t) : (s <= t);
          Pw[(fq * 4 + j) * GL_VT_STRIDE + s] = f2bf(ok ? sa[j] : 0.f);
        }
      }
      __builtin_amdgcn_wave_barrier();
#pragma unroll
      for (int ks = 0; ks < 2; ++ks) {
        const bf16x8 ap = *(const bf16x8*)(Pw + fr * GL_VT_STRIDE + ks * 32 + fq * 8);
#pragma unroll
        for (int n = 0; n < 4; ++n) {
          const bf16x8 bv = *(const bf16x8*)(vT + (n * 16 + fr) * GL_VT_STRIDE + ks * 32 + fq * 8);
          o[n] = __builtin_amdgcn_mfma_f32_16x16x32_bf16(ap, bv, o[n], 0, 0, 0);
        }
      }
      __builtin_amdgcn_wave_barrier();
      {
        const float* Sg = ST + dir * 64 * GL_LB_STRIDE + fq * 8;
#pragma unroll
        for (int n = 0; n < 4; ++n) {
          float s8[8];
          gl_load8(Sg + (n * 16 + fr) * GL_LB_STRIDE, s8);
          const bf16x8 bS = pack_bf16x8(s8);
          o[n] = __builtin_amdgcn_mfma_f32_16x16x32_bf16(aqe, bS, o[n], 0, 0, 0);
        }
      }
    }
    __builtin_amdgcn_wave_barrier();
#pragma unroll
    for (int j = 0; j < 4; ++j) {
      float ss = o[0][j] * o[0][j] + o[1][j] * o[1][j] + o[2][j] * o[2][j] + o[3][j] * o[3][j];
      ss += __shfl_xor(ss, 1); ss += __shfl_xor(ss, 2); ss += __shfl_xor(ss, 4); ss += __shfl_xor(ss, 8);
      const float rstd = rsqrtf(ss * (1.f / 64.f) + EPSV);
#pragma unroll
      for (int n = 0; n < 4; ++n) Pw[(fq * 4 + j) * GL_VT_STRIDE + n * 16 + fr] = f2bf(o[n][j] * rstd);
    }
    __builtin_amdgcn_wave_barrier();
    {
      const int tl = lane >> 2, dq = (lane & 3) * 16;
      const int tok = gla_tok(sc, w * 16 + tl);
      const bf16_t* grow = p.cols + (size_t)tok * INW + C_GG + h * 64 + dq;
      float ov[16], gv[16];
      unpack8(*(const uint4*)(Pw + tl * GL_VT_STRIDE + dq), ov); unpack8(*(const uint4*)(Pw + tl * GL_VT_STRIDE + dq + 8), ov + 8);
      unpack8(*(const uint4*)grow, gv); unpack8(*(const uint4*)(grow + 8), gv + 8);
      const float* ng = p.gla_ng + layer * 512 + h * 64 + dq;
      unsigned wv[8];
#pragma unroll
      for (int e = 0; e < 8; ++e) {
        const float a = ov[2 * e] * ng[2 * e] * silu_f(gv[2 * e]), b = ov[2 * e + 1] * ng[2 * e + 1] * silu_f(gv[2 * e + 1]);
        wv[e] = (unsigned)f2bf(a) | ((unsigned)f2bf(b) << 16);
      }
      bf16_t* orow = p.mix + (size_t)tok * 1024 + 512 + h * 64 + dq;
      *(uint4*)orow = make_uint4(wv[0], wv[1], wv[2], wv[3]);
      *(uint4*)(orow + 8) = make_uint4(wv[4], wv[5], wv[6], wv[7]);
    }
    __builtin_amdgcn_wave_barrier();
    cur = nxt;
  }
  __syncthreads();
}

__device__ __forceinline__ unsigned fkey(float f) { const unsigned u = __float_as_uint(f); return u ^ ((u >> 31) ? 0xFFFFFFFFu : 0x80000000u); }
__device__ __forceinline__ float funkey(unsigned k) { return __uint_as_float((k >> 31) ? (k ^ 0x80000000u) : ~k); }
__device__ __forceinline__ unsigned umax3(unsigned a, unsigned b) { return a > b ? a : b; }
__device__ __forceinline__ unsigned umin3(unsigned a, unsigned b) { return a < b ? a : b; }
__device__ __forceinline__ unsigned umed3(unsigned a, unsigned b, unsigned c) { return umax3(umin3(a, b), umin3(umax3(a, b), c)); }
__device__ __forceinline__ void top16_insert(unsigned (&L)[16], unsigned x) {
#pragma unroll
  for (int q = 15; q >= 1; --q) L[q] = umed3(L[q - 1], L[q], x);
  L[0] = umax3(L[0], x);
}
template <int XM>
__device__ __forceinline__ void top16_merge(unsigned (&L)[16]) {
  unsigned P[16];
#pragma unroll
  for (int i = 0; i < 16; ++i) P[i] = (unsigned)__shfl_xor((int)L[i], XM);
  unsigned M[16];
#pragma unroll
  for (int i = 0; i < 16; ++i) M[i] = umax3(L[i], P[15 - i]);
#pragma unroll
  for (int d = 8; d >= 1; d >>= 1) {
#pragma unroll
    for (int i = 0; i < 16; ++i) {
      if ((i & d) == 0) { const unsigned hi = umax3(M[i], M[i + d]), lo = umin3(M[i], M[i + d]); M[i] = hi; M[i + d] = lo; }
    }
  }
#pragma unroll
  for (int i = 0; i < 16; ++i) L[i] = M[i];
}
#define RT_SC_STRIDE 132
#define RT_MAX_ITEMS 5
__device__ __forceinline__ void phase_route(const Params& p, int layer, int ntok, int bid, int nblk, unsigned char* smem) {
  const int tid = opaque_tid(); const int lane = tid & 63, wid = tid >> 6;
  float* sc = (float*)smem;
  unsigned* lists_all = (unsigned*)(sc + 128 * RT_SC_STRIDE);
  const int fr = lane & 15, fq = lane >> 4;
  const bf16_t* qb = p.cols;
  const int nitems = ntok / 16;
  for (int item0 = bid; item0 < nitems; item0 += nblk * RT_MAX_ITEMS) {
    for (int ph = 0; ph < 2; ++ph) {
      bf16x8 bk[8][4];
      {
        const bf16_t* kb = p.keysb + ((((size_t)layer * 2 + ph) * 8 + wid) * 128) * 128 + (size_t)fr * 128 + fq * 8;
#pragma unroll
        for (int n = 0; n < 8; ++n)
#pragma unroll
          for (int kt = 0; kt < 4; ++kt) bk[n][kt] = *(const bf16x8*)(kb + (size_t)n * 16 * 128 + kt * 32);
      }
      bf16x8 an[4];
      {
        const bf16_t* qrow = qb + (size_t)(item0 * 16 + fr) * 2048 + wid * 256 + ph * 128 + fq * 8;
#pragma unroll
        for (int kt = 0; kt < 4; ++kt) an[kt] = *(const bf16x8*)(qrow + kt * 32);
      }
      for (int ii = 0; ii < RT_MAX_ITEMS; ++ii) {
        const int item = item0 + ii * nblk;
        if (item >= nitems) break;
        const int tok0 = item * 16;
        unsigned* lists = lists_all + ii * 4096;
        {
          bf16x8 a[4];
#pragma unroll
          for (int kt = 0; kt < 4; ++kt) a[kt] = an[kt];
          {
            const int itn = item0 + (ii + 1) * nblk;
            const int tokn = (ii + 1 < RT_MAX_ITEMS && itn < nitems) ? itn * 16 : tok0;
            const bf16_t* qrow = qb + (size_t)(tokn + fr) * 2048 + wid * 256 + ph * 128 + fq * 8;
#pragma unroll
            for (int kt = 0; kt < 4; ++kt) an[kt] = *(const bf16x8*)(qrow + kt * 32);
          }
#pragma unroll
          for (int n = 0; n < 8; ++n) {
            f32x4 acc = (f32x4){0.f, 0.f, 0.f, 0.f};
#pragma unroll
            for (int kt = 0; kt < 4; ++kt) acc = __builtin_amdgcn_mfma_f32_16x16x32_bf16(a[kt], bk[n][kt], acc, 0, 0, 0);
#pragma unroll
            for (int j = 0; j < 4; ++j) sc[(wid * 16 + fq * 4 + j) * RT_SC_STRIDE + n * 16 + fr] = acc[j];
          }
        }
        lds_barrier();
        {
          const int row = tid >> 2, qr = tid & 3;
          unsigned L[16];
#pragma unroll
          for (int i = 0; i < 16; ++i) L[i] = 0u;
          const float* rp = sc + row * RT_SC_STRIDE + qr * 32;
#pragma unroll
          for (int i = 0; i < 8; ++i) {
            const f32x4 v = *(const f32x4*)(rp + i * 4);
#pragma unroll
            for (int j = 0; j < 4; ++j) top16_insert(L, (fkey(v[j]) & 0xFFFFFF80u) | (unsigned)(qr * 32 + i * 4 + j));
          }
          top16_merge<1>(L);
          top16_merge<2>(L);
          if (qr == 0) {
            unsigned* dst = lists + (((row >> 4) * 2 + ph) * 16 + (row & 15)) * 16;
#pragma unroll
            for (int i = 0; i < 4; ++i) *(uint4*)(dst + i * 4) = make_uint4(L[i * 4], L[i * 4 + 1], L[i * 4 + 2], L[i * 4 + 3]);
          }
        }
        lds_barrier();
      }
    }
    for (int ii = 0; ii < RT_MAX_ITEMS; ++ii) {
      const int item = item0 + ii * nblk;
      if (item >= nitems) break;
      const int tok0 = item * 16;
      const unsigned* lists = lists_all + ii * 4096;
    {
      const int pair = tid >> 2, part = tid & 3;
      const int tk = pair & 15, hd = pair >> 4;
      const unsigned* l1 = lists + ((hd * 2 + 0) * 16 + tk) * 16;
      const unsigned* l2 = lists + ((hd * 2 + 1) * 16 + tk) * 16;
      static const unsigned char STAIR[52] = {0, 1, 2, 3, 4, 5, 6, 7, 8, 9, 10, 11, 12, 13, 14, 15, 16, 17, 18, 19, 20, 21, 22, 23, 32, 33, 34, 35, 36, 48, 49, 50, 51, 64, 65, 66, 80, 81, 96, 97, 112, 113, 128, 144, 160, 176, 192, 208, 224, 240, 255, 255};
      unsigned T[16];
#pragma unroll
      for (int i = 0; i < 16; ++i) T[i] = 0u;
#pragma unroll
      for (int j = 0; j < 13; ++j) {
        const unsigned c = STAIR[part + 4 * j];
        const float sa = funkey(l1[(c >> 4) & 15] & 0xFFFFFF80u), sb = funkey(l2[c & 15] & 0xFFFFFF80u);
        const unsigned key = (fkey(sa + sb) & 0xFFFFFF00u) | c;
        top16_insert(T, c == 255u ? 0u : key);
      }
      top16_merge<1>(T);
      top16_merge<2>(T);
      const float mx = funkey(T[0] & 0xFFFFFF00u);
      float ex[16], sum = 0.f;
#pragma unroll
      for (int r = 0; r < 16; ++r) { ex[r] = __expf(funkey(T[r] & 0xFFFFFF00u) - mx); sum += ex[r]; }
      const float inv = 1.f / sum;
      int eid[4]; float gt[4];
#pragma unroll
      for (int r = 0; r < 16; ++r) {
        if ((r >> 2) == part) {
          const int a = (T[r] >> 4) & 15, b = T[r] & 15;
          eid[r & 3] = (int)(l1[a] & 127u) * 128 + (int)(l2[b] & 127u);
          gt[r & 3] = ex[r] * inv;
        }
      }
      const size_t o = (size_t)(tok0 + tk) * 128 + hd * 16 + part * 4;
      *(int4*)(p.pidx + o) = make_int4(eid[0], eid[1], eid[2], eid[3]);
      *(f32x4*)(p.pgate + o) = (f32x4){gt[0], gt[1], gt[2], gt[3]};
    }
    }
    lds_barrier();
  }
}

typedef float f32x2 __attribute__((ext_vector_type(2)));
__device__ __forceinline__ float dot16_fp8(const uint4& r, const f32x2* h2) {
  const unsigned w[4] = {r.x, r.y, r.z, r.w};
  f32x2 d = {0.f, 0.f};
#pragma unroll
  for (int q = 0; q < 4; ++q) {
    d += __builtin_amdgcn_cvt_pk_f32_fp8(w[q], false) * h2[q * 2];
    d += __builtin_amdgcn_cvt_pk_f32_fp8(w[q], true) * h2[q * 2 + 1];
  }
  return d.x + d.y;
}
__device__ __forceinline__ void fma16_fp8(f32x2* acc2, const uint4& r, float w8) {
  const unsigned w[4] = {r.x, r.y, r.z, r.w};
  const f32x2 ww = {w8, w8};
#pragma unroll
  for (int q = 0; q < 4; ++q) {
    acc2[q * 2] += ww * __builtin_amdgcn_cvt_pk_f32_fp8(w[q], false);
    acc2[q * 2 + 1] += ww * __builtin_amdgcn_cvt_pk_f32_fp8(w[q], true);
  }
}
struct XcdInfo { int rank, nloc, xi, nx; };
__device__ __forceinline__ XcdInfo xcd_info(const XcdBarrier& b) {
  if (threadIdx.x == 0) {
    unsigned xi = 0;
    for (unsigned j = 0; j < 16; ++j) { const unsigned c = xb_ld(&b.bar[XB_XCNT(j)]); if (j < b.x && c > 0u) ++xi; }
    b.st[3] = xi;
  }
  __syncthreads();
  XcdInfo r;
  r.nloc = __builtin_amdgcn_readfirstlane((int)b.st[0]); r.nx = __builtin_amdgcn_readfirstlane((int)b.st[1]);
  r.rank = __builtin_amdgcn_readfirstlane((int)b.st[2]); r.xi = __builtin_amdgcn_readfirstlane((int)b.st[3]);
  return r;
}
__device__ __forceinline__ void gs_issue(uint4 (&buf)[16], const unsigned char* tab, const int* el, int grp) {
#pragma unroll
  for (int k = 0; k < 16; ++k) buf[k] = *(const uint4*)(tab + (size_t)el[k * 8 + grp] * 1024);
}
__device__ __forceinline__ void phase_gather_u(const Params& p, int layer, int ntok, const XcdInfo xin, unsigned char* smem) {
  const int tid = opaque_tid(); const int lane = tid & 63, wid = tid >> 6;
  int* elw = (int*)smem + wid * 256;
  float* pbuf = (float*)p.cols;
  const int sub = lane & 7, grp = lane >> 3;
  const bool b0 = (lane & 1) != 0, b1 = (lane & 2) != 0, b2 = (lane & 4) != 0;
  const int tstep = xin.nloc * NW;
  for (int s = xin.xi; s < 8; s += xin.nx) {
    const unsigned char* EU = p.eu8 + (size_t)layer * 16384 * 1024 + s * 128 + sub * 16;
    const int t0 = xin.rank * NW + wid;
    if (t0 >= ntok) continue;
    const int kslot = ((b0 ? 8 : 0) + (b1 ? 4 : 0) + (b2 ? 2 : 0)) * 8 + grp;
    uint4 bufA[16], bufB[16];
    uint4 hA0, hA1, hB0, hB1;
    int i0n, i1n;
    {
      elw[lane] = p.pidx[(size_t)t0 * 128 + lane]; elw[64 + lane] = p.pidx[(size_t)t0 * 128 + 64 + lane];
      __builtin_amdgcn_wave_barrier();
      gs_issue(bufA, EU, elw, grp);
      hA0 = *(const uint4*)(p.abuf + (size_t)t0 * 1024 + s * 128 + sub * 16); hA1 = *(const uint4*)(p.abuf + (size_t)t0 * 1024 + s * 128 + sub * 16 + 8);
      const int t1 = t0 + tstep < ntok ? t0 + tstep : t0;
      i0n = p.pidx[(size_t)t1 * 128 + lane]; i1n = p.pidx[(size_t)t1 * 128 + 64 + lane];
    }
    int par = 0;
    for (int t = t0; t < ntok; t += 2 * tstep) {
#pragma unroll
      for (int hh = 0; hh < 2; ++hh) {
        const int tc = t + hh * tstep;
        if (tc < ntok) {
          uint4 (&cur)[16] = hh ? bufB : bufA;
          uint4 (&nxt)[16] = hh ? bufA : bufB;
          const uint4 hc0 = hh ? hB0 : hA0, hc1 = hh ? hB1 : hA1;
          const int tn = tc + tstep < ntok ? tc + tstep : tc;
          par ^= 1;
          int* eln = elw + par * 128;
          eln[lane] = i0n; eln[64 + lane] = i1n;
          __builtin_amdgcn_wave_barrier();
          gs_issue(nxt, EU, eln, grp);
          const uint4 hn0 = *(const uint4*)(p.abuf + (size_t)tn * 1024 + s * 128 + sub * 16), hn1 = *(const uint4*)(p.abuf + (size_t)tn * 1024 + s * 128 + sub * 16 + 8);
          const int tnn = tn + tstep < ntok ? tn + tstep : tn;
          i0n = p.pidx[(size_t)tnn * 128 + lane]; i1n = p.pidx[(size_t)tnn * 128 + 64 + lane];
          f32x2 hv2[8];
          {
            float hv[16];
            unpack8(hc0, hv); unpack8(hc1, hv + 8);
#pragma unroll
            for (int q = 0; q < 8; ++q) hv2[q] = (f32x2){hv[2 * q], hv[2 * q + 1]};
          }
          float d[16];
#pragma unroll
          for (int k = 0; k < 16; ++k) d[k] = dot16_fp8(cur[k], hv2);
          float d8[8], d4[4], d2[2];
#pragma unroll
          for (int q = 0; q < 8; ++q) { const float send = b0 ? d[q] : d[q + 8]; const float keep = b0 ? d[q + 8] : d[q]; d8[q] = keep + __shfl_xor(send, 1); }
#pragma unroll
          for (int q = 0; q < 4; ++q) { const float send = b1 ? d8[q] : d8[q + 4]; const float keep = b1 ? d8[q + 4] : d8[q]; d4[q] = keep + __shfl_xor(send, 2); }
#pragma unroll
          for (int q = 0; q < 2; ++q) { const float send = b2 ? d4[q] : d4[q + 2]; const float keep = b2 ? d4[q + 2] : d4[q]; d2[q] = keep + __shfl_xor(send, 4); }
          float* dst = pbuf + ((size_t)s * TT + tc) * 128 + kslot;
          dst[0] = d2[0]; dst[8] = d2[1];
          if (hh) { hA0 = hn0; hA1 = hn1; } else { hB0 = hn0; hB1 = hn1; }
        }
      }
    }
    __builtin_amdgcn_wave_barrier();
  }
}
__device__ __forceinline__ void phase_gather_r(const Params& p, int layer, int ntok, int bid, int nblk) {
  const int tid = opaque_tid();
  const float* pbuf = (const float*)p.cols;
  const size_t n4 = (size_t)ntok * 32;
  for (size_t i = (size_t)bid * NT + tid; i < n4; i += (size_t)nblk * NT) {
    f32x4 z = *(const f32x4*)(pbuf + i * 4);
#pragma unroll
    for (int s = 1; s < 8; ++s) z += *(const f32x4*)(pbuf + (size_t)s * TT * 128 + i * 4);
    const f32x4 g = *(const f32x4*)(p.pgate + i * 4);
    const int4 e = *(const int4*)(p.pidx + i * 4);
    const int ev[4] = {e.x, e.y, e.z, e.w};
    f32x4 w;
#pragma unroll
    for (int j = 0; j < 4; ++j) w[j] = g[j] * gelu_f(z[j] * p.su[layer * 16384 + ev[j]]) * p.sv[layer * 16384 + ev[j]];
    *(f32x4*)(p.wbuf + i * 4) = w;
  }
}
template <bool DUMMY>
__device__ __forceinline__ void phase_gather_v(const Params& p, int layer, int ntok, const XcdInfo xin, unsigned char* smem) {
  float* xout = DUMMY ? (float*)p.cols : p.xres;
  const int tid = opaque_tid(); const int lane = tid & 63, wid = tid >> 6;
  int* elw = (int*)smem + wid * 512;
  float* wlw = (float*)(elw + 256);
  const int sub = lane & 7, grp = lane >> 3;
  const bool b5 = (lane & 32) != 0, b4 = (lane & 16) != 0, b3 = (lane & 8) != 0;
  const int tstep = xin.nloc * NW;
  for (int s = xin.xi; s < 8; s += xin.nx) {
    const unsigned char* EV = p.ev8 + (size_t)layer * 16384 * 1024 + s * 128 + sub * 16;
    const int col = s * 128 + sub * 16 + (b3 ? 8 : 0) + (b4 ? 4 : 0) + (b5 ? 2 : 0);
    const int t0 = xin.rank * NW + wid;
    if (t0 >= ntok) continue;
    uint4 bufA[16], bufB[16];
    int i0n, i1n; float w0n, w1n;
    f32x2 xc, gc, xn, gn;
    {
      elw[lane] = p.pidx[(size_t)t0 * 128 + lane]; elw[64 + lane] = p.pidx[(size_t)t0 * 128 + 64 + lane];
      wlw[lane] = p.wbuf[(size_t)t0 * 128 + lane]; wlw[64 + lane] = p.wbuf[(size_t)t0 * 128 + 64 + lane];
      __builtin_amdgcn_wave_barrier();
      gs_issue(bufA, EV, elw, grp);
      xc = *(const f32x2*)(p.xres + (size_t)t0 * 1024 + col);
      gc = *(const f32x2*)(p.modv + ((size_t)layer * 5 + tok_batch(t0)) * NMOD + 5120 + col);
      const int t1 = t0 + tstep < ntok ? t0 + tstep : t0;
      i0n = p.pidx[(size_t)t1 * 128 + lane]; i1n = p.pidx[(size_t)t1 * 128 + 64 + lane];
      w0n = p.wbuf[(size_t)t1 * 128 + lane]; w1n = p.wbuf[(size_t)t1 * 128 + 64 + lane];
      xn = *(const f32x2*)(p.xres + (size_t)t1 * 1024 + col);
      gn = *(const f32x2*)(p.modv + ((size_t)layer * 5 + tok_batch(t1)) * NMOD + 5120 + col);
    }
    int par = 0;
    for (int t = t0; t < ntok; t += 2 * tstep) {
#pragma unroll
      for (int hh = 0; hh < 2; ++hh) {
        const int tc = t + hh * tstep;
        if (tc < ntok) {
          uint4 (&cur)[16] = hh ? bufB : bufA;
          uint4 (&nxt)[16] = hh ? bufA : bufB;
          const float* wlc = wlw + par * 128;
          const int tn = tc + tstep < ntok ? tc + tstep : tc;
          par ^= 1;
          int* eln = elw + par * 128; float* wln = wlw + par * 128;
          eln[lane] = i0n; eln[64 + lane] = i1n; wln[lane] = w0n; wln[64 + lane] = w1n;
          __builtin_amdgcn_wave_barrier();
          gs_issue(nxt, EV, eln, grp);
          const f32x2 xcur = xc, gcur = gc;
          xc = xn; gc = gn;
          const int tnn = tn + tstep < ntok ? tn + tstep : tn;
          i0n = p.pidx[(size_t)tnn * 128 + lane]; i1n = p.pidx[(size_t)tnn * 128 + 64 + lane];
          w0n = p.wbuf[(size_t)tnn * 128 + lane]; w1n = p.wbuf[(size_t)tnn * 128 + 64 + lane];
          xn = *(const f32x2*)(p.xres + (size_t)tnn * 1024 + col);
          gn = *(const f32x2*)(p.modv + ((size_t)layer * 5 + tok_batch(tnn)) * NMOD + 5120 + col);
          f32x2 acc2[8];
#pragma unroll
          for (int j = 0; j < 8; ++j) acc2[j] = (f32x2){0.f, 0.f};
#pragma unroll
          for (int k = 0; k < 16; ++k) fma16_fp8(acc2, cur[k], wlc[k * 8 + grp]);
          float a16[16];
#pragma unroll
          for (int q = 0; q < 8; ++q) { a16[2 * q] = acc2[q].x; a16[2 * q + 1] = acc2[q].y; }
          float a8[8], a4[4], a2[2];
#pragma unroll
          for (int q = 0; q < 8; ++q) { const float send = b3 ? a16[q] : a16[q + 8]; const float keep = b3 ? a16[q + 8] : a16[q]; a8[q] = keep + __shfl_xor(send, 8); }
#pragma unroll
          for (int q = 0; q < 4; ++q) { const float send = b4 ? a8[q] : a8[q + 4]; const float keep = b4 ? a8[q + 4] : a8[q]; a4[q] = keep + __shfl_xor(send, 16); }
#pragma unroll
          for (int q = 0; q < 2; ++q) { const float send = b5 ? a4[q] : a4[q + 2]; const float keep = b5 ? a4[q + 2] : a4[q]; a2[q] = keep + __shfl_xor(send, 32); }
          f32x2 xv = xcur;
          xv.x += gcur.x * a2[0]; xv.y += gcur.y * a2[1];
          *(f32x2*)(xout + (size_t)tc * 1024 + col) = xv;
        }
      }
    }
    __builtin_amdgcn_wave_barrier();
  }
}
__device__ __forceinline__ void phase_gather_norm(const Params& p, int layer, int ntok, int bid, int nblk) {
  const int tid = opaque_tid(); const int lane = tid & 63, wid = tid >> 6;
  for (int t = bid * NW + wid; t < ntok; t += nblk * NW) {
    f32x4 xv[4];
    float ss = 0.f;
#pragma unroll
    for (int q = 0; q < 4; ++q) {
      xv[q] = *(const f32x4*)(p.xres + (size_t)t * 1024 + lane * 16 + q * 4);
      ss += xv[q][0] * xv[q][0] + xv[q][1] * xv[q][1] + xv[q][2] * xv[q][2] + xv[q][3] * xv[q][3];
    }
    ss = wave_sum(ss);
    const float rstd = rsqrtf(ss * (1.f / 1024.f) + EPSV);
    if (layer == 0) {
      const float* md1 = p.modv + ((size_t)5 + tok_batch(t)) * NMOD;
#pragma unroll
      for (int q = 0; q < 4; ++q) {
        const int c0 = lane * 16 + q * 4;
        const f32x4 g = *(const f32x4*)(p.norm1_g + 1024 + c0);
        const f32x4 sh = *(const f32x4*)(md1 + c0);
        const f32x4 sc = *(const f32x4*)(md1 + 1024 + c0);
        ushort4 o;
        o.x = f2bf(xv[q][0] * rstd * g[0] * (1.f + sc[0]) + sh[0]);
        o.y = f2bf(xv[q][1] * rstd * g[1] * (1.f + sc[1]) + sh[1]);
        o.z = f2bf(xv[q][2] * rstd * g[2] * (1.f + sc[2]) + sh[2]);
        o.w = f2bf(xv[q][3] * rstd * g[3] * (1.f + sc[3]) + sh[3]);
        *(ushort4*)(p.abuf + (size_t)t * 1024 + c0) = o;
      }
    } else {
#pragma unroll
      for (int q = 0; q < 4; ++q) {
        const int c0 = lane * 16 + q * 4;
        const f32x4 g = *(const f32x4*)(p.final_g + c0);
        f32x4 o;
        o[0] = xv[q][0] * rstd * g[0]; o[1] = xv[q][1] * rstd * g[1]; o[2] = xv[q][2] * rstd * g[2]; o[3] = xv[q][3] * rstd * g[3];
        *(f32x4*)(p.out + (size_t)t * 1024 + c0) = o;
      }
    }
  }
}

__device__ __forceinline__ void phase_final(const Params& p, int bid, int nblk) {
  const int tid = opaque_tid(); const int lane = tid & 63, wid = tid >> 6;
  for (int t = bid * 4 + wid; t < TL; t += nblk * 4) {
    const float* row = p.xres + (size_t)t * 1024;
    f32x4 v[4];
    float ss = 0.f;
#pragma unroll
    for (int j = 0; j < 4; ++j) {
      v[j] = *(const f32x4*)(row + j * 256 + lane * 4);
      ss += v[j][0] * v[j][0] + v[j][1] * v[j][1] + v[j][2] * v[j][2] + v[j][3] * v[j][3];
    }
    ss = wave_sum(ss);
    const float rstd = rsqrtf(ss * (1.f / 1024.f) + EPSV);
#pragma unroll
    for (int j = 0; j < 4; ++j) {
      const int c0 = j * 256 + lane * 4;
      const f32x4 g = *(const f32x4*)(p.final_g + c0);
      f32x4 o;
      o[0] = v[j][0] * rstd * g[0]; o[1] = v[j][1] * rstd * g[1]; o[2] = v[j][2] * rstd * g[2]; o[3] = v[j][3] * rstd * g[3];
      *(f32x4*)(p.out + (size_t)t * 1024 + c0) = o;
    }
  }
}

template <class Epi>
__device__ __forceinline__ void run_gemm(const bf16_t* A, const bf16_t* Bt, int M, int N, int K, const Epi& epi, int bid, int nblk, unsigned char* smem) {
  pg8::Gemm g{A, Bt, M, N, K};
  pg8::StaticOrder S; S.init(M, N, nblk, bid);
  pg8::gemm_phase(( PG8_LAS unsigned char*)smem, g, S, epi);
}
__device__ __forceinline__ void phase_gemm_in(const Params& p, int layer, int bid, int nblk, unsigned char* smem) {
  pg8::EpiBf16 epi{p.cols, INW, INW};
  run_gemm(p.abuf, p.wt_in + (size_t)layer * INWP * 1024, TT, INWP, 1024, epi, bid, nblk, smem);
}
__device__ __forceinline__ void phase_gemm_glu(const Params& p, int layer, int ntok, int bid, int nblk, unsigned char* smem) {
  pg8::EpiGlu epi{p.mix};
  run_gemm(p.yg, p.wt_glu + (size_t)layer * 512 * 256, ntok, 512, 256, epi, bid, nblk, smem);
}
__device__ __forceinline__ void phase_gemm_out(const Params& p, int layer, int ntok, int bid, int nblk, unsigned char* smem) {
  pg8::EpiResid epi{p.xres, p.modv + (size_t)layer * 5 * NMOD, 2048};
  run_gemm(p.mix, p.wt_out + (size_t)layer * 1024 * 1024, ntok, 1024, 1024, epi, bid, nblk, smem);
}
__device__ __forceinline__ void phase_gemm_q(const Params& p, int layer, int ntok, int bid, int nblk, unsigned char* smem) {
  pg8::EpiBf16 epi{p.cols  , 2048, 2048};
  run_gemm(p.abuf, p.wt_q + (size_t)layer * 2048 * 1024, ntok, 2048, 1024, epi, bid, nblk, smem);
}

template <int L>
__device__ __forceinline__ void layer_body(const Params& p, const XcdBarrier& bar, const XcdInfo xin, int bid, int nblk, unsigned char* smem) {
  constexpr int l = L;
  constexpr int ntok = L == 0 ? TT : TL;
  for (int rep = 0; rep < REP_GEMM; ++rep) phase_gemm_in(p, l, bid, nblk, smem);
  xcd_barrier(bar);
  for (int rep = 0; rep < REP_MIX; ++rep) {
    phase_s5a(p, l, bid, nblk, smem);
    if (REP_S5 > 1) phase_s5a(p, l, bid, nblk, smem);
    for (int r2 = 0; r2 < REP_GLA; ++r2) phase_glaa(p, l, bid, nblk, smem);
  }
  xcd_barrier(bar);
  phase_scan(p, l, bid, nblk);
  for (int r2 = 0; r2 < REP_SGU; ++r2) phase_sgu(p, l, ntok / 128, bid, nblk, smem);
  xcd_barrier(bar);
  for (int rep = 0; rep < REP_MIX; ++rep) {
    phase_s5c(p, l, ntok / 64, bid, nblk, smem);
    if (REP_S5 > 1) phase_s5c(p, l, ntok / 64, bid, nblk, smem);
    for (int r2 = 0; r2 < REP_GLA; ++r2) phase_glac(p, l, ntok / 64, 16 * ((ntok / 64 / 16 + 1) / 2), bid, nblk, smem);
  }
  xcd_barrier(bar);
  for (int rep = 0; rep < REP_GEMM; ++rep) phase_gemm_glu(p, l, ntok, bid, nblk, smem);
  xcd_barrier(bar);
  if (REP_GEMM > 1) {
    pg8::EpiBf16 epi{p.abuf, 1024, 1024};
    for (int rep = 1; rep < REP_GEMM; ++rep) run_gemm(p.mix, p.wt_out + (size_t)l * 1024 * 1024, ntok, 1024, 1024, epi, bid, nblk, smem);
  }
  phase_gemm_out(p, l, ntok, bid, nblk, smem);
  if (l == 0 && nblk > 16 && bid >= 16) {
    const int tid = opaque_tid();
    for (int j = bid - 16; j < 2048; j += nblk - 16) convert_rows(p, (j >> 10) * 2048 + 1024 + (j & 1023), tid);
  } else if (l == 0 && nblk <= 16) {
    const int tid = opaque_tid();
    for (int j = bid; j < 2048; j += nblk) convert_rows(p, (j >> 10) * 2048 + 1024 + (j & 1023), tid);
  }
  xcd_barrier(bar);
  for (int rep = 0; rep < REP_PRO; ++rep)
    phase_normmod(p, p.xres, p.xres + (size_t)TL * 1024, p.norm2_g + l * 1024, p.modv + (size_t)l * 5 * NMOD, 3072, 4096, ntok, 0, bid, nblk);
  xcd_barrier(bar);
  for (int rep = 0; rep < REP_GEMM; ++rep) phase_gemm_q(p, l, ntok, bid, nblk, smem);
  xcd_barrier(bar);
  for (int rep = 0; rep < REP_ROUTE; ++rep) phase_route(p, l, ntok, bid, nblk, smem);
  xcd_barrier(bar);
  phase_gather_u(p, l, ntok, xin, smem);
  if (REP_GATHER == 2) phase_gather_u(p, l, ntok, xin, smem);
  xcd_barrier(bar);
  phase_gather_r(p, l, ntok, bid, nblk);
  xcd_barrier(bar);
  if (REP_GATHER > 2) phase_gather_v<true>(p, l, ntok, xin, smem);
  phase_gather_v<false>(p, l, ntok, xin, smem);
  xcd_barrier(bar);
  phase_gather_norm(p, l, ntok, bid, nblk);
  if (l == 0) xcd_barrier(bar);
}

#define SMEM_BYTES (148 * 1024)
__global__ void __launch_bounds__(NT) mega_kernel(Params p) {
  __shared__ __attribute__((aligned(16))) unsigned char smem[SMEM_BYTES + 16];
  const int bid = blockIdx.x, nblk = gridDim.x;
  volatile LAS unsigned* xbw = (volatile LAS unsigned*)(smem + SMEM_BYTES);
  if (threadIdx.x == 0) { xbw[0] = 0u; xbw[1] = 0u; xbw[2] = 0u; xbw[3] = 0u; }
  __syncthreads();
  XcdBarrier bar = xcd_barrier_post(p.bar, xbw);
  for (int rep = 0; rep < REP_PRO; ++rep) {
    phase_mod(p, bid, nblk, smem);
    phase_wprep(p, bid, nblk, smem);
  }
  xcd_barrier(bar);
  for (int rep = 0; rep < REP_PRO; ++rep) phase_normmod(p, p.x, p.ctx, p.norm1_g, p.modv, 0, 1024, TT, 1, bid, nblk);
  xcd_barrier(bar);
  const XcdInfo xin = xcd_info(bar);
  layer_body<0>(p, bar, xin, bid, nblk, smem);
  layer_body<1>(p, bar, xin, bid, nblk, smem);
}

static inline size_t align_up(size_t v, size_t a) { return (v + a - 1) / a * a; }

extern "C" void kernel_launch(void* const* d_in, const int* in_sizes, int n_in, void* d_out, int out_size, void* d_ws, size_t ws_size,
                              hipStream_t stream) {
  Params p{};
  const float* const* in = (const float* const*)d_in;
  p.x = in[0]; p.c = in[1]; p.ctx = in[2]; p.c_ctx = in[3]; p.w_mod = in[4]; p.b_mod = in[5]; p.norm1_g = in[6]; p.norm2_g = in[7];
  p.w_in = in[8]; p.w_out = in[9]; p.sgu_w = in[10]; p.sgu_b = in[11]; p.lam_re = in[12]; p.lam_im = in[13]; p.b_re = in[14]; p.b_im = in[15];
  p.c_re = in[16]; p.c_im = in[17]; p.log_step = in[18]; p.s5_d = in[19]; p.w_glu = in[20]; p.gla_wg = in[21]; p.gla_bg = in[22]; p.gla_ng = in[23];
  p.w_query = in[24]; p.sub_keys = in[25]; p.exp_u = in[26]; p.exp_v = in[27]; p.final_g = in[28];
  p.out = (float*)d_out;
  unsigned char* w = (unsigned char*)d_ws;
  size_t off = 0;
  auto take = [&](size_t bytes) { void* r = w + off; off = align_up(off + bytes, 256); return r; };
  p.bar = (unsigned*)take(16384);
  p.xres = (float*)take((size_t)TT * 1024 * 4);
  p.modv = (float*)take((size_t)2 * 5 * NMOD * 4);
  p.abuf = (bf16_t*)take((size_t)TT * 1024 * 2);
  p.cols = (bf16_t*)take((size_t)TT * INW * 2);
  p.mix = (bf16_t*)take((size_t)TT * 1024 * 2);
  p.yg = (bf16_t*)take((size_t)TT * 256 * 2);
  p.wt_in = (bf16_t*)take((size_t)2 * INWP * 1024 * 2);
  p.wt_out = (bf16_t*)take((size_t)2 * 1024 * 1024 * 2);
  p.wt_q = (bf16_t*)take((size_t)2 * 2048 * 1024 * 2);
  p.wt_glu = (bf16_t*)take((size_t)2 * 512 * 256 * 2);
  p.keysb = (bf16_t*)take((size_t)2 * 2 * 8 * 128 * 128 * 2);
  p.sgu_wb = (bf16_t*)take((size_t)2 * 4 * 128 * 128 * 2);
  p.s5a = (float*)take((size_t)4096 * 2 * 4);
  p.s5a64 = (float*)take((size_t)4096 * 2 * 4);
  p.s5bb = (float*)take((size_t)4096 * 32 * 4);
  p.s5K = (bf16_t*)take((size_t)64 * 16384 * 2);
  p.s5M1 = (bf16_t*)take((size_t)64 * 131072 * 2);
  p.s5N2 = (bf16_t*)take((size_t)64 * 131072 * 2);
  p.s5S = (float*)take((size_t)2 * NSC * 16 * 64 * 2 * 4);
  p.s5H = (float*)take((size_t)2 * NSC * 16 * 64 * 2 * 4);
  p.gkv = (float*)take((size_t)2 * NSC * 8 * 2048 * 4);
  p.gdec = (float*)take((size_t)2 * NSC * 8 * 32 * 4);
  p.eu8 = (unsigned char*)take((size_t)2 * 16384 * 1024);
  p.ev8 = (unsigned char*)take((size_t)2 * 16384 * 1024);
  p.su = (float*)take((size_t)2 * 16384 * 4);
  p.sv = (float*)take((size_t)2 * 16384 * 4);
  p.glb = (float*)take((size_t)2 * TT * 256 * 4);
  p.wbuf = (float*)take((size_t)TT * 128 * 4);
  p.ssbuf = (float*)take((size_t)TT * 8 * 4);
  p.pidx = (int*)take((size_t)TT * 128 * 4);
  p.pgate = (float*)take((size_t)TT * 128 * 4);
  if (off > ws_size) { fprintf(stderr, "workspace too small: need %zu have %zu\n", off, ws_size); return; }

  (void)hipMemsetAsync(p.bar, 0, XCD_BAR_WORDS * 4, stream);
  static int grid_blocks = 0;
  if (!grid_blocks) {
    int dev = 0, cus = 0, per_cu = 0;
    (void)hipGetDevice(&dev);
    (void)hipDeviceGetAttribute(&cus, hipDeviceAttributeMultiprocessorCount, dev);
    (void)hipOccupancyMaxActiveBlocksPerMultiprocessor(&per_cu, (const void*)mega_kernel, NT, 0);
    if (per_cu < 1) { fprintf(stderr, "occupancy query says 0 blocks/CU\n"); per_cu = 1; }
    grid_blocks = cus;
  }
  void* args[] = {&p};
  hipError_t e = hipLaunchCooperativeKernel((const void*)mega_kernel, dim3(grid_blocks), dim3(NT), args, 0, stream);
  if (e != hipSuccess) fprintf(stderr, "cooperative launch failed: %s (grid %d)\n", hipGetErrorString(e), grid_blocks);
}
```

```cpp
#include <hip/hip_runtime.h>
#include <cstdio>
#include <cstdint>
#include <cmath>

typedef unsigned short bf16_t;
typedef short bf16x8 __attribute__((ext_vector_type(8)));
typedef float f32x4 __attribute__((ext_vector_type(4)));

#define DM 1024
#define NBATCH 4
#define SEQ 4096
#define CTXL 256
#define TL (NBATCH * SEQ)
#define TC (NBATCH * CTXL)
#define TT (TL + TC)
#define INW 2336
#define INWP 2560
#define NMOD 6144
#define NSC 272
#define EPSV 1e-6f
#define NT 512
#define NW 8
#ifndef REP_GATHER
#define REP_GATHER 1
#endif
#ifndef REP_ROUTE
#define REP_ROUTE 1
#endif
#ifndef REP_GEMM
#define REP_GEMM 1
#endif
#ifndef REP_MIX
#define REP_MIX 1
#endif
#ifndef REP_PRO
#define REP_PRO 1
#endif
#ifndef REP_SGU
#define REP_SGU 1
#endif
#ifndef REP_S5
#define REP_S5 1
#endif
#ifndef REP_GLA
#define REP_GLA 1
#endif

#define C_SGU_U 0
#define C_SGU_V 256
#define C_S5 512
#define C_GQ 768
#define C_GK 1024
#define C_GV 1280
#define C_GG 1792
#define C_ZF 2304

struct Params {
  const float *x, *c, *ctx, *c_ctx, *w_mod, *b_mod, *norm1_g, *norm2_g, *w_in, *w_out, *sgu_w, *sgu_b;
  const float *lam_re, *lam_im, *b_re, *b_im, *c_re, *c_im, *log_step, *s5_d, *w_glu, *gla_wg, *gla_bg, *gla_ng;
  const float *w_query, *sub_keys, *exp_u, *exp_v, *final_g;
  float* out;
  unsigned* bar;
  float* xres;
  float* modv;
  bf16_t* abuf;
  bf16_t* cols;
  bf16_t* mix;
  bf16_t* yg;
  bf16_t *wt_in, *wt_out, *wt_q, *wt_glu, *keysb, *sgu_wb;
  float *s5a, *s5a64, *s5bb;
  bf16_t *s5K, *s5M1, *s5N2;
  float *s5S, *s5H;
  float *gkv, *gdec;
  unsigned char *eu8, *ev8;
  float *su, *sv;
  float* glb;
  float *wbuf, *ssbuf;
  int* pidx;
  float* pgate;
};

__device__ __forceinline__ bf16_t f2bf(float f) {
  unsigned u = __float_as_uint(f);
  u += 0x7fffu + ((u >> 16) & 1u);
  return (bf16_t)(u >> 16);
}
__device__ __forceinline__ float bf2f(bf16_t h) { return __uint_as_float(((unsigned)h) << 16); }
__device__ __forceinline__ bf16x8 pack_bf16x8(const float* v) {
  bf16x8 r;
#pragma unroll
  for (int c = 0; c < 8; ++c) r[c] = (short)f2bf(v[c]);
  return r;
}

__device__ __forceinline__ float bflo(unsigned u) { return __uint_as_float(u << 16); }
__device__ __forceinline__ float bfhi(unsigned u) { return __uint_as_float(u & 0xffff0000u); }
__device__ __forceinline__ float gelu_f(float x) {
  const float y = 0.7978845608028654f * (x + 0.044715f * x * x * x);
  const float e = __expf(2.f * y);
  const float th = 1.f - 2.f / (1.f + e);
  return 0.5f * x * (1.f + th);
}
__device__ __forceinline__ float sigmoid_f(float x) { return 1.f / (1.f + __expf(-x)); }
__device__ __forceinline__ float silu_f(float x) { return x * sigmoid_f(x); }
__device__ __forceinline__ float logsigmoid_f(float x) { return fminf(x, 0.f) - log1pf(__expf(-fabsf(x))); }
__device__ __forceinline__ float wave_sum(float v) {
#pragma unroll
  for (int o = 32; o > 0; o >>= 1) v += __shfl_xor(v, o);
  return v;
}
__device__ __forceinline__ void lds_barrier() {
  asm volatile("s_waitcnt lgkmcnt(0)" ::: "memory");
  __builtin_amdgcn_s_barrier();
  asm volatile("" ::: "memory");
}
__device__ __forceinline__ int opaque_tid() { int t = threadIdx.x; asm volatile("" : "+v"(t)); return t; }
__device__ __forceinline__ int tok_batch(int t) { return t < TL ? (t >> 12) : 4; }
__device__ __forceinline__ int s5_tok(int sc, int i) { return sc < 256 ? ((sc >> 6) * SEQ + (sc & 63) * 64 + i) : (TL + (sc - 256) * 64 + i); }
__device__ __forceinline__ int gla_tok(int sc, int i) { return sc < 256 ? ((sc >> 6) * SEQ + i * 64 + (sc & 63)) : (TL + (sc - 256) * 64 + i); }


#define XB_TMO      128
#define XB_XCNT(j)  (256  + 64 * (j))
#define XB_XSUB(j)  (1280 + 64 * (j))
#define XB_XGEN(j)  (2304 + 64 * (j))
#define XB_TOP      3328
#define XB_TOPGEN   3392
#define XCD_BAR_WORDS 3456
#define XB_SPIN_CAP (1u << 22)
#define LAS __attribute__((address_space(3)))
__device__ __forceinline__ unsigned xb_ld(unsigned* p)              { return __hip_atomic_load(p, __ATOMIC_RELAXED, __HIP_MEMORY_SCOPE_AGENT); }
__device__ __forceinline__ unsigned xb_add(unsigned* p, unsigned v) { return __hip_atomic_fetch_add(p, v, __ATOMIC_RELAXED, __HIP_MEMORY_SCOPE_AGENT); }
__device__ __forceinline__ unsigned xb_xcc_id() { return (unsigned)__builtin_amdgcn_s_getreg((3 << 11) | 20) & 0xFu; }
#define XB_SPIN(cond, bar) do { unsigned _sp = 0; while (cond) { __builtin_amdgcn_s_sleep(1); \
    if ((++_sp & 255u) == 0u) { if (xb_ld(&(bar)[XB_TMO])) break; if (_sp > XB_SPIN_CAP) { atomicAdd(&(bar)[XB_TMO], 1u); break; } } } } while (0)
struct XcdBarrier { unsigned* bar; unsigned x; volatile LAS unsigned* st; };
__device__ __forceinline__ XcdBarrier xcd_barrier_post(unsigned* bar, volatile LAS unsigned* st) {
  XcdBarrier b; b.bar = bar; b.x = xb_xcc_id(); b.st = st;
  if (threadIdx.x == 0) st[2] = xb_add(&bar[XB_XCNT(b.x)], 1u);
  return b;
}
__device__ __forceinline__ void xcd_barrier_complete(unsigned* bar, unsigned x, unsigned& nloc, unsigned& nx) {
  const unsigned G = gridDim.x * gridDim.y * gridDim.z;
  unsigned sum, cnt, mine, sp = 0u;
  for (;;) {
    sum = 0u; cnt = 0u; mine = 0u;
#pragma unroll
    for (unsigned j = 0; j < 16; ++j) { const unsigned c = xb_ld(&bar[XB_XCNT(j)]); sum += c; cnt += (c > 0u) ? 1u : 0u; mine = (j == x) ? c : mine; }
    if (sum == G) break;
    __builtin_amdgcn_s_sleep(1);
    if ((++sp & 255u) == 0u) { if (xb_ld(&bar[XB_TMO])) break; if (sp > XB_SPIN_CAP) { atomicAdd(&bar[XB_TMO], 1u); break; } }
  }
  nloc = mine > 0u ? mine : 1u; nx = cnt > 0u ? cnt : 1u;
}
__device__ __forceinline__ void xcd_barrier(const XcdBarrier& b) {
  asm volatile("s_waitcnt vmcnt(0)" ::: "memory");
  __syncthreads();
  if (threadIdx.x == 0) {
    unsigned* bar = b.bar;
    __builtin_amdgcn_s_waitcnt(0);
    unsigned nloc = b.st[0], nx = b.st[1];
    if (nloc == 0u) { xcd_barrier_complete(bar, b.x, nloc, nx); b.st[0] = nloc; b.st[1] = nx; }
    const unsigned old = xb_add(&bar[XB_XSUB(b.x)], 1u);
    const unsigned gen = old / nloc;
    if (old + 1u == (gen + 1u) * nloc) {
      __builtin_amdgcn_fence(__ATOMIC_RELEASE, "agent");
      asm volatile("s_waitcnt vmcnt(0)" ::: "memory");
      const unsigned og = xb_add(&bar[XB_TOP], 1u);
      const unsigned tg = og / nx;
      if (og + 1u == (tg + 1u) * nx) xb_add(&bar[XB_TOPGEN], 1u);
      else XB_SPIN(xb_ld(&bar[XB_TOPGEN]) == tg, bar);
      __builtin_amdgcn_fence(__ATOMIC_ACQUIRE, "agent");
      xb_add(&bar[XB_XGEN(b.x)], 1u);
      asm volatile("s_waitcnt vmcnt(0)" ::: "memory");
    } else {
      XB_SPIN(xb_ld(&bar[XB_XGEN(b.x)]) == gen, bar);
      __builtin_amdgcn_fence(__ATOMIC_ACQUIRE, "agent");
      asm volatile("s_waitcnt vmcnt(0)" ::: "memory");
    }
  }
  __syncthreads();
}

__device__ __forceinline__ void phase_mod(const Params& p, int bid, int nblk, unsigned char* smem) {
  float* sil = (float*)smem;
  float* red = sil + 5 * 1024;
  const int tid = opaque_tid();
  for (int i = tid; i < 5 * 1024; i += NT) {
    const int r = i >> 10, k = i & 1023;
    const float v = r < 4 ? p.c[r * 1024 + k] : p.c_ctx[k];
    sil[i] = silu_f(v);
  }
  __syncthreads();
  for (int item = bid; item < 192; item += nblk) {
    const int l = item / 96, j0 = (item % 96) * 64;
    const int cc = tid & 63, kg = tid >> 6;
    float acc[5] = {0.f, 0.f, 0.f, 0.f, 0.f};
    const float* w = p.w_mod + (size_t)l * 1024 * NMOD + j0 + cc;
#pragma unroll 32
    for (int k = kg * 128; k < kg * 128 + 128; ++k) {
      const float wv = w[(size_t)k * NMOD];
#pragma unroll
      for (int r = 0; r < 5; ++r) acc[r] += sil[r * 1024 + k] * wv;
    }
#pragma unroll
    for (int r = 0; r < 5; ++r) red[(kg * 5 + r) * 64 + cc] = acc[r];
    __syncthreads();
    if (tid < 320) {
      const int r = tid >> 6;
      float s = 0.f;
#pragma unroll
      for (int g = 0; g < 8; ++g) s += red[(g * 5 + r) * 64 + cc];
      p.modv[((size_t)l * 5 + r) * NMOD + j0 + cc] = s + p.b_mod[l * NMOD + j0 + cc];
    }
    __syncthreads();
  }
}

__device__ __forceinline__ void transpose_tile(const float* src, int ldsrc, bf16_t* dst, int lddst, int k0, int r0, int nsrc, int glu, float* tile) {
  const int tid = opaque_tid();
  const int j = tid & 63;
  const int r = r0 + j;
  int scol;
  if (glu) {
    const int pn = r >> 8, bj = (r >> 7) & 1, i = r & 127;
    scol = bj * 256 + pn * 128 + i;
  } else {
    scol = r < nsrc ? r : -1;
  }
  float v[32];
#pragma unroll
  for (int it = 0; it < 32; ++it) {
    const int kk = (tid >> 6) + it * 8;
    v[it] = scol >= 0 ? src[(size_t)(k0 + kk) * ldsrc + scol] : 0.f;
  }
#pragma unroll
  for (int it = 0; it < 32; ++it) {
    const int kk = (tid >> 6) + it * 8;
    tile[(kk >> 6) * 4160 + (kk & 63) * 65 + j] = v[it];
  }
  __syncthreads();
  const int kq = tid & 63;
#pragma unroll
  for (int it = 0; it < 32; ++it) {
    const int jj = (tid >> 6) + (it & 7) * 8, sub = it >> 3;
    dst[(size_t)(r0 + jj) * lddst + k0 + sub * 64 + kq] = f2bf(tile[sub * 4160 + kq * 65 + jj]);
  }
  __syncthreads();
}

__device__ __forceinline__ void s5_tables(const Params& p, int id, int part, unsigned char* smem) {
  const int tid = opaque_tid();
  float2* Apow = (float2*)smem;
  float2* Bbs = Apow + 65 * 64;
  float2* Cs = Bbs + 64 * 16;
  __syncthreads();
  if (tid < 64) {
    const int pid = id * 64 + tid;
    double lre = (double)p.lam_re[pid];
    if (lre > -1e-4) lre = -1e-4;
    const double lim = (double)p.lam_im[pid];
    const double dt = exp((double)p.log_step[id]);
    const double mag = exp(lre * dt);
    const double are = mag * cos(lim * dt), aim = mag * sin(lim * dt);
    {
      double pr = 1.0, pi = 0.0;
      for (int n = 0; n <= 64; ++n) {
        Apow[n * 64 + tid] = make_float2((float)pr, (float)pi);
        const double nr = pr * are - pi * aim, ni = pr * aim + pi * are;
        pr = nr; pi = ni;
      }
    }
    const double den = lre * lre + lim * lim;
    const double fre = ((are - 1.0) * lre + aim * lim) / den;
    const double fim = (aim * lre - (are - 1.0) * lim) / den;
    for (int h = 0; h < 16; ++h) {
      const double br = (double)p.b_re[(size_t)pid * 16 + h], bi = (double)p.b_im[(size_t)pid * 16 + h];
      Bbs[tid * 16 + h] = make_float2((float)(fre * br - fim * bi), (float)(fre * bi + fim * br));
    }
  }
  for (int e = tid; e < 1024; e += NT) Cs[e] = make_float2(p.c_re[(size_t)id * 1024 + e], p.c_im[(size_t)id * 1024 + e]);
  __syncthreads();
  bf16_t* Kt = p.s5K + (size_t)id * 16384;
  for (int e = part * 2048 + tid; e < part * 2048 + 2048; e += NT) {
    const int d = e >> 8, hp = (e >> 4) & 15, h = e & 15;
    float acc = 0.f;
    for (int pp = 0; pp < 64; ++pp) {
      const float2 c = Cs[hp * 64 + pp], a = Apow[d * 64 + pp], b = Bbs[pp * 16 + h];
      const float cr = c.x * a.x - c.y * a.y, ci = c.x * a.y + c.y * a.x;
      acc += cr * b.x - ci * b.y;
    }
    Kt[e] = f2bf(acc);
  }
  bf16_t* M1 = p.s5M1 + (size_t)id * 131072;
  for (int e = part * 16384 + tid; e < part * 16384 + 16384; e += NT) {
    const int c = e >> 10, k = e & 1023, ri = c >> 6, pp = c & 63, tau = k >> 4, h = k & 15;
    const float2 a = Apow[(63 - tau) * 64 + pp], b = Bbs[pp * 16 + h];
    M1[e] = f2bf(ri ? (a.x * b.y + a.y * b.x) : (a.x * b.x - a.y * b.y));
  }
  bf16_t* N2 = p.s5N2 + (size_t)id * 131072;
  for (int e = part * 16384 + tid; e < part * 16384 + 16384; e += NT) {
    const int col = e >> 7, kk = e & 127, tau = col >> 4, hp = col & 15, ri = kk >> 6, pp = kk & 63;
    const float2 c = Cs[hp * 64 + pp], a = Apow[(tau + 1) * 64 + pp];
    N2[e] = f2bf(ri ? -(c.x * a.y + c.y * a.x) : (c.x * a.x - c.y * a.y));
  }
  __syncthreads();
}

__device__ __forceinline__ void convert_rows(const Params& p, int it, int tid) {
      const int lane = tid & 63;
      const int row0 = it * 16 + (tid >> 6) * 2;
      const int tab = row0 >> 15, r0 = row0 & 32767;
      const float* s = (tab ? p.exp_v : p.exp_u) + (size_t)r0 * 1024 + lane * 16;
      f32x4 v[2][4];
#pragma unroll
      for (int rr = 0; rr < 2; ++rr)
#pragma unroll
        for (int q = 0; q < 4; ++q) v[rr][q] = *(const f32x4*)(s + rr * 1024 + q * 4);
#pragma unroll
      for (int rr = 0; rr < 2; ++rr) {
        float m = 0.f;
#pragma unroll
        for (int q = 0; q < 4; ++q) m = fmaxf(m, fmaxf(fmaxf(fabsf(v[rr][q][0]), fabsf(v[rr][q][1])), fmaxf(fabsf(v[rr][q][2]), fabsf(v[rr][q][3]))));
#pragma unroll
        for (int o = 32; o > 0; o >>= 1) m = fmaxf(m, __shfl_xor(m, o));
        const float scale = m > 0.f ? m * (1.f / 400.f) : 1.f;
        const float inv = 1.f / scale;
        unsigned wv[4];
#pragma unroll
        for (int q = 0; q < 4; ++q) {
          unsigned w = 0;
          w = __builtin_amdgcn_cvt_pk_fp8_f32(v[rr][q][0] * inv, v[rr][q][1] * inv, w, false);
          w = __builtin_amdgcn_cvt_pk_fp8_f32(v[rr][q][2] * inv, v[rr][q][3] * inv, w, true);
          wv[q] = w;
        }
        *(uint4*)((tab ? p.ev8 : p.eu8) + (size_t)(r0 + rr) * 1024 + lane * 16) = make_uint4(wv[0], wv[1], wv[2], wv[3]);
        if (lane == 0) (tab ? p.sv : p.su)[r0 + rr] = scale;
      }
}

__device__ __forceinline__ void phase_wprep(const Params& p, int bid, int nblk, unsigned char* smem) {
  float* tile = (float*)smem;
  const int tid = opaque_tid();
  const int NT_L = 360;
  const int n_tr = 2 * NT_L;
  const int n_keys = 256 + 64;
  const int n_disc = 8;
  const int n_exp = 2048;
  const int n_s5t = 512;
  const int total = n_tr + n_keys + n_disc + n_exp + n_s5t;
  for (int item0 = bid; item0 < total; item0 += nblk) {
    const int item = item0 - n_s5t;
    if (item0 < n_s5t) {
      s5_tables(p, item0 >> 3, item0 & 7, smem);
    } else if (item < n_tr) {
      const int l = item / NT_L;
      int t = item % NT_L;
      if (t < 160) {
        transpose_tile(p.w_in + (size_t)l * 1024 * INW, INW, p.wt_in + (size_t)l * INWP * 1024, 1024, (t % 4) * 256, (t / 4) * 64, INW, 0, tile);
      } else if (t < 224) {
        t -= 160;
        transpose_tile(p.w_out + (size_t)l * 1024 * 1024, 1024, p.wt_out + (size_t)l * 1024 * 1024, 1024, (t % 4) * 256, (t / 4) * 64, 1024, 0, tile);
      } else if (t < 352) {
        t -= 224;
        transpose_tile(p.w_query + (size_t)l * 1024 * 2048, 2048, p.wt_q + (size_t)l * 2048 * 1024, 1024, (t % 4) * 256, (t / 4) * 64, 2048, 0, tile);
      } else {
        t -= 352;
        transpose_tile(p.w_glu + (size_t)l * 256 * 512, 512, p.wt_glu + (size_t)l * 512 * 256, 256, 0, t * 64, 512, 1, tile);
      }
    } else if (item < n_tr + n_keys) {
      const int ki = item - n_tr;
      if (ki < 256) {
        const int base = ki * 2048;
        for (int i = tid; i < 2048; i += NT) p.keysb[base + i] = f2bf(p.sub_keys[base + i]);
      } else {
        const int base = (ki - 256) * 2048;
        for (int i = tid; i < 2048; i += NT) p.sgu_wb[base + i] = f2bf(p.sgu_w[base + i]);
      }
    } else if (item >= n_tr + n_keys + n_disc) {
      const int j = item - (n_tr + n_keys + n_disc);
      convert_rows(p, (j >> 10) * 2048 + (j & 1023), tid);
    } else {
      const int id = (item - n_tr - n_keys) * NT + tid;
      const int g = (id >> 6) & 15;
      const int ldg = id >> 6;
      double lre = (double)p.lam_re[id];
      if (lre > -1e-4) lre = -1e-4;
      const double lim = (double)p.lam_im[id];
      const double dt = exp((double)p.log_step[ldg]);
      const double mag = exp(lre * dt);
      const double are = mag * cos(lim * dt), aim = mag * sin(lim * dt);
      const double den = lre * lre + lim * lim;
      const double fre = ((are - 1.0) * lre + aim * lim) / den;
      const double fim = (aim * lre - (are - 1.0) * lim) / den;
      p.s5a[id * 2 + 0] = (float)are;
      p.s5a[id * 2 + 1] = (float)aim;
      double pr = are, pi = aim;
      for (int s = 0; s < 6; ++s) { const double nr = pr * pr - pi * pi, ni = 2.0 * pr * pi; pr = nr; pi = ni; }
      p.s5a64[id * 2 + 0] = (float)pr;
      p.s5a64[id * 2 + 1] = (float)pi;
      for (int h = 0; h < 16; ++h) {
        const double br = (double)p.b_re[(size_t)id * 16 + h], bi = (double)p.b_im[(size_t)id * 16 + h];
        p.s5bb[(size_t)id * 32 + h] = (float)(fre * br - fim * bi);
        p.s5bb[(size_t)id * 32 + 16 + h] = (float)(fre * bi + fim * br);
      }
      (void)g;
    }
  }
}

__device__ __forceinline__ void phase_normmod(const Params& p, const float* src_l, const float* src_c, const float* gain, const float* modl, int shift_off, int scale_off,
                              int ntok, int copy, int bid, int nblk) {
  const int tid = opaque_tid(); const int lane = tid & 63, wid = tid >> 6;
  for (int t = bid * NW + wid; t < ntok; t += nblk * NW) {
    const float* row = t < TL ? src_l + (size_t)t * 1024 : src_c + (size_t)(t - TL) * 1024;
    const float* md = modl + (size_t)tok_batch(t) * NMOD;
    f32x4 v[4];
    float ss = 0.f;
#pragma unroll
    for (int j = 0; j < 4; ++j) {
      v[j] = *(const f32x4*)(row + j * 256 + lane * 4);
      ss += v[j][0] * v[j][0] + v[j][1] * v[j][1] + v[j][2] * v[j][2] + v[j][3] * v[j][3];
    }
    ss = wave_sum(ss);
    const float rstd = rsqrtf(ss * (1.f / 1024.f) + EPSV);
#pragma unroll
    for (int j = 0; j < 4; ++j) {
      const int c0 = j * 256 + lane * 4;
      const f32x4 g = *(const f32x4*)(gain + c0);
      const f32x4 sh = *(const f32x4*)(md + shift_off + c0);
      const f32x4 sc = *(const f32x4*)(md + scale_off + c0);
      ushort4 o;
      o.x = f2bf(v[j][0] * rstd * g[0] * (1.f + sc[0]) + sh[0]);
      o.y = f2bf(v[j][1] * rstd * g[1] * (1.f + sc[1]) + sh[1]);
      o.z = f2bf(v[j][2] * rstd * g[2] * (1.f + sc[2]) + sh[2]);
      o.w = f2bf(v[j][3] * rstd * g[3] * (1.f + sc[3]) + sh[3]);
      *(ushort4*)(p.abuf + (size_t)t * 1024 + c0) = o;
      if (copy) *(f32x4*)(p.xres + (size_t)t * 1024 + c0) = v[j];
    }
  }
}

namespace pg8 {
#define PG8_LAS __attribute__((address_space(3)))
typedef unsigned u32x4 __attribute__((ext_vector_type(4)));
constexpr int BM = 256, BK = 64, HALF = 128, HTB = HALF * BK * 2, STAGE_BYTES = 8 * HTB, NXCD = 8, WGM = 8;
__device__ __forceinline__ int lds_byte(int r, int c) { const int st = (r >> 4) * 2 + (c >> 5), rr = r & 15, cc = c & 31, ob = rr * 64 + cc * 2; return st * 1024 + (ob ^ (((ob >> 9) & 1) << 5)); }
__device__ __forceinline__ void stage_rc(int b, int& R, int& C) { const int st = b / 1024, sb = b % 1024, swz = sb ^ (((sb >> 9) & 1) << 5); R = (st >> 1) * 16 + swz / 64; C = (st & 1) * 32 + (swz % 64) / 2; }
__device__ __forceinline__ int perm32(int rho) { const int n = rho >> 4, i = rho & 15; return 8 * (i >> 2) + 4 * n + (i & 3); }
struct Unit { int pm, pn; };
struct Gemm { const bf16_t* A; const bf16_t* Bt; int M, N, K; };
struct StaticOrder {
  int nM, nN, nwg, G, c;
  __device__ void init(int M, int N, int G_, int c_) { nM = M / BM; nN = N / BM; nwg = nM * nN; G = G_; c = c_; }
  __device__ bool next(int i, Unit& u) const {
    const long L = (long)i * G + c; if (L >= nwg) return false;
    int wgid = (int)L; { const int q = nwg / NXCD, r = nwg % NXCD, xcd = wgid % NXCD, off = wgid / NXCD; wgid = (xcd < r ? xcd * (q + 1) : r * (q + 1) + (xcd - r) * q) + off; }
    const int nig = WGM * nN, gid = wgid / nig, fm = gid * WGM, gsz = (nM - fm) < WGM ? (nM - fm) : WGM;
    u.pm = fm + ((wgid % nig) % gsz); u.pn = (wgid % nig) / gsz; return true;
  }
};
__device__ __forceinline__ unsigned cvt_pk_bf16(float lo, float hi) { unsigned r; asm volatile("v_cvt_pk_bf16_f32 %0, %1, %2" : "=v"(r) : "v"(lo), "v"(hi)); return r; }

template <class Epi>
__device__ __forceinline__ void gemm_phase(PG8_LAS unsigned char* lds, const Gemm g, const StaticOrder& S, const Epi& E) {
  const int tid = opaque_tid(), wid = __builtin_amdgcn_readfirstlane(tid >> 6), lane = tid & 63, wr = wid >> 2, wc = wid & 3, fr = lane & 15, fq = lane >> 4;
  const int K = g.K, nt = K / BK;
  unsigned voffA[2], voffB[2];
#pragma unroll
  for (int i = 0; i < 2; ++i) { int R, C; stage_rc(tid * 16 + i * 8192, R, C); const int Rb = Epi::PERM ? ((R & ~31) + perm32(R & 31)) : R;
    voffA[i] = (unsigned)(R * K + C) * 2u; voffB[i] = (unsigned)(Rb * K + C) * 2u; }
  const size_t kstep = (size_t)(BK * 2);
  const size_t hstep = (size_t)HALF * K * 2;
  const size_t tstep = 2 * hstep;
  const unsigned ldsw = (unsigned)wid * 1024u;
  const int aoff = lds_byte(wr * 64 + fr, fq * 8), boff = lds_byte(wc * 32 + fr, fq * 8);
#define PG8_SA(b, h) (((b) * 2 + (h)) * HTB)
#define PG8_SB(b, h) ((4 + (b) * 2 + (h)) * HTB)
#define PG8_STAGE(bufoff, gbase, voff) do { _Pragma("unroll") for (int _i = 0; _i < 2; ++_i) \
    __builtin_amdgcn_global_load_lds((const unsigned*)((const char*)(gbase) + (voff)[_i]), (PG8_LAS unsigned*)(lds + (bufoff) + ldsw + _i * 8192), 16, 0, 0); } while (0)
#define PG8_LDA(dst, b, h) do { _Pragma("unroll") for (int m = 0; m < 4; ++m) _Pragma("unroll") for (int k = 0; k < 2; ++k) dst[m][k] = *(const PG8_LAS bf16x8*)(lds + PG8_SA(b, h) + aoff + m * 2048 + k * 1024); } while (0)
#define PG8_LDB(dst, b, h) do { _Pragma("unroll") for (int n = 0; n < 2; ++n) _Pragma("unroll") for (int k = 0; k < 2; ++k) dst[n][k] = *(const PG8_LAS bf16x8*)(lds + PG8_SB(b, h) + boff + n * 2048 + k * 1024); } while (0)
#define PG8_MMA(ai, bj, At, Bt) do { __builtin_amdgcn_s_setprio(1); _Pragma("unroll") for (int m = 0; m < 4; ++m) _Pragma("unroll") for (int n = 0; n < 2; ++n) _Pragma("unroll") for (int k = 0; k < 2; ++k) \
    acc[ai][bj][m][n] = __builtin_amdgcn_mfma_f32_16x16x32_bf16(Bt[n][k], At[m][k], acc[ai][bj][m][n], 0, 0, 0); __builtin_amdgcn_s_setprio(0); } while (0)
#define PG8_WAIT_V(n) asm volatile("s_waitcnt vmcnt(" #n ")" ::: "memory")
#define PG8_WAIT_L(n) asm volatile("s_waitcnt lgkmcnt(" #n ")" ::: "memory")
#define PG8_BAR __builtin_amdgcn_s_barrier()
#define PG8_SCHED __builtin_amdgcn_sched_barrier(0)
  Unit cur, nxt; int ui = 0;
  if (!S.next(0, cur)) return;
  f32x4 acc[2][2][4][2];
#pragma unroll
  for (int a = 0; a < 2; ++a)
#pragma unroll
    for (int b = 0; b < 2; ++b)
#pragma unroll
      for (int m = 0; m < 4; ++m)
#pragma unroll
        for (int n = 0; n < 2; ++n) acc[a][b][m][n] = (f32x4){0.f, 0.f, 0.f, 0.f};
  bf16x8 At[4][2], B0[2][2], B1[2][2];
  const char* cA = (const char*)g.A + (size_t)cur.pm * tstep; const char* cB = (const char*)g.Bt + (size_t)cur.pn * tstep;
  PG8_STAGE(PG8_SB(0, 0), cB, voffB); PG8_STAGE(PG8_SA(0, 0), cA, voffA); PG8_STAGE(PG8_SB(0, 1), cB + hstep, voffB); PG8_STAGE(PG8_SA(0, 1), cA + hstep, voffA);
  if (wr == 1) PG8_BAR;
  PG8_WAIT_V(4); PG8_BAR;
  PG8_STAGE(PG8_SB(1, 0), cB + kstep, voffB); PG8_STAGE(PG8_SA(1, 0), cA + kstep, voffA); PG8_STAGE(PG8_SB(1, 1), cB + hstep + kstep, voffB);
  PG8_WAIT_V(6); PG8_BAR;
  for (;;) {
    const bool has_next = S.next(ui + 1, nxt);
    const char* nA = has_next ? (const char*)g.A + (size_t)nxt.pm * tstep : cA; const char* nB = has_next ? (const char*)g.Bt + (size_t)nxt.pn * tstep : cB;
#pragma unroll 1
    for (int t = 0; t < nt; t += 2) {
      const bool last = (t == nt - 2);
      const char* a1 = cA + (size_t)(t + 1) * kstep;
      const char* a2 = last ? nA : cA + (size_t)(t + 2) * kstep; const char* b2 = last ? nB : cB + (size_t)(t + 2) * kstep;
      const char* a3 = a2 + kstep; const char* b3 = b2 + kstep;
      PG8_LDB(B0, 0, 0); PG8_SCHED; PG8_LDA(At, 0, 0); PG8_STAGE(PG8_SA(1, 1), a1 + hstep, voffA);
      PG8_WAIT_L(8); PG8_BAR; PG8_WAIT_L(0); PG8_MMA(0, 0, At, B0); PG8_BAR; PG8_SCHED;
      PG8_LDB(B1, 0, 1); PG8_STAGE(PG8_SB(0, 0), b2, voffB);
      PG8_BAR; PG8_WAIT_L(0); PG8_MMA(0, 1, At, B1); PG8_BAR;
      PG8_LDA(At, 0, 1); PG8_STAGE(PG8_SA(0, 0), a2, voffA);
      PG8_BAR; PG8_WAIT_L(0); PG8_MMA(1, 0, At, B0); PG8_BAR; PG8_SCHED;
      PG8_STAGE(PG8_SB(0, 1), b2 + hstep, voffB);
      PG8_WAIT_V(6); PG8_BAR; PG8_MMA(1, 1, At, B1); PG8_BAR;
      PG8_LDB(B0, 1, 0); PG8_SCHED; PG8_LDA(At, 1, 0); PG8_STAGE(PG8_SA(0, 1), a2 + hstep, voffA);
      PG8_WAIT_L(8); PG8_BAR; PG8_WAIT_L(0); PG8_MMA(0, 0, At, B0); PG8_BAR; PG8_SCHED;
      PG8_LDB(B1, 1, 1); PG8_STAGE(PG8_SB(1, 0), b3, voffB);
      PG8_BAR; PG8_WAIT_L(0); PG8_MMA(0, 1, At, B1); PG8_BAR;
      PG8_LDA(At, 1, 1); PG8_STAGE(PG8_SA(1, 0), a3, voffA);
      PG8_BAR; PG8_WAIT_L(0); PG8_MMA(1, 0, At, B0); PG8_BAR; PG8_SCHED;
      PG8_STAGE(PG8_SB(1, 1), b3 + hstep, voffB);
      PG8_WAIT_V(6); PG8_BAR; PG8_MMA(1, 1, At, B1); PG8_BAR;
    }
    E(acc, cur, wr, wc, fr, fq);
    if (!has_next) break;
#pragma unroll
    for (int a = 0; a < 2; ++a)
#pragma unroll
      for (int b = 0; b < 2; ++b)
#pragma unroll
        for (int m = 0; m < 4; ++m)
#pragma unroll
          for (int n = 0; n < 2; ++n) acc[a][b][m][n] = (f32x4){0.f, 0.f, 0.f, 0.f};
    cur = nxt; cA = nA; cB = nB; ++ui;
  }
  PG8_WAIT_V(0);
  if (wr == 0) PG8_BAR;
  PG8_BAR;
#undef PG8_SA
#undef PG8_SB
#undef PG8_STAGE
#undef PG8_LDA
#undef PG8_LDB
#undef PG8_MMA
#undef PG8_WAIT_V
#undef PG8_WAIT_L
#undef PG8_BAR
#undef PG8_SCHED
}

struct EpiBf16 {
  static constexpr bool PERM = true;
  bf16_t* O; int ldc; int ncols;
  __device__ __forceinline__ void operator()(const f32x4 (&acc)[2][2][4][2], const Unit& u, int wr, int wc, int fr, int fq) const {
    const int row0 = u.pm * BM + wr * 64 + fr, col0 = u.pn * BM + wc * 32 + 8 * fq;
#pragma unroll
    for (int ai = 0; ai < 2; ++ai)
#pragma unroll
      for (int m = 0; m < 4; ++m) {
        bf16_t* rowp = O + (size_t)(row0 + ai * HALF + m * 16) * ldc + col0;
#pragma unroll
        for (int bj = 0; bj < 2; ++bj) {
          if (col0 + bj * HALF < ncols) {
            const f32x4 v0 = acc[ai][bj][m][0], v1 = acc[ai][bj][m][1];
            u32x4 w; w.x = cvt_pk_bf16(v0[0], v0[1]); w.y = cvt_pk_bf16(v0[2], v0[3]); w.z = cvt_pk_bf16(v1[0], v1[1]); w.w = cvt_pk_bf16(v1[2], v1[3]);
            *(u32x4*)(rowp + bj * HALF) = w;
          }
        }
      }
  }
};
struct EpiResid {
  static constexpr bool PERM = false;
  float* xres; const float* modl; int gate_off;
  __device__ __forceinline__ void operator()(const f32x4 (&acc)[2][2][4][2], const Unit& u, int wr, int wc, int fr, int fq) const {
    const int row0 = u.pm * BM + wr * 64 + fr, col0 = u.pn * BM + wc * 32 + 4 * fq;
#pragma unroll
    for (int ai = 0; ai < 2; ++ai)
#pragma unroll
      for (int m = 0; m < 4; ++m) {
        const int row = row0 + ai * HALF + m * 16;
        float* rowp = xres + (size_t)row * 1024 + col0;
        const float* md = modl + (size_t)tok_batch(row) * NMOD + gate_off + col0;
#pragma unroll
        for (int bj = 0; bj < 2; ++bj)
#pragma unroll
          for (int n = 0; n < 2; ++n) {
            const f32x4 g = *(const f32x4*)(md + bj * HALF + n * 16);
            f32x4 x = *(const f32x4*)(rowp + bj * HALF + n * 16);
            x += g * acc[ai][bj][m][n];
            *(f32x4*)(rowp + bj * HALF + n * 16) = x;
          }
      }
  }
};
struct EpiGlu {
  static constexpr bool PERM = true;
  bf16_t* mix;
  __device__ __forceinline__ void operator()(const f32x4 (&acc)[2][2][4][2], const Unit& u, int wr, int wc, int fr, int fq) const {
    const int row0 = u.pm * BM + wr * 64 + fr, col0 = 256 + u.pn * HALF + wc * 32 + 8 * fq;
#pragma unroll
    for (int ai = 0; ai < 2; ++ai)
#pragma unroll
      for (int m = 0; m < 4; ++m) {
        float v[8];
#pragma unroll
        for (int n = 0; n < 2; ++n)
#pragma unroll
          for (int j = 0; j < 4; ++j) v[n * 4 + j] = acc[ai][0][m][n][j] * sigmoid_f(acc[ai][1][m][n][j]);
        u32x4 w; w.x = cvt_pk_bf16(v[0], v[1]); w.y = cvt_pk_bf16(v[2], v[3]); w.z = cvt_pk_bf16(v[4], v[5]); w.w = cvt_pk_bf16(v[6], v[7]);
        *(u32x4*)(mix + (size_t)(row0 + ai * HALF + m * 16) * 1024 + col0) = w;
        __builtin_amdgcn_sched_barrier(0);
      }
  }
};
}

#define VNT_STRIDE 136
__device__ __forceinline__ void phase_sgu(const Params& p, int layer, int nchunks, int bid, int nblk, unsigned char* smem) {
  bf16_t* vnT = (bf16_t*)smem;
  const int tid = opaque_tid(); const int lane = tid & 63, wid = tid >> 6;
  const int fr = lane & 15, fq = lane >> 4;
  for (int item = bid; item < nchunks * 4; item += nblk) {
    const int ch = item >> 2, h = item & 3;
    const int tok0 = ch * 128;
    {
      const int s = tid >> 2, q = tid & 3;
      const bf16_t* vrow = p.cols + (size_t)(tok0 + s) * INW + C_SGU_V + h * 64 + q * 16;
      const uint4 r0 = *(const uint4*)vrow, r1 = *(const uint4*)(vrow + 8);
      float gv[16];
      gv[0] = bflo(r0.x); gv[1] = bfhi(r0.x); gv[2] = bflo(r0.y); gv[3] = bfhi(r0.y); gv[4] = bflo(r0.z); gv[5] = bfhi(r0.z); gv[6] = bflo(r0.w); gv[7] = bfhi(r0.w);
      gv[8] = bflo(r1.x); gv[9] = bfhi(r1.x); gv[10] = bflo(r1.y); gv[11] = bfhi(r1.y); gv[12] = bflo(r1.z); gv[13] = bfhi(r1.z); gv[14] = bflo(r1.w); gv[15] = bfhi(r1.w);
      float ss = 0.f;
#pragma unroll
      for (int d = 0; d < 16; ++d) { gv[d] = gelu_f(gv[d]); ss += gv[d] * gv[d]; }
      ss += __shfl_xor(ss, 1);
      ss += __shfl_xor(ss, 2);
      const float rstd = rsqrtf(ss * (1.f / 64.f) + EPSV);
#pragma unroll
      for (int d = 0; d < 16; ++d) vnT[(q * 16 + d) * VNT_STRIDE + s] = f2bf(gv[d] * rstd);
    }
    __syncthreads();
    {
      const bf16_t* wrow = p.sgu_wb + (((size_t)layer * 4 + h) * 128 + wid * 16 + fr) * 128 + fq * 8;
      f32x4 acc[4];
#pragma unroll
      for (int n = 0; n < 4; ++n) acc[n] = (f32x4){0.f, 0.f, 0.f, 0.f};
#pragma unroll
      for (int ks = 0; ks < 4; ++ks) {
        const bf16x8 a = *(const bf16x8*)(wrow + ks * 32);
#pragma unroll
        for (int n = 0; n < 4; ++n) {
          const bf16x8 b = *(const bf16x8*)(vnT + (n * 16 + fr) * VNT_STRIDE + ks * 32 + fq * 8);
          acc[n] = __builtin_amdgcn_mfma_f32_16x16x32_bf16(a, b, acc[n], 0, 0, 0);
        }
      }
#pragma unroll
      for (int j = 0; j < 4; ++j) {
        const int t = wid * 16 + fq * 4 + j;
        const float bs = p.sgu_b[((size_t)layer * 4 + h) * 128 + t];
        const bf16_t* urow = p.cols + (size_t)(tok0 + t) * INW + C_SGU_U + h * 64;
        bf16_t* orow = p.mix + (size_t)(tok0 + t) * 1024 + h * 64;
#pragma unroll
        for (int n = 0; n < 4; ++n) orow[n * 16 + fr] = f2bf(gelu_f(bf2f(urow[n * 16 + fr])) * (acc[n][j] + bs));
      }
    }
    __syncthreads();
  }
}

__device__ __forceinline__ void phase_s5a(const Params& p, int layer, int bid, int nblk, unsigned char* smem) {
  const int tid = opaque_tid(); const int lane = tid & 63, wid = tid >> 6, fr = lane & 15, fq = lane >> 4;
  const int ntask = 2 * 16 * 17 * 2;
  for (int task = wid * nblk + bid; task < ntask; task += nblk * NW) {
    const int nh = task & 1, t2 = task >> 1;
    const int dir = t2 / 272, rem = t2 % 272, g = rem / 17, mt = rem % 17;
    const bf16_t* tab = p.s5M1 + (size_t)((layer * 2 + dir) * 16 + g) * 131072 + (size_t)(nh * 64 + fr) * 1024 + fq * 8;
    const int scr = mt * 16 + fr;
    const bf16_t* ub = p.cols + C_S5 + g * 16 + (fq & 1) * 8;
    f32x4 acc[4];
#pragma unroll
    for (int n = 0; n < 4; ++n) acc[n] = (f32x4){0.f, 0.f, 0.f, 0.f};
#pragma unroll 8
    for (int ks = 0; ks < 32; ++ks) {
      const int tau = 2 * ks + (fq >> 1);
      const int i = dir ? 63 - tau : tau;
      const bf16x8 a = *(const bf16x8*)(ub + (size_t)s5_tok(scr, i) * INW);
#pragma unroll
      for (int n = 0; n < 4; ++n) {
        const bf16x8 b = *(const bf16x8*)(tab + (size_t)n * 16 * 1024 + ks * 32);
        acc[n] = __builtin_amdgcn_mfma_f32_16x16x32_bf16(a, b, acc[n], 0, 0, 0);
      }
    }
#pragma unroll
    for (int n = 0; n < 4; ++n)
#pragma unroll
      for (int j = 0; j < 4; ++j) p.s5S[(((size_t)dir * NSC + mt * 16 + fq * 4 + j) * 16 + g) * 128 + nh * 64 + n * 16 + fr] = acc[n][j];
  }
}

__device__ __forceinline__ int scan_sc(int s, int b, int dir) {
  return s < 4 ? 256 + b * 4 + (dir ? 3 - s : s) : b * 64 + (dir ? 63 - (s - 4) : (s - 4));
}
__device__ __forceinline__ void phase_scan(const Params& p, int layer, int bid, int nblk) {
  const int tid = opaque_tid();
  for (int item = bid; item < 16 + 256; item += nblk) {
    if (item < 16) {
      const int id = item * NT + tid;
      const int pp = id & 63, g = (id >> 6) & 15, b = (id >> 10) & 3, dir = id >> 12;
      const int pid = ((layer * 2 + dir) * 16 + g) * 64 + pp;
      const float ar = p.s5a64[pid * 2], ai = p.s5a64[pid * 2 + 1];
      float hr = 0.f, hi = 0.f;
      for (int s0 = 0; s0 < 68; s0 += 17) {
        float sr[17], si[17];
#pragma unroll
        for (int k = 0; k < 17; ++k) {
          const size_t o = (((size_t)dir * NSC + scan_sc(s0 + k, b, dir)) * 16 + g) * 128 + pp;
          sr[k] = p.s5S[o]; si[k] = p.s5S[o + 64];
        }
#pragma unroll
        for (int k = 0; k < 17; ++k) {
          const size_t o = (((size_t)dir * NSC + scan_sc(s0 + k, b, dir)) * 16 + g) * 128 + pp;
          p.s5H[o] = hr; p.s5H[o + 64] = hi;
          const float nr = ar * hr - ai * hi + sr[k];
          const float ni = ar * hi + ai * hr + si[k];
          hr = nr; hi = ni;
        }
      }
    } else {
      const int id = (item - 16) * NT + tid;
      const int e = id & 2047, h = (id >> 11) & 7, b = (id >> 14) & 3, dir = id >> 16;
      const int dk = e & 31;
      float S = 0.f;
      for (int s0 = 0; s0 < 68; s0 += 17) {
        float kv[17], dc[17];
#pragma unroll
        for (int k = 0; k < 17; ++k) {
          const size_t o = (((size_t)dir * NSC + scan_sc(s0 + k, b, dir)) * 8 + h);
          kv[k] = p.gkv[o * 2048 + e]; dc[k] = p.gdec[o * 32 + dk];
        }
#pragma unroll
        for (int k = 0; k < 17; ++k) {
          const size_t o = (((size_t)dir * NSC + scan_sc(s0 + k, b, dir)) * 8 + h);
          p.gkv[o * 2048 + e] = S;
          S = dc[k] * S + kv[k];
        }
      }
    }
  }
}

__device__ __forceinline__ bf16x8 s5_kfrag(const bf16_t* kb, int delta, int sh) {
  const int d = delta - sh;
  bf16x8 r = *(const bf16x8*)(kb + (size_t)(d < 0 ? 0 : d) * 256);
  if (d < 0) r = (bf16x8){0, 0, 0, 0, 0, 0, 0, 0};
  return r;
}
#define S5_UCH 1032
typedef const __attribute__((address_space(3))) bf16_t* lds_bf16_cp;
template <int DIR, bool DIAG>
__device__ __forceinline__ void s5_group8(f32x4 (&acc)[16], bf16x8 (&W)[16], const bf16_t* ul  , const bf16_t* kl  , int ks0, int E, int sh) {
  const bf16x8 zero8 = (bf16x8){0, 0, 0, 0, 0, 0, 0, 0};
#pragma unroll
  for (int j = 0; j < 8; ++j) {
    const int sigma = 2 * (ks0 + j) + sh;
    const bf16x8 a = *(const bf16x8*)(ul + (DIR ? 63 - sigma : sigma) * 16);
    bf16x8 n0 = zero8, n1 = zero8;
    if (!DIAG) {
      if (j + 1 < 8) { n0 = *(const bf16x8*)(kl + (E - 2 * (j + 1) - sh) * 256); n1 = *(const bf16x8*)(kl + (E - 2 * (j + 1) + 1 - sh) * 256); }
      else { n0 = s5_kfrag(kl, E - 16, sh); n1 = s5_kfrag(kl, E - 15, sh); }
    }
#pragma unroll
    for (int i = 0; i < 16; ++i) {
      if (!(DIAG && i < 2 * j)) {
        const int sl = DIR ? 15 - i : i;
        acc[sl] = __builtin_amdgcn_mfma_f32_16x16x32_bf16(a, W[(i - 2 * j) & 15], acc[sl], 0, 0, 0);
      }
    }
    if (!DIAG) { W[(16 - 2 * (j + 1)) & 15] = n0; W[(17 - 2 * (j + 1)) & 15] = n1; }
  }
}
template <int DIR>
__device__ __forceinline__ void s5_dir(f32x4 (&acc)[16], const Params& p, int layer, int g, int scr, int qd, int fr, int fq, const bf16_t* ul, const bf16_t* kl) {
  const int sh = fq >> 1;
  {
    bf16x8 W[16];
#pragma unroll
    for (int i = 0; i < 16; ++i) W[i] = s5_kfrag(kl, 16 * qd + i, sh);
    for (int c = 0; c < qd; ++c) s5_group8<DIR, false>(acc, W, ul, kl, 8 * c, 16 * (qd - c), sh);
    s5_group8<DIR, true>(acc, W, ul, kl, 8 * qd, 0, sh);
  }
  const size_t tb = (size_t)((layer * 2 + DIR) * 16 + g);
  const float* hin = p.s5H + (((size_t)DIR * NSC + scr) * 16 + g) * 128 + fq * 8;
  const bf16_t* n2 = p.s5N2 + tb * 131072 + (size_t)(16 * qd * 16 + fr) * 128 + fq * 8;
  bf16x8 ah[4];
#pragma unroll
  for (int ks = 0; ks < 4; ++ks) {
    const f32x4 h0 = *(const f32x4*)(hin + ks * 32), h1 = *(const f32x4*)(hin + ks * 32 + 4);
    const float h8[8] = {h0[0], h0[1], h0[2], h0[3], h1[0], h1[1], h1[2], h1[3]};
    ah[ks] = pack_bf16x8(h8);
  }
#pragma unroll
  for (int ks = 0; ks < 4; ++ks) {
    bf16x8 b[16];
#pragma unroll
    for (int i = 0; i < 16; ++i) b[i] = *(const bf16x8*)(n2 + (size_t)i * 16 * 128 + ks * 32);
#pragma unroll
    for (int i = 0; i < 16; ++i) {
      const int sl = DIR ? 15 - i : i;
      acc[sl] = __builtin_amdgcn_mfma_f32_16x16x32_bf16(ah[ks], b[i], acc[sl], 0, 0, 0);
    }
    __builtin_amdgcn_sched_barrier(0);
  }
}
__device__ __forceinline__ void phase_s5c(const Params& p, int layer, int nsc, int bid, int nblk, unsigned char* smem) {
  const int tid = opaque_tid(); const int lane = tid & 63, wid = tid >> 6;
  bf16_t* Kl = (bf16_t*)smem;
  bf16_t* Ul = Kl + 2 * 16384;
  const int nmt = nsc / 16, npair = (nmt + 1) / 2;
  const int ntask = 16 * npair;
  for (int task = bid; task < ntask; task += nblk) {
    const int g = task / npair, mt0 = (task % npair) * 2;
    __syncthreads();
    int tid_o = tid; asm volatile("" : "+v"(tid_o));
#pragma unroll
    for (int it = 0; it < 8; ++it) {
      const int e = it * NT + tid_o;
      const int dir = e >> 11, off = (e & 2047) * 8;
      *(uint4*)(Kl + dir * 16384 + off) = *(const uint4*)(p.s5K + (size_t)((layer * 2 + dir) * 16 + g) * 16384 + off);
    }
#pragma unroll
    for (int it = 0; it < 8; ++it) {
      const int e = it * NT + tid_o;
      const int hf = e & 1, tk = (e >> 1) & 63, chk = (e >> 7) & 15, tl = e >> 11;
      const int mt = mt0 + tl;
      uint4 v = make_uint4(0u, 0u, 0u, 0u);
      if (mt < nmt) v = *(const uint4*)(p.cols + (size_t)s5_tok(mt * 16 + chk, tk) * INW + C_S5 + g * 16 + hf * 8);
      *(uint4*)(Ul + (tl * 16 + chk) * S5_UCH + tk * 16 + hf * 8) = v;
    }
    __syncthreads();
    int lane_o = lane; asm volatile("" : "+v"(lane_o));
    const int fr = lane_o & 15, fq = lane_o >> 4;
    const int tl = wid >> 2, q = wid & 3, mt = mt0 + tl;
    if (mt < nmt) {
      const int scr = mt * 16 + fr;
      const bf16_t* ul = Ul + (tl * 16 + fr) * S5_UCH + (fq & 1) * 8;
      f32x4 acc[16];
#pragma unroll
      for (int i = 0; i < 16; ++i) acc[i] = (f32x4){0.f, 0.f, 0.f, 0.f};
      s5_dir<0>(acc, p, layer, g, scr, q, fr, fq, ul, Kl + fr * 16 + (fq & 1) * 8);
      s5_dir<1>(acc, p, layer, g, scr, 3 - q, fr, fq, ul, Kl + 16384 + fr * 16 + (fq & 1) * 8);
      const int ch = g * 16 + fr;
      const float dsk = p.s5_d[layer * 256 + ch];
#pragma unroll
      for (int j = 0; j < 4; ++j) {
        const int chk = fq * 4 + j;
        const size_t tok0 = (size_t)s5_tok(mt * 16 + chk, 16 * q);
        const bf16_t* up = Ul + (tl * 16 + chk) * S5_UCH + (16 * q) * 16 + fr;
        bf16_t* yp = p.yg + tok0 * 256 + ch;
#pragma unroll
        for (int i = 0; i < 16; ++i) {
          const float v = acc[i][j] + dsk * bf2f(up[i * 16]);
          yp[(size_t)i * 256] = f2bf(gelu_f(v));
        }
        __builtin_amdgcn_sched_barrier(0);
      }
    }
  }
  __syncthreads();
}

#define GL_VT_STRIDE 72
#define GL_LB_STRIDE 36
#define GL_HALF_BYTES (64 * 72 * 2 + 64 * 36 * 4 + 64 * 72 * 2)
__device__ __forceinline__ void unpack8(const uint4& r, float* v) {
  v[0] = bflo(r.x); v[1] = bfhi(r.x); v[2] = bflo(r.y); v[3] = bfhi(r.y); v[4] = bflo(r.z); v[5] = bfhi(r.z); v[6] = bflo(r.w); v[7] = bfhi(r.w);
}
__device__ __forceinline__ void gla_store_vT(const uint4& r0, const uint4& r1, bf16_t* vT, int ltid) {
  const int i = ltid & 63, part = ltid >> 6;
  const unsigned w[8] = {r0.x, r0.y, r0.z, r0.w, r1.x, r1.y, r1.z, r1.w};
#pragma unroll
  for (int e = 0; e < 8; ++e) {
    vT[(part * 16 + 2 * e) * GL_VT_STRIDE + i] = (bf16_t)(w[e] & 0xffffu);
    vT[(part * 16 + 2 * e + 1) * GL_VT_STRIDE + i] = (bf16_t)(w[e] >> 16);
  }
}
__device__ __forceinline__ void gla_logdecay(const Params& p, int layer, int sc, int h, int dir, const uint4& z0, const uint4& z1, float* lb, int ltid, float* glb) {
  const int lane = ltid & 63;
  const int wu = __builtin_amdgcn_readfirstlane(ltid >> 6);
  float z[16];
  unpack8(z0, z); unpack8(z1, z + 8);
  const float* wg = p.gla_wg + ((size_t)(layer * 2 + dir) * 16) * 256 + h * 32 + wu * 8;
  const float* bg = p.gla_bg + (layer * 2 + dir) * 256 + h * 32 + wu * 8;
  float la[8];
#pragma unroll
  for (int c = 0; c < 8; ++c) la[c] = bg[c];
#pragma unroll
  for (int r = 0; r < 16; ++r) {
#pragma unroll
    for (int c = 0; c < 8; ++c) la[c] += z[r] * wg[r * 256 + c];
  }
#pragma unroll
  for (int c = 0; c < 8; ++c) la[c] = (fminf(la[c], 0.f) - __logf(1.f + __expf(-fabsf(la[c])))) * (1.f / 16.f);
#pragma unroll
  for (int c = 0; c < 8; ++c) {
    float v = la[c];
    if (dir == 0) {
      v += __builtin_bit_cast(float, __builtin_amdgcn_update_dpp(0, __builtin_bit_cast(int, v), 0x111, 0xf, 0xf, true));
      v += __builtin_bit_cast(float, __builtin_amdgcn_update_dpp(0, __builtin_bit_cast(int, v), 0x112, 0xf, 0xf, true));
      v += __builtin_bit_cast(float, __builtin_amdgcn_update_dpp(0, __builtin_bit_cast(int, v), 0x114, 0xf, 0xf, true));
      v += __builtin_bit_cast(float, __builtin_amdgcn_update_dpp(0, __builtin_bit_cast(int, v), 0x118, 0xf, 0xf, true));
      const float t0 = __builtin_bit_cast(float, __builtin_amdgcn_readlane(__builtin_bit_cast(int, v), 15));
      const float t1 = __builtin_bit_cast(float, __builtin_amdgcn_readlane(__builtin_bit_cast(int, v), 31));
      const float t2 = __builtin_bit_cast(float, __builtin_amdgcn_readlane(__builtin_bit_cast(int, v), 47));
      const int row = lane >> 4;
      v += row == 0 ? 0.f : (row == 1 ? t0 : (row == 2 ? t0 + t1 : (t0 + t1) + t2));
    } else {
      v += __builtin_bit_cast(float, __builtin_amdgcn_update_dpp(0, __builtin_bit_cast(int, v), 0x101, 0xf, 0xf, true));
      v += __builtin_bit_cast(float, __builtin_amdgcn_update_dpp(0, __builtin_bit_cast(int, v), 0x102, 0xf, 0xf, true));
      v += __builtin_bit_cast(float, __builtin_amdgcn_update_dpp(0, __builtin_bit_cast(int, v), 0x104, 0xf, 0xf, true));
      v += __builtin_bit_cast(float, __builtin_amdgcn_update_dpp(0, __builtin_bit_cast(int, v), 0x108, 0xf, 0xf, true));
      const float t1 = __builtin_bit_cast(float, __builtin_amdgcn_readlane(__builtin_bit_cast(int, v), 16));
      const float t2 = __builtin_bit_cast(float, __builtin_amdgcn_readlane(__builtin_bit_cast(int, v), 32));
      const float t3 = __builtin_bit_cast(float, __builtin_amdgcn_readlane(__builtin_bit_cast(int, v), 48));
      const int row = lane >> 4;
      v += row == 3 ? 0.f : (row == 2 ? t3 : (row == 1 ? t3 + t2 : (t3 + t2) + t1));
    }
    la[c] = v;
  }
  *(f32x4*)(lb + lane * GL_LB_STRIDE + wu * 8) = (f32x4){la[0], la[1], la[2], la[3]};
  *(f32x4*)(lb + lane * GL_LB_STRIDE + wu * 8 + 4) = (f32x4){la[4], la[5], la[6], la[7]};
  float* gp = glb + ((size_t)dir * TT + gla_tok(sc, lane)) * 256 + h * 32 + wu * 8;
  *(f32x4*)gp = (f32x4){la[0], la[1], la[2], la[3]};
  *(f32x4*)(gp + 4) = (f32x4){la[4], la[5], la[6], la[7]};
}

struct GlaAPre { uint4 v0, v1, za0, za1, zb0, zb1, k; };
__device__ __forceinline__ GlaAPre glaa_prefetch(const Params& p, int item, int ltid) {
  const int sc = item >> 3, h = item & 7;
  const int i = ltid & 63, part = ltid >> 6;
  const bf16_t* row = p.cols + (size_t)gla_tok(sc, i) * INW;
  GlaAPre r;
  r.v0 = *(const uint4*)(row + C_GV + h * 64 + part * 16); r.v1 = *(const uint4*)(row + C_GV + h * 64 + part * 16 + 8);
  r.za0 = *(const uint4*)(row + C_ZF); r.za1 = *(const uint4*)(row + C_ZF + 8);
  r.zb0 = *(const uint4*)(row + C_ZF + 16); r.zb1 = *(const uint4*)(row + C_ZF + 24);
  r.k = *(const uint4*)(row + C_GK + h * 32 + part * 8);
  return r;
}
__device__ __forceinline__ void phase_glaa(const Params& p, int layer, int bid, int nblk, unsigned char* smem) {
  const int tid = opaque_tid(); const int half = __builtin_amdgcn_readfirstlane(tid >> 8), ltid = tid & 255;
  const int lane = tid & 63, w = ltid >> 6, fr = lane & 15, fq = lane >> 4;
  bf16_t* vT = (bf16_t*)(smem + half * GL_HALF_BYTES);
  float* lb = (float*)(vT + 64 * GL_VT_STRIDE);
  bf16_t* kT = (bf16_t*)(lb + 64 * GL_LB_STRIDE);
  const int nit = NSC * 8 / 2;
  if (bid >= nit) return;
  GlaAPre cur = glaa_prefetch(p, bid * 2 + half, ltid);
  for (int it = bid; it < nit; it += nblk) {
    const int item = it * 2 + half;
    const int sc = item >> 3, h = item & 7;
    const int itn = it + nblk < nit ? it + nblk : it;
    const GlaAPre nxt = glaa_prefetch(p, itn * 2 + half, ltid);
    gla_store_vT(cur.v0, cur.v1, vT, ltid);
#pragma unroll
    for (int dir = 0; dir < 2; ++dir) {
      gla_logdecay(p, layer, sc, h, dir, dir ? cur.zb0 : cur.za0, dir ? cur.zb1 : cur.za1, lb, ltid, p.glb);
      __syncthreads();
      const int ilast = dir ? 0 : 63;
      {
        const int i = ltid & 63, part = ltid >> 6;
        float kv8[8];
        unpack8(cur.k, kv8);
#pragma unroll
        for (int c = 0; c < 8; ++c) {
          const int dk = part * 8 + c;
          kT[dk * GL_VT_STRIDE + i] = f2bf(kv8[c] * __expf(lb[ilast * GL_LB_STRIDE + dk] - lb[i * GL_LB_STRIDE + dk]));
        }
      }
      const size_t o = (((size_t)dir * NSC + sc) * 8 + h);
      if (ltid < 32) p.gdec[o * 32 + ltid] = __expf(lb[ilast * GL_LB_STRIDE + ltid]);
      __syncthreads();
      {
        f32x4 acc[2];
        acc[0] = (f32x4){0.f, 0.f, 0.f, 0.f}; acc[1] = acc[0];
#pragma unroll
        for (int ks = 0; ks < 2; ++ks) {
          const bf16x8 b = *(const bf16x8*)(vT + (w * 16 + fr) * GL_VT_STRIDE + ks * 32 + fq * 8);
#pragma unroll
          for (int m = 0; m < 2; ++m) {
            const bf16x8 a = *(const bf16x8*)(kT + (m * 16 + fr) * GL_VT_STRIDE + ks * 32 + fq * 8);
            acc[m] = __builtin_amdgcn_mfma_f32_16x16x32_bf16(a, b, acc[m], 0, 0, 0);
          }
        }
#pragma unroll
        for (int m = 0; m < 2; ++m) *(f32x4*)(p.gkv + o * 2048 + (size_t)(w * 16 + fr) * 32 + m * 16 + fq * 4) = acc[m];
      }
      __syncthreads();
    }
    cur = nxt;
  }
}

__device__ __forceinline__ void gl_load8(const float* g, float* v) {
  const f32x4 a = *(const f32x4*)g, b = *(const f32x4*)(g + 4);
  v[0] = a[0]; v[1] = a[1]; v[2] = a[2]; v[3] = a[3]; v[4] = b[0]; v[5] = b[1]; v[6] = b[2]; v[7] = b[3];
}
#define GLC_HALF_BYTES (64 * 72 * 2 + 64 * 72 * 2 + 2 * 64 * 36 * 4 + 2 * 64 * 36 * 4)
struct GlaCPre { uint4 v0, v1, q, k[4], lb[2][2], st[2][2]; };
__device__ __forceinline__ GlaCPre glac_prefetch(const Params& p, int item, int ltid, int w, int fr, int fq) {
  const int sc = item >> 3, h = item & 7;
  GlaCPre r;
  {
    const int i = ltid & 63, part = ltid >> 6;
    const bf16_t* row = p.cols + (size_t)gla_tok(sc, i) * INW + C_GV + h * 64 + part * 16;
    r.v0 = *(const uint4*)row; r.v1 = *(const uint4*)(row + 8);
  }
  r.q = *(const uint4*)(p.cols + (size_t)gla_tok(sc, w * 16 + fr) * INW + C_GQ + h * 32 + fq * 8);
#pragma unroll
  for (int n = 0; n < 4; ++n) r.k[n] = *(const uint4*)(p.cols + (size_t)gla_tok(sc, n * 16 + fr) * INW + C_GK + h * 32 + fq * 8);
  {
    const int i = ltid >> 2, piece = ltid & 3;
#pragma unroll
    for (int dir = 0; dir < 2; ++dir) {
      const float* g = p.glb + ((size_t)dir * TT + gla_tok(sc, i)) * 256 + h * 32 + piece * 8;
      r.lb[dir][0] = *(const uint4*)g; r.lb[dir][1] = *(const uint4*)(g + 4);
      const float* s = p.gkv + (((size_t)dir * NSC + sc) * 8 + h) * 2048 + i * 32 + piece * 8;
      r.st[dir][0] = *(const uint4*)s; r.st[dir][1] = *(const uint4*)(s + 4);
    }
  }
  return r;
}
#define GLC_BONUS 4
__device__ __forceinline__ void phase_glac(const Params& p, int layer, int nsc, int nbusy, int bid, int nblk, unsigned char* smem) {
  const int tid = opaque_tid(); const int half = __builtin_amdgcn_readfirstlane(tid >> 8), ltid = tid & 255;
  const int lane = tid & 63, w = ltid >> 6, fr = lane & 15, fq = lane >> 4;
  bf16_t* vT = (bf16_t*)(smem + half * GLC_HALF_BYTES);
  bf16_t* Pw = vT + 64 * GL_VT_STRIDE + w * 16 * GL_VT_STRIDE;
  float* lbT = (float*)(vT + 2 * 64 * GL_VT_STRIDE);
  float* ST = lbT + 2 * 64 * GL_LB_STRIDE;
  const int nit = nsc * 4;
  const int nfree = nblk - nbusy;
  const int nbonus = (nbusy > 0 && nfree > 0 && nfree * GLC_BONUS < nit) ? nfree * GLC_BONUS : 0;
  auto itof = [&](int k) -> int {
    if (nbonus == 0) return bid + k * nblk;
    if (bid >= nbusy) return k < GLC_BONUS ? k * nfree + (bid - nbusy) : nbonus + bid + (k - GLC_BONUS) * nblk;
    return nbonus + bid + k * nblk;
  };
  if (itof(0) >= nit) return;
  GlaCPre cur = glac_prefetch(p, itof(0) * 2 + half, ltid, w, fr, fq);
  for (int kk = 0; itof(kk) < nit; ++kk) {
    const int it = itof(kk);
    const int item = it * 2 + half;
    const int sc = item >> 3, h = item & 7;
    __syncthreads();
    gla_store_vT(cur.v0, cur.v1, vT, ltid);
    {
      const int i = ltid >> 2, piece = ltid & 3;
#pragma unroll
      for (int dir = 0; dir < 2; ++dir) {
        *(uint4*)(lbT + (dir * 64 + i) * GL_LB_STRIDE + piece * 8) = cur.lb[dir][0]; *(uint4*)(lbT + (dir * 64 + i) * GL_LB_STRIDE + piece * 8 + 4) = cur.lb[dir][1];
        *(uint4*)(ST + (dir * 64 + i) * GL_LB_STRIDE + piece * 8) = cur.st[dir][0]; *(uint4*)(ST + (dir * 64 + i) * GL_LB_STRIDE + piece * 8 + 4) = cur.st[dir][1];
      }
    }
    const int itn = itof(kk + 1) < nit ? itof(kk + 1) : it;
    const GlaCPre nxt = glac_prefetch(p, itn * 2 + half, ltid, w, fr, fq);
    __syncthreads();
    f32x4 o[4];
#pragma unroll
    for (int n = 0; n < 4; ++n) o[n] = (f32x4){0.f, 0.f, 0.f, 0.f};
#pragma unroll
    for (int dir = 0; dir < 2; ++dir) {
      const float* lbd = lbT + dir * 64 * GL_LB_STRIDE + fq * 8;
      float bref[8], bt[8];
      gl_load8(lbd + (dir ? 31 : 32) * GL_LB_STRIDE, bref);
      gl_load8(lbd + (w * 16 + fr) * GL_LB_STRIDE, bt);
      bf16x8 aqs, aqe;
      {
        float q8[8], s8[8], e8[8];
        unpack8(cur.q, q8);
#pragma unroll
        for (int c = 0; c < 8; ++c) {
          const float qx = q8[c] * 0.17677669529663687f;
          s8[c] = qx * __expf(bt[c] - bref[c]);
          e8[c] = qx * __expf(bt[c]);
        }
        aqs = pack_bf16x8(s8); aqe = pack_bf16x8(e8);
      }
#pragma unroll
      for (int n = 0; n < 4; ++n) {
        const int s = n * 16 + fr;
        float k8[8], bs[8];
        unpack8(cur.k[n], k8);
        gl_load8(lbd + s * GL_LB_STRIDE, bs);
#pragma unroll
        for (int c = 0; c < 8; ++c) k8[c] *= __expf(bref[c] - bs[c]);
        const bf16x8 bks = pack_bf16x8(k8);
        const f32x4 sa = __builtin_amdgcn_mfma_f32_16x16x32_bf16(aqs, bks, (f32x4){0.f, 0.f, 0.f, 0.f}, 0, 0, 0);
#pragma unroll
        for (int j = 0; j < 4; ++j) {
          const int t = w * 16 + fq * 4 + j;
          const bool ok = dir ? (s >= t) : (s <= t);
          Pw[(fq * 4 + j) * GL_VT_STRIDE + s] = f2bf(ok ? sa[j] : 0.f);
        }
      }
      __builtin_amdgcn_wave_barrier();
#pragma unroll
      for (int ks = 0; ks < 2; ++ks) {
        const bf16x8 ap = *(const bf16x8*)(Pw + fr * GL_VT_STRIDE + ks * 32 + fq * 8);
#pragma unroll
        for (int n = 0; n < 4; ++n) {
          const bf16x8 bv = *(const bf16x8*)(vT + (n * 16 + fr) * GL_VT_STRIDE + ks * 32 + fq * 8);
          o[n] = __builtin_amdgcn_mfma_f32_16x16x32_bf16(ap, bv, o[n], 0, 0, 0);
        }
      }
      __builtin_amdgcn_wave_barrier();
      {
        const float* Sg = ST + dir * 64 * GL_LB_STRIDE + fq * 8;
#pragma unroll
        for (int n = 0; n < 4; ++n) {
          float s8[8];
          gl_load8(Sg + (n * 16 + fr) * GL_LB_STRIDE, s8);
          const bf16x8 bS = pack_bf16x8(s8);
          o[n] = __builtin_amdgcn_mfma_f32_16x16x32_bf16(aqe, bS, o[n], 0, 0, 0);
        }
      }
    }
    __builtin_amdgcn_wave_barrier();
#pragma unroll
    for (int j = 0; j < 4; ++j) {
      float ss = o[0][j] * o[0][j] + o[1][j] * o[1][j] + o[2][j] * o[2][j] + o[3][j] * o[3][j];
      ss += __shfl_xor(ss, 1); ss += __shfl_xor(ss, 2); ss += __shfl_xor(ss, 4); ss += __shfl_xor(ss, 8);
      const float rstd = rsqrtf(ss * (1.f / 64.f) + EPSV);
#pragma unroll
      for (int n = 0; n < 4; ++n) Pw[(fq * 4 + j) * GL_VT_STRIDE + n * 16 + fr] = f2bf(o[n][j] * rstd);
    }
    __builtin_amdgcn_wave_barrier();
    {
      const int tl = lane >> 2, dq = (lane & 3) * 16;
      const int tok = gla_tok(sc, w * 16 + tl);
      const bf16_t* grow = p.cols + (size_t)tok * INW + C_GG + h * 64 + dq;
      float ov[16], gv[16];
      unpack8(*(const uint4*)(Pw + tl * GL_VT_STRIDE + dq), ov); unpack8(*(const uint4*)(Pw + tl * GL_VT_STRIDE + dq + 8), ov + 8);
      unpack8(*(const uint4*)grow, gv); unpack8(*(const uint4*)(grow + 8), gv + 8);
      const float* ng = p.gla_ng + layer * 512 + h * 64 + dq;
      unsigned wv[8];
#pragma unroll
      for (int e = 0; e < 8; ++e) {
        const float a = ov[2 * e] * ng[2 * e] * silu_f(gv[2 * e]), b = ov[2 * e + 1] * ng[2 * e + 1] * silu_f(gv[2 * e + 1]);
        wv[e] = (unsigned)f2bf(a) | ((unsigned)f2bf(b) << 16);
      }
      bf16_t* orow = p.mix + (size_t)tok * 1024 + 512 + h * 64 + dq;
      *(uint4*)orow = make_uint4(wv[0], wv[1], wv[2], wv[3]);
      *(uint4*)(orow + 8) = make_uint4(wv[4], wv[5], wv[6], wv[7]);
    }
    __builtin_amdgcn_wave_barrier();
    cur = nxt;
  }
  __syncthreads();
}

__device__ __forceinline__ unsigned fkey(float f) { const unsigned u = __float_as_uint(f); return u ^ ((u >> 31) ? 0xFFFFFFFFu : 0x80000000u); }
__device__ __forceinline__ float funkey(unsigned k) { return __uint_as_float((k >> 31) ? (k ^ 0x80000000u) : ~k); }
__device__ __forceinline__ unsigned umax3(unsigned a, unsigned b) { return a > b ? a : b; }
__device__ __forceinline__ unsigned umin3(unsigned a, unsigned b) { return a < b ? a : b; }
__device__ __forceinline__ unsigned umed3(unsigned a, unsigned b, unsigned c) { return umax3(umin3(a, b), umin3(umax3(a, b), c)); }
__device__ __forceinline__ void top16_insert(unsigned (&L)[16], unsigned x) {
#pragma unroll
  for (int q = 15; q >= 1; --q) L[q] = umed3(L[q - 1], L[q], x);
  L[0] = umax3(L[0], x);
}
template <int XM>
__device__ __forceinline__ void top16_merge(unsigned (&L)[16]) {
  unsigned P[16];
#pragma unroll
  for (int i = 0; i < 16; ++i) P[i] = (unsigned)__shfl_xor((int)L[i], XM);
  unsigned M[16];
#pragma unroll
  for (int i = 0; i < 16; ++i) M[i] = umax3(L[i], P[15 - i]);
#pragma unroll
  for (int d = 8; d >= 1; d >>= 1) {
#pragma unroll
    for (int i = 0; i < 16; ++i) {
      if ((i & d) == 0) { const unsigned hi = umax3(M[i], M[i + d]), lo = umin3(M[i], M[i + d]); M[i] = hi; M[i + d] = lo; }
    }
  }
#pragma unroll
  for (int i = 0; i < 16; ++i) L[i] = M[i];
}
#define RT_MAX_ITEMS 5
__device__ __forceinline__ void phase_route(const Params& p, int layer, int ntok, int bid, int nblk, unsigned char* smem) {
  const int tid = opaque_tid(); const int lane = tid & 63, wid = tid >> 6;
  unsigned* lists_w = (unsigned*)smem + wid * (RT_MAX_ITEMS * 2 * 16 * 16);
  const int fr = lane & 15, fq = lane >> 4;
  const bf16_t* qb = p.cols;
  const int nitems = ntok / 16;
  static const unsigned char STAIR[52] = {0, 1, 2, 3, 4, 5, 6, 7, 8, 9, 10, 11, 12, 13, 14, 15, 16, 17, 18, 19, 20, 21, 22, 23, 32, 33, 34, 35, 36, 48, 49, 50, 51, 64, 65, 66, 80, 81, 96, 97, 112, 113, 128, 144, 160, 176, 192, 208, 224, 240, 255, 255};
  for (int item0 = bid; item0 < nitems; item0 += nblk * RT_MAX_ITEMS) {
    for (int ph = 0; ph < 2; ++ph) {
      bf16x8 bk[8][4];
      {
        const bf16_t* kb = p.keysb + ((((size_t)layer * 2 + ph) * 8 + wid) * 128) * 128 + (size_t)fr * 128 + fq * 8;
#pragma unroll
        for (int n = 0; n < 8; ++n)
#pragma unroll
          for (int kt = 0; kt < 4; ++kt) bk[n][kt] = *(const bf16x8*)(kb + (size_t)n * 16 * 128 + kt * 32);
      }
      bf16x8 an[4];
      {
        const bf16_t* qrow = qb + (size_t)(item0 * 16 + fr) * 2048 + wid * 256 + ph * 128 + fq * 8;
#pragma unroll
        for (int kt = 0; kt < 4; ++kt) an[kt] = *(const bf16x8*)(qrow + kt * 32);
      }
      for (int ii = 0; ii < RT_MAX_ITEMS; ++ii) {
        const int item = item0 + ii * nblk;
        if (item >= nitems) break;
        const int tok0 = item * 16;
        bf16x8 a[4];
#pragma unroll
        for (int kt = 0; kt < 4; ++kt) a[kt] = an[kt];
        {
          const int itn = item0 + (ii + 1) * nblk;
          const int tokn = (ii + 1 < RT_MAX_ITEMS && itn < nitems) ? itn * 16 : tok0;
          const bf16_t* qrow = qb + (size_t)(tokn + fr) * 2048 + wid * 256 + ph * 128 + fq * 8;
#pragma unroll
          for (int kt = 0; kt < 4; ++kt) an[kt] = *(const bf16x8*)(qrow + kt * 32);
        }
        unsigned L[16];
#pragma unroll
        for (int i = 0; i < 16; ++i) L[i] = 0u;
#pragma unroll
        for (int n = 0; n < 8; ++n) {
          f32x4 acc = (f32x4){0.f, 0.f, 0.f, 0.f};
#pragma unroll
          for (int kt = 0; kt < 4; ++kt) acc = __builtin_amdgcn_mfma_f32_16x16x32_bf16(bk[n][kt], a[kt], acc, 0, 0, 0);
#pragma unroll
          for (int j = 0; j < 4; ++j) top16_insert(L, (fkey(acc[j]) & 0xFFFFFF80u) | (unsigned)(n * 16 + fq * 4 + j));
        }
        top16_merge<16>(L);
        top16_merge<32>(L);
        if (fq == 0) {
          unsigned* dst = lists_w + ((ii * 2 + ph) * 16 + fr) * 16;
#pragma unroll
          for (int i = 0; i < 4; ++i) *(uint4*)(dst + i * 4) = make_uint4(L[i * 4], L[i * 4 + 1], L[i * 4 + 2], L[i * 4 + 3]);
        }
      }
    }
    __builtin_amdgcn_wave_barrier();
    for (int ii = 0; ii < RT_MAX_ITEMS; ++ii) {
      const int item = item0 + ii * nblk;
      if (item >= nitems) break;
      const int tok0 = item * 16;
      const unsigned* l1 = lists_w + ((ii * 2 + 0) * 16 + fr) * 16;
      const unsigned* l2 = lists_w + ((ii * 2 + 1) * 16 + fr) * 16;
      unsigned T[16];
#pragma unroll
      for (int i = 0; i < 16; ++i) T[i] = 0u;
#pragma unroll
      for (int j = 0; j < 13; ++j) {
        const unsigned c = STAIR[fq + 4 * j];
        const float sa = funkey(l1[(c >> 4) & 15] & 0xFFFFFF80u), sb = funkey(l2[c & 15] & 0xFFFFFF80u);
        const unsigned key = (fkey(sa + sb) & 0xFFFFFF00u) | c;
        top16_insert(T, c == 255u ? 0u : key);
      }
      top16_merge<16>(T);
      top16_merge<32>(T);
      const float mx = funkey(T[0] & 0xFFFFFF00u);
      float ex[16], sum = 0.f;
#pragma unroll
      for (int r = 0; r < 16; ++r) { ex[r] = __expf(funkey(T[r] & 0xFFFFFF00u) - mx); sum += ex[r]; }
      const float inv = 1.f / sum;
      int eid[4]; float gt[4];
#pragma unroll
      for (int r = 0; r < 16; ++r) {
        if ((r >> 2) == fq) {
          const int a = (T[r] >> 4) & 15, b = T[r] & 15;
          eid[r & 3] = (int)(l1[a] & 127u) * 128 + (int)(l2[b] & 127u);
          gt[r & 3] = ex[r] * inv;
        }
      }
      const size_t o = (size_t)(tok0 + fr) * 128 + wid * 16 + fq * 4;
      *(int4*)(p.pidx + o) = make_int4(eid[0], eid[1], eid[2], eid[3]);
      *(f32x4*)(p.pgate + o) = (f32x4){gt[0], gt[1], gt[2], gt[3]};
    }
    __builtin_amdgcn_wave_barrier();
  }
  __syncthreads();
}

typedef float f32x2 __attribute__((ext_vector_type(2)));
__device__ __forceinline__ float dot16_fp8(const uint4& r, const f32x2* h2) {
  const unsigned w[4] = {r.x, r.y, r.z, r.w};
  f32x2 d = {0.f, 0.f};
#pragma unroll
  for (int q = 0; q < 4; ++q) {
    d += __builtin_amdgcn_cvt_pk_f32_fp8(w[q], false) * h2[q * 2];
    d += __builtin_amdgcn_cvt_pk_f32_fp8(w[q], true) * h2[q * 2 + 1];
  }
  return d.x + d.y;
}
__device__ __forceinline__ void fma16_fp8(f32x2* acc2, const uint4& r, float w8) {
  const unsigned w[4] = {r.x, r.y, r.z, r.w};
  const f32x2 ww = {w8, w8};
#pragma unroll
  for (int q = 0; q < 4; ++q) {
    acc2[q * 2] += ww * __builtin_amdgcn_cvt_pk_f32_fp8(w[q], false);
    acc2[q * 2 + 1] += ww * __builtin_amdgcn_cvt_pk_f32_fp8(w[q], true);
  }
}
struct XcdInfo { int rank, nloc, xi, nx; };
__device__ __forceinline__ XcdInfo xcd_info(const XcdBarrier& b) {
  if (threadIdx.x == 0) {
    unsigned xi = 0;
    for (unsigned j = 0; j < 16; ++j) { const unsigned c = xb_ld(&b.bar[XB_XCNT(j)]); if (j < b.x && c > 0u) ++xi; }
    b.st[3] = xi;
  }
  __syncthreads();
  XcdInfo r;
  r.nloc = __builtin_amdgcn_readfirstlane((int)b.st[0]); r.nx = __builtin_amdgcn_readfirstlane((int)b.st[1]);
  r.rank = __builtin_amdgcn_readfirstlane((int)b.st[2]); r.xi = __builtin_amdgcn_readfirstlane((int)b.st[3]);
  return r;
}
__device__ __forceinline__ void gs_issue(uint4 (&buf)[16], const unsigned char* tab, const int* el, int grp) {
#pragma unroll
  for (int k = 0; k < 16; ++k) buf[k] = *(const uint4*)(tab + (size_t)el[k * 8 + grp] * 1024);
}
__device__ __forceinline__ void phase_gather_u(const Params& p, int layer, int ntok, const XcdInfo xin, unsigned char* smem) {
  const int tid = opaque_tid(); const int lane = tid & 63, wid = tid >> 6;
  int* elw = (int*)smem + wid * 256;
  float* pbuf = (float*)p.cols;
  const int sub = lane & 7, grp = lane >> 3;
  const bool b0 = (lane & 1) != 0, b1 = (lane & 2) != 0, b2 = (lane & 4) != 0;
  const int tstep = xin.nloc * NW;
  for (int s = xin.xi; s < 8; s += xin.nx) {
    const unsigned char* EU = p.eu8 + (size_t)layer * 16384 * 1024 + s * 128 + sub * 16;
    const int t0 = xin.rank * NW + wid;
    if (t0 >= ntok) continue;
    const int kslot = ((b0 ? 8 : 0) + (b1 ? 4 : 0) + (b2 ? 2 : 0)) * 8 + grp;
    uint4 bufA[16], bufB[16];
    uint4 hA0, hA1, hB0, hB1;
    int i0n, i1n;
    {
      elw[lane] = p.pidx[(size_t)t0 * 128 + lane]; elw[64 + lane] = p.pidx[(size_t)t0 * 128 + 64 + lane];
      __builtin_amdgcn_wave_barrier();
      gs_issue(bufA, EU, elw, grp);
      hA0 = *(const uint4*)(p.abuf + (size_t)t0 * 1024 + s * 128 + sub * 16); hA1 = *(const uint4*)(p.abuf + (size_t)t0 * 1024 + s * 128 + sub * 16 + 8);
      const int t1 = t0 + tstep < ntok ? t0 + tstep : t0;
      i0n = p.pidx[(size_t)t1 * 128 + lane]; i1n = p.pidx[(size_t)t1 * 128 + 64 + lane];
    }
    int par = 0;
    for (int t = t0; t < ntok; t += 2 * tstep) {
#pragma unroll
      for (int hh = 0; hh < 2; ++hh) {
        const int tc = t + hh * tstep;
        if (tc < ntok) {
          uint4 (&cur)[16] = hh ? bufB : bufA;
          uint4 (&nxt)[16] = hh ? bufA : bufB;
          const uint4 hc0 = hh ? hB0 : hA0, hc1 = hh ? hB1 : hA1;
          const int tn = tc + tstep < ntok ? tc + tstep : tc;
          par ^= 1;
          int* eln = elw + par * 128;
          eln[lane] = i0n; eln[64 + lane] = i1n;
          __builtin_amdgcn_wave_barrier();
          gs_issue(nxt, EU, eln, grp);
          const uint4 hn0 = *(const uint4*)(p.abuf + (size_t)tn * 1024 + s * 128 + sub * 16), hn1 = *(const uint4*)(p.abuf + (size_t)tn * 1024 + s * 128 + sub * 16 + 8);
          const int tnn = tn + tstep < ntok ? tn + tstep : tn;
          i0n = p.pidx[(size_t)tnn * 128 + lane]; i1n = p.pidx[(size_t)tnn * 128 + 64 + lane];
          f32x2 hv2[8];
          {
            float hv[16];
            unpack8(hc0, hv); unpack8(hc1, hv + 8);
#pragma unroll
            for (int q = 0; q < 8; ++q) hv2[q] = (f32x2){hv[2 * q], hv[2 * q + 1]};
          }
          float d[16];
#pragma unroll
          for (int k = 0; k < 16; ++k) d[k] = dot16_fp8(cur[k], hv2);
          float d8[8], d4[4], d2[2];
#pragma unroll
          for (int q = 0; q < 8; ++q) { const float send = b0 ? d[q] : d[q + 8]; const float keep = b0 ? d[q + 8] : d[q]; d8[q] = keep + __shfl_xor(send, 1); }
#pragma unroll
          for (int q = 0; q < 4; ++q) { const float send = b1 ? d8[q] : d8[q + 4]; const float keep = b1 ? d8[q + 4] : d8[q]; d4[q] = keep + __shfl_xor(send, 2); }
#pragma unroll
          for (int q = 0; q < 2; ++q) { const float send = b2 ? d4[q] : d4[q + 2]; const float keep = b2 ? d4[q + 2] : d4[q]; d2[q] = keep + __shfl_xor(send, 4); }
          float* dst = pbuf + ((size_t)s * TT + tc) * 128 + kslot;
          dst[0] = d2[0]; dst[8] = d2[1];
          if (hh) { hA0 = hn0; hA1 = hn1; } else { hB0 = hn0; hB1 = hn1; }
        }
      }
    }
    __builtin_amdgcn_wave_barrier();
  }
}
__device__ __forceinline__ void phase_gather_r(const Params& p, int layer, int ntok, int bid, int nblk) {
  const int tid = opaque_tid();
  const float* pbuf = (const float*)p.cols;
  const size_t n4 = (size_t)ntok * 32;
  for (size_t i = (size_t)bid * NT + tid; i < n4; i += (size_t)nblk * NT) {
    f32x4 z = *(const f32x4*)(pbuf + i * 4);
#pragma unroll
    for (int s = 1; s < 8; ++s) z += *(const f32x4*)(pbuf + (size_t)s * TT * 128 + i * 4);
    const f32x4 g = *(const f32x4*)(p.pgate + i * 4);
    const int4 e = *(const int4*)(p.pidx + i * 4);
    const int ev[4] = {e.x, e.y, e.z, e.w};
    f32x4 w;
#pragma unroll
    for (int j = 0; j < 4; ++j) w[j] = g[j] * gelu_f(z[j] * p.su[layer * 16384 + ev[j]]) * p.sv[layer * 16384 + ev[j]];
    *(f32x4*)(p.wbuf + i * 4) = w;
  }
}
template <bool DUMMY>
__device__ __forceinline__ void phase_gather_v(const Params& p, int layer, int ntok, const XcdInfo xin, unsigned char* smem) {
  float* xout = DUMMY ? (float*)p.cols : p.xres;
  const int tid = opaque_tid(); const int lane = tid & 63, wid = tid >> 6;
  int* elw = (int*)smem + wid * 512;
  float* wlw = (float*)(elw + 256);
  const int sub = lane & 7, grp = lane >> 3;
  const bool b5 = (lane & 32) != 0, b4 = (lane & 16) != 0, b3 = (lane & 8) != 0;
  const int tstep = xin.nloc * NW;
  for (int s = xin.xi; s < 8; s += xin.nx) {
    const unsigned char* EV = p.ev8 + (size_t)layer * 16384 * 1024 + s * 128 + sub * 16;
    const int col = s * 128 + sub * 16 + (b3 ? 8 : 0) + (b4 ? 4 : 0) + (b5 ? 2 : 0);
    const int t0 = xin.rank * NW + wid;
    if (t0 >= ntok) continue;
    uint4 bufA[16], bufB[16];
    int i0n, i1n; float w0n, w1n;
    f32x2 xc, gc, xn, gn;
    {
      elw[lane] = p.pidx[(size_t)t0 * 128 + lane]; elw[64 + lane] = p.pidx[(size_t)t0 * 128 + 64 + lane];
      wlw[lane] = p.wbuf[(size_t)t0 * 128 + lane]; wlw[64 + lane] = p.wbuf[(size_t)t0 * 128 + 64 + lane];
      __builtin_amdgcn_wave_barrier();
      gs_issue(bufA, EV, elw, grp);
      xc = *(const f32x2*)(p.xres + (size_t)t0 * 1024 + col);
      gc = *(const f32x2*)(p.modv + ((size_t)layer * 5 + tok_batch(t0)) * NMOD + 5120 + col);
      const int t1 = t0 + tstep < ntok ? t0 + tstep : t0;
      i0n = p.pidx[(size_t)t1 * 128 + lane]; i1n = p.pidx[(size_t)t1 * 128 + 64 + lane];
      w0n = p.wbuf[(size_t)t1 * 128 + lane]; w1n = p.wbuf[(size_t)t1 * 128 + 64 + lane];
      xn = *(const f32x2*)(p.xres + (size_t)t1 * 1024 + col);
      gn = *(const f32x2*)(p.modv + ((size_t)layer * 5 + tok_batch(t1)) * NMOD + 5120 + col);
    }
    int par = 0;
    for (int t = t0; t < ntok; t += 2 * tstep) {
#pragma unroll
      for (int hh = 0; hh < 2; ++hh) {
        const int tc = t + hh * tstep;
        if (tc < ntok) {
          uint4 (&cur)[16] = hh ? bufB : bufA;
          uint4 (&nxt)[16] = hh ? bufA : bufB;
          const float* wlc = wlw + par * 128;
          const int tn = tc + tstep < ntok ? tc + tstep : tc;
          par ^= 1;
          int* eln = elw + par * 128; float* wln = wlw + par * 128;
          eln[lane] = i0n; eln[64 + lane] = i1n; wln[lane] = w0n; wln[64 + lane] = w1n;
          __builtin_amdgcn_wave_barrier();
          gs_issue(nxt, EV, eln, grp);
          const f32x2 xcur = xc, gcur = gc;
          xc = xn; gc = gn;
          const int tnn = tn + tstep < ntok ? tn + tstep : tn;
          i0n = p.pidx[(size_t)tnn * 128 + lane]; i1n = p.pidx[(size_t)tnn * 128 + 64 + lane];
          w0n = p.wbuf[(size_t)tnn * 128 + lane]; w1n = p.wbuf[(size_t)tnn * 128 + 64 + lane];
          xn = *(const f32x2*)(p.xres + (size_t)tnn * 1024 + col);
          gn = *(const f32x2*)(p.modv + ((size_t)layer * 5 + tok_batch(tnn)) * NMOD + 5120 + col);
          f32x2 acc2[8];
#pragma unroll
          for (int j = 0; j < 8; ++j) acc2[j] = (f32x2){0.f, 0.f};
#pragma unroll
          for (int k = 0; k < 16; ++k) fma16_fp8(acc2, cur[k], wlc[k * 8 + grp]);
          float a16[16];
#pragma unroll
          for (int q = 0; q < 8; ++q) { a16[2 * q] = acc2[q].x; a16[2 * q + 1] = acc2[q].y; }
          float a8[8], a4[4], a2[2];
#pragma unroll
          for (int q = 0; q < 8; ++q) { const float send = b3 ? a16[q] : a16[q + 8]; const float keep = b3 ? a16[q + 8] : a16[q]; a8[q] = keep + __shfl_xor(send, 8); }
#pragma unroll
          for (int q = 0; q < 4; ++q) { const float send = b4 ? a8[q] : a8[q + 4]; const float keep = b4 ? a8[q + 4] : a8[q]; a4[q] = keep + __shfl_xor(send, 16); }
#pragma unroll
          for (int q = 0; q < 2; ++q) { const float send = b5 ? a4[q] : a4[q + 2]; const float keep = b5 ? a4[q + 2] : a4[q]; a2[q] = keep + __shfl_xor(send, 32); }
          f32x2 xv = xcur;
          xv.x += gcur.x * a2[0]; xv.y += gcur.y * a2[1];
          *(f32x2*)(xout + (size_t)tc * 1024 + col) = xv;
        }
      }
    }
    __builtin_amdgcn_wave_barrier();
  }
}
__device__ __forceinline__ void phase_gather_norm(const Params& p, int layer, int ntok, int bid, int nblk) {
  const int tid = opaque_tid(); const int lane = tid & 63, wid = tid >> 6;
  for (int t = bid * NW + wid; t < ntok; t += nblk * NW) {
    f32x4 xv[4];
    float ss = 0.f;
#pragma unroll
    for (int q = 0; q < 4; ++q) {
      xv[q] = *(const f32x4*)(p.xres + (size_t)t * 1024 + lane * 16 + q * 4);
      ss += xv[q][0] * xv[q][0] + xv[q][1] * xv[q][1] + xv[q][2] * xv[q][2] + xv[q][3] * xv[q][3];
    }
    ss = wave_sum(ss);
    const float rstd = rsqrtf(ss * (1.f / 1024.f) + EPSV);
    if (layer == 0) {
      const float* md1 = p.modv + ((size_t)5 + tok_batch(t)) * NMOD;
#pragma unroll
      for (int q = 0; q < 4; ++q) {
        const int c0 = lane * 16 + q * 4;
        const f32x4 g = *(const f32x4*)(p.norm1_g + 1024 + c0);
        const f32x4 sh = *(const f32x4*)(md1 + c0);
        const f32x4 sc = *(const f32x4*)(md1 + 1024 + c0);
        ushort4 o;
        o.x = f2bf(xv[q][0] * rstd * g[0] * (1.f + sc[0]) + sh[0]);
        o.y = f2bf(xv[q][1] * rstd * g[1] * (1.f + sc[1]) + sh[1]);
        o.z = f2bf(xv[q][2] * rstd * g[2] * (1.f + sc[2]) + sh[2]);
        o.w = f2bf(xv[q][3] * rstd * g[3] * (1.f + sc[3]) + sh[3]);
        *(ushort4*)(p.abuf + (size_t)t * 1024 + c0) = o;
      }
    } else {
#pragma unroll
      for (int q = 0; q < 4; ++q) {
        const int c0 = lane * 16 + q * 4;
        const f32x4 g = *(const f32x4*)(p.final_g + c0);
        f32x4 o;
        o[0] = xv[q][0] * rstd * g[0]; o[1] = xv[q][1] * rstd * g[1]; o[2] = xv[q][2] * rstd * g[2]; o[3] = xv[q][3] * rstd * g[3];
        *(f32x4*)(p.out + (size_t)t * 1024 + c0) = o;
      }
    }
  }
}

__device__ __forceinline__ void phase_final(const Params& p, int bid, int nblk) {
  const int tid = opaque_tid(); const int lane = tid & 63, wid = tid >> 6;
  for (int t = bid * 4 + wid; t < TL; t += nblk * 4) {
    const float* row = p.xres + (size_t)t * 1024;
    f32x4 v[4];
    float ss = 0.f;
#pragma unroll
    for (int j = 0; j < 4; ++j) {
      v[j] = *(const f32x4*)(row + j * 256 + lane * 4);
      ss += v[j][0] * v[j][0] + v[j][1] * v[j][1] + v[j][2] * v[j][2] + v[j][3] * v[j][3];
    }
    ss = wave_sum(ss);
    const float rstd = rsqrtf(ss * (1.f / 1024.f) + EPSV);
#pragma unroll
    for (int j = 0; j < 4; ++j) {
      const int c0 = j * 256 + lane * 4;
      const f32x4 g = *(const f32x4*)(p.final_g + c0);
      f32x4 o;
      o[0] = v[j][0] * rstd * g[0]; o[1] = v[j][1] * rstd * g[1]; o[2] = v[j][2] * rstd * g[2]; o[3] = v[j][3] * rstd * g[3];
      *(f32x4*)(p.out + (size_t)t * 1024 + c0) = o;
    }
  }
}

template <class Epi>
__device__ __forceinline__ void run_gemm(const bf16_t* A, const bf16_t* Bt, int M, int N, int K, const Epi& epi, int bid, int nblk, unsigned char* smem) {
  pg8::Gemm g{A, Bt, M, N, K};
  pg8::StaticOrder S; S.init(M, N, nblk, bid);
  pg8::gemm_phase(( PG8_LAS unsigned char*)smem, g, S, epi);
}
__device__ __forceinline__ void phase_gemm_in(const Params& p, int layer, int bid, int nblk, unsigned char* smem) {
  pg8::EpiBf16 epi{p.cols, INW, INW};
  run_gemm(p.abuf, p.wt_in + (size_t)layer * INWP * 1024, TT, INWP, 1024, epi, bid, nblk, smem);
}
__device__ __forceinline__ void phase_gemm_glu(const Params& p, int layer, int ntok, int bid, int nblk, unsigned char* smem) {
  pg8::EpiGlu epi{p.mix};
  run_gemm(p.yg, p.wt_glu + (size_t)layer * 512 * 256, ntok, 512, 256, epi, bid, nblk, smem);
}
__device__ __forceinline__ void phase_gemm_out(const Params& p, int layer, int ntok, int bid, int nblk, unsigned char* smem) {
  pg8::EpiResid epi{p.xres, p.modv + (size_t)layer * 5 * NMOD, 2048};
  run_gemm(p.mix, p.wt_out + (size_t)layer * 1024 * 1024, ntok, 1024, 1024, epi, bid, nblk, smem);
}
__device__ __forceinline__ void phase_gemm_q(const Params& p, int layer, int ntok, int bid, int nblk, unsigned char* smem) {
  pg8::EpiBf16 epi{p.cols  , 2048, 2048};
  run_gemm(p.abuf, p.wt_q + (size_t)layer * 2048 * 1024, ntok, 2048, 1024, epi, bid, nblk, smem);
}

template <int L>
__device__ __forceinline__ void layer_body(const Params& p, const XcdBarrier& bar, const XcdInfo xin, int bid, int nblk, unsigned char* smem) {
  constexpr int l = L;
  constexpr int ntok = L == 0 ? TT : TL;
  for (int rep = 0; rep < REP_GEMM; ++rep) phase_gemm_in(p, l, bid, nblk, smem);
  xcd_barrier(bar);
  for (int rep = 0; rep < REP_MIX; ++rep) {
    phase_s5a(p, l, bid, nblk, smem);
    if (REP_S5 > 1) phase_s5a(p, l, bid, nblk, smem);
    for (int r2 = 0; r2 < REP_GLA; ++r2) phase_glaa(p, l, bid, nblk, smem);
  }
  xcd_barrier(bar);
  phase_scan(p, l, bid, nblk);
  for (int r2 = 0; r2 < REP_SGU; ++r2) phase_sgu(p, l, ntok / 128, bid, nblk, smem);
  xcd_barrier(bar);
  for (int rep = 0; rep < REP_MIX; ++rep) {
    phase_s5c(p, l, ntok / 64, bid, nblk, smem);
    if (REP_S5 > 1) phase_s5c(p, l, ntok / 64, bid, nblk, smem);
    for (int r2 = 0; r2 < REP_GLA; ++r2) phase_glac(p, l, ntok / 64, 16 * ((ntok / 64 / 16 + 1) / 2), bid, nblk, smem);
  }
  xcd_barrier(bar);
  for (int rep = 0; rep < REP_GEMM; ++rep) phase_gemm_glu(p, l, ntok, bid, nblk, smem);
  xcd_barrier(bar);
  if (REP_GEMM > 1) {
    pg8::EpiBf16 epi{p.abuf, 1024, 1024};
    for (int rep = 1; rep < REP_GEMM; ++rep) run_gemm(p.mix, p.wt_out + (size_t)l * 1024 * 1024, ntok, 1024, 1024, epi, bid, nblk, smem);
  }
  phase_gemm_out(p, l, ntok, bid, nblk, smem);
  if (l == 0 && nblk > 16 && bid >= 16) {
    const int tid = opaque_tid();
    for (int j = bid - 16; j < 2048; j += nblk - 16) convert_rows(p, (j >> 10) * 2048 + 1024 + (j & 1023), tid);
  } else if (l == 0 && nblk <= 16) {
    const int tid = opaque_tid();
    for (int j = bid; j < 2048; j += nblk) convert_rows(p, (j >> 10) * 2048 + 1024 + (j & 1023), tid);
  }
  xcd_barrier(bar);
  for (int rep = 0; rep < REP_PRO; ++rep)
    phase_normmod(p, p.xres, p.xres + (size_t)TL * 1024, p.norm2_g + l * 1024, p.modv + (size_t)l * 5 * NMOD, 3072, 4096, ntok, 0, bid, nblk);
  xcd_barrier(bar);
  for (int rep = 0; rep < REP_GEMM; ++rep) phase_gemm_q(p, l, ntok, bid, nblk, smem);
  xcd_barrier(bar);
  for (int rep = 0; rep < REP_ROUTE; ++rep) phase_route(p, l, ntok, bid, nblk, smem);
  xcd_barrier(bar);
  phase_gather_u(p, l, ntok, xin, smem);
  if (REP_GATHER == 2) phase_gather_u(p, l, ntok, xin, smem);
  xcd_barrier(bar);
  phase_gather_r(p, l, ntok, bid, nblk);
  xcd_barrier(bar);
  if (REP_GATHER > 2) phase_gather_v<true>(p, l, ntok, xin, smem);
  phase_gather_v<false>(p, l, ntok, xin, smem);
  xcd_barrier(bar);
  phase_gather_norm(p, l, ntok, bid, nblk);
  if (l == 0) xcd_barrier(bar);
}

#define SMEM_BYTES (148 * 1024)
__global__ void __launch_bounds__(NT) mega_kernel(Params p) {
  __shared__ __attribute__((aligned(16))) unsigned char smem[SMEM_BYTES + 16];
  const int bid = blockIdx.x, nblk = gridDim.x;
  volatile LAS unsigned* xbw = (volatile LAS unsigned*)(smem + SMEM_BYTES);
  if (threadIdx.x == 0) { xbw[0] = 0u; xbw[1] = 0u; xbw[2] = 0u; xbw[3] = 0u; }
  __syncthreads();
  XcdBarrier bar = xcd_barrier_post(p.bar, xbw);
  for (int rep = 0; rep < REP_PRO; ++rep) {
    phase_mod(p, bid, nblk, smem);
    phase_wprep(p, bid, nblk, smem);
  }
  xcd_barrier(bar);
  for (int rep = 0; rep < REP_PRO; ++rep) phase_normmod(p, p.x, p.ctx, p.norm1_g, p.modv, 0, 1024, TT, 1, bid, nblk);
  xcd_barrier(bar);
  const XcdInfo xin = xcd_info(bar);
  layer_body<0>(p, bar, xin, bid, nblk, smem);
  layer_body<1>(p, bar, xin, bid, nblk, smem);
}

static inline size_t align_up(size_t v, size_t a) { return (v + a - 1) / a * a; }

extern "C" void kernel_launch(void* const* d_in, const int* in_sizes, int n_in, void* d_out, int out_size, void* d_ws, size_t ws_size,
                              hipStream_t stream) {
  Params p{};
  const float* const* in = (const float* const*)d_in;
  p.x = in[0]; p.c = in[1]; p.ctx = in[2]; p.c_ctx = in[3]; p.w_mod = in[4]; p.b_mod = in[5]; p.norm1_g = in[6]; p.norm2_g = in[7];
  p.w_in = in[8]; p.w_out = in[9]; p.sgu_w = in[10]; p.sgu_b = in[11]; p.lam_re = in[12]; p.lam_im = in[13]; p.b_re = in[14]; p.b_im = in[15];
  p.c_re = in[16]; p.c_im = in[17]; p.log_step = in[18]; p.s5_d = in[19]; p.w_glu = in[20]; p.gla_wg = in[21]; p.gla_bg = in[22]; p.gla_ng = in[23];
  p.w_query = in[24]; p.sub_keys = in[25]; p.exp_u = in[26]; p.exp_v = in[27]; p.final_g = in[28];
  p.out = (float*)d_out;
  unsigned char* w = (unsigned char*)d_ws;
  size_t off = 0;
  auto take = [&](size_t bytes) { void* r = w + off; off = align_up(off + bytes, 256); return r; };
  p.bar = (unsigned*)take(16384);
  p.xres = (float*)take((size_t)TT * 1024 * 4);
  p.modv = (float*)take((size_t)2 * 5 * NMOD * 4);
  p.abuf = (bf16_t*)take((size_t)TT * 1024 * 2);
  p.cols = (bf16_t*)take((size_t)TT * INW * 2);
  p.mix = (bf16_t*)take((size_t)TT * 1024 * 2);
  p.yg = (bf16_t*)take((size_t)TT * 256 * 2);
  p.wt_in = (bf16_t*)take((size_t)2 * INWP * 1024 * 2);
  p.wt_out = (bf16_t*)take((size_t)2 * 1024 * 1024 * 2);
  p.wt_q = (bf16_t*)take((size_t)2 * 2048 * 1024 * 2);
  p.wt_glu = (bf16_t*)take((size_t)2 * 512 * 256 * 2);
  p.keysb = (bf16_t*)take((size_t)2 * 2 * 8 * 128 * 128 * 2);
  p.sgu_wb = (bf16_t*)take((size_t)2 * 4 * 128 * 128 * 2);
  p.s5a = (float*)take((size_t)4096 * 2 * 4);
  p.s5a64 = (float*)take((size_t)4096 * 2 * 4);
  p.s5bb = (float*)take((size_t)4096 * 32 * 4);
  p.s5K = (bf16_t*)take((size_t)64 * 16384 * 2);
  p.s5M1 = (bf16_t*)take((size_t)64 * 131072 * 2);
  p.s5N2 = (bf16_t*)take((size_t)64 * 131072 * 2);
  p.s5S = (float*)take((size_t)2 * NSC * 16 * 64 * 2 * 4);
  p.s5H = (float*)take((size_t)2 * NSC * 16 * 64 * 2 * 4);
  p.gkv = (float*)take((size_t)2 * NSC * 8 * 2048 * 4);
  p.gdec = (float*)take((size_t)2 * NSC * 8 * 32 * 4);
  p.eu8 = (unsigned char*)take((size_t)2 * 16384 * 1024);
  p.ev8 = (unsigned char*)take((size_t)2 * 16384 * 1024);
  p.su = (float*)take((size_t)2 * 16384 * 4);
  p.sv = (float*)take((size_t)2 * 16384 * 4);
  p.glb = (float*)take((size_t)2 * TT * 256 * 4);
  p.wbuf = (float*)take((size_t)TT * 128 * 4);
  p.ssbuf = (float*)take((size_t)TT * 8 * 4);
  p.pidx = (int*)take((size_t)TT * 128 * 4);
  p.pgate = (float*)take((size_t)TT * 128 * 4);
  if (off > ws_size) { fprintf(stderr, "workspace too small: need %zu have %zu\n", off, ws_size); return; }

  (void)hipMemsetAsync(p.bar, 0, XCD_BAR_WORDS * 4, stream);
  static int grid_blocks = 0;
  if (!grid_blocks) {
    int dev = 0, cus = 0, per_cu = 0;
    (void)hipGetDevice(&dev);
    (void)hipDeviceGetAttribute(&cus, hipDeviceAttributeMultiprocessorCount, dev);
    (void)hipOccupancyMaxActiveBlocksPerMultiprocessor(&per_cu, (const void*)mega_kernel, NT, 0);
    if (per_cu < 1) { fprintf(stderr, "occupancy query says 0 blocks/CU\n"); per_cu = 1; }
    grid_blocks = cus;
  }
  void* args[] = {&p};
  hipError_t e = hipLaunchCooperativeKernel((const void*)mega_kernel, dim3(grid_blocks), dim3(NT), args, 0, stream);
  if (e != hipSuccess) fprintf(stderr, "cooperative launch failed: %s (grid %d)\n", hipGetErrorString(e), grid_blocks);
}
```

```cpp
#include <hip/hip_runtime.h>
#include <cstdio>
#include <cstdint>
#include <cmath>

typedef unsigned short bf16_t;
typedef short bf16x8 __attribute__((ext_vector_type(8)));
typedef float f32x4 __attribute__((ext_vector_type(4)));

#define DM 1024
#define NBATCH 4
#define SEQ 4096
#define CTXL 256
#define TL (NBATCH * SEQ)
#define TC (NBATCH * CTXL)
#define TT (TL + TC)
#define INW 2336
#define INWP 2560
#define NMOD 6144
#define NSC 272
#define EPSV 1e-6f
#define NT 512
#define NW 8
#ifndef REP_GATHER
#define REP_GATHER 1
#endif
#ifndef REP_ROUTE
#define REP_ROUTE 1
#endif
#ifndef REP_GEMM
#define REP_GEMM 1
#endif
#ifndef REP_MIX
#define REP_MIX 1
#endif
#ifndef REP_PRO
#define REP_PRO 1
#endif
#ifndef REP_SGU
#define REP_SGU 1
#endif
#ifndef REP_S5
#define REP_S5 1
#endif
#ifndef REP_GLA
#define REP_GLA 1
#endif

#define C_SGU_U 0
#define C_SGU_V 256
#define C_S5 512
#define C_GQ 768
#define C_GK 1024
#define C_GV 1280
#define C_GG 1792
#define C_ZF 2304

struct Params {
  const float *x, *c, *ctx, *c_ctx, *w_mod, *b_mod, *norm1_g, *norm2_g, *w_in, *w_out, *sgu_w, *sgu_b;
  const float *lam_re, *lam_im, *b_re, *b_im, *c_re, *c_im, *log_step, *s5_d, *w_glu, *gla_wg, *gla_bg, *gla_ng;
  const float *w_query, *sub_keys, *exp_u, *exp_v, *final_g;
  float* out;
  unsigned* bar;
  float* xres;
  float* modv;
  bf16_t* abuf;
  bf16_t* cols;
  bf16_t* mix;
  bf16_t* yg;
  bf16_t *wt_in, *wt_out, *wt_q, *wt_glu, *keysb, *sgu_wb;
  float *s5a, *s5a64, *s5bb;
  bf16_t *s5K, *s5M1, *s5N2;
  float *s5S, *s5H;
  float *gkv, *gdec;
  unsigned char *eu8, *ev8;
  float *su, *sv;
  float* glb;
  float *wbuf, *ssbuf;
  int* pidx;
  float* pgate;
};

__device__ __forceinline__ bf16_t f2bf(float f) {
  unsigned u = __float_as_uint(f);
  u += 0x7fffu + ((u >> 16) & 1u);
  return (bf16_t)(u >> 16);
}
__device__ __forceinline__ float bf2f(bf16_t h) { return __uint_as_float(((unsigned)h) << 16); }
__device__ __forceinline__ bf16x8 pack_bf16x8(const float* v) {
  bf16x8 r;
#pragma unroll
  for (int c = 0; c < 8; ++c) r[c] = (short)f2bf(v[c]);
  return r;
}

__device__ __forceinline__ float bflo(unsigned u) { return __uint_as_float(u << 16); }
__device__ __forceinline__ float bfhi(unsigned u) { return __uint_as_float(u & 0xffff0000u); }
__device__ __forceinline__ float gelu_f(float x) {
  const float y = 0.7978845608028654f * (x + 0.044715f * x * x * x);
  const float e = __expf(2.f * y);
  const float th = 1.f - 2.f / (1.f + e);
  return 0.5f * x * (1.f + th);
}
__device__ __forceinline__ float sigmoid_f(float x) { return 1.f / (1.f + __expf(-x)); }
__device__ __forceinline__ float silu_f(float x) { return x * sigmoid_f(x); }
__device__ __forceinline__ float logsigmoid_f(float x) { return fminf(x, 0.f) - log1pf(__expf(-fabsf(x))); }
template <int M>
__device__ __forceinline__ unsigned xor_lane_u(unsigned x) {
  if constexpr (M == 1) return (unsigned)__builtin_amdgcn_mov_dpp((int)x, 0xB1, 0xf, 0xf, true);
  else if constexpr (M == 2) return (unsigned)__builtin_amdgcn_mov_dpp((int)x, 0x4E, 0xf, 0xf, true);
  else if constexpr (M == 4) {
    const int a = __builtin_amdgcn_update_dpp((int)x, (int)x, 0x104, 0xf, 0x5, false);
    return (unsigned)__builtin_amdgcn_update_dpp(a, (int)x, 0x114, 0xf, 0xa, false);
  } else if constexpr (M == 8) return (unsigned)__builtin_amdgcn_mov_dpp((int)x, 0x128, 0xf, 0xf, true);
  else if constexpr (M == 16) {
    const auto r = __builtin_amdgcn_permlane16_swap(x, x, false, false);
    return ((threadIdx.x >> 4) & 1) ? r[0] : r[1];
  } else if constexpr (M == 32) {
    const auto r = __builtin_amdgcn_permlane32_swap(x, x, false, false);
    return (threadIdx.x & 32) ? r[0] : r[1];
  } else return (unsigned)__shfl_xor((int)x, M);
}
template <int M>
__device__ __forceinline__ float xor_lane_f(float x) { return __uint_as_float(xor_lane_u<M>(__float_as_uint(x))); }
__device__ __forceinline__ float wave_sum(float v) {
  v += xor_lane_f<32>(v); v += xor_lane_f<16>(v); v += xor_lane_f<8>(v); v += xor_lane_f<4>(v); v += xor_lane_f<2>(v); v += xor_lane_f<1>(v);
  return v;
}
__device__ __forceinline__ void lds_barrier() {
  asm volatile("s_waitcnt lgkmcnt(0)" ::: "memory");
  __builtin_amdgcn_s_barrier();
  asm volatile("" ::: "memory");
}
__device__ __forceinline__ int opaque_tid() { int t = threadIdx.x; asm volatile("" : "+v"(t)); return t; }
__device__ __forceinline__ int tok_batch(int t) { return t < TL ? (t >> 12) : 4; }
__device__ __forceinline__ int s5_tok(int sc, int i) { return sc < 256 ? ((sc >> 6) * SEQ + (sc & 63) * 64 + i) : (TL + (sc - 256) * 64 + i); }
__device__ __forceinline__ int gla_tok(int sc, int i) { return sc < 256 ? ((sc >> 6) * SEQ + i * 64 + (sc & 63)) : (TL + (sc - 256) * 64 + i); }


#define XB_TMO      128
#define XB_XCNT(j)  (256  + 64 * (j))
#define XB_XSUB(j)  (1280 + 64 * (j))
#define XB_XGEN(j)  (2304 + 64 * (j))
#define XB_TOP      3328
#define XB_TOPGEN   3392
#define XCD_BAR_WORDS 3456
#define XB_SPIN_CAP (1u << 22)
#define LAS __attribute__((address_space(3)))
__device__ __forceinline__ unsigned xb_ld(unsigned* p)              { return __hip_atomic_load(p, __ATOMIC_RELAXED, __HIP_MEMORY_SCOPE_AGENT); }
__device__ __forceinline__ unsigned xb_add(unsigned* p, unsigned v) { return __hip_atomic_fetch_add(p, v, __ATOMIC_RELAXED, __HIP_MEMORY_SCOPE_AGENT); }
__device__ __forceinline__ unsigned xb_xcc_id() { return (unsigned)__builtin_amdgcn_s_getreg((3 << 11) | 20) & 0xFu; }
#define XB_SPIN(cond, bar) do { unsigned _sp = 0; while (cond) { __builtin_amdgcn_s_sleep(1); \
    if ((++_sp & 255u) == 0u) { if (xb_ld(&(bar)[XB_TMO])) break; if (_sp > XB_SPIN_CAP) { atomicAdd(&(bar)[XB_TMO], 1u); break; } } } } while (0)
struct XcdBarrier { unsigned* bar; unsigned x; volatile LAS unsigned* st; };
__device__ __forceinline__ XcdBarrier xcd_barrier_post(unsigned* bar, volatile LAS unsigned* st) {
  XcdBarrier b; b.bar = bar; b.x = xb_xcc_id(); b.st = st;
  if (threadIdx.x == 0) st[2] = xb_add(&bar[XB_XCNT(b.x)], 1u);
  return b;
}
__device__ __forceinline__ void xcd_barrier_complete(unsigned* bar, unsigned x, unsigned& nloc, unsigned& nx) {
  const unsigned G = gridDim.x * gridDim.y * gridDim.z;
  unsigned sum, cnt, mine, sp = 0u;
  for (;;) {
    sum = 0u; cnt = 0u; mine = 0u;
#pragma unroll
    for (unsigned j = 0; j < 16; ++j) { const unsigned c = xb_ld(&bar[XB_XCNT(j)]); sum += c; cnt += (c > 0u) ? 1u : 0u; mine = (j == x) ? c : mine; }
    if (sum == G) break;
    __builtin_amdgcn_s_sleep(1);
    if ((++sp & 255u) == 0u) { if (xb_ld(&bar[XB_TMO])) break; if (sp > XB_SPIN_CAP) { atomicAdd(&bar[XB_TMO], 1u); break; } }
  }
  nloc = mine > 0u ? mine : 1u; nx = cnt > 0u ? cnt : 1u;
}
__device__ __forceinline__ void xcd_barrier(const XcdBarrier& b) {
  asm volatile("s_waitcnt vmcnt(0)" ::: "memory");
  __syncthreads();
  if (threadIdx.x == 0) {
    unsigned* bar = b.bar;
    __builtin_amdgcn_s_waitcnt(0);
    unsigned nloc = b.st[0], nx = b.st[1];
    if (nloc == 0u) { xcd_barrier_complete(bar, b.x, nloc, nx); b.st[0] = nloc; b.st[1] = nx; }
    const unsigned old = xb_add(&bar[XB_XSUB(b.x)], 1u);
    const unsigned gen = old / nloc;
    if (old + 1u == (gen + 1u) * nloc) {
      __builtin_amdgcn_fence(__ATOMIC_RELEASE, "agent");
      asm volatile("s_waitcnt vmcnt(0)" ::: "memory");
      const unsigned og = xb_add(&bar[XB_TOP], 1u);
      const unsigned tg = og / nx;
      if (og + 1u == (tg + 1u) * nx) xb_add(&bar[XB_TOPGEN], 1u);
      else XB_SPIN(xb_ld(&bar[XB_TOPGEN]) == tg, bar);
      __builtin_amdgcn_fence(__ATOMIC_ACQUIRE, "agent");
      xb_add(&bar[XB_XGEN(b.x)], 1u);
      asm volatile("s_waitcnt vmcnt(0)" ::: "memory");
    } else {
      XB_SPIN(xb_ld(&bar[XB_XGEN(b.x)]) == gen, bar);
      __builtin_amdgcn_fence(__ATOMIC_ACQUIRE, "agent");
      asm volatile("s_waitcnt vmcnt(0)" ::: "memory");
    }
  }
  __syncthreads();
}

__device__ __forceinline__ void phase_mod(const Params& p, int bid, int nblk, unsigned char* smem) {
  float* sil = (float*)smem;
  float* red = sil + 5 * 1024;
  const int tid = opaque_tid();
  for (int i = tid; i < 5 * 1024; i += NT) {
    const int r = i >> 10, k = i & 1023;
    const float v = r < 4 ? p.c[r * 1024 + k] : p.c_ctx[k];
    sil[i] = silu_f(v);
  }
  __syncthreads();
  for (int item = bid; item < 192; item += nblk) {
    const int l = item / 96, j0 = (item % 96) * 64;
    const int cc = tid & 63, kg = tid >> 6;
    float acc[5] = {0.f, 0.f, 0.f, 0.f, 0.f};
    const float* w = p.w_mod + (size_t)l * 1024 * NMOD + j0 + cc;
#pragma unroll 32
    for (int k = kg * 128; k < kg * 128 + 128; ++k) {
      const float wv = w[(size_t)k * NMOD];
#pragma unroll
      for (int r = 0; r < 5; ++r) acc[r] += sil[r * 1024 + k] * wv;
    }
#pragma unroll
    for (int r = 0; r < 5; ++r) red[(kg * 5 + r) * 64 + cc] = acc[r];
    __syncthreads();
    if (tid < 320) {
      const int r = tid >> 6;
      float s = 0.f;
#pragma unroll
      for (int g = 0; g < 8; ++g) s += red[(g * 5 + r) * 64 + cc];
      p.modv[((size_t)l * 5 + r) * NMOD + j0 + cc] = s + p.b_mod[l * NMOD + j0 + cc];
    }
    __syncthreads();
  }
}

__device__ __forceinline__ void transpose_tile(const float* src, int ldsrc, bf16_t* dst, int lddst, int k0, int r0, int nsrc, int glu, float* tile) {
  const int tid = opaque_tid();
  const int j = tid & 63;
  const int r = r0 + j;
  int scol;
  if (glu) {
    const int pn = r >> 8, bj = (r >> 7) & 1, i = r & 127;
    scol = bj * 256 + pn * 128 + i;
  } else {
    scol = r < nsrc ? r : -1;
  }
  float v[32];
#pragma unroll
  for (int it = 0; it < 32; ++it) {
    const int kk = (tid >> 6) + it * 8;
    v[it] = scol >= 0 ? src[(size_t)(k0 + kk) * ldsrc + scol] : 0.f;
  }
#pragma unroll
  for (int it = 0; it < 32; ++it) {
    const int kk = (tid >> 6) + it * 8;
    tile[(kk >> 6) * 4160 + (kk & 63) * 65 + j] = v[it];
  }
  __syncthreads();
  const int kq = tid & 63;
#pragma unroll
  for (int it = 0; it < 32; ++it) {
    const int jj = (tid >> 6) + (it & 7) * 8, sub = it >> 3;
    dst[(size_t)(r0 + jj) * lddst + k0 + sub * 64 + kq] = f2bf(tile[sub * 4160 + kq * 65 + jj]);
  }
  __syncthreads();
}

__device__ __forceinline__ void s5_tables(const Params& p, int id, int part, unsigned char* smem) {
  const int tid = opaque_tid();
  float2* Apow = (float2*)smem;
  float2* Bbs = Apow + 65 * 64;
  float2* Cs = Bbs + 64 * 16;
  __syncthreads();
  if (tid < 64) {
    const int pid = id * 64 + tid;
    double lre = (double)p.lam_re[pid];
    if (lre > -1e-4) lre = -1e-4;
    const double lim = (double)p.lam_im[pid];
    const double dt = exp((double)p.log_step[id]);
    const double mag = exp(lre * dt);
    const double are = mag * cos(lim * dt), aim = mag * sin(lim * dt);
    {
      double pr = 1.0, pi = 0.0;
      for (int n = 0; n <= 64; ++n) {
        Apow[n * 64 + tid] = make_float2((float)pr, (float)pi);
        const double nr = pr * are - pi * aim, ni = pr * aim + pi * are;
        pr = nr; pi = ni;
      }
    }
    const double den = lre * lre + lim * lim;
    const double fre = ((are - 1.0) * lre + aim * lim) / den;
    const double fim = (aim * lre - (are - 1.0) * lim) / den;
    for (int h = 0; h < 16; ++h) {
      const double br = (double)p.b_re[(size_t)pid * 16 + h], bi = (double)p.b_im[(size_t)pid * 16 + h];
      Bbs[tid * 16 + h] = make_float2((float)(fre * br - fim * bi), (float)(fre * bi + fim * br));
    }
  }
  for (int e = tid; e < 1024; e += NT) Cs[e] = make_float2(p.c_re[(size_t)id * 1024 + e], p.c_im[(size_t)id * 1024 + e]);
  __syncthreads();
  bf16_t* Kt = p.s5K + (size_t)id * 16384;
  for (int e = part * 2048 + tid; e < part * 2048 + 2048; e += NT) {
    const int d = e >> 8, hp = (e >> 4) & 15, h = e & 15;
    float acc = 0.f;
    for (int pp = 0; pp < 64; ++pp) {
      const float2 c = Cs[hp * 64 + pp], a = Apow[d * 64 + pp], b = Bbs[pp * 16 + h];
      const float cr = c.x * a.x - c.y * a.y, ci = c.x * a.y + c.y * a.x;
      acc += cr * b.x - ci * b.y;
    }
    Kt[e] = f2bf(acc);
  }
  bf16_t* M1 = p.s5M1 + (size_t)id * 131072;
  for (int e = part * 16384 + tid; e < part * 16384 + 16384; e += NT) {
    const int c = e >> 10, k = e & 1023, ri = c >> 6, pp = c & 63, tau = k >> 4, h = k & 15;
    const float2 a = Apow[(63 - tau) * 64 + pp], b = Bbs[pp * 16 + h];
    M1[e] = f2bf(ri ? (a.x * b.y + a.y * b.x) : (a.x * b.x - a.y * b.y));
  }
  bf16_t* N2 = p.s5N2 + (size_t)id * 131072;
  for (int e = part * 16384 + tid; e < part * 16384 + 16384; e += NT) {
    const int col = e >> 7, kk = e & 127, tau = col >> 4, hp = col & 15, ri = kk >> 6, pp = kk & 63;
    const float2 c = Cs[hp * 64 + pp], a = Apow[(tau + 1) * 64 + pp];
    N2[e] = f2bf(ri ? -(c.x * a.y + c.y * a.x) : (c.x * a.x - c.y * a.y));
  }
  __syncthreads();
}

__device__ __forceinline__ void convert_rows(const Params& p, int it, int tid) {
      const int lane = tid & 63;
      const int row0 = it * 16 + (tid >> 6) * 2;
      const int tab = row0 >> 15, r0 = row0 & 32767;
      const float* s = (tab ? p.exp_v : p.exp_u) + (size_t)r0 * 1024 + lane * 16;
      f32x4 v[2][4];
#pragma unroll
      for (int rr = 0; rr < 2; ++rr)
#pragma unroll
        for (int q = 0; q < 4; ++q) v[rr][q] = *(const f32x4*)(s + rr * 1024 + q * 4);
#pragma unroll
      for (int rr = 0; rr < 2; ++rr) {
        float m = 0.f;
#pragma unroll
        for (int q = 0; q < 4; ++q) m = fmaxf(m, fmaxf(fmaxf(fabsf(v[rr][q][0]), fabsf(v[rr][q][1])), fmaxf(fabsf(v[rr][q][2]), fabsf(v[rr][q][3]))));
#pragma unroll
        for (int o = 32; o > 0; o >>= 1) m = fmaxf(m, __shfl_xor(m, o));
        const float scale = m > 0.f ? m * (1.f / 400.f) : 1.f;
        const float inv = 1.f / scale;
        unsigned wv[4];
#pragma unroll
        for (int q = 0; q < 4; ++q) {
          unsigned w = 0;
          w = __builtin_amdgcn_cvt_pk_fp8_f32(v[rr][q][0] * inv, v[rr][q][1] * inv, w, false);
          w = __builtin_amdgcn_cvt_pk_fp8_f32(v[rr][q][2] * inv, v[rr][q][3] * inv, w, true);
          wv[q] = w;
        }
        *(uint4*)((tab ? p.ev8 : p.eu8) + (size_t)(r0 + rr) * 1024 + lane * 16) = make_uint4(wv[0], wv[1], wv[2], wv[3]);
        if (lane == 0) (tab ? p.sv : p.su)[r0 + rr] = scale;
      }
}

__device__ __forceinline__ void phase_wprep(const Params& p, int bid, int nblk, unsigned char* smem) {
  float* tile = (float*)smem;
  const int tid = opaque_tid();
  const int NT_L = 360;
  const int n_tr = 2 * NT_L;
  const int n_keys = 256 + 64;
  const int n_disc = 8;
  const int n_exp = 2048;
  const int n_s5t = 512;
  const int total = n_tr + n_keys + n_disc + n_exp + n_s5t;
  for (int item0 = bid; item0 < total; item0 += nblk) {
    const int item = item0 - n_s5t;
    if (item0 < n_s5t) {
      s5_tables(p, item0 >> 3, item0 & 7, smem);
    } else if (item < n_tr) {
      const int l = item / NT_L;
      int t = item % NT_L;
      if (t < 160) {
        transpose_tile(p.w_in + (size_t)l * 1024 * INW, INW, p.wt_in + (size_t)l * INWP * 1024, 1024, (t % 4) * 256, (t / 4) * 64, INW, 0, tile);
      } else if (t < 224) {
        t -= 160;
        transpose_tile(p.w_out + (size_t)l * 1024 * 1024, 1024, p.wt_out + (size_t)l * 1024 * 1024, 1024, (t % 4) * 256, (t / 4) * 64, 1024, 0, tile);
      } else if (t < 352) {
        t -= 224;
        transpose_tile(p.w_query + (size_t)l * 1024 * 2048, 2048, p.wt_q + (size_t)l * 2048 * 1024, 1024, (t % 4) * 256, (t / 4) * 64, 2048, 0, tile);
      } else {
        t -= 352;
        transpose_tile(p.w_glu + (size_t)l * 256 * 512, 512, p.wt_glu + (size_t)l * 512 * 256, 256, 0, t * 64, 512, 1, tile);
      }
    } else if (item < n_tr + n_keys) {
      const int ki = item - n_tr;
      if (ki < 256) {
        const int base = ki * 2048;
        for (int i = tid; i < 2048; i += NT) p.keysb[base + i] = f2bf(p.sub_keys[base + i]);
      } else {
        const int base = (ki - 256) * 2048;
        for (int i = tid; i < 2048; i += NT) p.sgu_wb[base + i] = f2bf(p.sgu_w[base + i]);
      }
    } else if (item >= n_tr + n_keys + n_disc) {
      const int j = item - (n_tr + n_keys + n_disc);
      convert_rows(p, (j >> 10) * 2048 + (j & 1023), tid);
    } else {
      const int id = (item - n_tr - n_keys) * NT + tid;
      const int g = (id >> 6) & 15;
      const int ldg = id >> 6;
      double lre = (double)p.lam_re[id];
      if (lre > -1e-4) lre = -1e-4;
      const double lim = (double)p.lam_im[id];
      const double dt = exp((double)p.log_step[ldg]);
      const double mag = exp(lre * dt);
      const double are = mag * cos(lim * dt), aim = mag * sin(lim * dt);
      const double den = lre * lre + lim * lim;
      const double fre = ((are - 1.0) * lre + aim * lim) / den;
      const double fim = (aim * lre - (are - 1.0) * lim) / den;
      p.s5a[id * 2 + 0] = (float)are;
      p.s5a[id * 2 + 1] = (float)aim;
      double pr = are, pi = aim;
      for (int s = 0; s < 6; ++s) { const double nr = pr * pr - pi * pi, ni = 2.0 * pr * pi; pr = nr; pi = ni; }
      p.s5a64[id * 2 + 0] = (float)pr;
      p.s5a64[id * 2 + 1] = (float)pi;
      for (int h = 0; h < 16; ++h) {
        const double br = (double)p.b_re[(size_t)id * 16 + h], bi = (double)p.b_im[(size_t)id * 16 + h];
        p.s5bb[(size_t)id * 32 + h] = (float)(fre * br - fim * bi);
        p.s5bb[(size_t)id * 32 + 16 + h] = (float)(fre * bi + fim * br);
      }
      (void)g;
    }
  }
}

__device__ __forceinline__ void phase_normmod(const Params& p, const float* src_l, const float* src_c, const float* gain, const float* modl, int shift_off, int scale_off,
                              int ntok, int copy, int bid, int nblk) {
  const int tid = opaque_tid(); const int lane = tid & 63, wid = tid >> 6;
  for (int t = bid * NW + wid; t < ntok; t += nblk * NW) {
    const float* row = t < TL ? src_l + (size_t)t * 1024 : src_c + (size_t)(t - TL) * 1024;
    const float* md = modl + (size_t)tok_batch(t) * NMOD;
    f32x4 v[4];
    float ss = 0.f;
#pragma unroll
    for (int j = 0; j < 4; ++j) {
      v[j] = *(const f32x4*)(row + j * 256 + lane * 4);
      ss += v[j][0] * v[j][0] + v[j][1] * v[j][1] + v[j][2] * v[j][2] + v[j][3] * v[j][3];
    }
    ss = wave_sum(ss);
    const float rstd = rsqrtf(ss * (1.f / 1024.f) + EPSV);
#pragma unroll
    for (int j = 0; j < 4; ++j) {
      const int c0 = j * 256 + lane * 4;
      const f32x4 g = *(const f32x4*)(gain + c0);
      const f32x4 sh = *(const f32x4*)(md + shift_off + c0);
      const f32x4 sc = *(const f32x4*)(md + scale_off + c0);
      ushort4 o;
      o.x = f2bf(v[j][0] * rstd * g[0] * (1.f + sc[0]) + sh[0]);
      o.y = f2bf(v[j][1] * rstd * g[1] * (1.f + sc[1]) + sh[1]);
      o.z = f2bf(v[j][2] * rstd * g[2] * (1.f + sc[2]) + sh[2]);
      o.w = f2bf(v[j][3] * rstd * g[3] * (1.f + sc[3]) + sh[3]);
      *(ushort4*)(p.abuf + (size_t)t * 1024 + c0) = o;
      if (copy) *(f32x4*)(p.xres + (size_t)t * 1024 + c0) = v[j];
    }
  }
}

namespace pg8 {
#define PG8_LAS __attribute__((address_space(3)))
typedef unsigned u32x4 __attribute__((ext_vector_type(4)));
constexpr int BM = 256, BK = 64, HALF = 128, HTB = HALF * BK * 2, STAGE_BYTES = 8 * HTB, NXCD = 8, WGM = 8;
__device__ __forceinline__ int lds_byte(int r, int c) { const int st = (r >> 4) * 2 + (c >> 5), rr = r & 15, cc = c & 31, ob = rr * 64 + cc * 2; return st * 1024 + (ob ^ (((ob >> 9) & 1) << 5)); }
__device__ __forceinline__ void stage_rc(int b, int& R, int& C) { const int st = b / 1024, sb = b % 1024, swz = sb ^ (((sb >> 9) & 1) << 5); R = (st >> 1) * 16 + swz / 64; C = (st & 1) * 32 + (swz % 64) / 2; }
__device__ __forceinline__ int perm32(int rho) { const int n = rho >> 4, i = rho & 15; return 8 * (i >> 2) + 4 * n + (i & 3); }
struct Unit { int pm, pn; };
struct Gemm { const bf16_t* A; const bf16_t* Bt; int M, N, K; };
struct StaticOrder {
  int nM, nN, nwg, G, c;
  __device__ void init(int M, int N, int G_, int c_) { nM = M / BM; nN = N / BM; nwg = nM * nN; G = G_; c = c_; }
  __device__ bool next(int i, Unit& u) const {
    const long L = (long)i * G + c; if (L >= nwg) return false;
    int wgid = (int)L; { const int q = nwg / NXCD, r = nwg % NXCD, xcd = wgid % NXCD, off = wgid / NXCD; wgid = (xcd < r ? xcd * (q + 1) : r * (q + 1) + (xcd - r) * q) + off; }
    const int nig = WGM * nN, gid = wgid / nig, fm = gid * WGM, gsz = (nM - fm) < WGM ? (nM - fm) : WGM;
    u.pm = fm + ((wgid % nig) % gsz); u.pn = (wgid % nig) / gsz; return true;
  }
};
__device__ __forceinline__ unsigned cvt_pk_bf16(float lo, float hi) { unsigned r; asm volatile("v_cvt_pk_bf16_f32 %0, %1, %2" : "=v"(r) : "v"(lo), "v"(hi)); return r; }

template <class Epi>
__device__ __forceinline__ void gemm_phase(PG8_LAS unsigned char* lds, const Gemm g, const StaticOrder& S, const Epi& E) {
  const int tid = opaque_tid(), wid = __builtin_amdgcn_readfirstlane(tid >> 6), lane = tid & 63, wr = wid >> 2, wc = wid & 3, fr = lane & 15, fq = lane >> 4;
  const int K = g.K, nt = K / BK;
  unsigned voffA[2], voffB[2];
#pragma unroll
  for (int i = 0; i < 2; ++i) { int R, C; stage_rc(tid * 16 + i * 8192, R, C); const int Rb = Epi::PERM ? ((R & ~31) + perm32(R & 31)) : R;
    voffA[i] = (unsigned)(R * K + C) * 2u; voffB[i] = (unsigned)(Rb * K + C) * 2u; }
  const size_t kstep = (size_t)(BK * 2);
  const size_t hstep = (size_t)HALF * K * 2;
  const size_t tstep = 2 * hstep;
  const unsigned ldsw = (unsigned)wid * 1024u;
  const int aoff = lds_byte(wr * 64 + fr, fq * 8), boff = lds_byte(wc * 32 + fr, fq * 8);
#define PG8_SA(b, h) (((b) * 2 + (h)) * HTB)
#define PG8_SB(b, h) ((4 + (b) * 2 + (h)) * HTB)
#define PG8_STAGE(bufoff, gbase, voff) do { _Pragma("unroll") for (int _i = 0; _i < 2; ++_i) \
    __builtin_amdgcn_global_load_lds((const unsigned*)((const char*)(gbase) + (voff)[_i]), (PG8_LAS unsigned*)(lds + (bufoff) + ldsw + _i * 8192), 16, 0, 0); } while (0)
#define PG8_LDA(dst, b, h) do { _Pragma("unroll") for (int m = 0; m < 4; ++m) _Pragma("unroll") for (int k = 0; k < 2; ++k) dst[m][k] = *(const PG8_LAS bf16x8*)(lds + PG8_SA(b, h) + aoff + m * 2048 + k * 1024); } while (0)
#define PG8_LDB(dst, b, h) do { _Pragma("unroll") for (int n = 0; n < 2; ++n) _Pragma("unroll") for (int k = 0; k < 2; ++k) dst[n][k] = *(const PG8_LAS bf16x8*)(lds + PG8_SB(b, h) + boff + n * 2048 + k * 1024); } while (0)
#define PG8_MMA(ai, bj, At, Bt) do { __builtin_amdgcn_s_setprio(1); _Pragma("unroll") for (int m = 0; m < 4; ++m) _Pragma("unroll") for (int n = 0; n < 2; ++n) _Pragma("unroll") for (int k = 0; k < 2; ++k) \
    acc[ai][bj][m][n] = __builtin_amdgcn_mfma_f32_16x16x32_bf16(Bt[n][k], At[m][k], acc[ai][bj][m][n], 0, 0, 0); __builtin_amdgcn_s_setprio(0); } while (0)
#define PG8_WAIT_V(n) asm volatile("s_waitcnt vmcnt(" #n ")" ::: "memory")
#define PG8_WAIT_L(n) asm volatile("s_waitcnt lgkmcnt(" #n ")" ::: "memory")
#define PG8_BAR __builtin_amdgcn_s_barrier()
#define PG8_SCHED __builtin_amdgcn_sched_barrier(0)
  Unit cur, nxt; int ui = 0;
  if (!S.next(0, cur)) return;
  f32x4 acc[2][2][4][2];
#pragma unroll
  for (int a = 0; a < 2; ++a)
#pragma unroll
    for (int b = 0; b < 2; ++b)
#pragma unroll
      for (int m = 0; m < 4; ++m)
#pragma unroll
        for (int n = 0; n < 2; ++n) acc[a][b][m][n] = (f32x4){0.f, 0.f, 0.f, 0.f};
  bf16x8 At[4][2], B0[2][2], B1[2][2];
  const char* cA = (const char*)g.A + (size_t)cur.pm * tstep; const char* cB = (const char*)g.Bt + (size_t)cur.pn * tstep;
  PG8_STAGE(PG8_SB(0, 0), cB, voffB); PG8_STAGE(PG8_SA(0, 0), cA, voffA); PG8_STAGE(PG8_SB(0, 1), cB + hstep, voffB); PG8_STAGE(PG8_SA(0, 1), cA + hstep, voffA);
  if (wr == 1) PG8_BAR;
  PG8_WAIT_V(4); PG8_BAR;
  PG8_STAGE(PG8_SB(1, 0), cB + kstep, voffB); PG8_STAGE(PG8_SA(1, 0), cA + kstep, voffA); PG8_STAGE(PG8_SB(1, 1), cB + hstep + kstep, voffB);
  PG8_WAIT_V(6); PG8_BAR;
  for (;;) {
    const bool has_next = S.next(ui + 1, nxt);
    const char* nA = has_next ? (const char*)g.A + (size_t)nxt.pm * tstep : cA; const char* nB = has_next ? (const char*)g.Bt + (size_t)nxt.pn * tstep : cB;
#pragma unroll 1
    for (int t = 0; t < nt; t += 2) {
      const bool last = (t == nt - 2);
      const char* a1 = cA + (size_t)(t + 1) * kstep;
      const char* a2 = last ? nA : cA + (size_t)(t + 2) * kstep; const char* b2 = last ? nB : cB + (size_t)(t + 2) * kstep;
      const char* a3 = a2 + kstep; const char* b3 = b2 + kstep;
      PG8_LDB(B0, 0, 0); PG8_SCHED; PG8_LDA(At, 0, 0); PG8_STAGE(PG8_SA(1, 1), a1 + hstep, voffA);
      PG8_WAIT_L(8); PG8_BAR; PG8_WAIT_L(0); PG8_MMA(0, 0, At, B0); PG8_BAR; PG8_SCHED;
      PG8_LDB(B1, 0, 1); PG8_STAGE(PG8_SB(0, 0), b2, voffB);
      PG8_BAR; PG8_WAIT_L(0); PG8_MMA(0, 1, At, B1); PG8_BAR;
      PG8_LDA(At, 0, 1); PG8_STAGE(PG8_SA(0, 0), a2, voffA);
      PG8_BAR; PG8_WAIT_L(0); PG8_MMA(1, 0, At, B0); PG8_BAR; PG8_SCHED;
      PG8_STAGE(PG8_SB(0, 1), b2 + hstep, voffB);
      PG8_WAIT_V(6); PG8_BAR; PG8_MMA(1, 1, At, B1); PG8_BAR;
      PG8_LDB(B0, 1, 0); PG8_SCHED; PG8_LDA(At, 1, 0); PG8_STAGE(PG8_SA(0, 1), a2 + hstep, voffA);
      PG8_WAIT_L(8); PG8_BAR; PG8_WAIT_L(0); PG8_MMA(0, 0, At, B0); PG8_BAR; PG8_SCHED;
      PG8_LDB(B1, 1, 1); PG8_STAGE(PG8_SB(1, 0), b3, voffB);
      PG8_BAR; PG8_WAIT_L(0); PG8_MMA(0, 1, At, B1); PG8_BAR;
      PG8_LDA(At, 1, 1); PG8_STAGE(PG8_SA(1, 0), a3, voffA);
      PG8_BAR; PG8_WAIT_L(0); PG8_MMA(1, 0, At, B0); PG8_BAR; PG8_SCHED;
      PG8_STAGE(PG8_SB(1, 1), b3 + hstep, voffB);
      PG8_WAIT_V(6); PG8_BAR; PG8_MMA(1, 1, At, B1); PG8_BAR;
    }
    E(acc, cur, wr, wc, fr, fq);
    if (!has_next) break;
#pragma unroll
    for (int a = 0; a < 2; ++a)
#pragma unroll
      for (int b = 0; b < 2; ++b)
#pragma unroll
        for (int m = 0; m < 4; ++m)
#pragma unroll
          for (int n = 0; n < 2; ++n) acc[a][b][m][n] = (f32x4){0.f, 0.f, 0.f, 0.f};
    cur = nxt; cA = nA; cB = nB; ++ui;
  }
  PG8_WAIT_V(0);
  if (wr == 0) PG8_BAR;
  PG8_BAR;
#undef PG8_SA
#undef PG8_SB
#undef PG8_STAGE
#undef PG8_LDA
#undef PG8_LDB
#undef PG8_MMA
#undef PG8_WAIT_V
#undef PG8_WAIT_L
#undef PG8_BAR
#undef PG8_SCHED
}

struct EpiBf16 {
  static constexpr bool PERM = true;
  bf16_t* O; int ldc; int ncols;
  __device__ __forceinline__ void operator()(const f32x4 (&acc)[2][2][4][2], const Unit& u, int wr, int wc, int fr, int fq) const {
    const int row0 = u.pm * BM + wr * 64 + fr, col0 = u.pn * BM + wc * 32 + 8 * fq;
#pragma unroll
    for (int ai = 0; ai < 2; ++ai)
#pragma unroll
      for (int m = 0; m < 4; ++m) {
        bf16_t* rowp = O + (size_t)(row0 + ai * HALF + m * 16) * ldc + col0;
#pragma unroll
        for (int bj = 0; bj < 2; ++bj) {
          if (col0 + bj * HALF < ncols) {
            const f32x4 v0 = acc[ai][bj][m][0], v1 = acc[ai][bj][m][1];
            u32x4 w; w.x = cvt_pk_bf16(v0[0], v0[1]); w.y = cvt_pk_bf16(v0[2], v0[3]); w.z = cvt_pk_bf16(v1[0], v1[1]); w.w = cvt_pk_bf16(v1[2], v1[3]);
            *(u32x4*)(rowp + bj * HALF) = w;
          }
        }
      }
  }
};
struct EpiResid {
  static constexpr bool PERM = false;
  float* xres; const float* modl; int gate_off;
  __device__ __forceinline__ void operator()(const f32x4 (&acc)[2][2][4][2], const Unit& u, int wr, int wc, int fr, int fq) const {
    const int row0 = u.pm * BM + wr * 64 + fr, col0 = u.pn * BM + wc * 32 + 4 * fq;
#pragma unroll
    for (int ai = 0; ai < 2; ++ai)
#pragma unroll
      for (int m = 0; m < 4; ++m) {
        const int row = row0 + ai * HALF + m * 16;
        float* rowp = xres + (size_t)row * 1024 + col0;
        const float* md = modl + (size_t)tok_batch(row) * NMOD + gate_off + col0;
#pragma unroll
        for (int bj = 0; bj < 2; ++bj)
#pragma unroll
          for (int n = 0; n < 2; ++n) {
            const f32x4 g = *(const f32x4*)(md + bj * HALF + n * 16);
            f32x4 x = *(const f32x4*)(rowp + bj * HALF + n * 16);
            x += g * acc[ai][bj][m][n];
            *(f32x4*)(rowp + bj * HALF + n * 16) = x;
          }
      }
  }
};
struct EpiGlu {
  static constexpr bool PERM = true;
  bf16_t* mix;
  __device__ __forceinline__ void operator()(const f32x4 (&acc)[2][2][4][2], const Unit& u, int wr, int wc, int fr, int fq) const {
    const int row0 = u.pm * BM + wr * 64 + fr, col0 = 256 + u.pn * HALF + wc * 32 + 8 * fq;
#pragma unroll
    for (int ai = 0; ai < 2; ++ai)
#pragma unroll
      for (int m = 0; m < 4; ++m) {
        float v[8];
#pragma unroll
        for (int n = 0; n < 2; ++n)
#pragma unroll
          for (int j = 0; j < 4; ++j) v[n * 4 + j] = acc[ai][0][m][n][j] * sigmoid_f(acc[ai][1][m][n][j]);
        u32x4 w; w.x = cvt_pk_bf16(v[0], v[1]); w.y = cvt_pk_bf16(v[2], v[3]); w.z = cvt_pk_bf16(v[4], v[5]); w.w = cvt_pk_bf16(v[6], v[7]);
        *(u32x4*)(mix + (size_t)(row0 + ai * HALF + m * 16) * 1024 + col0) = w;
        __builtin_amdgcn_sched_barrier(0);
      }
  }
};
}

#define VNT_STRIDE 136
__device__ __forceinline__ void phase_sgu(const Params& p, int layer, int nchunks, int bid, int nblk, unsigned char* smem) {
  bf16_t* vnT = (bf16_t*)smem;
  const int tid = opaque_tid(); const int lane = tid & 63, wid = tid >> 6;
  const int fr = lane & 15, fq = lane >> 4;
  for (int item = bid; item < nchunks * 4; item += nblk) {
    const int ch = item >> 2, h = item & 3;
    const int tok0 = ch * 128;
    {
      const int s = tid >> 2, q = tid & 3;
      const bf16_t* vrow = p.cols + (size_t)(tok0 + s) * INW + C_SGU_V + h * 64 + q * 16;
      const uint4 r0 = *(const uint4*)vrow, r1 = *(const uint4*)(vrow + 8);
      float gv[16];
      gv[0] = bflo(r0.x); gv[1] = bfhi(r0.x); gv[2] = bflo(r0.y); gv[3] = bfhi(r0.y); gv[4] = bflo(r0.z); gv[5] = bfhi(r0.z); gv[6] = bflo(r0.w); gv[7] = bfhi(r0.w);
      gv[8] = bflo(r1.x); gv[9] = bfhi(r1.x); gv[10] = bflo(r1.y); gv[11] = bfhi(r1.y); gv[12] = bflo(r1.z); gv[13] = bfhi(r1.z); gv[14] = bflo(r1.w); gv[15] = bfhi(r1.w);
      float ss = 0.f;
#pragma unroll
      for (int d = 0; d < 16; ++d) { gv[d] = gelu_f(gv[d]); ss += gv[d] * gv[d]; }
      ss += xor_lane_f<1>(ss);
      ss += xor_lane_f<2>(ss);
      const float rstd = rsqrtf(ss * (1.f / 64.f) + EPSV);
#pragma unroll
      for (int d = 0; d < 16; ++d) vnT[(q * 16 + d) * VNT_STRIDE + s] = f2bf(gv[d] * rstd);
    }
    __syncthreads();
    {
      const bf16_t* wrow = p.sgu_wb + (((size_t)layer * 4 + h) * 128 + wid * 16 + fr) * 128 + fq * 8;
      f32x4 acc[4];
#pragma unroll
      for (int n = 0; n < 4; ++n) acc[n] = (f32x4){0.f, 0.f, 0.f, 0.f};
#pragma unroll
      for (int ks = 0; ks < 4; ++ks) {
        const bf16x8 a = *(const bf16x8*)(wrow + ks * 32);
#pragma unroll
        for (int n = 0; n < 4; ++n) {
          const bf16x8 b = *(const bf16x8*)(vnT + (n * 16 + fr) * VNT_STRIDE + ks * 32 + fq * 8);
          acc[n] = __builtin_amdgcn_mfma_f32_16x16x32_bf16(a, b, acc[n], 0, 0, 0);
        }
      }
#pragma unroll
      for (int j = 0; j < 4; ++j) {
        const int t = wid * 16 + fq * 4 + j;
        const float bs = p.sgu_b[((size_t)layer * 4 + h) * 128 + t];
        const bf16_t* urow = p.cols + (size_t)(tok0 + t) * INW + C_SGU_U + h * 64;
        bf16_t* orow = p.mix + (size_t)(tok0 + t) * 1024 + h * 64;
#pragma unroll
        for (int n = 0; n < 4; ++n) orow[n * 16 + fr] = f2bf(gelu_f(bf2f(urow[n * 16 + fr])) * (acc[n][j] + bs));
      }
    }
    __syncthreads();
  }
}

__device__ __forceinline__ void phase_s5a(const Params& p, int layer, int bid, int nblk, unsigned char* smem) {
  const int tid = opaque_tid(); const int lane = tid & 63, wid = tid >> 6, fr = lane & 15, fq = lane >> 4;
  const int ntask = 2 * 16 * 17 * 2;
  for (int task = wid * nblk + bid; task < ntask; task += nblk * NW) {
    const int nh = task & 1, t2 = task >> 1;
    const int dir = t2 / 272, rem = t2 % 272, g = rem / 17, mt = rem % 17;
    const bf16_t* tab = p.s5M1 + (size_t)((layer * 2 + dir) * 16 + g) * 131072 + (size_t)(nh * 64 + fr) * 1024 + fq * 8;
    const int scr = mt * 16 + fr;
    const bf16_t* ub = p.cols + C_S5 + g * 16 + (fq & 1) * 8;
    f32x4 acc[4];
#pragma unroll
    for (int n = 0; n < 4; ++n) acc[n] = (f32x4){0.f, 0.f, 0.f, 0.f};
#pragma unroll 8
    for (int ks = 0; ks < 32; ++ks) {
      const int tau = 2 * ks + (fq >> 1);
      const int i = dir ? 63 - tau : tau;
      const bf16x8 a = *(const bf16x8*)(ub + (size_t)s5_tok(scr, i) * INW);
#pragma unroll
      for (int n = 0; n < 4; ++n) {
        const bf16x8 b = *(const bf16x8*)(tab + (size_t)n * 16 * 1024 + ks * 32);
        acc[n] = __builtin_amdgcn_mfma_f32_16x16x32_bf16(a, b, acc[n], 0, 0, 0);
      }
    }
#pragma unroll
    for (int n = 0; n < 4; ++n)
#pragma unroll
      for (int j = 0; j < 4; ++j) p.s5S[(((size_t)dir * NSC + mt * 16 + fq * 4 + j) * 16 + g) * 128 + nh * 64 + n * 16 + fr] = acc[n][j];
  }
}

__device__ __forceinline__ int scan_sc(int s, int b, int dir) {
  return s < 4 ? 256 + b * 4 + (dir ? 3 - s : s) : b * 64 + (dir ? 63 - (s - 4) : (s - 4));
}
__device__ __forceinline__ void phase_scan(const Params& p, int layer, int bid, int nblk) {
  const int tid = opaque_tid();
  for (int item = bid; item < 16 + 256; item += nblk) {
    if (item < 16) {
      const int id = item * NT + tid;
      const int pp = id & 63, g = (id >> 6) & 15, b = (id >> 10) & 3, dir = id >> 12;
      const int pid = ((layer * 2 + dir) * 16 + g) * 64 + pp;
      const float ar = p.s5a64[pid * 2], ai = p.s5a64[pid * 2 + 1];
      float hr = 0.f, hi = 0.f;
      for (int s0 = 0; s0 < 68; s0 += 17) {
        float sr[17], si[17];
#pragma unroll
        for (int k = 0; k < 17; ++k) {
          const size_t o = (((size_t)dir * NSC + scan_sc(s0 + k, b, dir)) * 16 + g) * 128 + pp;
          sr[k] = p.s5S[o]; si[k] = p.s5S[o + 64];
        }
#pragma unroll
        for (int k = 0; k < 17; ++k) {
          const size_t o = (((size_t)dir * NSC + scan_sc(s0 + k, b, dir)) * 16 + g) * 128 + pp;
          p.s5H[o] = hr; p.s5H[o + 64] = hi;
          const float nr = ar * hr - ai * hi + sr[k];
          const float ni = ar * hi + ai * hr + si[k];
          hr = nr; hi = ni;
        }
      }
    } else {
      const int id = (item - 16) * NT + tid;
      const int e = id & 2047, h = (id >> 11) & 7, b = (id >> 14) & 3, dir = id >> 16;
      const int dk = e & 31;
      float S = 0.f;
      for (int s0 = 0; s0 < 68; s0 += 17) {
        float kv[17], dc[17];
#pragma unroll
        for (int k = 0; k < 17; ++k) {
          const size_t o = (((size_t)dir * NSC + scan_sc(s0 + k, b, dir)) * 8 + h);
          kv[k] = p.gkv[o * 2048 + e]; dc[k] = p.gdec[o * 32 + dk];
        }
#pragma unroll
        for (int k = 0; k < 17; ++k) {
          const size_t o = (((size_t)dir * NSC + scan_sc(s0 + k, b, dir)) * 8 + h);
          p.gkv[o * 2048 + e] = S;
          S = dc[k] * S + kv[k];
        }
      }
    }
  }
}

__device__ __forceinline__ bf16x8 s5_kfrag(const bf16_t* kb, int delta, int sh) {
  const int d = delta - sh;
  bf16x8 r = *(const bf16x8*)(kb + (size_t)(d < 0 ? 0 : d) * 256);
  if (d < 0) r = (bf16x8){0, 0, 0, 0, 0, 0, 0, 0};
  return r;
}
#define S5_UCH 1032
typedef const __attribute__((address_space(3))) bf16_t* lds_bf16_cp;
template <int DIR, bool DIAG>
__device__ __forceinline__ void s5_group8(f32x4 (&acc)[16], bf16x8 (&W)[16], const bf16_t* ul  , const bf16_t* kl  , int ks0, int E, int sh) {
  const bf16x8 zero8 = (bf16x8){0, 0, 0, 0, 0, 0, 0, 0};
#pragma unroll
  for (int j = 0; j < 8; ++j) {
    const int sigma = 2 * (ks0 + j) + sh;
    const bf16x8 a = *(const bf16x8*)(ul + (DIR ? 63 - sigma : sigma) * 16);
    bf16x8 n0 = zero8, n1 = zero8;
    if (!DIAG) {
      if (j + 1 < 8) { n0 = *(const bf16x8*)(kl + (E - 2 * (j + 1) - sh) * 256); n1 = *(const bf16x8*)(kl + (E - 2 * (j + 1) + 1 - sh) * 256); }
      else { n0 = s5_kfrag(kl, E - 16, sh); n1 = s5_kfrag(kl, E - 15, sh); }
    }
#pragma unroll
    for (int i = 0; i < 16; ++i) {
      if (!(DIAG && i < 2 * j)) {
        const int sl = DIR ? 15 - i : i;
        acc[sl] = __builtin_amdgcn_mfma_f32_16x16x32_bf16(a, W[(i - 2 * j) & 15], acc[sl], 0, 0, 0);
      }
    }
    if (!DIAG) { W[(16 - 2 * (j + 1)) & 15] = n0; W[(17 - 2 * (j + 1)) & 15] = n1; }
  }
}
template <int DIR>
__device__ __forceinline__ void s5_dir(f32x4 (&acc)[16], const Params& p, int layer, int g, int scr, int qd, int fr, int fq, const bf16_t* ul, const bf16_t* kl) {
  const int sh = fq >> 1;
  {
    bf16x8 W[16];
#pragma unroll
    for (int i = 0; i < 16; ++i) W[i] = s5_kfrag(kl, 16 * qd + i, sh);
    for (int c = 0; c < qd; ++c) s5_group8<DIR, false>(acc, W, ul, kl, 8 * c, 16 * (qd - c), sh);
    s5_group8<DIR, true>(acc, W, ul, kl, 8 * qd, 0, sh);
  }
  const size_t tb = (size_t)((layer * 2 + DIR) * 16 + g);
  const float* hin = p.s5H + (((size_t)DIR * NSC + scr) * 16 + g) * 128 + fq * 8;
  const bf16_t* n2 = p.s5N2 + tb * 131072 + (size_t)(16 * qd * 16 + fr) * 128 + fq * 8;
  bf16x8 ah[4];
#pragma unroll
  for (int ks = 0; ks < 4; ++ks) {
    const f32x4 h0 = *(const f32x4*)(hin + ks * 32), h1 = *(const f32x4*)(hin + ks * 32 + 4);
    const float h8[8] = {h0[0], h0[1], h0[2], h0[3], h1[0], h1[1], h1[2], h1[3]};
    ah[ks] = pack_bf16x8(h8);
  }
#pragma unroll
  for (int ks = 0; ks < 4; ++ks) {
    bf16x8 b[16];
#pragma unroll
    for (int i = 0; i < 16; ++i) b[i] = *(const bf16x8*)(n2 + (size_t)i * 16 * 128 + ks * 32);
#pragma unroll
    for (int i = 0; i < 16; ++i) {
      const int sl = DIR ? 15 - i : i;
      acc[sl] = __builtin_amdgcn_mfma_f32_16x16x32_bf16(ah[ks], b[i], acc[sl], 0, 0, 0);
    }
    __builtin_amdgcn_sched_barrier(0);
  }
}
__device__ __forceinline__ void phase_s5c(const Params& p, int layer, int nsc, int bid, int nblk, unsigned char* smem) {
  const int tid = opaque_tid(); const int lane = tid & 63, wid = tid >> 6;
  bf16_t* Kl = (bf16_t*)smem;
  bf16_t* Ul = Kl + 2 * 16384;
  const int nmt = nsc / 16, npair = (nmt + 1) / 2;
  const int ntask = 16 * npair;
  for (int task = bid; task < ntask; task += nblk) {
    const int g = task / npair, mt0 = (task % npair) * 2;
    __syncthreads();
    int tid_o = tid; asm volatile("" : "+v"(tid_o));
#pragma unroll
    for (int it = 0; it < 8; ++it) {
      const int e = it * NT + tid_o;
      const int dir = e >> 11, off = (e & 2047) * 8;
      *(uint4*)(Kl + dir * 16384 + off) = *(const uint4*)(p.s5K + (size_t)((layer * 2 + dir) * 16 + g) * 16384 + off);
    }
#pragma unroll
    for (int it = 0; it < 8; ++it) {
      const int e = it * NT + tid_o;
      const int hf = e & 1, tk = (e >> 1) & 63, chk = (e >> 7) & 15, tl = e >> 11;
      const int mt = mt0 + tl;
      uint4 v = make_uint4(0u, 0u, 0u, 0u);
      if (mt < nmt) v = *(const uint4*)(p.cols + (size_t)s5_tok(mt * 16 + chk, tk) * INW + C_S5 + g * 16 + hf * 8);
      *(uint4*)(Ul + (tl * 16 + chk) * S5_UCH + tk * 16 + hf * 8) = v;
    }
    __syncthreads();
    int lane_o = lane; asm volatile("" : "+v"(lane_o));
    const int fr = lane_o & 15, fq = lane_o >> 4;
    const int tl = wid >> 2, q = wid & 3, mt = mt0 + tl;
    if (mt < nmt) {
      const int scr = mt * 16 + fr;
      const bf16_t* ul = Ul + (tl * 16 + fr) * S5_UCH + (fq & 1) * 8;
      f32x4 acc[16];
#pragma unroll
      for (int i = 0; i < 16; ++i) acc[i] = (f32x4){0.f, 0.f, 0.f, 0.f};
      s5_dir<0>(acc, p, layer, g, scr, q, fr, fq, ul, Kl + fr * 16 + (fq & 1) * 8);
      s5_dir<1>(acc, p, layer, g, scr, 3 - q, fr, fq, ul, Kl + 16384 + fr * 16 + (fq & 1) * 8);
      const int ch = g * 16 + fr;
      const float dsk = p.s5_d[layer * 256 + ch];
#pragma unroll
      for (int j = 0; j < 4; ++j) {
        const int chk = fq * 4 + j;
        const size_t tok0 = (size_t)s5_tok(mt * 16 + chk, 16 * q);
        const bf16_t* up = Ul + (tl * 16 + chk) * S5_UCH + (16 * q) * 16 + fr;
        bf16_t* yp = p.yg + tok0 * 256 + ch;
#pragma unroll
        for (int i = 0; i < 16; ++i) {
          const float v = acc[i][j] + dsk * bf2f(up[i * 16]);
          yp[(size_t)i * 256] = f2bf(gelu_f(v));
        }
        __builtin_amdgcn_sched_barrier(0);
      }
    }
  }
  __syncthreads();
}

#define GL_VT_STRIDE 72
#define GL_LB_STRIDE 36
#define GL_HALF_BYTES (64 * 72 * 2 + 64 * 36 * 4 + 64 * 72 * 2)
__device__ __forceinline__ void unpack8(const uint4& r, float* v) {
  v[0] = bflo(r.x); v[1] = bfhi(r.x); v[2] = bflo(r.y); v[3] = bfhi(r.y); v[4] = bflo(r.z); v[5] = bfhi(r.z); v[6] = bflo(r.w); v[7] = bfhi(r.w);
}
__device__ __forceinline__ void gla_store_vT(const uint4& r0, const uint4& r1, bf16_t* vT, int ltid) {
  const int i = ltid & 63, part = ltid >> 6;
  const unsigned w[8] = {r0.x, r0.y, r0.z, r0.w, r1.x, r1.y, r1.z, r1.w};
#pragma unroll
  for (int e = 0; e < 8; ++e) {
    vT[(part * 16 + 2 * e) * GL_VT_STRIDE + i] = (bf16_t)(w[e] & 0xffffu);
    vT[(part * 16 + 2 * e + 1) * GL_VT_STRIDE + i] = (bf16_t)(w[e] >> 16);
  }
}
__device__ __forceinline__ void gla_logdecay(const Params& p, int layer, int sc, int h, int dir, const uint4& z0, const uint4& z1, float* lb, int ltid, float* glb) {
  const int lane = ltid & 63;
  const int wu = __builtin_amdgcn_readfirstlane(ltid >> 6);
  float z[16];
  unpack8(z0, z); unpack8(z1, z + 8);
  const float* wg = p.gla_wg + ((size_t)(layer * 2 + dir) * 16) * 256 + h * 32 + wu * 8;
  const float* bg = p.gla_bg + (layer * 2 + dir) * 256 + h * 32 + wu * 8;
  float la[8];
#pragma unroll
  for (int c = 0; c < 8; ++c) la[c] = bg[c];
#pragma unroll
  for (int r = 0; r < 16; ++r) {
#pragma unroll
    for (int c = 0; c < 8; ++c) la[c] += z[r] * wg[r * 256 + c];
  }
#pragma unroll
  for (int c = 0; c < 8; ++c) la[c] = (fminf(la[c], 0.f) - __logf(1.f + __expf(-fabsf(la[c])))) * (1.f / 16.f);
#pragma unroll
  for (int c = 0; c < 8; ++c) {
    float v = la[c];
    if (dir == 0) {
      v += __builtin_bit_cast(float, __builtin_amdgcn_update_dpp(0, __builtin_bit_cast(int, v), 0x111, 0xf, 0xf, true));
      v += __builtin_bit_cast(float, __builtin_amdgcn_update_dpp(0, __builtin_bit_cast(int, v), 0x112, 0xf, 0xf, true));
      v += __builtin_bit_cast(float, __builtin_amdgcn_update_dpp(0, __builtin_bit_cast(int, v), 0x114, 0xf, 0xf, true));
      v += __builtin_bit_cast(float, __builtin_amdgcn_update_dpp(0, __builtin_bit_cast(int, v), 0x118, 0xf, 0xf, true));
      const float t0 = __builtin_bit_cast(float, __builtin_amdgcn_readlane(__builtin_bit_cast(int, v), 15));
      const float t1 = __builtin_bit_cast(float, __builtin_amdgcn_readlane(__builtin_bit_cast(int, v), 31));
      const float t2 = __builtin_bit_cast(float, __builtin_amdgcn_readlane(__builtin_bit_cast(int, v), 47));
      const int row = lane >> 4;
      v += row == 0 ? 0.f : (row == 1 ? t0 : (row == 2 ? t0 + t1 : (t0 + t1) + t2));
    } else {
      v += __builtin_bit_cast(float, __builtin_amdgcn_update_dpp(0, __builtin_bit_cast(int, v), 0x101, 0xf, 0xf, true));
      v += __builtin_bit_cast(float, __builtin_amdgcn_update_dpp(0, __builtin_bit_cast(int, v), 0x102, 0xf, 0xf, true));
      v += __builtin_bit_cast(float, __builtin_amdgcn_update_dpp(0, __builtin_bit_cast(int, v), 0x104, 0xf, 0xf, true));
      v += __builtin_bit_cast(float, __builtin_amdgcn_update_dpp(0, __builtin_bit_cast(int, v), 0x108, 0xf, 0xf, true));
      const float t1 = __builtin_bit_cast(float, __builtin_amdgcn_readlane(__builtin_bit_cast(int, v), 16));
      const float t2 = __builtin_bit_cast(float, __builtin_amdgcn_readlane(__builtin_bit_cast(int, v), 32));
      const float t3 = __builtin_bit_cast(float, __builtin_amdgcn_readlane(__builtin_bit_cast(int, v), 48));
      const int row = lane >> 4;
      v += row == 3 ? 0.f : (row == 2 ? t3 : (row == 1 ? t3 + t2 : (t3 + t2) + t1));
    }
    la[c] = v;
  }
  *(f32x4*)(lb + lane * GL_LB_STRIDE + wu * 8) = (f32x4){la[0], la[1], la[2], la[3]};
  *(f32x4*)(lb + lane * GL_LB_STRIDE + wu * 8 + 4) = (f32x4){la[4], la[5], la[6], la[7]};
  float* gp = glb + ((size_t)dir * TT + gla_tok(sc, lane)) * 256 + h * 32 + wu * 8;
  *(f32x4*)gp = (f32x4){la[0], la[1], la[2], la[3]};
  *(f32x4*)(gp + 4) = (f32x4){la[4], la[5], la[6], la[7]};
}

struct GlaAPre { uint4 v0, v1, za0, za1, zb0, zb1, k; };
__device__ __forceinline__ GlaAPre glaa_prefetch(const Params& p, int item, int ltid) {
  const int sc = item >> 3, h = item & 7;
  const int i = ltid & 63, part = ltid >> 6;
  const bf16_t* row = p.cols + (size_t)gla_tok(sc, i) * INW;
  GlaAPre r;
  r.v0 = *(const uint4*)(row + C_GV + h * 64 + part * 16); r.v1 = *(const uint4*)(row + C_GV + h * 64 + part * 16 + 8);
  r.za0 = *(const uint4*)(row + C_ZF); r.za1 = *(const uint4*)(row + C_ZF + 8);
  r.zb0 = *(const uint4*)(row + C_ZF + 16); r.zb1 = *(const uint4*)(row + C_ZF + 24);
  r.k = *(const uint4*)(row + C_GK + h * 32 + part * 8);
  return r;
}
__device__ __forceinline__ void phase_glaa(const Params& p, int layer, int bid, int nblk, unsigned char* smem) {
  const int tid = opaque_tid(); const int half = __builtin_amdgcn_readfirstlane(tid >> 8), ltid = tid & 255;
  const int lane = tid & 63, w = ltid >> 6, fr = lane & 15, fq = lane >> 4;
  bf16_t* vT = (bf16_t*)(smem + half * GL_HALF_BYTES);
  float* lb = (float*)(vT + 64 * GL_VT_STRIDE);
  bf16_t* kT = (bf16_t*)(lb + 64 * GL_LB_STRIDE);
  const int nit = NSC * 8 / 2;
  if (bid >= nit) return;
  GlaAPre cur = glaa_prefetch(p, bid * 2 + half, ltid);
  for (int it = bid; it < nit; it += nblk) {
    const int item = it * 2 + half;
    const int sc = item >> 3, h = item & 7;
    const int itn = it + nblk < nit ? it + nblk : it;
    const GlaAPre nxt = glaa_prefetch(p, itn * 2 + half, ltid);
    gla_store_vT(cur.v0, cur.v1, vT, ltid);
#pragma unroll
    for (int dir = 0; dir < 2; ++dir) {
      gla_logdecay(p, layer, sc, h, dir, dir ? cur.zb0 : cur.za0, dir ? cur.zb1 : cur.za1, lb, ltid, p.glb);
      __syncthreads();
      const int ilast = dir ? 0 : 63;
      {
        const int i = ltid & 63, part = ltid >> 6;
        float kv8[8];
        unpack8(cur.k, kv8);
#pragma unroll
        for (int c = 0; c < 8; ++c) {
          const int dk = part * 8 + c;
          kT[dk * GL_VT_STRIDE + i] = f2bf(kv8[c] * __expf(lb[ilast * GL_LB_STRIDE + dk] - lb[i * GL_LB_STRIDE + dk]));
        }
      }
      const size_t o = (((size_t)dir * NSC + sc) * 8 + h);
      if (ltid < 32) p.gdec[o * 32 + ltid] = __expf(lb[ilast * GL_LB_STRIDE + ltid]);
      __syncthreads();
      {
        f32x4 acc[2];
        acc[0] = (f32x4){0.f, 0.f, 0.f, 0.f}; acc[1] = acc[0];
#pragma unroll
        for (int ks = 0; ks < 2; ++ks) {
          const bf16x8 b = *(const bf16x8*)(vT + (w * 16 + fr) * GL_VT_STRIDE + ks * 32 + fq * 8);
#pragma unroll
          for (int m = 0; m < 2; ++m) {
            const bf16x8 a = *(const bf16x8*)(kT + (m * 16 + fr) * GL_VT_STRIDE + ks * 32 + fq * 8);
            acc[m] = __builtin_amdgcn_mfma_f32_16x16x32_bf16(a, b, acc[m], 0, 0, 0);
          }
        }
#pragma unroll
        for (int m = 0; m < 2; ++m) *(f32x4*)(p.gkv + o * 2048 + (size_t)(w * 16 + fr) * 32 + m * 16 + fq * 4) = acc[m];
      }
      __syncthreads();
    }
    cur = nxt;
  }
}

__device__ __forceinline__ void gl_load8(const float* g, float* v) {
  const f32x4 a = *(const f32x4*)g, b = *(const f32x4*)(g + 4);
  v[0] = a[0]; v[1] = a[1]; v[2] = a[2]; v[3] = a[3]; v[4] = b[0]; v[5] = b[1]; v[6] = b[2]; v[7] = b[3];
}
#define GLC_HALF_BYTES (64 * 72 * 2 + 64 * 72 * 2 + 2 * 64 * 36 * 4 + 2 * 64 * 36 * 4)
struct GlaCPre { uint4 v0, v1, q, k[4], lb[2][2], st[2][2]; };
__device__ __forceinline__ GlaCPre glac_prefetch(const Params& p, int item, int ltid, int w, int fr, int fq) {
  const int sc = item >> 3, h = item & 7;
  GlaCPre r;
  {
    const int i = ltid & 63, part = ltid >> 6;
    const bf16_t* row = p.cols + (size_t)gla_tok(sc, i) * INW + C_GV + h * 64 + part * 16;
    r.v0 = *(const uint4*)row; r.v1 = *(const uint4*)(row + 8);
  }
  r.q = *(const uint4*)(p.cols + (size_t)gla_tok(sc, w * 16 + fr) * INW + C_GQ + h * 32 + fq * 8);
#pragma unroll
  for (int n = 0; n < 4; ++n) r.k[n] = *(const uint4*)(p.cols + (size_t)gla_tok(sc, n * 16 + fr) * INW + C_GK + h * 32 + fq * 8);
  {
    const int i = ltid >> 2, piece = ltid & 3;
#pragma unroll
    for (int dir = 0; dir < 2; ++dir) {
      const float* g = p.glb + ((size_t)dir * TT + gla_tok(sc, i)) * 256 + h * 32 + piece * 8;
      r.lb[dir][0] = *(const uint4*)g; r.lb[dir][1] = *(const uint4*)(g + 4);
      const float* s = p.gkv + (((size_t)dir * NSC + sc) * 8 + h) * 2048 + i * 32 + piece * 8;
      r.st[dir][0] = *(const uint4*)s; r.st[dir][1] = *(const uint4*)(s + 4);
    }
  }
  return r;
}
#define GLC_BONUS 6
__device__ __forceinline__ void phase_glac(const Params& p, int layer, int nsc, int nbusy, int bid, int nblk, unsigned char* smem) {
  const int tid = opaque_tid(); const int half = __builtin_amdgcn_readfirstlane(tid >> 8), ltid = tid & 255;
  const int lane = tid & 63, w = ltid >> 6, fr = lane & 15, fq = lane >> 4;
  bf16_t* vT = (bf16_t*)(smem + half * GLC_HALF_BYTES);
  bf16_t* Pw = vT + 64 * GL_VT_STRIDE + w * 16 * GL_VT_STRIDE;
  float* lbT = (float*)(vT + 2 * 64 * GL_VT_STRIDE);
  float* ST = lbT + 2 * 64 * GL_LB_STRIDE;
  const int nit = nsc * 4;
  const int nfree = nblk - nbusy;
  const int nbonus = (nbusy > 0 && nfree > 0 && nfree * GLC_BONUS < nit) ? nfree * GLC_BONUS : 0;
  auto itof = [&](int k) -> int {
    if (nbonus == 0) return bid + k * nblk;
    if (bid >= nbusy) return k < GLC_BONUS ? k * nfree + (bid - nbusy) : nbonus + bid + (k - GLC_BONUS) * nblk;
    return nbonus + bid + k * nblk;
  };
  if (itof(0) >= nit) return;
  GlaCPre cur = glac_prefetch(p, itof(0) * 2 + half, ltid, w, fr, fq);
  for (int kk = 0; itof(kk) < nit; ++kk) {
    const int it = itof(kk);
    const int item = it * 2 + half;
    const int sc = item >> 3, h = item & 7;
    __syncthreads();
    gla_store_vT(cur.v0, cur.v1, vT, ltid);
    {
      const int i = ltid >> 2, piece = ltid & 3;
#pragma unroll
      for (int dir = 0; dir < 2; ++dir) {
        *(uint4*)(lbT + (dir * 64 + i) * GL_LB_STRIDE + piece * 8) = cur.lb[dir][0]; *(uint4*)(lbT + (dir * 64 + i) * GL_LB_STRIDE + piece * 8 + 4) = cur.lb[dir][1];
        *(uint4*)(ST + (dir * 64 + i) * GL_LB_STRIDE + piece * 8) = cur.st[dir][0]; *(uint4*)(ST + (dir * 64 + i) * GL_LB_STRIDE + piece * 8 + 4) = cur.st[dir][1];
      }
    }
    const int itn = itof(kk + 1) < nit ? itof(kk + 1) : it;
    const GlaCPre nxt = glac_prefetch(p, itn * 2 + half, ltid, w, fr, fq);
    __syncthreads();
    f32x4 o[4];
#pragma unroll
    for (int n = 0; n < 4; ++n) o[n] = (f32x4){0.f, 0.f, 0.f, 0.f};
#pragma unroll
    for (int dir = 0; dir < 2; ++dir) {
      const float* lbd = lbT + dir * 64 * GL_LB_STRIDE + fq * 8;
      float bref[8], bt[8];
      gl_load8(lbd + (dir ? 31 : 32) * GL_LB_STRIDE, bref);
      gl_load8(lbd + (w * 16 + fr) * GL_LB_STRIDE, bt);
      bf16x8 aqs, aqe;
      {
        float q8[8], s8[8], e8[8];
        unpack8(cur.q, q8);
#pragma unroll
        for (int c = 0; c < 8; ++c) {
          const float qx = q8[c] * 0.17677669529663687f;
          s8[c] = qx * __expf(bt[c] - bref[c]);
          e8[c] = qx * __expf(bt[c]);
        }
        aqs = pack_bf16x8(s8); aqe = pack_bf16x8(e8);
      }
#pragma unroll
      for (int n = 0; n < 4; ++n) {
        const int s = n * 16 + fr;
        float k8[8], bs[8];
        unpack8(cur.k[n], k8);
        gl_load8(lbd + s * GL_LB_STRIDE, bs);
#pragma unroll
        for (int c = 0; c < 8; ++c) k8[c] *= __expf(bref[c] - bs[c]);
        const bf16x8 bks = pack_bf16x8(k8);
        const f32x4 sa = __builtin_amdgcn_mfma_f32_16x16x32_bf16(aqs, bks, (f32x4){0.f, 0.f, 0.f, 0.f}, 0, 0, 0);
#pragma unroll
        for (int j = 0; j < 4; ++j) {
          const int t = w * 16 + fq * 4 + j;
          const bool ok = dir ? (s >= t) : (s <= t);
          Pw[(fq * 4 + j) * GL_VT_STRIDE + s] = f2bf(ok ? sa[j] : 0.f);
        }
      }
      __builtin_amdgcn_wave_barrier();
#pragma unroll
      for (int ks = 0; ks < 2; ++ks) {
        const bf16x8 ap = *(const bf16x8*)(Pw + fr * GL_VT_STRIDE + ks * 32 + fq * 8);
#pragma unroll
        for (int n = 0; n < 4; ++n) {
          const bf16x8 bv = *(const bf16x8*)(vT + (n * 16 + fr) * GL_VT_STRIDE + ks * 32 + fq * 8);
          o[n] = __builtin_amdgcn_mfma_f32_16x16x32_bf16(ap, bv, o[n], 0, 0, 0);
        }
      }
      __builtin_amdgcn_wave_barrier();
      {
        const float* Sg = ST + dir * 64 * GL_LB_STRIDE + fq * 8;
#pragma unroll
        for (int n = 0; n < 4; ++n) {
          float s8[8];
          gl_load8(Sg + (n * 16 + fr) * GL_LB_STRIDE, s8);
          const bf16x8 bS = pack_bf16x8(s8);
          o[n] = __builtin_amdgcn_mfma_f32_16x16x32_bf16(aqe, bS, o[n], 0, 0, 0);
        }
      }
    }
    __builtin_amdgcn_wave_barrier();
#pragma unroll
    for (int j = 0; j < 4; ++j) {
      float ss = o[0][j] * o[0][j] + o[1][j] * o[1][j] + o[2][j] * o[2][j] + o[3][j] * o[3][j];
      ss += xor_lane_f<1>(ss); ss += xor_lane_f<2>(ss); ss += xor_lane_f<4>(ss); ss += xor_lane_f<8>(ss);
      const float rstd = rsqrtf(ss * (1.f / 64.f) + EPSV);
#pragma unroll
      for (int n = 0; n < 4; ++n) Pw[(fq * 4 + j) * GL_VT_STRIDE + n * 16 + fr] = f2bf(o[n][j] * rstd);
    }
    __builtin_amdgcn_wave_barrier();
    {
      const int tl = lane >> 2, dq = (lane & 3) * 16;
      const int tok = gla_tok(sc, w * 16 + tl);
      const bf16_t* grow = p.cols + (size_t)tok * INW + C_GG + h * 64 + dq;
      float ov[16], gv[16];
      unpack8(*(const uint4*)(Pw + tl * GL_VT_STRIDE + dq), ov); unpack8(*(const uint4*)(Pw + tl * GL_VT_STRIDE + dq + 8), ov + 8);
      unpack8(*(const uint4*)grow, gv); unpack8(*(const uint4*)(grow + 8), gv + 8);
      const float* ng = p.gla_ng + layer * 512 + h * 64 + dq;
      unsigned wv[8];
#pragma unroll
      for (int e = 0; e < 8; ++e) {
        const float a = ov[2 * e] * ng[2 * e] * silu_f(gv[2 * e]), b = ov[2 * e + 1] * ng[2 * e + 1] * silu_f(gv[2 * e + 1]);
        wv[e] = (unsigned)f2bf(a) | ((unsigned)f2bf(b) << 16);
      }
      bf16_t* orow = p.mix + (size_t)tok * 1024 + 512 + h * 64 + dq;
      *(uint4*)orow = make_uint4(wv[0], wv[1], wv[2], wv[3]);
      *(uint4*)(orow + 8) = make_uint4(wv[4], wv[5], wv[6], wv[7]);
    }
    __builtin_amdgcn_wave_barrier();
    cur = nxt;
  }
  __syncthreads();
}

__device__ __forceinline__ unsigned fkey(float f) { const unsigned u = __float_as_uint(f); return u ^ ((u >> 31) ? 0xFFFFFFFFu : 0x80000000u); }
__device__ __forceinline__ float funkey(unsigned k) { return __uint_as_float((k >> 31) ? (k ^ 0x80000000u) : ~k); }
__device__ __forceinline__ unsigned umax3(unsigned a, unsigned b) { return a > b ? a : b; }
__device__ __forceinline__ unsigned umin3(unsigned a, unsigned b) { return a < b ? a : b; }
__device__ __forceinline__ unsigned umed3(unsigned a, unsigned b, unsigned c) { return umax3(umin3(a, b), umin3(umax3(a, b), c)); }
__device__ __forceinline__ void top16_insert(unsigned (&L)[16], unsigned x) {
#pragma unroll
  for (int q = 15; q >= 1; --q) L[q] = umed3(L[q - 1], L[q], x);
  L[0] = umax3(L[0], x);
}
template <int XM>
__device__ __forceinline__ void top16_merge(unsigned (&L)[16]) {
  unsigned P[16];
#pragma unroll
  for (int i = 0; i < 16; ++i) P[i] = xor_lane_u<XM>(L[i]);
  unsigned M[16];
#pragma unroll
  for (int i = 0; i < 16; ++i) M[i] = umax3(L[i], P[15 - i]);
#pragma unroll
  for (int d = 8; d >= 1; d >>= 1) {
#pragma unroll
    for (int i = 0; i < 16; ++i) {
      if ((i & d) == 0) { const unsigned hi = umax3(M[i], M[i + d]), lo = umin3(M[i], M[i + d]); M[i] = hi; M[i + d] = lo; }
    }
  }
#pragma unroll
  for (int i = 0; i < 16; ++i) L[i] = M[i];
}
#define RT_MAX_ITEMS 5
__device__ __forceinline__ void phase_route(const Params& p, int layer, int ntok, int bid, int nblk, unsigned char* smem) {
  const int tid = opaque_tid(); const int lane = tid & 63, wid = tid >> 6;
  unsigned* lists_w = (unsigned*)smem + wid * (RT_MAX_ITEMS * 2 * 16 * 16);
  const int fr = lane & 15, fq = lane >> 4;
  const bf16_t* qb = p.cols;
  const int nitems = ntok / 16;
  static const unsigned char STAIR[52] = {0, 1, 2, 3, 4, 5, 6, 7, 8, 9, 10, 11, 12, 13, 14, 15, 16, 17, 18, 19, 20, 21, 22, 23, 32, 33, 34, 35, 36, 48, 49, 50, 51, 64, 65, 66, 80, 81, 96, 97, 112, 113, 128, 144, 160, 176, 192, 208, 224, 240, 255, 255};
  for (int item0 = bid; item0 < nitems; item0 += nblk * RT_MAX_ITEMS) {
    for (int ph = 0; ph < 2; ++ph) {
      bf16x8 bk[8][4];
      {
        const bf16_t* kb = p.keysb + ((((size_t)layer * 2 + ph) * 8 + wid) * 128) * 128 + (size_t)fr * 128 + fq * 8;
#pragma unroll
        for (int n = 0; n < 8; ++n)
#pragma unroll
          for (int kt = 0; kt < 4; ++kt) bk[n][kt] = *(const bf16x8*)(kb + (size_t)n * 16 * 128 + kt * 32);
      }
      bf16x8 an[4];
      {
        const bf16_t* qrow = qb + (size_t)(item0 * 16 + fr) * 2048 + wid * 256 + ph * 128 + fq * 8;
#pragma unroll
        for (int kt = 0; kt < 4; ++kt) an[kt] = *(const bf16x8*)(qrow + kt * 32);
      }
      for (int ii = 0; ii < RT_MAX_ITEMS; ++ii) {
        const int item = item0 + ii * nblk;
        if (item >= nitems) break;
        const int tok0 = item * 16;
        bf16x8 a[4];
#pragma unroll
        for (int kt = 0; kt < 4; ++kt) a[kt] = an[kt];
        {
          const int itn = item0 + (ii + 1) * nblk;
          const int tokn = (ii + 1 < RT_MAX_ITEMS && itn < nitems) ? itn * 16 : tok0;
          const bf16_t* qrow = qb + (size_t)(tokn + fr) * 2048 + wid * 256 + ph * 128 + fq * 8;
#pragma unroll
          for (int kt = 0; kt < 4; ++kt) an[kt] = *(const bf16x8*)(qrow + kt * 32);
        }
        unsigned L[16];
#pragma unroll
        for (int i = 0; i < 16; ++i) L[i] = 0u;
#pragma unroll
        for (int n = 0; n < 8; ++n) {
          f32x4 acc = (f32x4){0.f, 0.f, 0.f, 0.f};
#pragma unroll
          for (int kt = 0; kt < 4; ++kt) acc = __builtin_amdgcn_mfma_f32_16x16x32_bf16(bk[n][kt], a[kt], acc, 0, 0, 0);
#pragma unroll
          for (int j = 0; j < 4; ++j) top16_insert(L, (fkey(acc[j]) & 0xFFFFFF80u) | (unsigned)(n * 16 + fq * 4 + j));
        }
        top16_merge<16>(L);
        top16_merge<32>(L);
        if (fq == 0) {
          unsigned* dst = lists_w + ((ii * 2 + ph) * 16 + fr) * 16;
#pragma unroll
          for (int i = 0; i < 4; ++i) *(uint4*)(dst + i * 4) = make_uint4(L[i * 4], L[i * 4 + 1], L[i * 4 + 2], L[i * 4 + 3]);
        }
      }
    }
    __builtin_amdgcn_wave_barrier();
    for (int ii = 0; ii < RT_MAX_ITEMS; ++ii) {
      const int item = item0 + ii * nblk;
      if (item >= nitems) break;
      const int tok0 = item * 16;
      const unsigned* l1 = lists_w + ((ii * 2 + 0) * 16 + fr) * 16;
      const unsigned* l2 = lists_w + ((ii * 2 + 1) * 16 + fr) * 16;
      unsigned T[16];
#pragma unroll
      for (int i = 0; i < 16; ++i) T[i] = 0u;
#pragma unroll
      for (int j = 0; j < 13; ++j) {
        const unsigned c = STAIR[fq + 4 * j];
        const float sa = funkey(l1[(c >> 4) & 15] & 0xFFFFFF80u), sb = funkey(l2[c & 15] & 0xFFFFFF80u);
        const unsigned key = (fkey(sa + sb) & 0xFFFFFF00u) | c;
        top16_insert(T, c == 255u ? 0u : key);
      }
      top16_merge<16>(T);
      top16_merge<32>(T);
      const float mx = funkey(T[0] & 0xFFFFFF00u);
      float ex[16], sum = 0.f;
#pragma unroll
      for (int r = 0; r < 16; ++r) { ex[r] = __expf(funkey(T[r] & 0xFFFFFF00u) - mx); sum += ex[r]; }
      const float inv = 1.f / sum;
      int eid[4]; float gt[4];
#pragma unroll
      for (int r = 0; r < 16; ++r) {
        if ((r >> 2) == fq) {
          const int a = (T[r] >> 4) & 15, b = T[r] & 15;
          eid[r & 3] = (int)(l1[a] & 127u) * 128 + (int)(l2[b] & 127u);
          gt[r & 3] = ex[r] * inv;
        }
      }
      const size_t o = (size_t)(tok0 + fr) * 128 + wid * 16 + fq * 4;
      *(int4*)(p.pidx + o) = make_int4(eid[0], eid[1], eid[2], eid[3]);
      *(f32x4*)(p.pgate + o) = (f32x4){gt[0], gt[1], gt[2], gt[3]};
    }
    __builtin_amdgcn_wave_barrier();
  }
  __syncthreads();
}

typedef float f32x2 __attribute__((ext_vector_type(2)));
__device__ __forceinline__ float dot16_fp8(const uint4& r, const f32x2* h2) {
  const unsigned w[4] = {r.x, r.y, r.z, r.w};
  f32x2 d = {0.f, 0.f};
#pragma unroll
  for (int q = 0; q < 4; ++q) {
    d += __builtin_amdgcn_cvt_pk_f32_fp8(w[q], false) * h2[q * 2];
    d += __builtin_amdgcn_cvt_pk_f32_fp8(w[q], true) * h2[q * 2 + 1];
  }
  return d.x + d.y;
}
__device__ __forceinline__ void fma16_fp8(f32x2* acc2, const uint4& r, float w8) {
  const unsigned w[4] = {r.x, r.y, r.z, r.w};
  const f32x2 ww = {w8, w8};
#pragma unroll
  for (int q = 0; q < 4; ++q) {
    acc2[q * 2] += ww * __builtin_amdgcn_cvt_pk_f32_fp8(w[q], false);
    acc2[q * 2 + 1] += ww * __builtin_amdgcn_cvt_pk_f32_fp8(w[q], true);
  }
}
struct XcdInfo { int rank, nloc, xi, nx; };
__device__ __forceinline__ XcdInfo xcd_info(const XcdBarrier& b) {
  if (threadIdx.x == 0) {
    unsigned xi = 0;
    for (unsigned j = 0; j < 16; ++j) { const unsigned c = xb_ld(&b.bar[XB_XCNT(j)]); if (j < b.x && c > 0u) ++xi; }
    b.st[3] = xi;
  }
  __syncthreads();
  XcdInfo r;
  r.nloc = __builtin_amdgcn_readfirstlane((int)b.st[0]); r.nx = __builtin_amdgcn_readfirstlane((int)b.st[1]);
  r.rank = __builtin_amdgcn_readfirstlane((int)b.st[2]); r.xi = __builtin_amdgcn_readfirstlane((int)b.st[3]);
  return r;
}
__device__ __forceinline__ void gs_issue(uint4 (&buf)[16], const unsigned char* tab, const int* el, int grp) {
#pragma unroll
  for (int k = 0; k < 16; ++k) buf[k] = *(const uint4*)(tab + (size_t)el[k * 8 + grp] * 1024);
}
__device__ __forceinline__ void phase_gather_u(const Params& p, int layer, int ntok, const XcdInfo xin, unsigned char* smem) {
  const int tid = opaque_tid(); const int lane = tid & 63, wid = tid >> 6;
  int* elw = (int*)smem + wid * 256;
  float* pbuf = (float*)p.cols;
  const int sub = lane & 7, grp = lane >> 3;
  const bool b0 = (lane & 1) != 0, b1 = (lane & 2) != 0, b2 = (lane & 4) != 0;
  const int tstep = xin.nloc * NW;
  for (int s = xin.xi; s < 8; s += xin.nx) {
    const unsigned char* EU = p.eu8 + (size_t)layer * 16384 * 1024 + s * 128 + sub * 16;
    const int t0 = xin.rank * NW + wid;
    if (t0 >= ntok) continue;
    const int kslot = ((b0 ? 8 : 0) + (b1 ? 4 : 0) + (b2 ? 2 : 0)) * 8 + grp;
    uint4 bufA[16], bufB[16];
    uint4 hA0, hA1, hB0, hB1;
    int i0n, i1n;
    {
      elw[lane] = p.pidx[(size_t)t0 * 128 + lane]; elw[64 + lane] = p.pidx[(size_t)t0 * 128 + 64 + lane];
      __builtin_amdgcn_wave_barrier();
      gs_issue(bufA, EU, elw, grp);
      hA0 = *(const uint4*)(p.abuf + (size_t)t0 * 1024 + s * 128 + sub * 16); hA1 = *(const uint4*)(p.abuf + (size_t)t0 * 1024 + s * 128 + sub * 16 + 8);
      const int t1 = t0 + tstep < ntok ? t0 + tstep : t0;
      i0n = p.pidx[(size_t)t1 * 128 + lane]; i1n = p.pidx[(size_t)t1 * 128 + 64 + lane];
    }
    int par = 0;
    for (int t = t0; t < ntok; t += 2 * tstep) {
#pragma unroll
      for (int hh = 0; hh < 2; ++hh) {
        const int tc = t + hh * tstep;
        if (tc < ntok) {
          uint4 (&cur)[16] = hh ? bufB : bufA;
          uint4 (&nxt)[16] = hh ? bufA : bufB;
          const uint4 hc0 = hh ? hB0 : hA0, hc1 = hh ? hB1 : hA1;
          const int tn = tc + tstep < ntok ? tc + tstep : tc;
          par ^= 1;
          int* eln = elw + par * 128;
          eln[lane] = i0n; eln[64 + lane] = i1n;
          __builtin_amdgcn_wave_barrier();
          gs_issue(nxt, EU, eln, grp);
          const uint4 hn0 = *(const uint4*)(p.abuf + (size_t)tn * 1024 + s * 128 + sub * 16), hn1 = *(const uint4*)(p.abuf + (size_t)tn * 1024 + s * 128 + sub * 16 + 8);
          const int tnn = tn + tstep < ntok ? tn + tstep : tn;
          i0n = p.pidx[(size_t)tnn * 128 + lane]; i1n = p.pidx[(size_t)tnn * 128 + 64 + lane];
          f32x2 hv2[8];
          {
            float hv[16];
            unpack8(hc0, hv); unpack8(hc1, hv + 8);
#pragma unroll
            for (int q = 0; q < 8; ++q) hv2[q] = (f32x2){hv[2 * q], hv[2 * q + 1]};
          }
          float d[16];
#pragma unroll
          for (int k = 0; k < 16; ++k) d[k] = dot16_fp8(cur[k], hv2);
          float d8[8], d4[4], d2[2];
#pragma unroll
          for (int q = 0; q < 8; ++q) { const float send = b0 ? d[q] : d[q + 8]; const float keep = b0 ? d[q + 8] : d[q]; d8[q] = keep + xor_lane_f<1>(send); }
#pragma unroll
          for (int q = 0; q < 4; ++q) { const float send = b1 ? d8[q] : d8[q + 4]; const float keep = b1 ? d8[q + 4] : d8[q]; d4[q] = keep + xor_lane_f<2>(send); }
#pragma unroll
          for (int q = 0; q < 2; ++q) { const float send = b2 ? d4[q] : d4[q + 2]; const float keep = b2 ? d4[q + 2] : d4[q]; d2[q] = keep + xor_lane_f<4>(send); }
          float* dst = pbuf + ((size_t)s * TT + tc) * 128 + kslot;
          dst[0] = d2[0]; dst[8] = d2[1];
          if (hh) { hA0 = hn0; hA1 = hn1; } else { hB0 = hn0; hB1 = hn1; }
        }
      }
    }
    __builtin_amdgcn_wave_barrier();
  }
}
__device__ __forceinline__ void phase_gather_r(const Params& p, int layer, int ntok, int bid, int nblk) {
  const int tid = opaque_tid();
  const float* pbuf = (const float*)p.cols;
  const size_t n4 = (size_t)ntok * 32;
  for (size_t i = (size_t)bid * NT + tid; i < n4; i += (size_t)nblk * NT) {
    f32x4 z = *(const f32x4*)(pbuf + i * 4);
#pragma unroll
    for (int s = 1; s < 8; ++s) z += *(const f32x4*)(pbuf + (size_t)s * TT * 128 + i * 4);
    const f32x4 g = *(const f32x4*)(p.pgate + i * 4);
    const int4 e = *(const int4*)(p.pidx + i * 4);
    const int ev[4] = {e.x, e.y, e.z, e.w};
    f32x4 w;
#pragma unroll
    for (int j = 0; j < 4; ++j) w[j] = g[j] * gelu_f(z[j] * p.su[layer * 16384 + ev[j]]) * p.sv[layer * 16384 + ev[j]];
    *(f32x4*)(p.wbuf + i * 4) = w;
  }
}
template <bool DUMMY>
__device__ __forceinline__ void phase_gather_v(const Params& p, int layer, int ntok, const XcdInfo xin, unsigned char* smem) {
  float* xout = DUMMY ? (float*)p.cols : p.xres;
  const int tid = opaque_tid(); const int lane = tid & 63, wid = tid >> 6;
  int* elw = (int*)smem + wid * 512;
  float* wlw = (float*)(elw + 256);
  const int sub = lane & 7, grp = lane >> 3;
  const bool b5 = (lane & 32) != 0, b4 = (lane & 16) != 0, b3 = (lane & 8) != 0;
  const int tstep = xin.nloc * NW;
  for (int s = xin.xi; s < 8; s += xin.nx) {
    const unsigned char* EV = p.ev8 + (size_t)layer * 16384 * 1024 + s * 128 + sub * 16;
    const int col = s * 128 + sub * 16 + (b3 ? 8 : 0) + (b4 ? 4 : 0) + (b5 ? 2 : 0);
    const int t0 = xin.rank * NW + wid;
    if (t0 >= ntok) continue;
    uint4 bufA[16], bufB[16];
    int i0n, i1n; float w0n, w1n;
    f32x2 xc, gc, xn, gn;
    {
      elw[lane] = p.pidx[(size_t)t0 * 128 + lane]; elw[64 + lane] = p.pidx[(size_t)t0 * 128 + 64 + lane];
      wlw[lane] = p.wbuf[(size_t)t0 * 128 + lane]; wlw[64 + lane] = p.wbuf[(size_t)t0 * 128 + 64 + lane];
      __builtin_amdgcn_wave_barrier();
      gs_issue(bufA, EV, elw, grp);
      xc = *(const f32x2*)(p.xres + (size_t)t0 * 1024 + col);
      gc = *(const f32x2*)(p.modv + ((size_t)layer * 5 + tok_batch(t0)) * NMOD + 5120 + col);
      const int t1 = t0 + tstep < ntok ? t0 + tstep : t0;
      i0n = p.pidx[(size_t)t1 * 128 + lane]; i1n = p.pidx[(size_t)t1 * 128 + 64 + lane];
      w0n = p.wbuf[(size_t)t1 * 128 + lane]; w1n = p.wbuf[(size_t)t1 * 128 + 64 + lane];
      xn = *(const f32x2*)(p.xres + (size_t)t1 * 1024 + col);
      gn = *(const f32x2*)(p.modv + ((size_t)layer * 5 + tok_batch(t1)) * NMOD + 5120 + col);
    }
    int par = 0;
    for (int t = t0; t < ntok; t += 2 * tstep) {
#pragma unroll
      for (int hh = 0; hh < 2; ++hh) {
        const int tc = t + hh * tstep;
        if (tc < ntok) {
          uint4 (&cur)[16] = hh ? bufB : bufA;
          uint4 (&nxt)[16] = hh ? bufA : bufB;
          const float* wlc = wlw + par * 128;
          const int tn = tc + tstep < ntok ? tc + tstep : tc;
          par ^= 1;
          int* eln = elw + par * 128; float* wln = wlw + par * 128;
          eln[lane] = i0n; eln[64 + lane] = i1n; wln[lane] = w0n; wln[64 + lane] = w1n;
          __builtin_amdgcn_wave_barrier();
          gs_issue(nxt, EV, eln, grp);
          const f32x2 xcur = xc, gcur = gc;
          xc = xn; gc = gn;
          const int tnn = tn + tstep < ntok ? tn + tstep : tn;
          i0n = p.pidx[(size_t)tnn * 128 + lane]; i1n = p.pidx[(size_t)tnn * 128 + 64 + lane];
          w0n = p.wbuf[(size_t)tnn * 128 + lane]; w1n = p.wbuf[(size_t)tnn * 128 + 64 + lane];
          xn = *(const f32x2*)(p.xres + (size_t)tnn * 1024 + col);
          gn = *(const f32x2*)(p.modv + ((size_t)layer * 5 + tok_batch(tnn)) * NMOD + 5120 + col);
          f32x2 acc2[8];
#pragma unroll
          for (int j = 0; j < 8; ++j) acc2[j] = (f32x2){0.f, 0.f};
#pragma unroll
          for (int k = 0; k < 16; ++k) fma16_fp8(acc2, cur[k], wlc[k * 8 + grp]);
          float a16[16];
#pragma unroll
          for (int q = 0; q < 8; ++q) { a16[2 * q] = acc2[q].x; a16[2 * q + 1] = acc2[q].y; }
          float a8[8], a4[4], a2[2];
#pragma unroll
          for (int q = 0; q < 8; ++q) { const float send = b3 ? a16[q] : a16[q + 8]; const float keep = b3 ? a16[q + 8] : a16[q]; a8[q] = keep + xor_lane_f<8>(send); }
#pragma unroll
          for (int q = 0; q < 4; ++q) { const float send = b4 ? a8[q] : a8[q + 4]; const float keep = b4 ? a8[q + 4] : a8[q]; a4[q] = keep + xor_lane_f<16>(send); }
#pragma unroll
          for (int q = 0; q < 2; ++q) { const float send = b5 ? a4[q] : a4[q + 2]; const float keep = b5 ? a4[q + 2] : a4[q]; a2[q] = keep + xor_lane_f<32>(send); }
          f32x2 xv = xcur;
          xv.x += gcur.x * a2[0]; xv.y += gcur.y * a2[1];
          *(f32x2*)(xout + (size_t)tc * 1024 + col) = xv;
        }
      }
    }
    __builtin_amdgcn_wave_barrier();
  }
}
__device__ __forceinline__ void phase_gather_norm(const Params& p, int layer, int ntok, int bid, int nblk) {
  const int tid = opaque_tid(); const int lane = tid & 63, wid = tid >> 6;
  for (int t = bid * NW + wid; t < ntok; t += nblk * NW) {
    f32x4 xv[4];
    float ss = 0.f;
#pragma unroll
    for (int q = 0; q < 4; ++q) {
      xv[q] = *(const f32x4*)(p.xres + (size_t)t * 1024 + lane * 16 + q * 4);
      ss += xv[q][0] * xv[q][0] + xv[q][1] * xv[q][1] + xv[q][2] * xv[q][2] + xv[q][3] * xv[q][3];
    }
    ss = wave_sum(ss);
    const float rstd = rsqrtf(ss * (1.f / 1024.f) + EPSV);
    if (layer == 0) {
      const float* md1 = p.modv + ((size_t)5 + tok_batch(t)) * NMOD;
#pragma unroll
      for (int q = 0; q < 4; ++q) {
        const int c0 = lane * 16 + q * 4;
        const f32x4 g = *(const f32x4*)(p.norm1_g + 1024 + c0);
        const f32x4 sh = *(const f32x4*)(md1 + c0);
        const f32x4 sc = *(const f32x4*)(md1 + 1024 + c0);
        ushort4 o;
        o.x = f2bf(xv[q][0] * rstd * g[0] * (1.f + sc[0]) + sh[0]);
        o.y = f2bf(xv[q][1] * rstd * g[1] * (1.f + sc[1]) + sh[1]);
        o.z = f2bf(xv[q][2] * rstd * g[2] * (1.f + sc[2]) + sh[2]);
        o.w = f2bf(xv[q][3] * rstd * g[3] * (1.f + sc[3]) + sh[3]);
        *(ushort4*)(p.abuf + (size_t)t * 1024 + c0) = o;
      }
    } else {
#pragma unroll
      for (int q = 0; q < 4; ++q) {
        const int c0 = lane * 16 + q * 4;
        const f32x4 g = *(const f32x4*)(p.final_g + c0);
        f32x4 o;
        o[0] = xv[q][0] * rstd * g[0]; o[1] = xv[q][1] * rstd * g[1]; o[2] = xv[q][2] * rstd * g[2]; o[3] = xv[q][3] * rstd * g[3];
        *(f32x4*)(p.out + (size_t)t * 1024 + c0) = o;
      }
    }
  }
}

__device__ __forceinline__ void phase_final(const Params& p, int bid, int nblk) {
  const int tid = opaque_tid(); const int lane = tid & 63, wid = tid >> 6;
  for (int t = bid * 4 + wid; t < TL; t += nblk * 4) {
    const float* row = p.xres + (size_t)t * 1024;
    f32x4 v[4];
    float ss = 0.f;
#pragma unroll
    for (int j = 0; j < 4; ++j) {
      v[j] = *(const f32x4*)(row + j * 256 + lane * 4);
      ss += v[j][0] * v[j][0] + v[j][1] * v[j][1] + v[j][2] * v[j][2] + v[j][3] * v[j][3];
    }
    ss = wave_sum(ss);
    const float rstd = rsqrtf(ss * (1.f / 1024.f) + EPSV);
#pragma unroll
    for (int j = 0; j < 4; ++j) {
      const int c0 = j * 256 + lane * 4;
      const f32x4 g = *(const f32x4*)(p.final_g + c0);
      f32x4 o;
      o[0] = v[j][0] * rstd * g[0]; o[1] = v[j][1] * rstd * g[1]; o[2] = v[j][2] * rstd * g[2]; o[3] = v[j][3] * rstd * g[3];
      *(f32x4*)(p.out + (size_t)t * 1024 + c0) = o;
    }
  }
}

template <class Epi>
__device__ __forceinline__ void run_gemm(const bf16_t* A, const bf16_t* Bt, int M, int N, int K, const Epi& epi, int bid, int nblk, unsigned char* smem) {
  pg8::Gemm g{A, Bt, M, N, K};
  pg8::StaticOrder S; S.init(M, N, nblk, bid);
  pg8::gemm_phase(( PG8_LAS unsigned char*)smem, g, S, epi);
}
__device__ __forceinline__ void phase_gemm_in(const Params& p, int layer, int bid, int nblk, unsigned char* smem) {
  pg8::EpiBf16 epi{p.cols, INW, INW};
  run_gemm(p.abuf, p.wt_in + (size_t)layer * INWP * 1024, TT, INWP, 1024, epi, bid, nblk, smem);
}
__device__ __forceinline__ void phase_gemm_glu(const Params& p, int layer, int ntok, int bid, int nblk, unsigned char* smem) {
  pg8::EpiGlu epi{p.mix};
  run_gemm(p.yg, p.wt_glu + (size_t)layer * 512 * 256, ntok, 512, 256, epi, bid, nblk, smem);
}
__device__ __forceinline__ void phase_gemm_out(const Params& p, int layer, int ntok, int bid, int nblk, unsigned char* smem) {
  pg8::EpiResid epi{p.xres, p.modv + (size_t)layer * 5 * NMOD, 2048};
  run_gemm(p.mix, p.wt_out + (size_t)layer * 1024 * 1024, ntok, 1024, 1024, epi, bid, nblk, smem);
}
__device__ __forceinline__ void phase_gemm_q(const Params& p, int layer, int ntok, int bid, int nblk, unsigned char* smem) {
  pg8::EpiBf16 epi{p.cols  , 2048, 2048};
  run_gemm(p.abuf, p.wt_q + (size_t)layer * 2048 * 1024, ntok, 2048, 1024, epi, bid, nblk, smem);
}

template <int L>
__device__ __forceinline__ void layer_body(const Params& p, const XcdBarrier& bar, const XcdInfo xin, int bid, int nblk, unsigned char* smem) {
  constexpr int l = L;
  constexpr int ntok = L == 0 ? TT : TL;
  for (int rep = 0; rep < REP_GEMM; ++rep) phase_gemm_in(p, l, bid, nblk, smem);
  xcd_barrier(bar);
  for (int rep = 0; rep < REP_MIX; ++rep) {
    phase_s5a(p, l, bid, nblk, smem);
    if (REP_S5 > 1) phase_s5a(p, l, bid, nblk, smem);
    for (int r2 = 0; r2 < REP_GLA; ++r2) phase_glaa(p, l, bid, nblk, smem);
  }
  xcd_barrier(bar);
  phase_scan(p, l, bid, nblk);
  for (int r2 = 0; r2 < REP_SGU; ++r2) phase_sgu(p, l, ntok / 128, bid, nblk, smem);
  xcd_barrier(bar);
  for (int rep = 0; rep < REP_MIX; ++rep) {
    phase_s5c(p, l, ntok / 64, bid, nblk, smem);
    if (REP_S5 > 1) phase_s5c(p, l, ntok / 64, bid, nblk, smem);
    for (int r2 = 0; r2 < REP_GLA; ++r2) phase_glac(p, l, ntok / 64, 16 * ((ntok / 64 / 16 + 1) / 2), bid, nblk, smem);
  }
  xcd_barrier(bar);
  for (int rep = 0; rep < REP_GEMM; ++rep) phase_gemm_glu(p, l, ntok, bid, nblk, smem);
  xcd_barrier(bar);
  if (REP_GEMM > 1) {
    pg8::EpiBf16 epi{p.abuf, 1024, 1024};
    for (int rep = 1; rep < REP_GEMM; ++rep) run_gemm(p.mix, p.wt_out + (size_t)l * 1024 * 1024, ntok, 1024, 1024, epi, bid, nblk, smem);
  }
  phase_gemm_out(p, l, ntok, bid, nblk, smem);
  if (l == 0 && nblk > 16 && bid >= 16) {
    const int tid = opaque_tid();
    for (int j = bid - 16; j < 2048; j += nblk - 16) convert_rows(p, (j >> 10) * 2048 + 1024 + (j & 1023), tid);
  } else if (l == 0 && nblk <= 16) {
    const int tid = opaque_tid();
    for (int j = bid; j < 2048; j += nblk) convert_rows(p, (j >> 10) * 2048 + 1024 + (j & 1023), tid);
  }
  xcd_barrier(bar);
  for (int rep = 0; rep < REP_PRO; ++rep)
    phase_normmod(p, p.xres, p.xres + (size_t)TL * 1024, p.norm2_g + l * 1024, p.modv + (size_t)l * 5 * NMOD, 3072, 4096, ntok, 0, bid, nblk);
  xcd_barrier(bar);
  for (int rep = 0; rep < REP_GEMM; ++rep) phase_gemm_q(p, l, ntok, bid, nblk, smem);
  xcd_barrier(bar);
  for (int rep = 0; rep < REP_ROUTE; ++rep) phase_route(p, l, ntok, bid, nblk, smem);
  xcd_barrier(bar);
  phase_gather_u(p, l, ntok, xin, smem);
  if (REP_GATHER == 2) phase_gather_u(p, l, ntok, xin, smem);
  xcd_barrier(bar);
  phase_gather_r(p, l, ntok, bid, nblk);
  xcd_barrier(bar);
  if (REP_GATHER > 2) phase_gather_v<true>(p, l, ntok, xin, smem);
  phase_gather_v<false>(p, l, ntok, xin, smem);
  xcd_barrier(bar);
  phase_gather_norm(p, l, ntok, bid, nblk);
  if (l == 0) xcd_barrier(bar);
}

#define SMEM_BYTES (148 * 1024)
__global__ void __launch_bounds__(NT) mega_kernel(Params p) {
  __shared__ __attribute__((aligned(16))) unsigned char smem[SMEM_BYTES + 16];
  const int bid = blockIdx.x, nblk = gridDim.x;
  volatile LAS unsigned* xbw = (volatile LAS unsigned*)(smem + SMEM_BYTES);
  if (threadIdx.x == 0) { xbw[0] = 0u; xbw[1] = 0u; xbw[2] = 0u; xbw[3] = 0u; }
  __syncthreads();
  XcdBarrier bar = xcd_barrier_post(p.bar, xbw);
  for (int rep = 0; rep < REP_PRO; ++rep) {
    phase_mod(p, bid, nblk, smem);
    phase_wprep(p, bid, nblk, smem);
  }
  xcd_barrier(bar);
  for (int rep = 0; rep < REP_PRO; ++rep) phase_normmod(p, p.x, p.ctx, p.norm1_g, p.modv, 0, 1024, TT, 1, bid, nblk);
  xcd_barrier(bar);
  const XcdInfo xin = xcd_info(bar);
  layer_body<0>(p, bar, xin, bid, nblk, smem);
  layer_body<1>(p, bar, xin, bid, nblk, smem);
}

static inline size_t align_up(size_t v, size_t a) { return (v + a - 1) / a * a; }

extern "C" void kernel_launch(void* const* d_in, const int* in_sizes, int n_in, void* d_out, int out_size, void* d_ws, size_t ws_size,
                              hipStream_t stream) {
  Params p{};
  const float* const* in = (const float* const*)d_in;
  p.x = in[0]; p.c = in[1]; p.ctx = in[2]; p.c_ctx = in[3]; p.w_mod = in[4]; p.b_mod = in[5]; p.norm1_g = in[6]; p.norm2_g = in[7];
  p.w_in = in[8]; p.w_out = in[9]; p.sgu_w = in[10]; p.sgu_b = in[11]; p.lam_re = in[12]; p.lam_im = in[13]; p.b_re = in[14]; p.b_im = in[15];
  p.c_re = in[16]; p.c_im = in[17]; p.log_step = in[18]; p.s5_d = in[19]; p.w_glu = in[20]; p.gla_wg = in[21]; p.gla_bg = in[22]; p.gla_ng = in[23];
  p.w_query = in[24]; p.sub_keys = in[25]; p.exp_u = in[26]; p.exp_v = in[27]; p.final_g = in[28];
  p.out = (float*)d_out;
  unsigned char* w = (unsigned char*)d_ws;
  size_t off = 0;
  auto take = [&](size_t bytes) { void* r = w + off; off = align_up(off + bytes, 256); return r; };
  p.bar = (unsigned*)take(16384);
  p.xres = (float*)take((size_t)TT * 1024 * 4);
  p.modv = (float*)take((size_t)2 * 5 * NMOD * 4);
  p.abuf = (bf16_t*)take((size_t)TT * 1024 * 2);
  p.cols = (bf16_t*)take((size_t)TT * INW * 2);
  p.mix = (bf16_t*)take((size_t)TT * 1024 * 2);
  p.yg = (bf16_t*)take((size_t)TT * 256 * 2);
  p.wt_in = (bf16_t*)take((size_t)2 * INWP * 1024 * 2);
  p.wt_out = (bf16_t*)take((size_t)2 * 1024 * 1024 * 2);
  p.wt_q = (bf16_t*)take((size_t)2 * 2048 * 1024 * 2);
  p.wt_glu = (bf16_t*)take((size_t)2 * 512 * 256 * 2);
  p.keysb = (bf16_t*)take((size_t)2 * 2 * 8 * 128 * 128 * 2);
  p.sgu_wb = (bf16_t*)take((size_t)2 * 4 * 128 * 128 * 2);
  p.s5a = (float*)take((size_t)4096 * 2 * 4);
  p.s5a64 = (float*)take((size_t)4096 * 2 * 4);
  p.s5bb = (float*)take((size_t)4096 * 32 * 4);
  p.s5K = (bf16_t*)take((size_t)64 * 16384 * 2);
  p.s5M1 = (bf16_t*)take((size_t)64 * 131072 * 2);
  p.s5N2 = (bf16_t*)take((size_t)64 * 131072 * 2);
  p.s5S = (float*)take((size_t)2 * NSC * 16 * 64 * 2 * 4);
  p.s5H = (float*)take((size_t)2 * NSC * 16 * 64 * 2 * 4);
  p.gkv = (float*)take((size_t)2 * NSC * 8 * 2048 * 4);
  p.gdec = (float*)take((size_t)2 * NSC * 8 * 32 * 4);
  p.eu8 = (unsigned char*)take((size_t)2 * 16384 * 1024);
  p.ev8 = (unsigned char*)take((size_t)2 * 16384 * 1024);
  p.su = (float*)take((size_t)2 * 16384 * 4);
  p.sv = (float*)take((size_t)2 * 16384 * 4);
  p.glb = (float*)take((size_t)2 * TT * 256 * 4);
  p.wbuf = (float*)take((size_t)TT * 128 * 4);
  p.ssbuf = (float*)take((size_t)TT * 8 * 4);
  p.pidx = (int*)take((size_t)TT * 128 * 4);
  p.pgate = (float*)take((size_t)TT * 128 * 4);
  if (off > ws_size) { fprintf(stderr, "workspace too small: need %zu have %zu\n", off, ws_size); return; }

  (void)hipMemsetAsync(p.bar, 0, XCD_BAR_WORDS * 4, stream);
  static int grid_blocks = 0;
  if (!grid_blocks) {
    int dev = 0, cus = 0, per_cu = 0;
    (void)hipGetDevice(&dev);
    (void)hipDeviceGetAttribute(&cus, hipDeviceAttributeMultiprocessorCount, dev);
    (void)hipOccupancyMaxActiveBlocksPerMultiprocessor(&per_cu, (const void*)mega_kernel, NT, 0);
    if (per_cu < 1) { fprintf(stderr, "occupancy query says 0 blocks/CU\n"); per_cu = 1; }
    grid_blocks = cus;
  }
  void* args[] = {&p};
  hipError_t e = hipLaunchCooperativeKernel((const void*)mega_kernel, dim3(grid_blocks), dim3(NT), args, 0, stream);
  if (e != hipSuccess) fprintf(stderr, "cooperative launch failed: %s (grid %d)\n", hipGetErrorString(e), grid_blocks);
}
```

```cpp
#include <hip/hip_runtime.h>
#include <cstdio>
#include <cstdint>
#include <cmath>

typedef unsigned short bf16_t;
typedef short bf16x8 __attribute__((ext_vector_type(8)));
typedef float f32x4 __attribute__((ext_vector_type(4)));

#define DM 1024
#define NBATCH 4
#define SEQ 4096
#define CTXL 256
#define TL (NBATCH * SEQ)
#define TC (NBATCH * CTXL)
#define TT (TL + TC)
#define INW 2336
#define INWP 2560
#define NMOD 6144
#define NSC 272
#define EPSV 1e-6f
#define NT 512
#define NW 8
#ifndef REP_GATHER
#define REP_GATHER 1
#endif
#ifndef REP_ROUTE
#define REP_ROUTE 1
#endif
#ifndef REP_GEMM
#define REP_GEMM 1
#endif
#ifndef REP_MIX
#define REP_MIX 1
#endif
#ifndef REP_PRO
#define REP_PRO 1
#endif
#ifndef REP_SGU
#define REP_SGU 1
#endif
#ifndef REP_S5
#define REP_S5 1
#endif
#ifndef REP_GLA
#define REP_GLA 1
#endif

#define C_SGU_U 0
#define C_SGU_V 256
#define C_S5 512
#define C_GQ 768
#define C_GK 1024
#define C_GV 1280
#define C_GG 1792
#define C_ZF 2304

struct Params {
  const float *x, *c, *ctx, *c_ctx, *w_mod, *b_mod, *norm1_g, *norm2_g, *w_in, *w_out, *sgu_w, *sgu_b;
  const float *lam_re, *lam_im, *b_re, *b_im, *c_re, *c_im, *log_step, *s5_d, *w_glu, *gla_wg, *gla_bg, *gla_ng;
  const float *w_query, *sub_keys, *exp_u, *exp_v, *final_g;
  float* out;
  unsigned* bar;
  float* xres;
  float* modv;
  bf16_t* abuf;
  bf16_t* cols;
  bf16_t* mix;
  bf16_t* yg;
  bf16_t *wt_in, *wt_out, *wt_q, *wt_glu, *keysb, *sgu_wb;
  float *s5a, *s5a64, *s5bb;
  bf16_t *s5K, *s5M1, *s5N2;
  float *s5S, *s5H;
  float *gkv, *gdec;
  unsigned char *eu8, *ev8;
  float *su, *sv;
  float* glb;
  float *wbuf, *ssbuf;
  int* pidx;
  float* pgate;
};

__device__ __forceinline__ bf16_t f2bf(float f) {
  unsigned u = __float_as_uint(f);
  u += 0x7fffu + ((u >> 16) & 1u);
  return (bf16_t)(u >> 16);
}
__device__ __forceinline__ float bf2f(bf16_t h) { return __uint_as_float(((unsigned)h) << 16); }
__device__ __forceinline__ bf16x8 pack_bf16x8(const float* v) {
  bf16x8 r;
#pragma unroll
  for (int c = 0; c < 8; ++c) r[c] = (short)f2bf(v[c]);
  return r;
}

__device__ __forceinline__ float bflo(unsigned u) { return __uint_as_float(u << 16); }
__device__ __forceinline__ float bfhi(unsigned u) { return __uint_as_float(u & 0xffff0000u); }
__device__ __forceinline__ float gelu_f(float x) {
  const float y = 0.7978845608028654f * (x + 0.044715f * x * x * x);
  const float e = __expf(2.f * y);
  const float th = 1.f - 2.f / (1.f + e);
  return 0.5f * x * (1.f + th);
}
__device__ __forceinline__ float sigmoid_f(float x) { return 1.f / (1.f + __expf(-x)); }
__device__ __forceinline__ float silu_f(float x) { return x * sigmoid_f(x); }
__device__ __forceinline__ float logsigmoid_f(float x) { return fminf(x, 0.f) - log1pf(__expf(-fabsf(x))); }
template <int M>
__device__ __forceinline__ unsigned xor_lane_u(unsigned x) {
  if constexpr (M == 1) return (unsigned)__builtin_amdgcn_mov_dpp((int)x, 0xB1, 0xf, 0xf, true);
  else if constexpr (M == 2) return (unsigned)__builtin_amdgcn_mov_dpp((int)x, 0x4E, 0xf, 0xf, true);
  else if constexpr (M == 4) {
    const int a = __builtin_amdgcn_update_dpp((int)x, (int)x, 0x104, 0xf, 0x5, false);
    return (unsigned)__builtin_amdgcn_update_dpp(a, (int)x, 0x114, 0xf, 0xa, false);
  } else if constexpr (M == 8) return (unsigned)__builtin_amdgcn_mov_dpp((int)x, 0x128, 0xf, 0xf, true);
  else if constexpr (M == 16) {
    const auto r = __builtin_amdgcn_permlane16_swap(x, x, false, false);
    return ((threadIdx.x >> 4) & 1) ? r[0] : r[1];
  } else if constexpr (M == 32) {
    const auto r = __builtin_amdgcn_permlane32_swap(x, x, false, false);
    return (threadIdx.x & 32) ? r[0] : r[1];
  } else return (unsigned)__shfl_xor((int)x, M);
}
template <int M>
__device__ __forceinline__ float xor_lane_f(float x) { return __uint_as_float(xor_lane_u<M>(__float_as_uint(x))); }
__device__ __forceinline__ float wave_sum(float v) {
  v += xor_lane_f<32>(v); v += xor_lane_f<16>(v); v += xor_lane_f<8>(v); v += xor_lane_f<4>(v); v += xor_lane_f<2>(v); v += xor_lane_f<1>(v);
  return v;
}
__device__ __forceinline__ void lds_barrier() {
  asm volatile("s_waitcnt lgkmcnt(0)" ::: "memory");
  __builtin_amdgcn_s_barrier();
  asm volatile("" ::: "memory");
}
__device__ __forceinline__ int opaque_tid() { int t = threadIdx.x; asm volatile("" : "+v"(t)); return t; }
__device__ __forceinline__ int tok_batch(int t) { return t < TL ? (t >> 12) : 4; }
__device__ __forceinline__ int s5_tok(int sc, int i) { return sc < 256 ? ((sc >> 6) * SEQ + (sc & 63) * 64 + i) : (TL + (sc - 256) * 64 + i); }
__device__ __forceinline__ int gla_tok(int sc, int i) { return sc < 256 ? ((sc >> 6) * SEQ + i * 64 + (sc & 63)) : (TL + (sc - 256) * 64 + i); }


#define XB_TMO      128
#define XB_XCNT(j)  (256  + 64 * (j))
#define XB_XSUB(j)  (1280 + 64 * (j))
#define XB_XGEN(j)  (2304 + 64 * (j))
#define XB_TOP      3328
#define XB_TOPGEN   3392
#define XCD_BAR_WORDS 3456
#define XB_SPIN_CAP (1u << 22)
#define LAS __attribute__((address_space(3)))
__device__ __forceinline__ unsigned xb_ld(unsigned* p)              { return __hip_atomic_load(p, __ATOMIC_RELAXED, __HIP_MEMORY_SCOPE_AGENT); }
__device__ __forceinline__ unsigned xb_add(unsigned* p, unsigned v) { return __hip_atomic_fetch_add(p, v, __ATOMIC_RELAXED, __HIP_MEMORY_SCOPE_AGENT); }
__device__ __forceinline__ unsigned xb_xcc_id() { return (unsigned)__builtin_amdgcn_s_getreg((3 << 11) | 20) & 0xFu; }
#define XB_SPIN(cond, bar) do { unsigned _sp = 0; while (cond) { __builtin_amdgcn_s_sleep(1); \
    if ((++_sp & 255u) == 0u) { if (xb_ld(&(bar)[XB_TMO])) break; if (_sp > XB_SPIN_CAP) { atomicAdd(&(bar)[XB_TMO], 1u); break; } } } } while (0)
struct XcdBarrier { unsigned* bar; unsigned x; volatile LAS unsigned* st; };
__device__ __forceinline__ XcdBarrier xcd_barrier_post(unsigned* bar, volatile LAS unsigned* st) {
  XcdBarrier b; b.bar = bar; b.x = xb_xcc_id(); b.st = st;
  if (threadIdx.x == 0) st[2] = xb_add(&bar[XB_XCNT(b.x)], 1u);
  return b;
}
__device__ __forceinline__ void xcd_barrier_complete(unsigned* bar, unsigned x, unsigned& nloc, unsigned& nx) {
  const unsigned G = gridDim.x * gridDim.y * gridDim.z;
  unsigned sum, cnt, mine, sp = 0u;
  for (;;) {
    sum = 0u; cnt = 0u; mine = 0u;
#pragma unroll
    for (unsigned j = 0; j < 16; ++j) { const unsigned c = xb_ld(&bar[XB_XCNT(j)]); sum += c; cnt += (c > 0u) ? 1u : 0u; mine = (j == x) ? c : mine; }
    if (sum == G) break;
    __builtin_amdgcn_s_sleep(1);
    if ((++sp & 255u) == 0u) { if (xb_ld(&bar[XB_TMO])) break; if (sp > XB_SPIN_CAP) { atomicAdd(&bar[XB_TMO], 1u); break; } }
  }
  nloc = mine > 0u ? mine : 1u; nx = cnt > 0u ? cnt : 1u;
}
__device__ __forceinline__ void xcd_barrier(const XcdBarrier& b) {
  asm volatile("s_waitcnt vmcnt(0)" ::: "memory");
  __syncthreads();
  if (threadIdx.x == 0) {
    unsigned* bar = b.bar;
    __builtin_amdgcn_s_waitcnt(0);
    unsigned nloc = b.st[0], nx = b.st[1];
    if (nloc == 0u) { xcd_barrier_complete(bar, b.x, nloc, nx); b.st[0] = nloc; b.st[1] = nx; }
    const unsigned old = xb_add(&bar[XB_XSUB(b.x)], 1u);
    const unsigned gen = old / nloc;
    if (old + 1u == (gen + 1u) * nloc) {
      __builtin_amdgcn_fence(__ATOMIC_RELEASE, "agent");
      asm volatile("s_waitcnt vmcnt(0)" ::: "memory");
      const unsigned og = xb_add(&bar[XB_TOP], 1u);
      const unsigned tg = og / nx;
      if (og + 1u == (tg + 1u) * nx) xb_add(&bar[XB_TOPGEN], 1u);
      else XB_SPIN(xb_ld(&bar[XB_TOPGEN]) == tg, bar);
      __builtin_amdgcn_fence(__ATOMIC_ACQUIRE, "agent");
      xb_add(&bar[XB_XGEN(b.x)], 1u);
      asm volatile("s_waitcnt vmcnt(0)" ::: "memory");
    } else {
      XB_SPIN(xb_ld(&bar[XB_XGEN(b.x)]) == gen, bar);
      __builtin_amdgcn_fence(__ATOMIC_ACQUIRE, "agent");
      asm volatile("s_waitcnt vmcnt(0)" ::: "memory");
    }
  }
  __syncthreads();
}

__device__ __forceinline__ void phase_mod(const Params& p, int bid, int nblk, unsigned char* smem) {
  float* sil = (float*)smem;
  float* red = sil + 5 * 1024;
  const int tid = opaque_tid();
  for (int i = tid; i < 5 * 1024; i += NT) {
    const int r = i >> 10, k = i & 1023;
    const float v = r < 4 ? p.c[r * 1024 + k] : p.c_ctx[k];
    sil[i] = silu_f(v);
  }
  __syncthreads();
  for (int item = bid; item < 192; item += nblk) {
    const int l = item / 96, j0 = (item % 96) * 64;
    const int cc = tid & 63, kg = tid >> 6;
    float acc[5] = {0.f, 0.f, 0.f, 0.f, 0.f};
    const float* w = p.w_mod + (size_t)l * 1024 * NMOD + j0 + cc;
#pragma unroll 32
    for (int k = kg * 128; k < kg * 128 + 128; ++k) {
      const float wv = w[(size_t)k * NMOD];
#pragma unroll
      for (int r = 0; r < 5; ++r) acc[r] += sil[r * 1024 + k] * wv;
    }
#pragma unroll
    for (int r = 0; r < 5; ++r) red[(kg * 5 + r) * 64 + cc] = acc[r];
    __syncthreads();
    if (tid < 320) {
      const int r = tid >> 6;
      float s = 0.f;
#pragma unroll
      for (int g = 0; g < 8; ++g) s += red[(g * 5 + r) * 64 + cc];
      p.modv[((size_t)l * 5 + r) * NMOD + j0 + cc] = s + p.b_mod[l * NMOD + j0 + cc];
    }
    __syncthreads();
  }
}

__device__ __forceinline__ void transpose_tile(const float* src, int ldsrc, bf16_t* dst, int lddst, int k0, int r0, int nsrc, int glu, float* tile) {
  const int tid = opaque_tid();
  const int j = tid & 63;
  const int r = r0 + j;
  int scol;
  if (glu) {
    const int pn = r >> 8, bj = (r >> 7) & 1, i = r & 127;
    scol = bj * 256 + pn * 128 + i;
  } else {
    scol = r < nsrc ? r : -1;
  }
  float v[32];
#pragma unroll
  for (int it = 0; it < 32; ++it) {
    const int kk = (tid >> 6) + it * 8;
    v[it] = scol >= 0 ? src[(size_t)(k0 + kk) * ldsrc + scol] : 0.f;
  }
#pragma unroll
  for (int it = 0; it < 32; ++it) {
    const int kk = (tid >> 6) + it * 8;
    tile[(kk >> 6) * 4160 + (kk & 63) * 65 + j] = v[it];
  }
  __syncthreads();
  const int kq = tid & 63;
#pragma unroll
  for (int it = 0; it < 32; ++it) {
    const int jj = (tid >> 6) + (it & 7) * 8, sub = it >> 3;
    dst[(size_t)(r0 + jj) * lddst + k0 + sub * 64 + kq] = f2bf(tile[sub * 4160 + kq * 65 + jj]);
  }
  __syncthreads();
}

__device__ __forceinline__ void s5_tables(const Params& p, int id, int part, unsigned char* smem) {
  const int tid = opaque_tid();
  float2* Apow = (float2*)smem;
  float2* Bbs = Apow + 65 * 64;
  float2* Cs = Bbs + 64 * 16;
  __syncthreads();
  if (tid < 64) {
    const int pid = id * 64 + tid;
    double lre = (double)p.lam_re[pid];
    if (lre > -1e-4) lre = -1e-4;
    const double lim = (double)p.lam_im[pid];
    const double dt = exp((double)p.log_step[id]);
    const double mag = exp(lre * dt);
    const double are = mag * cos(lim * dt), aim = mag * sin(lim * dt);
    {
      double pr = 1.0, pi = 0.0;
      for (int n = 0; n <= 64; ++n) {
        Apow[n * 64 + tid] = make_float2((float)pr, (float)pi);
        const double nr = pr * are - pi * aim, ni = pr * aim + pi * are;
        pr = nr; pi = ni;
      }
    }
    const double den = lre * lre + lim * lim;
    const double fre = ((are - 1.0) * lre + aim * lim) / den;
    const double fim = (aim * lre - (are - 1.0) * lim) / den;
    for (int h = 0; h < 16; ++h) {
      const double br = (double)p.b_re[(size_t)pid * 16 + h], bi = (double)p.b_im[(size_t)pid * 16 + h];
      Bbs[tid * 16 + h] = make_float2((float)(fre * br - fim * bi), (float)(fre * bi + fim * br));
    }
  }
  for (int e = tid; e < 1024; e += NT) Cs[e] = make_float2(p.c_re[(size_t)id * 1024 + e], p.c_im[(size_t)id * 1024 + e]);
  __syncthreads();
  bf16_t* Kt = p.s5K + (size_t)id * 16384;
  for (int e = part * 2048 + tid; e < part * 2048 + 2048; e += NT) {
    const int d = e >> 8, hp = (e >> 4) & 15, h = e & 15;
    float acc = 0.f;
    for (int pp = 0; pp < 64; ++pp) {
      const float2 c = Cs[hp * 64 + pp], a = Apow[d * 64 + pp], b = Bbs[pp * 16 + h];
      const float cr = c.x * a.x - c.y * a.y, ci = c.x * a.y + c.y * a.x;
      acc += cr * b.x - ci * b.y;
    }
    Kt[e] = f2bf(acc);
  }
  bf16_t* M1 = p.s5M1 + (size_t)id * 131072;
  for (int e = part * 16384 + tid; e < part * 16384 + 16384; e += NT) {
    const int c = e >> 10, k = e & 1023, ri = c >> 6, pp = c & 63, tau = k >> 4, h = k & 15;
    const float2 a = Apow[(63 - tau) * 64 + pp], b = Bbs[pp * 16 + h];
    M1[e] = f2bf(ri ? (a.x * b.y + a.y * b.x) : (a.x * b.x - a.y * b.y));
  }
  bf16_t* N2 = p.s5N2 + (size_t)id * 131072;
  for (int e = part * 16384 + tid; e < part * 16384 + 16384; e += NT) {
    const int col = e >> 7, kk = e & 127, tau = col >> 4, hp = col & 15, ri = kk >> 6, pp = kk & 63;
    const float2 c = Cs[hp * 64 + pp], a = Apow[(tau + 1) * 64 + pp];
    N2[e] = f2bf(ri ? -(c.x * a.y + c.y * a.x) : (c.x * a.x - c.y * a.y));
  }
  __syncthreads();
}

__device__ __forceinline__ void convert_rows(const Params& p, int it, int tid) {
      const int lane = tid & 63;
      const int row0 = it * 16 + (tid >> 6) * 2;
      const int tab = row0 >> 15, r0 = row0 & 32767;
      const float* s = (tab ? p.exp_v : p.exp_u) + (size_t)r0 * 1024 + lane * 16;
      f32x4 v[2][4];
#pragma unroll
      for (int rr = 0; rr < 2; ++rr)
#pragma unroll
        for (int q = 0; q < 4; ++q) v[rr][q] = *(const f32x4*)(s + rr * 1024 + q * 4);
#pragma unroll
      for (int rr = 0; rr < 2; ++rr) {
        float m = 0.f;
#pragma unroll
        for (int q = 0; q < 4; ++q) m = fmaxf(m, fmaxf(fmaxf(fabsf(v[rr][q][0]), fabsf(v[rr][q][1])), fmaxf(fabsf(v[rr][q][2]), fabsf(v[rr][q][3]))));
#pragma unroll
        for (int o = 32; o > 0; o >>= 1) m = fmaxf(m, __shfl_xor(m, o));
        const float scale = m > 0.f ? m * (1.f / 400.f) : 1.f;
        const float inv = 1.f / scale;
        unsigned wv[4];
#pragma unroll
        for (int q = 0; q < 4; ++q) {
          unsigned w = 0;
          w = __builtin_amdgcn_cvt_pk_fp8_f32(v[rr][q][0] * inv, v[rr][q][1] * inv, w, false);
          w = __builtin_amdgcn_cvt_pk_fp8_f32(v[rr][q][2] * inv, v[rr][q][3] * inv, w, true);
          wv[q] = w;
        }
        *(uint4*)((tab ? p.ev8 : p.eu8) + (size_t)(r0 + rr) * 1024 + lane * 16) = make_uint4(wv[0], wv[1], wv[2], wv[3]);
        if (lane == 0) (tab ? p.sv : p.su)[r0 + rr] = scale;
      }
}

__device__ __forceinline__ void phase_wprep(const Params& p, int bid, int nblk, unsigned char* smem) {
  float* tile = (float*)smem;
  const int tid = opaque_tid();
  const int NT_L = 360;
  const int n_tr = 2 * NT_L;
  const int n_keys = 256 + 64;
  const int n_disc = 8;
  const int n_exp = 2048;
  const int n_s5t = 512;
  const int total = n_tr + n_keys + n_disc + n_exp + n_s5t;
  for (int item0 = bid; item0 < total; item0 += nblk) {
    const int item = item0 - n_s5t;
    if (item0 < n_s5t) {
      s5_tables(p, item0 >> 3, item0 & 7, smem);
    } else if (item < n_tr) {
      const int l = item / NT_L;
      int t = item % NT_L;
      if (t < 160) {
        transpose_tile(p.w_in + (size_t)l * 1024 * INW, INW, p.wt_in + (size_t)l * INWP * 1024, 1024, (t % 4) * 256, (t / 4) * 64, INW, 0, tile);
      } else if (t < 224) {
        t -= 160;
        transpose_tile(p.w_out + (size_t)l * 1024 * 1024, 1024, p.wt_out + (size_t)l * 1024 * 1024, 1024, (t % 4) * 256, (t / 4) * 64, 1024, 0, tile);
      } else if (t < 352) {
        t -= 224;
        transpose_tile(p.w_query + (size_t)l * 1024 * 2048, 2048, p.wt_q + (size_t)l * 2048 * 1024, 1024, (t % 4) * 256, (t / 4) * 64, 2048, 0, tile);
      } else {
        t -= 352;
        transpose_tile(p.w_glu + (size_t)l * 256 * 512, 512, p.wt_glu + (size_t)l * 512 * 256, 256, 0, t * 64, 512, 1, tile);
      }
    } else if (item < n_tr + n_keys) {
      const int ki = item - n_tr;
      if (ki < 256) {
        const int base = ki * 2048;
        for (int i = tid; i < 2048; i += NT) p.keysb[base + i] = f2bf(p.sub_keys[base + i]);
      } else {
        const int base = (ki - 256) * 2048;
        for (int i = tid; i < 2048; i += NT) p.sgu_wb[base + i] = f2bf(p.sgu_w[base + i]);
      }
    } else if (item >= n_tr + n_keys + n_disc) {
      const int j = item - (n_tr + n_keys + n_disc);
      convert_rows(p, (j >> 10) * 2048 + (j & 1023), tid);
    } else {
      const int id = (item - n_tr - n_keys) * NT + tid;
      const int g = (id >> 6) & 15;
      const int ldg = id >> 6;
      double lre = (double)p.lam_re[id];
      if (lre > -1e-4) lre = -1e-4;
      const double lim = (double)p.lam_im[id];
      const double dt = exp((double)p.log_step[ldg]);
      const double mag = exp(lre * dt);
      const double are = mag * cos(lim * dt), aim = mag * sin(lim * dt);
      const double den = lre * lre + lim * lim;
      const double fre = ((are - 1.0) * lre + aim * lim) / den;
      const double fim = (aim * lre - (are - 1.0) * lim) / den;
      p.s5a[id * 2 + 0] = (float)are;
      p.s5a[id * 2 + 1] = (float)aim;
      double pr = are, pi = aim;
      for (int s = 0; s < 6; ++s) { const double nr = pr * pr - pi * pi, ni = 2.0 * pr * pi; pr = nr; pi = ni; }
      p.s5a64[id * 2 + 0] = (float)pr;
      p.s5a64[id * 2 + 1] = (float)pi;
      for (int h = 0; h < 16; ++h) {
        const double br = (double)p.b_re[(size_t)id * 16 + h], bi = (double)p.b_im[(size_t)id * 16 + h];
        p.s5bb[(size_t)id * 32 + h] = (float)(fre * br - fim * bi);
        p.s5bb[(size_t)id * 32 + 16 + h] = (float)(fre * bi + fim * br);
      }
      (void)g;
    }
  }
}

__device__ __forceinline__ void phase_normmod(const Params& p, const float* src_l, const float* src_c, const float* gain, const float* modl, int shift_off, int scale_off,
                              int ntok, int copy, int bid, int nblk) {
  const int tid = opaque_tid(); const int lane = tid & 63, wid = tid >> 6;
  for (int t = bid * NW + wid; t < ntok; t += nblk * NW) {
    const float* row = t < TL ? src_l + (size_t)t * 1024 : src_c + (size_t)(t - TL) * 1024;
    const float* md = modl + (size_t)tok_batch(t) * NMOD;
    f32x4 v[4];
    float ss = 0.f;
#pragma unroll
    for (int j = 0; j < 4; ++j) {
      v[j] = *(const f32x4*)(row + j * 256 + lane * 4);
      ss += v[j][0] * v[j][0] + v[j][1] * v[j][1] + v[j][2] * v[j][2] + v[j][3] * v[j][3];
    }
    ss = wave_sum(ss);
    const float rstd = rsqrtf(ss * (1.f / 1024.f) + EPSV);
#pragma unroll
    for (int j = 0; j < 4; ++j) {
      const int c0 = j * 256 + lane * 4;
      const f32x4 g = *(const f32x4*)(gain + c0);
      const f32x4 sh = *(const f32x4*)(md + shift_off + c0);
      const f32x4 sc = *(const f32x4*)(md + scale_off + c0);
      ushort4 o;
      o.x = f2bf(v[j][0] * rstd * g[0] * (1.f + sc[0]) + sh[0]);
      o.y = f2bf(v[j][1] * rstd * g[1] * (1.f + sc[1]) + sh[1]);
      o.z = f2bf(v[j][2] * rstd * g[2] * (1.f + sc[2]) + sh[2]);
      o.w = f2bf(v[j][3] * rstd * g[3] * (1.f + sc[3]) + sh[3]);
      *(ushort4*)(p.abuf + (size_t)t * 1024 + c0) = o;
      if (copy) *(f32x4*)(p.xres + (size_t)t * 1024 + c0) = v[j];
    }
  }
}

namespace pg8 {
#define PG8_LAS __attribute__((address_space(3)))
typedef unsigned u32x4 __attribute__((ext_vector_type(4)));
constexpr int BM = 256, BK = 64, HALF = 128, HTB = HALF * BK * 2, STAGE_BYTES = 8 * HTB, NXCD = 8, WGM = 8;
__device__ __forceinline__ int lds_byte(int r, int c) { const int st = (r >> 4) * 2 + (c >> 5), rr = r & 15, cc = c & 31, ob = rr * 64 + cc * 2; return st * 1024 + (ob ^ (((ob >> 9) & 1) << 5)); }
__device__ __forceinline__ void stage_rc(int b, int& R, int& C) { const int st = b / 1024, sb = b % 1024, swz = sb ^ (((sb >> 9) & 1) << 5); R = (st >> 1) * 16 + swz / 64; C = (st & 1) * 32 + (swz % 64) / 2; }
__device__ __forceinline__ int perm32(int rho) { const int n = rho >> 4, i = rho & 15; return 8 * (i >> 2) + 4 * n + (i & 3); }
struct Unit { int pm, pn; };
struct Gemm { const bf16_t* A; const bf16_t* Bt; int M, N, K; };
struct StaticOrder {
  int nM, nN, nwg, G, c;
  __device__ void init(int M, int N, int G_, int c_) { nM = M / BM; nN = N / BM; nwg = nM * nN; G = G_; c = c_; }
  __device__ bool next(int i, Unit& u) const {
    const long L = (long)i * G + c; if (L >= nwg) return false;
    int wgid = (int)L; { const int q = nwg / NXCD, r = nwg % NXCD, xcd = wgid % NXCD, off = wgid / NXCD; wgid = (xcd < r ? xcd * (q + 1) : r * (q + 1) + (xcd - r) * q) + off; }
    const int nig = WGM * nN, gid = wgid / nig, fm = gid * WGM, gsz = (nM - fm) < WGM ? (nM - fm) : WGM;
    u.pm = fm + ((wgid % nig) % gsz); u.pn = (wgid % nig) / gsz; return true;
  }
};
__device__ __forceinline__ unsigned cvt_pk_bf16(float lo, float hi) { unsigned r; asm volatile("v_cvt_pk_bf16_f32 %0, %1, %2" : "=v"(r) : "v"(lo), "v"(hi)); return r; }

template <class Epi>
__device__ __forceinline__ void gemm_phase(PG8_LAS unsigned char* lds, const Gemm g, const StaticOrder& S, const Epi& E) {
  const int tid = opaque_tid(), wid = __builtin_amdgcn_readfirstlane(tid >> 6), lane = tid & 63, wr = wid >> 2, wc = wid & 3, fr = lane & 15, fq = lane >> 4;
  const int K = g.K, nt = K / BK;
  unsigned voffA[2], voffB[2];
#pragma unroll
  for (int i = 0; i < 2; ++i) { int R, C; stage_rc(tid * 16 + i * 8192, R, C); const int Rb = Epi::PERM ? ((R & ~31) + perm32(R & 31)) : R;
    voffA[i] = (unsigned)(R * K + C) * 2u; voffB[i] = (unsigned)(Rb * K + C) * 2u; }
  const size_t kstep = (size_t)(BK * 2);
  const size_t hstep = (size_t)HALF * K * 2;
  const size_t tstep = 2 * hstep;
  const unsigned ldsw = (unsigned)wid * 1024u;
  const int aoff = lds_byte(wr * 64 + fr, fq * 8), boff = lds_byte(wc * 32 + fr, fq * 8);
#define PG8_SA(b, h) (((b) * 2 + (h)) * HTB)
#define PG8_SB(b, h) ((4 + (b) * 2 + (h)) * HTB)
#define PG8_STAGE(bufoff, gbase, voff) do { _Pragma("unroll") for (int _i = 0; _i < 2; ++_i) \
    __builtin_amdgcn_global_load_lds((const unsigned*)((const char*)(gbase) + (voff)[_i]), (PG8_LAS unsigned*)(lds + (bufoff) + ldsw + _i * 8192), 16, 0, 0); } while (0)
#define PG8_LDA(dst, b, h) do { _Pragma("unroll") for (int m = 0; m < 4; ++m) _Pragma("unroll") for (int k = 0; k < 2; ++k) dst[m][k] = *(const PG8_LAS bf16x8*)(lds + PG8_SA(b, h) + aoff + m * 2048 + k * 1024); } while (0)
#define PG8_LDB(dst, b, h) do { _Pragma("unroll") for (int n = 0; n < 2; ++n) _Pragma("unroll") for (int k = 0; k < 2; ++k) dst[n][k] = *(const PG8_LAS bf16x8*)(lds + PG8_SB(b, h) + boff + n * 2048 + k * 1024); } while (0)
#define PG8_MMA(ai, bj, At, Bt) do { __builtin_amdgcn_s_setprio(1); _Pragma("unroll") for (int m = 0; m < 4; ++m) _Pragma("unroll") for (int n = 0; n < 2; ++n) _Pragma("unroll") for (int k = 0; k < 2; ++k) \
    acc[ai][bj][m][n] = __builtin_amdgcn_mfma_f32_16x16x32_bf16(Bt[n][k], At[m][k], acc[ai][bj][m][n], 0, 0, 0); __builtin_amdgcn_s_setprio(0); } while (0)
#define PG8_WAIT_V(n) asm volatile("s_waitcnt vmcnt(" #n ")" ::: "memory")
#define PG8_WAIT_L(n) asm volatile("s_waitcnt lgkmcnt(" #n ")" ::: "memory")
#define PG8_BAR __builtin_amdgcn_s_barrier()
#define PG8_SCHED __builtin_amdgcn_sched_barrier(0)
  Unit cur, nxt; int ui = 0;
  if (!S.next(0, cur)) return;
  f32x4 acc[2][2][4][2];
#pragma unroll
  for (int a = 0; a < 2; ++a)
#pragma unroll
    for (int b = 0; b < 2; ++b)
#pragma unroll
      for (int m = 0; m < 4; ++m)
#pragma unroll
        for (int n = 0; n < 2; ++n) acc[a][b][m][n] = (f32x4){0.f, 0.f, 0.f, 0.f};
  bf16x8 At[4][2], B0[2][2], B1[2][2];
  const char* cA = (const char*)g.A + (size_t)cur.pm * tstep; const char* cB = (const char*)g.Bt + (size_t)cur.pn * tstep;
  PG8_STAGE(PG8_SB(0, 0), cB, voffB); PG8_STAGE(PG8_SA(0, 0), cA, voffA); PG8_STAGE(PG8_SB(0, 1), cB + hstep, voffB); PG8_STAGE(PG8_SA(0, 1), cA + hstep, voffA);
  if (wr == 1) PG8_BAR;
  PG8_WAIT_V(4); PG8_BAR;
  PG8_STAGE(PG8_SB(1, 0), cB + kstep, voffB); PG8_STAGE(PG8_SA(1, 0), cA + kstep, voffA); PG8_STAGE(PG8_SB(1, 1), cB + hstep + kstep, voffB);
  PG8_WAIT_V(6); PG8_BAR;
  for (;;) {
    const bool has_next = S.next(ui + 1, nxt);
    const char* nA = has_next ? (const char*)g.A + (size_t)nxt.pm * tstep : cA; const char* nB = has_next ? (const char*)g.Bt + (size_t)nxt.pn * tstep : cB;
#pragma unroll 1
    for (int t = 0; t < nt; t += 2) {
      const bool last = (t == nt - 2);
      const char* a1 = cA + (size_t)(t + 1) * kstep;
      const char* a2 = last ? nA : cA + (size_t)(t + 2) * kstep; const char* b2 = last ? nB : cB + (size_t)(t + 2) * kstep;
      const char* a3 = a2 + kstep; const char* b3 = b2 + kstep;
      PG8_LDB(B0, 0, 0); PG8_SCHED; PG8_LDA(At, 0, 0); PG8_STAGE(PG8_SA(1, 1), a1 + hstep, voffA);
      PG8_WAIT_L(8); PG8_BAR; PG8_WAIT_L(0); PG8_MMA(0, 0, At, B0); PG8_BAR; PG8_SCHED;
      PG8_LDB(B1, 0, 1); PG8_STAGE(PG8_SB(0, 0), b2, voffB);
      PG8_BAR; PG8_WAIT_L(0); PG8_MMA(0, 1, At, B1); PG8_BAR;
      PG8_LDA(At, 0, 1); PG8_STAGE(PG8_SA(0, 0), a2, voffA);
      PG8_BAR; PG8_WAIT_L(0); PG8_MMA(1, 0, At, B0); PG8_BAR; PG8_SCHED;
      PG8_STAGE(PG8_SB(0, 1), b2 + hstep, voffB);
      PG8_WAIT_V(6); PG8_BAR; PG8_MMA(1, 1, At, B1); PG8_BAR;
      PG8_LDB(B0, 1, 0); PG8_SCHED; PG8_LDA(At, 1, 0); PG8_STAGE(PG8_SA(0, 1), a2 + hstep, voffA);
      PG8_WAIT_L(8); PG8_BAR; PG8_WAIT_L(0); PG8_MMA(0, 0, At, B0); PG8_BAR; PG8_SCHED;
      PG8_LDB(B1, 1, 1); PG8_STAGE(PG8_SB(1, 0), b3, voffB);
      PG8_BAR; PG8_WAIT_L(0); PG8_MMA(0, 1, At, B1); PG8_BAR;
      PG8_LDA(At, 1, 1); PG8_STAGE(PG8_SA(1, 0), a3, voffA);
      PG8_BAR; PG8_WAIT_L(0); PG8_MMA(1, 0, At, B0); PG8_BAR; PG8_SCHED;
      PG8_STAGE(PG8_SB(1, 1), b3 + hstep, voffB);
      PG8_WAIT_V(6); PG8_BAR; PG8_MMA(1, 1, At, B1); PG8_BAR;
    }
    E(acc, cur, wr, wc, fr, fq);
    if (!has_next) break;
#pragma unroll
    for (int a = 0; a < 2; ++a)
#pragma unroll
      for (int b = 0; b < 2; ++b)
#pragma unroll
        for (int m = 0; m < 4; ++m)
#pragma unroll
          for (int n = 0; n < 2; ++n) acc[a][b][m][n] = (f32x4){0.f, 0.f, 0.f, 0.f};
    cur = nxt; cA = nA; cB = nB; ++ui;
  }
  PG8_WAIT_V(0);
  if (wr == 0) PG8_BAR;
  PG8_BAR;
#undef PG8_SA
#undef PG8_SB
#undef PG8_STAGE
#undef PG8_LDA
#undef PG8_LDB
#undef PG8_MMA
#undef PG8_WAIT_V
#undef PG8_WAIT_L
#undef PG8_BAR
#undef PG8_SCHED
}

struct EpiBf16 {
  static constexpr bool PERM = true;
  bf16_t* O; int ldc; int ncols;
  __device__ __forceinline__ void operator()(const f32x4 (&acc)[2][2][4][2], const Unit& u, int wr, int wc, int fr, int fq) const {
    const int row0 = u.pm * BM + wr * 64 + fr, col0 = u.pn * BM + wc * 32 + 8 * fq;
#pragma unroll
    for (int ai = 0; ai < 2; ++ai)
#pragma unroll
      for (int m = 0; m < 4; ++m) {
        bf16_t* rowp = O + (size_t)(row0 + ai * HALF + m * 16) * ldc + col0;
#pragma unroll
        for (int bj = 0; bj < 2; ++bj) {
          if (col0 + bj * HALF < ncols) {
            const f32x4 v0 = acc[ai][bj][m][0], v1 = acc[ai][bj][m][1];
            u32x4 w; w.x = cvt_pk_bf16(v0[0], v0[1]); w.y = cvt_pk_bf16(v0[2], v0[3]); w.z = cvt_pk_bf16(v1[0], v1[1]); w.w = cvt_pk_bf16(v1[2], v1[3]);
            *(u32x4*)(rowp + bj * HALF) = w;
          }
        }
      }
  }
};
struct EpiResid {
  static constexpr bool PERM = false;
  float* xres; const float* modl; int gate_off;
  __device__ __forceinline__ void operator()(const f32x4 (&acc)[2][2][4][2], const Unit& u, int wr, int wc, int fr, int fq) const {
    const int row0 = u.pm * BM + wr * 64 + fr, col0 = u.pn * BM + wc * 32 + 4 * fq;
#pragma unroll
    for (int ai = 0; ai < 2; ++ai)
#pragma unroll
      for (int m = 0; m < 4; ++m) {
        const int row = row0 + ai * HALF + m * 16;
        float* rowp = xres + (size_t)row * 1024 + col0;
        const float* md = modl + (size_t)tok_batch(row) * NMOD + gate_off + col0;
#pragma unroll
        for (int bj = 0; bj < 2; ++bj)
#pragma unroll
          for (int n = 0; n < 2; ++n) {
            const f32x4 g = *(const f32x4*)(md + bj * HALF + n * 16);
            f32x4 x = *(const f32x4*)(rowp + bj * HALF + n * 16);
            x += g * acc[ai][bj][m][n];
            *(f32x4*)(rowp + bj * HALF + n * 16) = x;
          }
      }
  }
};
struct EpiGlu {
  static constexpr bool PERM = true;
  bf16_t* mix;
  __device__ __forceinline__ void operator()(const f32x4 (&acc)[2][2][4][2], const Unit& u, int wr, int wc, int fr, int fq) const {
    const int row0 = u.pm * BM + wr * 64 + fr, col0 = 256 + u.pn * HALF + wc * 32 + 8 * fq;
#pragma unroll
    for (int ai = 0; ai < 2; ++ai)
#pragma unroll
      for (int m = 0; m < 4; ++m) {
        float v[8];
#pragma unroll
        for (int n = 0; n < 2; ++n)
#pragma unroll
          for (int j = 0; j < 4; ++j) v[n * 4 + j] = acc[ai][0][m][n][j] * sigmoid_f(acc[ai][1][m][n][j]);
        u32x4 w; w.x = cvt_pk_bf16(v[0], v[1]); w.y = cvt_pk_bf16(v[2], v[3]); w.z = cvt_pk_bf16(v[4], v[5]); w.w = cvt_pk_bf16(v[6], v[7]);
        *(u32x4*)(mix + (size_t)(row0 + ai * HALF + m * 16) * 1024 + col0) = w;
        __builtin_amdgcn_sched_barrier(0);
      }
  }
};
}

#define VNT_STRIDE 136
__device__ __forceinline__ void phase_sgu(const Params& p, int layer, int nchunks, int bid, int nblk, unsigned char* smem) {
  bf16_t* vnT = (bf16_t*)smem;
  const int tid = opaque_tid(); const int lane = tid & 63, wid = tid >> 6;
  const int fr = lane & 15, fq = lane >> 4;
  for (int item = bid; item < nchunks * 4; item += nblk) {
    const int ch = item >> 2, h = item & 3;
    const int tok0 = ch * 128;
    {
      const int s = tid >> 2, q = tid & 3;
      const bf16_t* vrow = p.cols + (size_t)(tok0 + s) * INW + C_SGU_V + h * 64 + q * 16;
      const uint4 r0 = *(const uint4*)vrow, r1 = *(const uint4*)(vrow + 8);
      float gv[16];
      gv[0] = bflo(r0.x); gv[1] = bfhi(r0.x); gv[2] = bflo(r0.y); gv[3] = bfhi(r0.y); gv[4] = bflo(r0.z); gv[5] = bfhi(r0.z); gv[6] = bflo(r0.w); gv[7] = bfhi(r0.w);
      gv[8] = bflo(r1.x); gv[9] = bfhi(r1.x); gv[10] = bflo(r1.y); gv[11] = bfhi(r1.y); gv[12] = bflo(r1.z); gv[13] = bfhi(r1.z); gv[14] = bflo(r1.w); gv[15] = bfhi(r1.w);
      float ss = 0.f;
#pragma unroll
      for (int d = 0; d < 16; ++d) { gv[d] = gelu_f(gv[d]); ss += gv[d] * gv[d]; }
      ss += xor_lane_f<1>(ss);
      ss += xor_lane_f<2>(ss);
      const float rstd = rsqrtf(ss * (1.f / 64.f) + EPSV);
#pragma unroll
      for (int d = 0; d < 16; ++d) vnT[(q * 16 + d) * VNT_STRIDE + s] = f2bf(gv[d] * rstd);
    }
    __syncthreads();
    {
      const bf16_t* wrow = p.sgu_wb + (((size_t)layer * 4 + h) * 128 + wid * 16 + fr) * 128 + fq * 8;
      f32x4 acc[4];
#pragma unroll
      for (int n = 0; n < 4; ++n) acc[n] = (f32x4){0.f, 0.f, 0.f, 0.f};
#pragma unroll
      for (int ks = 0; ks < 4; ++ks) {
        const bf16x8 a = *(const bf16x8*)(wrow + ks * 32);
#pragma unroll
        for (int n = 0; n < 4; ++n) {
          const bf16x8 b = *(const bf16x8*)(vnT + (n * 16 + fr) * VNT_STRIDE + ks * 32 + fq * 8);
          acc[n] = __builtin_amdgcn_mfma_f32_16x16x32_bf16(a, b, acc[n], 0, 0, 0);
        }
      }
#pragma unroll
      for (int j = 0; j < 4; ++j) {
        const int t = wid * 16 + fq * 4 + j;
        const float bs = p.sgu_b[((size_t)layer * 4 + h) * 128 + t];
        const bf16_t* urow = p.cols + (size_t)(tok0 + t) * INW + C_SGU_U + h * 64;
        bf16_t* orow = p.mix + (size_t)(tok0 + t) * 1024 + h * 64;
#pragma unroll
        for (int n = 0; n < 4; ++n) orow[n * 16 + fr] = f2bf(gelu_f(bf2f(urow[n * 16 + fr])) * (acc[n][j] + bs));
      }
    }
    __syncthreads();
  }
}

__device__ __forceinline__ void phase_s5a(const Params& p, int layer, int bid, int nblk, unsigned char* smem) {
  const int tid = opaque_tid(); const int lane = tid & 63, wid = tid >> 6, fr = lane & 15, fq = lane >> 4;
  const int ntask = 2 * 16 * 17 * 2;
  for (int task = wid * nblk + bid; task < ntask; task += nblk * NW) {
    const int nh = task & 1, t2 = task >> 1;
    const int dir = t2 / 272, rem = t2 % 272, g = rem / 17, mt = rem % 17;
    const bf16_t* tab = p.s5M1 + (size_t)((layer * 2 + dir) * 16 + g) * 131072 + (size_t)(nh * 64 + fr) * 1024 + fq * 8;
    const int scr = mt * 16 + fr;
    const bf16_t* ub = p.cols + C_S5 + g * 16 + (fq & 1) * 8;
    f32x4 acc[4];
#pragma unroll
    for (int n = 0; n < 4; ++n) acc[n] = (f32x4){0.f, 0.f, 0.f, 0.f};
#pragma unroll 8
    for (int ks = 0; ks < 32; ++ks) {
      const int tau = 2 * ks + (fq >> 1);
      const int i = dir ? 63 - tau : tau;
      const bf16x8 a = *(const bf16x8*)(ub + (size_t)s5_tok(scr, i) * INW);
#pragma unroll
      for (int n = 0; n < 4; ++n) {
        const bf16x8 b = *(const bf16x8*)(tab + (size_t)n * 16 * 1024 + ks * 32);
        acc[n] = __builtin_amdgcn_mfma_f32_16x16x32_bf16(a, b, acc[n], 0, 0, 0);
      }
    }
#pragma unroll
    for (int n = 0; n < 4; ++n)
#pragma unroll
      for (int j = 0; j < 4; ++j) p.s5S[(((size_t)dir * NSC + mt * 16 + fq * 4 + j) * 16 + g) * 128 + nh * 64 + n * 16 + fr] = acc[n][j];
  }
}

__device__ __forceinline__ int scan_sc(int s, int b, int dir) {
  return s < 4 ? 256 + b * 4 + (dir ? 3 - s : s) : b * 64 + (dir ? 63 - (s - 4) : (s - 4));
}
__device__ __forceinline__ void phase_scan(const Params& p, int layer, int bid, int nblk) {
  const int tid = opaque_tid();
  for (int item = bid; item < 16 + 256; item += nblk) {
    if (item < 16) {
      const int id = item * NT + tid;
      const int pp = id & 63, g = (id >> 6) & 15, b = (id >> 10) & 3, dir = id >> 12;
      const int pid = ((layer * 2 + dir) * 16 + g) * 64 + pp;
      const float ar = p.s5a64[pid * 2], ai = p.s5a64[pid * 2 + 1];
      float hr = 0.f, hi = 0.f;
      for (int s0 = 0; s0 < 68; s0 += 17) {
        float sr[17], si[17];
#pragma unroll
        for (int k = 0; k < 17; ++k) {
          const size_t o = (((size_t)dir * NSC + scan_sc(s0 + k, b, dir)) * 16 + g) * 128 + pp;
          sr[k] = p.s5S[o]; si[k] = p.s5S[o + 64];
        }
#pragma unroll
        for (int k = 0; k < 17; ++k) {
          const size_t o = (((size_t)dir * NSC + scan_sc(s0 + k, b, dir)) * 16 + g) * 128 + pp;
          p.s5H[o] = hr; p.s5H[o + 64] = hi;
          const float nr = ar * hr - ai * hi + sr[k];
          const float ni = ar * hi + ai * hr + si[k];
          hr = nr; hi = ni;
        }
      }
    } else {
      const int id = (item - 16) * NT + tid;
      const int e = id & 2047, h = (id >> 11) & 7, b = (id >> 14) & 3, dir = id >> 16;
      const int dk = e & 31;
      float S = 0.f;
      for (int s0 = 0; s0 < 68; s0 += 17) {
        float kv[17], dc[17];
#pragma unroll
        for (int k = 0; k < 17; ++k) {
          const size_t o = (((size_t)dir * NSC + scan_sc(s0 + k, b, dir)) * 8 + h);
          kv[k] = p.gkv[o * 2048 + e]; dc[k] = p.gdec[o * 32 + dk];
        }
#pragma unroll
        for (int k = 0; k < 17; ++k) {
          const size_t o = (((size_t)dir * NSC + scan_sc(s0 + k, b, dir)) * 8 + h);
          p.gkv[o * 2048 + e] = S;
          S = dc[k] * S + kv[k];
        }
      }
    }
  }
}

__device__ __forceinline__ bf16x8 s5_kfrag(const bf16_t* kb, int delta, int sh) {
  const int d = delta - sh;
  bf16x8 r = *(const bf16x8*)(kb + (size_t)(d < 0 ? 0 : d) * 256);
  if (d < 0) r = (bf16x8){0, 0, 0, 0, 0, 0, 0, 0};
  return r;
}
#define S5_UCH 1032
typedef const __attribute__((address_space(3))) bf16_t* lds_bf16_cp;
template <int DIR, bool DIAG>
__device__ __forceinline__ void s5_group8(f32x4 (&acc)[16], bf16x8 (&W)[16], const bf16_t* ul  , const bf16_t* kl  , int ks0, int E, int sh) {
  const bf16x8 zero8 = (bf16x8){0, 0, 0, 0, 0, 0, 0, 0};
#pragma unroll
  for (int j = 0; j < 8; ++j) {
    const int sigma = 2 * (ks0 + j) + sh;
    const bf16x8 a = *(const bf16x8*)(ul + (DIR ? 63 - sigma : sigma) * 16);
    bf16x8 n0 = zero8, n1 = zero8;
    if (!DIAG) {
      if (j + 1 < 8) { n0 = *(const bf16x8*)(kl + (E - 2 * (j + 1) - sh) * 256); n1 = *(const bf16x8*)(kl + (E - 2 * (j + 1) + 1 - sh) * 256); }
      else { n0 = s5_kfrag(kl, E - 16, sh); n1 = s5_kfrag(kl, E - 15, sh); }
    }
#pragma unroll
    for (int i = 0; i < 16; ++i) {
      if (!(DIAG && i < 2 * j)) {
        const int sl = DIR ? 15 - i : i;
        acc[sl] = __builtin_amdgcn_mfma_f32_16x16x32_bf16(a, W[(i - 2 * j) & 15], acc[sl], 0, 0, 0);
      }
    }
    if (!DIAG) { W[(16 - 2 * (j + 1)) & 15] = n0; W[(17 - 2 * (j + 1)) & 15] = n1; }
  }
}
template <int DIR>
__device__ __forceinline__ void s5_dir(f32x4 (&acc)[16], const Params& p, int layer, int g, int scr, int qd, int fr, int fq, const bf16_t* ul, const bf16_t* kl) {
  const int sh = fq >> 1;
  {
    bf16x8 W[16];
#pragma unroll
    for (int i = 0; i < 16; ++i) W[i] = s5_kfrag(kl, 16 * qd + i, sh);
    for (int c = 0; c < qd; ++c) s5_group8<DIR, false>(acc, W, ul, kl, 8 * c, 16 * (qd - c), sh);
    s5_group8<DIR, true>(acc, W, ul, kl, 8 * qd, 0, sh);
  }
  const size_t tb = (size_t)((layer * 2 + DIR) * 16 + g);
  const float* hin = p.s5H + (((size_t)DIR * NSC + scr) * 16 + g) * 128 + fq * 8;
  const bf16_t* n2 = p.s5N2 + tb * 131072 + (size_t)(16 * qd * 16 + fr) * 128 + fq * 8;
  bf16x8 ah[4];
#pragma unroll
  for (int ks = 0; ks < 4; ++ks) {
    const f32x4 h0 = *(const f32x4*)(hin + ks * 32), h1 = *(const f32x4*)(hin + ks * 32 + 4);
    const float h8[8] = {h0[0], h0[1], h0[2], h0[3], h1[0], h1[1], h1[2], h1[3]};
    ah[ks] = pack_bf16x8(h8);
  }
#pragma unroll
  for (int ks = 0; ks < 4; ++ks) {
    bf16x8 b[16];
#pragma unroll
    for (int i = 0; i < 16; ++i) b[i] = *(const bf16x8*)(n2 + (size_t)i * 16 * 128 + ks * 32);
#pragma unroll
    for (int i = 0; i < 16; ++i) {
      const int sl = DIR ? 15 - i : i;
      acc[sl] = __builtin_amdgcn_mfma_f32_16x16x32_bf16(ah[ks], b[i], acc[sl], 0, 0, 0);
    }
    __builtin_amdgcn_sched_barrier(0);
  }
}
__device__ __forceinline__ void phase_s5c(const Params& p, int layer, int nsc, int bid, int nblk, unsigned char* smem) {
  const int tid = opaque_tid(); const int lane = tid & 63, wid = tid >> 6;
  bf16_t* Kl = (bf16_t*)smem;
  bf16_t* Ul = Kl + 2 * 16384;
  const int nmt = nsc / 16, npair = (nmt + 1) / 2;
  const int ntask = 16 * npair;
  for (int task = bid; task < ntask; task += nblk) {
    const int g = task / npair, mt0 = (task % npair) * 2;
    __syncthreads();
    int tid_o = tid; asm volatile("" : "+v"(tid_o));
#pragma unroll
    for (int it = 0; it < 8; ++it) {
      const int e = it * NT + tid_o;
      const int dir = e >> 11, off = (e & 2047) * 8;
      *(uint4*)(Kl + dir * 16384 + off) = *(const uint4*)(p.s5K + (size_t)((layer * 2 + dir) * 16 + g) * 16384 + off);
    }
#pragma unroll
    for (int it = 0; it < 8; ++it) {
      const int e = it * NT + tid_o;
      const int hf = e & 1, tk = (e >> 1) & 63, chk = (e >> 7) & 15, tl = e >> 11;
      const int mt = mt0 + tl;
      uint4 v = make_uint4(0u, 0u, 0u, 0u);
      if (mt < nmt) v = *(const uint4*)(p.cols + (size_t)s5_tok(mt * 16 + chk, tk) * INW + C_S5 + g * 16 + hf * 8);
      *(uint4*)(Ul + (tl * 16 + chk) * S5_UCH + tk * 16 + hf * 8) = v;
    }
    __syncthreads();
    int lane_o = lane; asm volatile("" : "+v"(lane_o));
    const int fr = lane_o & 15, fq = lane_o >> 4;
    const int tl = wid >> 2, q = wid & 3, mt = mt0 + tl;
    if (mt < nmt) {
      const int scr = mt * 16 + fr;
      const bf16_t* ul = Ul + (tl * 16 + fr) * S5_UCH + (fq & 1) * 8;
      f32x4 acc[16];
#pragma unroll
      for (int i = 0; i < 16; ++i) acc[i] = (f32x4){0.f, 0.f, 0.f, 0.f};
      s5_dir<0>(acc, p, layer, g, scr, q, fr, fq, ul, Kl + fr * 16 + (fq & 1) * 8);
      s5_dir<1>(acc, p, layer, g, scr, 3 - q, fr, fq, ul, Kl + 16384 + fr * 16 + (fq & 1) * 8);
      const int ch = g * 16 + fr;
      const float dsk = p.s5_d[layer * 256 + ch];
#pragma unroll
      for (int j = 0; j < 4; ++j) {
        const int chk = fq * 4 + j;
        const size_t tok0 = (size_t)s5_tok(mt * 16 + chk, 16 * q);
        const bf16_t* up = Ul + (tl * 16 + chk) * S5_UCH + (16 * q) * 16 + fr;
        bf16_t* yp = p.yg + tok0 * 256 + ch;
#pragma unroll
        for (int i = 0; i < 16; ++i) {
          const float v = acc[i][j] + dsk * bf2f(up[i * 16]);
          yp[(size_t)i * 256] = f2bf(gelu_f(v));
        }
        __builtin_amdgcn_sched_barrier(0);
      }
    }
  }
  __syncthreads();
}

#define GL_VT_STRIDE 72
#define GL_LB_STRIDE 36
#define GL_HALF_BYTES (64 * 72 * 2 + 64 * 36 * 4 + 64 * 72 * 2)
__device__ __forceinline__ void unpack8(const uint4& r, float* v) {
  v[0] = bflo(r.x); v[1] = bfhi(r.x); v[2] = bflo(r.y); v[3] = bfhi(r.y); v[4] = bflo(r.z); v[5] = bfhi(r.z); v[6] = bflo(r.w); v[7] = bfhi(r.w);
}
__device__ __forceinline__ void gla_store_vT(const uint4& r0, const uint4& r1, bf16_t* vT, int i, int part) {
  const unsigned w[8] = {r0.x, r0.y, r0.z, r0.w, r1.x, r1.y, r1.z, r1.w};
#pragma unroll
  for (int e = 0; e < 8; ++e) {
    vT[(part * 16 + 2 * e) * GL_VT_STRIDE + i] = (bf16_t)(w[e] & 0xffffu);
    vT[(part * 16 + 2 * e + 1) * GL_VT_STRIDE + i] = (bf16_t)(w[e] >> 16);
  }
}
__device__ __forceinline__ void gla_logdecay(int dir, const bf16_t* zs, const float* wgs, float* lb, int ltid) {
  const int lane = ltid & 63;
  const int wu = __builtin_amdgcn_readfirstlane(ltid >> 6);
  float z[16];
  unpack8(*(const uint4*)(zs + lane * 32 + dir * 16), z); unpack8(*(const uint4*)(zs + lane * 32 + dir * 16 + 8), z + 8);
  const float* wg = wgs + dir * 512 + wu * 8;
  float la[8];
  {
    const f32x4 b0 = *(const f32x4*)(wgs + 1024 + dir * 32 + wu * 8), b1 = *(const f32x4*)(wgs + 1024 + dir * 32 + wu * 8 + 4);
    la[0] = b0[0]; la[1] = b0[1]; la[2] = b0[2]; la[3] = b0[3]; la[4] = b1[0]; la[5] = b1[1]; la[6] = b1[2]; la[7] = b1[3];
  }
#pragma unroll
  for (int r = 0; r < 16; ++r) {
    const f32x4 w0 = *(const f32x4*)(wg + r * 32), w1 = *(const f32x4*)(wg + r * 32 + 4);
    la[0] += z[r] * w0[0]; la[1] += z[r] * w0[1]; la[2] += z[r] * w0[2]; la[3] += z[r] * w0[3];
    la[4] += z[r] * w1[0]; la[5] += z[r] * w1[1]; la[6] += z[r] * w1[2]; la[7] += z[r] * w1[3];
  }
#pragma unroll
  for (int c = 0; c < 8; ++c) la[c] = (fminf(la[c], 0.f) - __logf(1.f + __expf(-fabsf(la[c])))) * (1.f / 16.f);
#pragma unroll
  for (int c = 0; c < 8; ++c) {
    float v = la[c];
    if (dir == 0) {
      v += __builtin_bit_cast(float, __builtin_amdgcn_update_dpp(0, __builtin_bit_cast(int, v), 0x111, 0xf, 0xf, true));
      v += __builtin_bit_cast(float, __builtin_amdgcn_update_dpp(0, __builtin_bit_cast(int, v), 0x112, 0xf, 0xf, true));
      v += __builtin_bit_cast(float, __builtin_amdgcn_update_dpp(0, __builtin_bit_cast(int, v), 0x114, 0xf, 0xf, true));
      v += __builtin_bit_cast(float, __builtin_amdgcn_update_dpp(0, __builtin_bit_cast(int, v), 0x118, 0xf, 0xf, true));
      const float t0 = __builtin_bit_cast(float, __builtin_amdgcn_readlane(__builtin_bit_cast(int, v), 15));
      const float t1 = __builtin_bit_cast(float, __builtin_amdgcn_readlane(__builtin_bit_cast(int, v), 31));
      const float t2 = __builtin_bit_cast(float, __builtin_amdgcn_readlane(__builtin_bit_cast(int, v), 47));
      const int row = lane >> 4;
      v += row == 0 ? 0.f : (row == 1 ? t0 : (row == 2 ? t0 + t1 : (t0 + t1) + t2));
    } else {
      v += __builtin_bit_cast(float, __builtin_amdgcn_update_dpp(0, __builtin_bit_cast(int, v), 0x101, 0xf, 0xf, true));
      v += __builtin_bit_cast(float, __builtin_amdgcn_update_dpp(0, __builtin_bit_cast(int, v), 0x102, 0xf, 0xf, true));
      v += __builtin_bit_cast(float, __builtin_amdgcn_update_dpp(0, __builtin_bit_cast(int, v), 0x104, 0xf, 0xf, true));
      v += __builtin_bit_cast(float, __builtin_amdgcn_update_dpp(0, __builtin_bit_cast(int, v), 0x108, 0xf, 0xf, true));
      const float t1 = __builtin_bit_cast(float, __builtin_amdgcn_readlane(__builtin_bit_cast(int, v), 16));
      const float t2 = __builtin_bit_cast(float, __builtin_amdgcn_readlane(__builtin_bit_cast(int, v), 32));
      const float t3 = __builtin_bit_cast(float, __builtin_amdgcn_readlane(__builtin_bit_cast(int, v), 48));
      const int row = lane >> 4;
      v += row == 3 ? 0.f : (row == 2 ? t3 : (row == 1 ? t3 + t2 : (t3 + t2) + t1));
    }
    la[c] = v;
  }
  *(f32x4*)(lb + lane * GL_LB_STRIDE + wu * 8) = (f32x4){la[0], la[1], la[2], la[3]};
  *(f32x4*)(lb + lane * GL_LB_STRIDE + wu * 8 + 4) = (f32x4){la[4], la[5], la[6], la[7]};
}

#define GLA_HALF_BYTES (64 * 72 * 2 + 64 * 36 * 4 + 32 * 72 * 2 + 64 * 32 * 2 + (1024 + 64) * 4)
struct GlaAPre { uint4 v0, v1, z, k; };
__device__ __forceinline__ GlaAPre glaa_prefetch(const Params& p, int item, int ltid) {
  const int sc = item >> 3, h = item & 7;
  const int i = ltid >> 2, pc = ltid & 3;
  const bf16_t* row = p.cols + (size_t)gla_tok(sc, i) * INW;
  GlaAPre r;
  r.v0 = *(const uint4*)(row + C_GV + h * 64 + pc * 16); r.v1 = *(const uint4*)(row + C_GV + h * 64 + pc * 16 + 8);
  r.z = *(const uint4*)(row + C_ZF + pc * 8);
  r.k = *(const uint4*)(row + C_GK + h * 32 + pc * 8);
  return r;
}
__device__ __forceinline__ void phase_glaa(const Params& p, int layer, int bid, int nblk, unsigned char* smem) {
  const int tid = opaque_tid(); const int half = __builtin_amdgcn_readfirstlane(tid >> 8), ltid = tid & 255;
  const int lane = tid & 63, w = ltid >> 6, fr = lane & 15, fq = lane >> 4;
  bf16_t* vT = (bf16_t*)(smem + half * GLA_HALF_BYTES);
  float* lb = (float*)(vT + 64 * GL_VT_STRIDE);
  bf16_t* kT = (bf16_t*)(lb + 64 * GL_LB_STRIDE);
  bf16_t* zs = kT + 32 * GL_VT_STRIDE;
  float* wgs = (float*)(zs + 64 * 32);
  const int nit = NSC * 8 / 2;
  if (bid >= nit) return;
  GlaAPre cur = glaa_prefetch(p, bid * 2 + half, ltid);
  for (int it = bid; it < nit; it += nblk) {
    const int item = it * 2 + half;
    const int sc = item >> 3, h = item & 7;
    const int itn = it + nblk < nit ? it + nblk : it;
    const GlaAPre nxt = glaa_prefetch(p, itn * 2 + half, ltid);
    const int ti = ltid >> 2, pc = ltid & 3;
    gla_store_vT(cur.v0, cur.v1, vT, ti, pc);
    *(uint4*)(zs + ti * 32 + pc * 8) = cur.z;
    {
      const int dir = ltid >> 7, r = (ltid >> 3) & 15, c4 = (ltid & 7) * 4;
      *(f32x4*)(wgs + dir * 512 + r * 32 + c4) = *(const f32x4*)(p.gla_wg + ((size_t)(layer * 2 + dir) * 16 + r) * 256 + h * 32 + c4);
      if (ltid < 16) *(f32x4*)(wgs + 1024 + ltid * 4) = *(const f32x4*)(p.gla_bg + (layer * 2 + (ltid >> 3)) * 256 + h * 32 + (ltid & 7) * 4);
    }
    __syncthreads();
#pragma unroll
    for (int dir = 0; dir < 2; ++dir) {
      gla_logdecay(dir, zs, wgs, lb, ltid);
      __syncthreads();
      const int ilast = dir ? 0 : 63;
      {
        float kv8[8];
        unpack8(cur.k, kv8);
#pragma unroll
        for (int c = 0; c < 8; ++c) {
          const int dk = pc * 8 + c;
          kT[dk * GL_VT_STRIDE + ti] = f2bf(kv8[c] * __expf(lb[ilast * GL_LB_STRIDE + dk] - lb[ti * GL_LB_STRIDE + dk]));
        }
      }
      const size_t o = (((size_t)dir * NSC + sc) * 8 + h);
      if (ltid < 32) p.gdec[o * 32 + ltid] = __expf(lb[ilast * GL_LB_STRIDE + ltid]);
      {
        float* gt = p.glb + o * 2048;
#pragma unroll
        for (int r = 0; r < 2; ++r) {
          const int q = ltid + 256 * r;
          *(f32x4*)(gt + q * 4) = *(const f32x4*)(lb + (q >> 3) * GL_LB_STRIDE + (q & 7) * 4);
        }
      }
      __syncthreads();
      {
        f32x4 acc[2];
        acc[0] = (f32x4){0.f, 0.f, 0.f, 0.f}; acc[1] = acc[0];
#pragma unroll
        for (int ks = 0; ks < 2; ++ks) {
          const bf16x8 b = *(const bf16x8*)(vT + (w * 16 + fr) * GL_VT_STRIDE + ks * 32 + fq * 8);
#pragma unroll
          for (int m = 0; m < 2; ++m) {
            const bf16x8 a = *(const bf16x8*)(kT + (m * 16 + fr) * GL_VT_STRIDE + ks * 32 + fq * 8);
            acc[m] = __builtin_amdgcn_mfma_f32_16x16x32_bf16(a, b, acc[m], 0, 0, 0);
          }
        }
#pragma unroll
        for (int m = 0; m < 2; ++m) *(f32x4*)(p.gkv + o * 2048 + (size_t)(w * 16 + fr) * 32 + m * 16 + fq * 4) = acc[m];
      }
      __syncthreads();
    }
    cur = nxt;
  }
}

__device__ __forceinline__ void gl_load8(const float* g, float* v) {
  const f32x4 a = *(const f32x4*)g, b = *(const f32x4*)(g + 4);
  v[0] = a[0]; v[1] = a[1]; v[2] = a[2]; v[3] = a[3]; v[4] = b[0]; v[5] = b[1]; v[6] = b[2]; v[7] = b[3];
}
#define GLC_HALF_BYTES (64 * 72 * 2 + 64 * 72 * 2 + 2 * 64 * 36 * 4 + 2 * 64 * 36 * 4)
struct GlaCPre { uint4 v0, v1, q, k[4], lb[2][2], st[2][2]; };
__device__ __forceinline__ GlaCPre glac_prefetch(const Params& p, int item, int ltid, int w, int fr, int fq) {
  const int sc = item >> 3, h = item & 7;
  GlaCPre r;
  {
    const int i = ltid & 63, part = ltid >> 6;
    const bf16_t* row = p.cols + (size_t)gla_tok(sc, i) * INW + C_GV + h * 64 + part * 16;
    r.v0 = *(const uint4*)row; r.v1 = *(const uint4*)(row + 8);
  }
  r.q = *(const uint4*)(p.cols + (size_t)gla_tok(sc, w * 16 + fr) * INW + C_GQ + h * 32 + fq * 8);
#pragma unroll
  for (int n = 0; n < 4; ++n) r.k[n] = *(const uint4*)(p.cols + (size_t)gla_tok(sc, n * 16 + fr) * INW + C_GK + h * 32 + fq * 8);
  {
#pragma unroll
    for (int dir = 0; dir < 2; ++dir) {
      const float* g = p.glb + (((size_t)dir * NSC + sc) * 8 + h) * 2048;
      r.lb[dir][0] = *(const uint4*)(g + ltid * 4); r.lb[dir][1] = *(const uint4*)(g + (ltid + 256) * 4);
      const float* s = p.gkv + (((size_t)dir * NSC + sc) * 8 + h) * 2048;
      r.st[dir][0] = *(const uint4*)(s + ltid * 4); r.st[dir][1] = *(const uint4*)(s + (ltid + 256) * 4);
    }
  }
  return r;
}
#define GLC_BONUS 6
__device__ __forceinline__ void phase_glac(const Params& p, int layer, int nsc, int nbusy, int bid, int nblk, unsigned char* smem) {
  const int tid = opaque_tid(); const int half = __builtin_amdgcn_readfirstlane(tid >> 8), ltid = tid & 255;
  const int lane = tid & 63, w = ltid >> 6, fr = lane & 15, fq = lane >> 4;
  bf16_t* vT = (bf16_t*)(smem + half * GLC_HALF_BYTES);
  bf16_t* Pw = vT + 64 * GL_VT_STRIDE + w * 16 * GL_VT_STRIDE;
  float* lbT = (float*)(vT + 2 * 64 * GL_VT_STRIDE);
  float* ST = lbT + 2 * 64 * GL_LB_STRIDE;
  const int nit = nsc * 4;
  const int nfree = nblk - nbusy;
  const int nbonus = (nbusy > 0 && nfree > 0 && nfree * GLC_BONUS < nit) ? nfree * GLC_BONUS : 0;
  auto itof = [&](int k) -> int {
    if (nbonus == 0) return bid + k * nblk;
    if (bid >= nbusy) return k < GLC_BONUS ? k * nfree + (bid - nbusy) : nbonus + bid + (k - GLC_BONUS) * nblk;
    return nbonus + bid + k * nblk;
  };
  if (itof(0) >= nit) return;
  GlaCPre cur = glac_prefetch(p, itof(0) * 2 + half, ltid, w, fr, fq);
  for (int kk = 0; itof(kk) < nit; ++kk) {
    const int it = itof(kk);
    const int item = it * 2 + half;
    const int sc = item >> 3, h = item & 7;
    __syncthreads();
    gla_store_vT(cur.v0, cur.v1, vT, ltid & 63, ltid >> 6);
    {
#pragma unroll
      for (int dir = 0; dir < 2; ++dir)
#pragma unroll
        for (int r = 0; r < 2; ++r) {
          const int q = ltid + 256 * r;
          *(uint4*)(lbT + (dir * 64 + (q >> 3)) * GL_LB_STRIDE + (q & 7) * 4) = cur.lb[dir][r];
          *(uint4*)(ST + (dir * 64 + (q >> 3)) * GL_LB_STRIDE + (q & 7) * 4) = cur.st[dir][r];
        }
    }
    const int itn = itof(kk + 1) < nit ? itof(kk + 1) : it;
    const GlaCPre nxt = glac_prefetch(p, itn * 2 + half, ltid, w, fr, fq);
    __syncthreads();
    f32x4 o[4];
#pragma unroll
    for (int n = 0; n < 4; ++n) o[n] = (f32x4){0.f, 0.f, 0.f, 0.f};
#pragma unroll
    for (int dir = 0; dir < 2; ++dir) {
      const float* lbd = lbT + dir * 64 * GL_LB_STRIDE + fq * 8;
      float bref[8], bt[8];
      gl_load8(lbd + (dir ? 31 : 32) * GL_LB_STRIDE, bref);
      gl_load8(lbd + (w * 16 + fr) * GL_LB_STRIDE, bt);
      bf16x8 aqs, aqe;
      {
        float q8[8], s8[8], e8[8];
        unpack8(cur.q, q8);
#pragma unroll
        for (int c = 0; c < 8; ++c) {
          const float qx = q8[c] * 0.17677669529663687f;
          s8[c] = qx * __expf(bt[c] - bref[c]);
          e8[c] = qx * __expf(bt[c]);
        }
        aqs = pack_bf16x8(s8); aqe = pack_bf16x8(e8);
      }
#pragma unroll
      for (int n = 0; n < 4; ++n) {
        const int s = n * 16 + fr;
        float k8[8], bs[8];
        unpack8(cur.k[n], k8);
        gl_load8(lbd + s * GL_LB_STRIDE, bs);
#pragma unroll
        for (int c = 0; c < 8; ++c) k8[c] *= __expf(bref[c] - bs[c]);
        const bf16x8 bks = pack_bf16x8(k8);
        const f32x4 sa = __builtin_amdgcn_mfma_f32_16x16x32_bf16(aqs, bks, (f32x4){0.f, 0.f, 0.f, 0.f}, 0, 0, 0);
#pragma unroll
        for (int j = 0; j < 4; ++j) {
          const int t = w * 16 + fq * 4 + j;
          const bool ok = dir ? (s >= t) : (s <= t);
          Pw[(fq * 4 + j) * GL_VT_STRIDE + s] = f2bf(ok ? sa[j] : 0.f);
        }
      }
      __builtin_amdgcn_wave_barrier();
#pragma unroll
      for (int ks = 0; ks < 2; ++ks) {
        const bf16x8 ap = *(const bf16x8*)(Pw + fr * GL_VT_STRIDE + ks * 32 + fq * 8);
#pragma unroll
        for (int n = 0; n < 4; ++n) {
          const bf16x8 bv = *(const bf16x8*)(vT + (n * 16 + fr) * GL_VT_STRIDE + ks * 32 + fq * 8);
          o[n] = __builtin_amdgcn_mfma_f32_16x16x32_bf16(ap, bv, o[n], 0, 0, 0);
        }
      }
      __builtin_amdgcn_wave_barrier();
      {
        const float* Sg = ST + dir * 64 * GL_LB_STRIDE + fq * 8;
#pragma unroll
        for (int n = 0; n < 4; ++n) {
          float s8[8];
          gl_load8(Sg + (n * 16 + fr) * GL_LB_STRIDE, s8);
          const bf16x8 bS = pack_bf16x8(s8);
          o[n] = __builtin_amdgcn_mfma_f32_16x16x32_bf16(aqe, bS, o[n], 0, 0, 0);
        }
      }
    }
    __builtin_amdgcn_wave_barrier();
#pragma unroll
    for (int j = 0; j < 4; ++j) {
      float ss = o[0][j] * o[0][j] + o[1][j] * o[1][j] + o[2][j] * o[2][j] + o[3][j] * o[3][j];
      ss += xor_lane_f<1>(ss); ss += xor_lane_f<2>(ss); ss += xor_lane_f<4>(ss); ss += xor_lane_f<8>(ss);
      const float rstd = rsqrtf(ss * (1.f / 64.f) + EPSV);
#pragma unroll
      for (int n = 0; n < 4; ++n) Pw[(fq * 4 + j) * GL_VT_STRIDE + n * 16 + fr] = f2bf(o[n][j] * rstd);
    }
    __builtin_amdgcn_wave_barrier();
    {
      const int tl = lane >> 2, dq = (lane & 3) * 16;
      const int tok = gla_tok(sc, w * 16 + tl);
      const bf16_t* grow = p.cols + (size_t)tok * INW + C_GG + h * 64 + dq;
      float ov[16], gv[16];
      unpack8(*(const uint4*)(Pw + tl * GL_VT_STRIDE + dq), ov); unpack8(*(const uint4*)(Pw + tl * GL_VT_STRIDE + dq + 8), ov + 8);
      unpack8(*(const uint4*)grow, gv); unpack8(*(const uint4*)(grow + 8), gv + 8);
      const float* ng = p.gla_ng + layer * 512 + h * 64 + dq;
      unsigned wv[8];
#pragma unroll
      for (int e = 0; e < 8; ++e) {
        const float a = ov[2 * e] * ng[2 * e] * silu_f(gv[2 * e]), b = ov[2 * e + 1] * ng[2 * e + 1] * silu_f(gv[2 * e + 1]);
        wv[e] = (unsigned)f2bf(a) | ((unsigned)f2bf(b) << 16);
      }
      bf16_t* orow = p.mix + (size_t)tok * 1024 + 512 + h * 64 + dq;
      *(uint4*)orow = make_uint4(wv[0], wv[1], wv[2], wv[3]);
      *(uint4*)(orow + 8) = make_uint4(wv[4], wv[5], wv[6], wv[7]);
    }
    __builtin_amdgcn_wave_barrier();
    cur = nxt;
  }
  __syncthreads();
}

__device__ __forceinline__ unsigned fkey(float f) { const unsigned u = __float_as_uint(f); return u ^ ((u >> 31) ? 0xFFFFFFFFu : 0x80000000u); }
__device__ __forceinline__ float funkey(unsigned k) { return __uint_as_float((k >> 31) ? (k ^ 0x80000000u) : ~k); }
__device__ __forceinline__ unsigned umax3(unsigned a, unsigned b) { return a > b ? a : b; }
__device__ __forceinline__ unsigned umin3(unsigned a, unsigned b) { return a < b ? a : b; }
__device__ __forceinline__ unsigned umed3(unsigned a, unsigned b, unsigned c) { return umax3(umin3(a, b), umin3(umax3(a, b), c)); }
__device__ __forceinline__ void top16_insert(unsigned (&L)[16], unsigned x) {
#pragma unroll
  for (int q = 15; q >= 1; --q) L[q] = umed3(L[q - 1], L[q], x);
  L[0] = umax3(L[0], x);
}
template <int XM>
__device__ __forceinline__ void top16_merge(unsigned (&L)[16]) {
  unsigned P[16];
#pragma unroll
  for (int i = 0; i < 16; ++i) P[i] = xor_lane_u<XM>(L[i]);
  unsigned M[16];
#pragma unroll
  for (int i = 0; i < 16; ++i) M[i] = umax3(L[i], P[15 - i]);
#pragma unroll
  for (int d = 8; d >= 1; d >>= 1) {
#pragma unroll
    for (int i = 0; i < 16; ++i) {
      if ((i & d) == 0) { const unsigned hi = umax3(M[i], M[i + d]), lo = umin3(M[i], M[i + d]); M[i] = hi; M[i + d] = lo; }
    }
  }
#pragma unroll
  for (int i = 0; i < 16; ++i) L[i] = M[i];
}
#define RT_MAX_ITEMS 5
__device__ __forceinline__ void phase_route(const Params& p, int layer, int ntok, int bid, int nblk, unsigned char* smem) {
  const int tid = opaque_tid(); const int lane = tid & 63, wid = tid >> 6;
  unsigned* lists_w = (unsigned*)smem + wid * (RT_MAX_ITEMS * 2 * 16 * 16);
  const int fr = lane & 15, fq = lane >> 4;
  const bf16_t* qb = p.cols;
  const int nitems = ntok / 16;
  static const unsigned char STAIR[52] = {0, 1, 2, 3, 4, 5, 6, 7, 8, 9, 10, 11, 12, 13, 14, 15, 16, 17, 18, 19, 20, 21, 22, 23, 32, 33, 34, 35, 36, 48, 49, 50, 51, 64, 65, 66, 80, 81, 96, 97, 112, 113, 128, 144, 160, 176, 192, 208, 224, 240, 255, 255};
  for (int item0 = bid; item0 < nitems; item0 += nblk * RT_MAX_ITEMS) {
    for (int ph = 0; ph < 2; ++ph) {
      bf16x8 bk[8][4];
      {
        const bf16_t* kb = p.keysb + ((((size_t)layer * 2 + ph) * 8 + wid) * 128) * 128 + (size_t)fr * 128 + fq * 8;
#pragma unroll
        for (int n = 0; n < 8; ++n)
#pragma unroll
          for (int kt = 0; kt < 4; ++kt) bk[n][kt] = *(const bf16x8*)(kb + (size_t)n * 16 * 128 + kt * 32);
      }
      bf16x8 an[4];
      {
        const bf16_t* qrow = qb + (size_t)(item0 * 16 + fr) * 2048 + wid * 256 + ph * 128 + fq * 8;
#pragma unroll
        for (int kt = 0; kt < 4; ++kt) an[kt] = *(const bf16x8*)(qrow + kt * 32);
      }
      for (int ii = 0; ii < RT_MAX_ITEMS; ++ii) {
        const int item = item0 + ii * nblk;
        if (item >= nitems) break;
        const int tok0 = item * 16;
        bf16x8 a[4];
#pragma unroll
        for (int kt = 0; kt < 4; ++kt) a[kt] = an[kt];
        {
          const int itn = item0 + (ii + 1) * nblk;
          const int tokn = (ii + 1 < RT_MAX_ITEMS && itn < nitems) ? itn * 16 : tok0;
          const bf16_t* qrow = qb + (size_t)(tokn + fr) * 2048 + wid * 256 + ph * 128 + fq * 8;
#pragma unroll
          for (int kt = 0; kt < 4; ++kt) an[kt] = *(const bf16x8*)(qrow + kt * 32);
        }
        unsigned L[16];
#pragma unroll
        for (int i = 0; i < 16; ++i) L[i] = 0u;
#pragma unroll
        for (int n = 0; n < 8; ++n) {
          f32x4 acc = (f32x4){0.f, 0.f, 0.f, 0.f};
#pragma unroll
          for (int kt = 0; kt < 4; ++kt) acc = __builtin_amdgcn_mfma_f32_16x16x32_bf16(bk[n][kt], a[kt], acc, 0, 0, 0);
#pragma unroll
          for (int j = 0; j < 4; ++j) top16_insert(L, (fkey(acc[j]) & 0xFFFFFF80u) | (unsigned)(n * 16 + fq * 4 + j));
        }
        top16_merge<16>(L);
        top16_merge<32>(L);
        if (fq == 0) {
          unsigned* dst = lists_w + ((ii * 2 + ph) * 16 + fr) * 16;
#pragma unroll
          for (int i = 0; i < 4; ++i) *(uint4*)(dst + i * 4) = make_uint4(L[i * 4], L[i * 4 + 1], L[i * 4 + 2], L[i * 4 + 3]);
        }
      }
    }
    __builtin_amdgcn_wave_barrier();
    for (int ii = 0; ii < RT_MAX_ITEMS; ++ii) {
      const int item = item0 + ii * nblk;
      if (item >= nitems) break;
      const int tok0 = item * 16;
      const unsigned* l1 = lists_w + ((ii * 2 + 0) * 16 + fr) * 16;
      const unsigned* l2 = lists_w + ((ii * 2 + 1) * 16 + fr) * 16;
      unsigned T[16];
#pragma unroll
      for (int i = 0; i < 16; ++i) T[i] = 0u;
#pragma unroll
      for (int j = 0; j < 13; ++j) {
        const unsigned c = STAIR[fq + 4 * j];
        const float sa = funkey(l1[(c >> 4) & 15] & 0xFFFFFF80u), sb = funkey(l2[c & 15] & 0xFFFFFF80u);
        const unsigned key = (fkey(sa + sb) & 0xFFFFFF00u) | c;
        top16_insert(T, c == 255u ? 0u : key);
      }
      top16_merge<16>(T);
      top16_merge<32>(T);
      const float mx = funkey(T[0] & 0xFFFFFF00u);
      float ex[16], sum = 0.f;
#pragma unroll
      for (int r = 0; r < 16; ++r) { ex[r] = __expf(funkey(T[r] & 0xFFFFFF00u) - mx); sum += ex[r]; }
      const float inv = 1.f / sum;
      int eid[4]; float gt[4];
#pragma unroll
      for (int r = 0; r < 16; ++r) {
        if ((r >> 2) == fq) {
          const int a = (T[r] >> 4) & 15, b = T[r] & 15;
          eid[r & 3] = (int)(l1[a] & 127u) * 128 + (int)(l2[b] & 127u);
          gt[r & 3] = ex[r] * inv;
        }
      }
      const size_t o = (size_t)(tok0 + fr) * 128 + wid * 16 + fq * 4;
      *(int4*)(p.pidx + o) = make_int4(eid[0], eid[1], eid[2], eid[3]);
      *(f32x4*)(p.pgate + o) = (f32x4){gt[0], gt[1], gt[2], gt[3]};
    }
    __builtin_amdgcn_wave_barrier();
  }
  __syncthreads();
}

typedef float f32x2 __attribute__((ext_vector_type(2)));
__device__ __forceinline__ float dot16_fp8(const uint4& r, const f32x2* h2) {
  const unsigned w[4] = {r.x, r.y, r.z, r.w};
  f32x2 d = {0.f, 0.f};
#pragma unroll
  for (int q = 0; q < 4; ++q) {
    d += __builtin_amdgcn_cvt_pk_f32_fp8(w[q], false) * h2[q * 2];
    d += __builtin_amdgcn_cvt_pk_f32_fp8(w[q], true) * h2[q * 2 + 1];
  }
  return d.x + d.y;
}
__device__ __forceinline__ void fma16_fp8(f32x2* acc2, const uint4& r, float w8) {
  const unsigned w[4] = {r.x, r.y, r.z, r.w};
  const f32x2 ww = {w8, w8};
#pragma unroll
  for (int q = 0; q < 4; ++q) {
    acc2[q * 2] += ww * __builtin_amdgcn_cvt_pk_f32_fp8(w[q], false);
    acc2[q * 2 + 1] += ww * __builtin_amdgcn_cvt_pk_f32_fp8(w[q], true);
  }
}
struct XcdInfo { int rank, nloc, xi, nx; };
__device__ __forceinline__ XcdInfo xcd_info(const XcdBarrier& b) {
  if (threadIdx.x == 0) {
    unsigned xi = 0;
    for (unsigned j = 0; j < 16; ++j) { const unsigned c = xb_ld(&b.bar[XB_XCNT(j)]); if (j < b.x && c > 0u) ++xi; }
    b.st[3] = xi;
  }
  __syncthreads();
  XcdInfo r;
  r.nloc = __builtin_amdgcn_readfirstlane((int)b.st[0]); r.nx = __builtin_amdgcn_readfirstlane((int)b.st[1]);
  r.rank = __builtin_amdgcn_readfirstlane((int)b.st[2]); r.xi = __builtin_amdgcn_readfirstlane((int)b.st[3]);
  return r;
}
__device__ __forceinline__ void gs_issue(uint4 (&buf)[16], const unsigned char* tab, const int* el, int grp) {
#pragma unroll
  for (int k = 0; k < 16; ++k) buf[k] = *(const uint4*)(tab + (size_t)el[k * 8 + grp] * 1024);
}
__device__ __forceinline__ void phase_gather_u(const Params& p, int layer, int ntok, const XcdInfo xin, unsigned char* smem) {
  const int tid = opaque_tid(); const int lane = tid & 63, wid = tid >> 6;
  int* elw = (int*)smem + wid * 256;
  float* pbuf = (float*)p.cols;
  const int sub = lane & 7, grp = lane >> 3;
  const bool b0 = (lane & 1) != 0, b1 = (lane & 2) != 0, b2 = (lane & 4) != 0;
  const int tstep = xin.nloc * NW;
  for (int s = xin.xi; s < 8; s += xin.nx) {
    const unsigned char* EU = p.eu8 + (size_t)layer * 16384 * 1024 + s * 128 + sub * 16;
    const int t0 = xin.rank * NW + wid;
    if (t0 >= ntok) continue;
    const int kslot = ((b0 ? 8 : 0) + (b1 ? 4 : 0) + (b2 ? 2 : 0)) * 8 + grp;
    uint4 bufA[16], bufB[16];
    uint4 hA0, hA1, hB0, hB1;
    int i0n, i1n;
    {
      elw[lane] = p.pidx[(size_t)t0 * 128 + lane]; elw[64 + lane] = p.pidx[(size_t)t0 * 128 + 64 + lane];
      __builtin_amdgcn_wave_barrier();
      gs_issue(bufA, EU, elw, grp);
      hA0 = *(const uint4*)(p.abuf + (size_t)t0 * 1024 + s * 128 + sub * 16); hA1 = *(const uint4*)(p.abuf + (size_t)t0 * 1024 + s * 128 + sub * 16 + 8);
      const int t1 = t0 + tstep < ntok ? t0 + tstep : t0;
      i0n = p.pidx[(size_t)t1 * 128 + lane]; i1n = p.pidx[(size_t)t1 * 128 + 64 + lane];
    }
    int par = 0;
    for (int t = t0; t < ntok; t += 2 * tstep) {
#pragma unroll
      for (int hh = 0; hh < 2; ++hh) {
        const int tc = t + hh * tstep;
        if (tc < ntok) {
          uint4 (&cur)[16] = hh ? bufB : bufA;
          uint4 (&nxt)[16] = hh ? bufA : bufB;
          const uint4 hc0 = hh ? hB0 : hA0, hc1 = hh ? hB1 : hA1;
          const int tn = tc + tstep < ntok ? tc + tstep : tc;
          par ^= 1;
          int* eln = elw + par * 128;
          eln[lane] = i0n; eln[64 + lane] = i1n;
          __builtin_amdgcn_wave_barrier();
          gs_issue(nxt, EU, eln, grp);
          const uint4 hn0 = *(const uint4*)(p.abuf + (size_t)tn * 1024 + s * 128 + sub * 16), hn1 = *(const uint4*)(p.abuf + (size_t)tn * 1024 + s * 128 + sub * 16 + 8);
          const int tnn = tn + tstep < ntok ? tn + tstep : tn;
          i0n = p.pidx[(size_t)tnn * 128 + lane]; i1n = p.pidx[(size_t)tnn * 128 + 64 + lane];
          f32x2 hv2[8];
          {
            float hv[16];
            unpack8(hc0, hv); unpack8(hc1, hv + 8);
#pragma unroll
            for (int q = 0; q < 8; ++q) hv2[q] = (f32x2){hv[2 * q], hv[2 * q + 1]};
          }
          float d[16];
#pragma unroll
          for (int k = 0; k < 16; ++k) d[k] = dot16_fp8(cur[k], hv2);
          float d8[8], d4[4], d2[2];
#pragma unroll
          for (int q = 0; q < 8; ++q) { const float send = b0 ? d[q] : d[q + 8]; const float keep = b0 ? d[q + 8] : d[q]; d8[q] = keep + xor_lane_f<1>(send); }
#pragma unroll
          for (int q = 0; q < 4; ++q) { const float send = b1 ? d8[q] : d8[q + 4]; const float keep = b1 ? d8[q + 4] : d8[q]; d4[q] = keep + xor_lane_f<2>(send); }
#pragma unroll
          for (int q = 0; q < 2; ++q) { const float send = b2 ? d4[q] : d4[q + 2]; const float keep = b2 ? d4[q + 2] : d4[q]; d2[q] = keep + xor_lane_f<4>(send); }
          float* dst = pbuf + ((size_t)s * TT + tc) * 128 + kslot;
          dst[0] = d2[0]; dst[8] = d2[1];
          if (hh) { hA0 = hn0; hA1 = hn1; } else { hB0 = hn0; hB1 = hn1; }
        }
      }
    }
    __builtin_amdgcn_wave_barrier();
  }
}
__device__ __forceinline__ void phase_gather_r(const Params& p, int layer, int ntok, int bid, int nblk) {
  const int tid = opaque_tid();
  const float* pbuf = (const float*)p.cols;
  const size_t n4 = (size_t)ntok * 32;
  for (size_t i = (size_t)bid * NT + tid; i < n4; i += (size_t)nblk * NT) {
    f32x4 z = *(const f32x4*)(pbuf + i * 4);
#pragma unroll
    for (int s = 1; s < 8; ++s) z += *(const f32x4*)(pbuf + (size_t)s * TT * 128 + i * 4);
    const f32x4 g = *(const f32x4*)(p.pgate + i * 4);
    const int4 e = *(const int4*)(p.pidx + i * 4);
    const int ev[4] = {e.x, e.y, e.z, e.w};
    f32x4 w;
#pragma unroll
    for (int j = 0; j < 4; ++j) w[j] = g[j] * gelu_f(z[j] * p.su[layer * 16384 + ev[j]]) * p.sv[layer * 16384 + ev[j]];
    *(f32x4*)(p.wbuf + i * 4) = w;
  }
}
template <bool DUMMY>
__device__ __forceinline__ void phase_gather_v(const Params& p, int layer, int ntok, const XcdInfo xin, unsigned char* smem) {
  float* xout = DUMMY ? (float*)p.cols : p.xres;
  const int tid = opaque_tid(); const int lane = tid & 63, wid = tid >> 6;
  int* elw = (int*)smem + wid * 512;
  float* wlw = (float*)(elw + 256);
  const int sub = lane & 7, grp = lane >> 3;
  const bool b5 = (lane & 32) != 0, b4 = (lane & 16) != 0, b3 = (lane & 8) != 0;
  const int tstep = xin.nloc * NW;
  for (int s = xin.xi; s < 8; s += xin.nx) {
    const unsigned char* EV = p.ev8 + (size_t)layer * 16384 * 1024 + s * 128 + sub * 16;
    const int col = s * 128 + sub * 16 + (b3 ? 8 : 0) + (b4 ? 4 : 0) + (b5 ? 2 : 0);
    const int t0 = xin.rank * NW + wid;
    if (t0 >= ntok) continue;
    uint4 bufA[16], bufB[16];
    int i0n, i1n; float w0n, w1n;
    f32x2 xc, gc, xn, gn;
    {
      elw[lane] = p.pidx[(size_t)t0 * 128 + lane]; elw[64 + lane] = p.pidx[(size_t)t0 * 128 + 64 + lane];
      wlw[lane] = p.wbuf[(size_t)t0 * 128 + lane]; wlw[64 + lane] = p.wbuf[(size_t)t0 * 128 + 64 + lane];
      __builtin_amdgcn_wave_barrier();
      gs_issue(bufA, EV, elw, grp);
      xc = *(const f32x2*)(p.xres + (size_t)t0 * 1024 + col);
      gc = *(const f32x2*)(p.modv + ((size_t)layer * 5 + tok_batch(t0)) * NMOD + 5120 + col);
      const int t1 = t0 + tstep < ntok ? t0 + tstep : t0;
      i0n = p.pidx[(size_t)t1 * 128 + lane]; i1n = p.pidx[(size_t)t1 * 128 + 64 + lane];
      w0n = p.wbuf[(size_t)t1 * 128 + lane]; w1n = p.wbuf[(size_t)t1 * 128 + 64 + lane];
      xn = *(const f32x2*)(p.xres + (size_t)t1 * 1024 + col);
      gn = *(const f32x2*)(p.modv + ((size_t)layer * 5 + tok_batch(t1)) * NMOD + 5120 + col);
    }
    int par = 0;
    for (int t = t0; t < ntok; t += 2 * tstep) {
#pragma unroll
      for (int hh = 0; hh < 2; ++hh) {
        const int tc = t + hh * tstep;
        if (tc < ntok) {
          uint4 (&cur)[16] = hh ? bufB : bufA;
          uint4 (&nxt)[16] = hh ? bufA : bufB;
          const float* wlc = wlw + par * 128;
          const int tn = tc + tstep < ntok ? tc + tstep : tc;
          par ^= 1;
          int* eln = elw + par * 128; float* wln = wlw + par * 128;
          eln[lane] = i0n; eln[64 + lane] = i1n; wln[lane] = w0n; wln[64 + lane] = w1n;
          __builtin_amdgcn_wave_barrier();
          gs_issue(nxt, EV, eln, grp);
          const f32x2 xcur = xc, gcur = gc;
          xc = xn; gc = gn;
          const int tnn = tn + tstep < ntok ? tn + tstep : tn;
          i0n = p.pidx[(size_t)tnn * 128 + lane]; i1n = p.pidx[(size_t)tnn * 128 + 64 + lane];
          w0n = p.wbuf[(size_t)tnn * 128 + lane]; w1n = p.wbuf[(size_t)tnn * 128 + 64 + lane];
          xn = *(const f32x2*)(p.xres + (size_t)tnn * 1024 + col);
          gn = *(const f32x2*)(p.modv + ((size_t)layer * 5 + tok_batch(tnn)) * NMOD + 5120 + col);
          f32x2 acc2[8];
#pragma unroll
          for (int j = 0; j < 8; ++j) acc2[j] = (f32x2){0.f, 0.f};
#pragma unroll
          for (int k = 0; k < 16; ++k) fma16_fp8(acc2, cur[k], wlc[k * 8 + grp]);
          float a16[16];
#pragma unroll
          for (int q = 0; q < 8; ++q) { a16[2 * q] = acc2[q].x; a16[2 * q + 1] = acc2[q].y; }
          float a8[8], a4[4], a2[2];
#pragma unroll
          for (int q = 0; q < 8; ++q) { const float send = b3 ? a16[q] : a16[q + 8]; const float keep = b3 ? a16[q + 8] : a16[q]; a8[q] = keep + xor_lane_f<8>(send); }
#pragma unroll
          for (int q = 0; q < 4; ++q) { const float send = b4 ? a8[q] : a8[q + 4]; const float keep = b4 ? a8[q + 4] : a8[q]; a4[q] = keep + xor_lane_f<16>(send); }
#pragma unroll
          for (int q = 0; q < 2; ++q) { const float send = b5 ? a4[q] : a4[q + 2]; const float keep = b5 ? a4[q + 2] : a4[q]; a2[q] = keep + xor_lane_f<32>(send); }
          f32x2 xv = xcur;
          xv.x += gcur.x * a2[0]; xv.y += gcur.y * a2[1];
          *(f32x2*)(xout + (size_t)tc * 1024 + col) = xv;
        }
      }
    }
    __builtin_amdgcn_wave_barrier();
  }
}
__device__ __forceinline__ void phase_gather_norm(const Params& p, int layer, int ntok, int bid, int nblk) {
  const int tid = opaque_tid(); const int lane = tid & 63, wid = tid >> 6;
  for (int t = bid * NW + wid; t < ntok; t += nblk * NW) {
    f32x4 xv[4];
    float ss = 0.f;
#pragma unroll
    for (int q = 0; q < 4; ++q) {
      xv[q] = *(const f32x4*)(p.xres + (size_t)t * 1024 + lane * 16 + q * 4);
      ss += xv[q][0] * xv[q][0] + xv[q][1] * xv[q][1] + xv[q][2] * xv[q][2] + xv[q][3] * xv[q][3];
    }
    ss = wave_sum(ss);
    const float rstd = rsqrtf(ss * (1.f / 1024.f) + EPSV);
    if (layer == 0) {
      const float* md1 = p.modv + ((size_t)5 + tok_batch(t)) * NMOD;
#pragma unroll
      for (int q = 0; q < 4; ++q) {
        const int c0 = lane * 16 + q * 4;
        const f32x4 g = *(const f32x4*)(p.norm1_g + 1024 + c0);
        const f32x4 sh = *(const f32x4*)(md1 + c0);
        const f32x4 sc = *(const f32x4*)(md1 + 1024 + c0);
        ushort4 o;
        o.x = f2bf(xv[q][0] * rstd * g[0] * (1.f + sc[0]) + sh[0]);
        o.y = f2bf(xv[q][1] * rstd * g[1] * (1.f + sc[1]) + sh[1]);
        o.z = f2bf(xv[q][2] * rstd * g[2] * (1.f + sc[2]) + sh[2]);
        o.w = f2bf(xv[q][3] * rstd * g[3] * (1.f + sc[3]) + sh[3]);
        *(ushort4*)(p.abuf + (size_t)t * 1024 + c0) = o;
      }
    } else {
#pragma unroll
      for (int q = 0; q < 4; ++q) {
        const int c0 = lane * 16 + q * 4;
        const f32x4 g = *(const f32x4*)(p.final_g + c0);
        f32x4 o;
        o[0] = xv[q][0] * rstd * g[0]; o[1] = xv[q][1] * rstd * g[1]; o[2] = xv[q][2] * rstd * g[2]; o[3] = xv[q][3] * rstd * g[3];
        *(f32x4*)(p.out + (size_t)t * 1024 + c0) = o;
      }
    }
  }
}

__device__ __forceinline__ void phase_final(const Params& p, int bid, int nblk) {
  const int tid = opaque_tid(); const int lane = tid & 63, wid = tid >> 6;
  for (int t = bid * 4 + wid; t < TL; t += nblk * 4) {
    const float* row = p.xres + (size_t)t * 1024;
    f32x4 v[4];
    float ss = 0.f;
#pragma unroll
    for (int j = 0; j < 4; ++j) {
      v[j] = *(const f32x4*)(row + j * 256 + lane * 4);
      ss += v[j][0] * v[j][0] + v[j][1] * v[j][1] + v[j][2] * v[j][2] + v[j][3] * v[j][3];
    }
    ss = wave_sum(ss);
    const float rstd = rsqrtf(ss * (1.f / 1024.f) + EPSV);
#pragma unroll
    for (int j = 0; j < 4; ++j) {
      const int c0 = j * 256 + lane * 4;
      const f32x4 g = *(const f32x4*)(p.final_g + c0);
      f32x4 o;
      o[0] = v[j][0] * rstd * g[0]; o[1] = v[j][1] * rstd * g[1]; o[2] = v[j][2] * rstd * g[2]; o[3] = v[j][3] * rstd * g[3];
      *(f32x4*)(p.out + (size_t)t * 1024 + c0) = o;
    }
  }
}

template <class Epi>
__device__ __forceinline__ void run_gemm(const bf16_t* A, const bf16_t* Bt, int M, int N, int K, const Epi& epi, int bid, int nblk, unsigned char* smem) {
  pg8::Gemm g{A, Bt, M, N, K};
  pg8::StaticOrder S; S.init(M, N, nblk, bid);
  pg8::gemm_phase(( PG8_LAS unsigned char*)smem, g, S, epi);
}
__device__ __forceinline__ void phase_gemm_in(const Params& p, int layer, int bid, int nblk, unsigned char* smem) {
  pg8::EpiBf16 epi{p.cols, INW, INW};
  run_gemm(p.abuf, p.wt_in + (size_t)layer * INWP * 1024, TT, INWP, 1024, epi, bid, nblk, smem);
}
__device__ __forceinline__ void phase_gemm_glu(const Params& p, int layer, int ntok, int bid, int nblk, unsigned char* smem) {
  pg8::EpiGlu epi{p.mix};
  run_gemm(p.yg, p.wt_glu + (size_t)layer * 512 * 256, ntok, 512, 256, epi, bid, nblk, smem);
}
__device__ __forceinline__ void phase_gemm_out(const Params& p, int layer, int ntok, int bid, int nblk, unsigned char* smem) {
  pg8::EpiResid epi{p.xres, p.modv + (size_t)layer * 5 * NMOD, 2048};
  run_gemm(p.mix, p.wt_out + (size_t)layer * 1024 * 1024, ntok, 1024, 1024, epi, bid, nblk, smem);
}
__device__ __forceinline__ void phase_gemm_q(const Params& p, int layer, int ntok, int bid, int nblk, unsigned char* smem) {
  pg8::EpiBf16 epi{p.cols  , 2048, 2048};
  run_gemm(p.abuf, p.wt_q + (size_t)layer * 2048 * 1024, ntok, 2048, 1024, epi, bid, nblk, smem);
}

template <int L>
__device__ __forceinline__ void layer_body(const Params& p, const XcdBarrier& bar, const XcdInfo xin, int bid, int nblk, unsigned char* smem) {
  constexpr int l = L;
  constexpr int ntok = L == 0 ? TT : TL;
  for (int rep = 0; rep < REP_GEMM; ++rep) phase_gemm_in(p, l, bid, nblk, smem);
  xcd_barrier(bar);
  for (int rep = 0; rep < REP_MIX; ++rep) {
    phase_s5a(p, l, bid, nblk, smem);
    if (REP_S5 > 1) phase_s5a(p, l, bid, nblk, smem);
    for (int r2 = 0; r2 < REP_GLA; ++r2) phase_glaa(p, l, bid, nblk, smem);
  }
  xcd_barrier(bar);
  phase_scan(p, l, bid, nblk);
  for (int r2 = 0; r2 < REP_SGU; ++r2) phase_sgu(p, l, ntok / 128, bid, nblk, smem);
  xcd_barrier(bar);
  for (int rep = 0; rep < REP_MIX; ++rep) {
    phase_s5c(p, l, ntok / 64, bid, nblk, smem);
    if (REP_S5 > 1) phase_s5c(p, l, ntok / 64, bid, nblk, smem);
    for (int r2 = 0; r2 < REP_GLA; ++r2) phase_glac(p, l, ntok / 64, 16 * ((ntok / 64 / 16 + 1) / 2), bid, nblk, smem);
  }
  xcd_barrier(bar);
  for (int rep = 0; rep < REP_GEMM; ++rep) phase_gemm_glu(p, l, ntok, bid, nblk, smem);
  xcd_barrier(bar);
  if (REP_GEMM > 1) {
    pg8::EpiBf16 epi{p.abuf, 1024, 1024};
    for (int rep = 1; rep < REP_GEMM; ++rep) run_gemm(p.mix, p.wt_out + (size_t)l * 1024 * 1024, ntok, 1024, 1024, epi, bid, nblk, smem);
  }
  phase_gemm_out(p, l, ntok, bid, nblk, smem);
  if (l == 0 && nblk > 16 && bid >= 16) {
    const int tid = opaque_tid();
    for (int j = bid - 16; j < 2048; j += nblk - 16) convert_rows(p, (j >> 10) * 2048 + 1024 + (j & 1023), tid);
  } else if (l == 0 && nblk <= 16) {
    const int tid = opaque_tid();
    for (int j = bid; j < 2048; j += nblk) convert_rows(p, (j >> 10) * 2048 + 1024 + (j & 1023), tid);
  }
  xcd_barrier(bar);
  for (int rep = 0; rep < REP_PRO; ++rep)
    phase_normmod(p, p.xres, p.xres + (size_t)TL * 1024, p.norm2_g + l * 1024, p.modv + (size_t)l * 5 * NMOD, 3072, 4096, ntok, 0, bid, nblk);
  xcd_barrier(bar);
  for (int rep = 0; rep < REP_GEMM; ++rep) phase_gemm_q(p, l, ntok, bid, nblk, smem);
  xcd_barrier(bar);
  for (int rep = 0; rep < REP_ROUTE; ++rep) phase_route(p, l, ntok, bid, nblk, smem);
  xcd_barrier(bar);
  phase_gather_u(p, l, ntok, xin, smem);
  if (REP_GATHER == 2) phase_gather_u(p, l, ntok, xin, smem);
  xcd_barrier(bar);
  phase_gather_r(p, l, ntok, bid, nblk);
  xcd_barrier(bar);
  if (REP_GATHER > 2) phase_gather_v<true>(p, l, ntok, xin, smem);
  phase_gather_v<false>(p, l, ntok, xin, smem);
  xcd_barrier(bar);
  phase_gather_norm(p, l, ntok, bid, nblk);
  if (l == 0) xcd_barrier(bar);
}

#define SMEM_BYTES (148 * 1024)
__global__ void __launch_bounds__(NT) mega_kernel(Params p) {
  __shared__ __attribute__((aligned(16))) unsigned char smem[SMEM_BYTES + 16];
  const int bid = blockIdx.x, nblk = gridDim.x;
  volatile LAS unsigned* xbw = (volatile LAS unsigned*)(smem + SMEM_BYTES);
  if (threadIdx.x == 0) { xbw[0] = 0u; xbw[1] = 0u; xbw[2] = 0u; xbw[3] = 0u; }
  __syncthreads();
  XcdBarrier bar = xcd_barrier_post(p.bar, xbw);
  for (int rep = 0; rep < REP_PRO; ++rep) {
    phase_mod(p, bid, nblk, smem);
    phase_wprep(p, bid, nblk, smem);
  }
  xcd_barrier(bar);
  for (int rep = 0; rep < REP_PRO; ++rep) phase_normmod(p, p.x, p.ctx, p.norm1_g, p.modv, 0, 1024, TT, 1, bid, nblk);
  xcd_barrier(bar);
  const XcdInfo xin = xcd_info(bar);
  layer_body<0>(p, bar, xin, bid, nblk, smem);
  layer_body<1>(p, bar, xin, bid, nblk, smem);
}

static inline size_t align_up(size_t v, size_t a) { return (v + a - 1) / a * a; }

extern "C" void kernel_launch(void* const* d_in, const int* in_sizes, int n_in, void* d_out, int out_size, void* d_ws, size_t ws_size,
                              hipStream_t stream) {
  Params p{};
  const float* const* in = (const float* const*)d_in;
  p.x = in[0]; p.c = in[1]; p.ctx = in[2]; p.c_ctx = in[3]; p.w_mod = in[4]; p.b_mod = in[5]; p.norm1_g = in[6]; p.norm2_g = in[7];
  p.w_in = in[8]; p.w_out = in[9]; p.sgu_w = in[10]; p.sgu_b = in[11]; p.lam_re = in[12]; p.lam_im = in[13]; p.b_re = in[14]; p.b_im = in[15];
  p.c_re = in[16]; p.c_im = in[17]; p.log_step = in[18]; p.s5_d = in[19]; p.w_glu = in[20]; p.gla_wg = in[21]; p.gla_bg = in[22]; p.gla_ng = in[23];
  p.w_query = in[24]; p.sub_keys = in[25]; p.exp_u = in[26]; p.exp_v = in[27]; p.final_g = in[28];
  p.out = (float*)d_out;
  unsigned char* w = (unsigned char*)d_ws;
  size_t off = 0;
  auto take = [&](size_t bytes) { void* r = w + off; off = align_up(off + bytes, 256); return r; };
  p.bar = (unsigned*)take(16384);
  p.xres = (float*)take((size_t)TT * 1024 * 4);
  p.modv = (float*)take((size_t)2 * 5 * NMOD * 4);
  p.abuf = (bf16_t*)take((size_t)TT * 1024 * 2);
  p.cols = (bf16_t*)take((size_t)TT * INW * 2);
  p.mix = (bf16_t*)take((size_t)TT * 1024 * 2);
  p.yg = (bf16_t*)take((size_t)TT * 256 * 2);
  p.wt_in = (bf16_t*)take((size_t)2 * INWP * 1024 * 2);
  p.wt_out = (bf16_t*)take((size_t)2 * 1024 * 1024 * 2);
  p.wt_q = (bf16_t*)take((size_t)2 * 2048 * 1024 * 2);
  p.wt_glu = (bf16_t*)take((size_t)2 * 512 * 256 * 2);
  p.keysb = (bf16_t*)take((size_t)2 * 2 * 8 * 128 * 128 * 2);
  p.sgu_wb = (bf16_t*)take((size_t)2 * 4 * 128 * 128 * 2);
  p.s5a = (float*)take((size_t)4096 * 2 * 4);
  p.s5a64 = (float*)take((size_t)4096 * 2 * 4);
  p.s5bb = (float*)take((size_t)4096 * 32 * 4);
  p.s5K = (bf16_t*)take((size_t)64 * 16384 * 2);
  p.s5M1 = (bf16_t*)take((size_t)64 * 131072 * 2);
  p.s5N2 = (bf16_t*)take((size_t)64 * 131072 * 2);
  p.s5S = (float*)take((size_t)2 * NSC * 16 * 64 * 2 * 4);
  p.s5H = (float*)take((size_t)2 * NSC * 16 * 64 * 2 * 4);
  p.gkv = (float*)take((size_t)2 * NSC * 8 * 2048 * 4);
  p.gdec = (float*)take((size_t)2 * NSC * 8 * 32 * 4);
  p.eu8 = (unsigned char*)take((size_t)2 * 16384 * 1024);
  p.ev8 = (unsigned char*)take((size_t)2 * 16384 * 1024);
  p.su = (float*)take((size_t)2 * 16384 * 4);
  p.sv = (float*)take((size_t)2 * 16384 * 4);
  p.glb = (float*)take((size_t)2 * TT * 256 * 4);
  p.wbuf = (float*)take((size_t)TT * 128 * 4);
  p.ssbuf = (float*)take((size_t)TT * 8 * 4);
  p.pidx = (int*)take((size_t)TT * 128 * 4);
  p.pgate = (float*)take((size_t)TT * 128 * 4);
  if (off > ws_size) { fprintf(stderr, "workspace too small: need %zu have %zu\n", off, ws_size); return; }

  (void)hipMemsetAsync(p.bar, 0, XCD_BAR_WORDS * 4, stream);
  static int grid_blocks = 0;
  if (!grid_blocks) {
    int dev = 0, cus = 0, per_cu = 0;
    (void)hipGetDevice(&dev);
    (void)hipDeviceGetAttribute(&cus, hipDeviceAttributeMultiprocessorCount, dev);
    (void)hipOccupancyMaxActiveBlocksPerMultiprocessor(&per_cu, (const void*)mega_kernel, NT, 0);
    if (per_cu < 1) { fprintf(stderr, "occupancy query says 0 blocks/CU\n"); per_cu = 1; }
    grid_blocks = cus;
  }
  void* args[] = {&p};
  hipError_t e = hipLaunchCooperativeKernel((const void*)mega_kernel, dim3(grid_blocks), dim3(NT), args, 0, stream);
  if (e != hipSuccess) fprintf(stderr, "cooperative launch failed: %s (grid %d)\n", hipGetErrorString(e), grid_blocks);
}
```

```cpp
#include <hip/hip_runtime.h>
#include <cstdio>
#include <cstdint>
#include <cmath>

typedef unsigned short bf16_t;
typedef short bf16x8 __attribute__((ext_vector_type(8)));
typedef float f32x4 __attribute__((ext_vector_type(4)));

#define DM 1024
#define NBATCH 4
#define SEQ 4096
#define CTXL 256
#define TL (NBATCH * SEQ)
#define TC (NBATCH * CTXL)
#define TT (TL + TC)
#define INW 2336
#define INWP 2560
#define NMOD 6144
#define NSC 272
#define EPSV 1e-6f
#define NT 512
#define NW 8
#ifndef REP_GATHER
#define REP_GATHER 1
#endif
#ifndef REP_ROUTE
#define REP_ROUTE 1
#endif
#ifndef REP_GEMM
#define REP_GEMM 1
#endif
#ifndef REP_MIX
#define REP_MIX 1
#endif
#ifndef REP_PRO
#define REP_PRO 1
#endif
#ifndef REP_SGU
#define REP_SGU 1
#endif
#ifndef REP_S5
#define REP_S5 1
#endif
#ifndef REP_GLA
#define REP_GLA 1
#endif

#define C_SGU_U 0
#define C_SGU_V 256
#define C_S5 512
#define C_GQ 768
#define C_GK 1024
#define C_GV 1280
#define C_GG 1792
#define C_ZF 2304

struct Params {
  const float *x, *c, *ctx, *c_ctx, *w_mod, *b_mod, *norm1_g, *norm2_g, *w_in, *w_out, *sgu_w, *sgu_b;
  const float *lam_re, *lam_im, *b_re, *b_im, *c_re, *c_im, *log_step, *s5_d, *w_glu, *gla_wg, *gla_bg, *gla_ng;
  const float *w_query, *sub_keys, *exp_u, *exp_v, *final_g;
  float* out;
  unsigned* bar;
  float* xres;
  float* modv;
  bf16_t* abuf;
  bf16_t* cols;
  bf16_t* mix;
  bf16_t* yg;
  bf16_t* s5u;
  bf16_t *wt_in, *wt_out, *wt_q, *wt_glu, *keysb, *sgu_wb;
  float *s5a, *s5a64, *s5bb;
  bf16_t *s5K, *s5M1, *s5N2;
  float *s5S, *s5H;
  float *gkv, *gdec;
  unsigned char *eu8, *ev8;
  float *su, *sv;
  float* glb;
  float *wbuf, *ssbuf;
  int* pidx;
  float* pgate;
};

__device__ __forceinline__ bf16_t f2bf(float f) {
  unsigned u = __float_as_uint(f);
  u += 0x7fffu + ((u >> 16) & 1u);
  return (bf16_t)(u >> 16);
}
__device__ __forceinline__ float bf2f(bf16_t h) { return __uint_as_float(((unsigned)h) << 16); }
__device__ __forceinline__ bf16x8 pack_bf16x8(const float* v) {
  bf16x8 r;
#pragma unroll
  for (int c = 0; c < 8; ++c) r[c] = (short)f2bf(v[c]);
  return r;
}

__device__ __forceinline__ float bflo(unsigned u) { return __uint_as_float(u << 16); }
__device__ __forceinline__ float bfhi(unsigned u) { return __uint_as_float(u & 0xffff0000u); }
__device__ __forceinline__ float gelu_f(float x) {
  const float y = 0.7978845608028654f * (x + 0.044715f * x * x * x);
  const float e = __expf(2.f * y);
  const float th = 1.f - 2.f / (1.f + e);
  return 0.5f * x * (1.f + th);
}
__device__ __forceinline__ float sigmoid_f(float x) { return 1.f / (1.f + __expf(-x)); }
__device__ __forceinline__ float silu_f(float x) { return x * sigmoid_f(x); }
__device__ __forceinline__ float logsigmoid_f(float x) { return fminf(x, 0.f) - log1pf(__expf(-fabsf(x))); }
template <int M>
__device__ __forceinline__ unsigned xor_lane_u(unsigned x) {
  if constexpr (M == 1) return (unsigned)__builtin_amdgcn_mov_dpp((int)x, 0xB1, 0xf, 0xf, true);
  else if constexpr (M == 2) return (unsigned)__builtin_amdgcn_mov_dpp((int)x, 0x4E, 0xf, 0xf, true);
  else if constexpr (M == 4) {
    const int a = __builtin_amdgcn_update_dpp((int)x, (int)x, 0x104, 0xf, 0x5, false);
    return (unsigned)__builtin_amdgcn_update_dpp(a, (int)x, 0x114, 0xf, 0xa, false);
  } else if constexpr (M == 8) return (unsigned)__builtin_amdgcn_mov_dpp((int)x, 0x128, 0xf, 0xf, true);
  else if constexpr (M == 16) {
    const auto r = __builtin_amdgcn_permlane16_swap(x, x, false, false);
    return ((threadIdx.x >> 4) & 1) ? r[0] : r[1];
  } else if constexpr (M == 32) {
    const auto r = __builtin_amdgcn_permlane32_swap(x, x, false, false);
    return (threadIdx.x & 32) ? r[0] : r[1];
  } else return (unsigned)__shfl_xor((int)x, M);
}
template <int M>
__device__ __forceinline__ float xor_lane_f(float x) { return __uint_as_float(xor_lane_u<M>(__float_as_uint(x))); }
__device__ __forceinline__ float wave_sum(float v) {
  v += xor_lane_f<32>(v); v += xor_lane_f<16>(v); v += xor_lane_f<8>(v); v += xor_lane_f<4>(v); v += xor_lane_f<2>(v); v += xor_lane_f<1>(v);
  return v;
}
__device__ __forceinline__ void lds_barrier() {
  asm volatile("s_waitcnt lgkmcnt(0)" ::: "memory");
  __builtin_amdgcn_s_barrier();
  asm volatile("" ::: "memory");
}
__device__ __forceinline__ int opaque_tid() { int t = threadIdx.x; asm volatile("" : "+v"(t)); return t; }
__device__ __forceinline__ int tok_batch(int t) { return t < TL ? (t >> 12) : 4; }
__device__ __forceinline__ int s5_tok(int sc, int i) { return sc < 256 ? ((sc >> 6) * SEQ + (sc & 63) * 64 + i) : (TL + (sc - 256) * 64 + i); }
__device__ __forceinline__ int gla_tok(int sc, int i) { return sc < 256 ? ((sc >> 6) * SEQ + i * 64 + (sc & 63)) : (TL + (sc - 256) * 64 + i); }


#define XB_TMO      128
#define XB_XCNT(j)  (256  + 64 * (j))
#define XB_XSUB(j)  (1280 + 64 * (j))
#define XB_XGEN(j)  (2304 + 64 * (j))
#define XB_TOP      3328
#define XB_TOPGEN   3392
#define XCD_BAR_WORDS 3456
#define XB_SPIN_CAP (1u << 22)
#define LAS __attribute__((address_space(3)))
__device__ __forceinline__ unsigned xb_ld(unsigned* p)              { return __hip_atomic_load(p, __ATOMIC_RELAXED, __HIP_MEMORY_SCOPE_AGENT); }
__device__ __forceinline__ unsigned xb_add(unsigned* p, unsigned v) { return __hip_atomic_fetch_add(p, v, __ATOMIC_RELAXED, __HIP_MEMORY_SCOPE_AGENT); }
__device__ __forceinline__ unsigned xb_xcc_id() { return (unsigned)__builtin_amdgcn_s_getreg((3 << 11) | 20) & 0xFu; }
#define XB_SPIN(cond, bar) do { unsigned _sp = 0; while (cond) { __builtin_amdgcn_s_sleep(1); \
    if ((++_sp & 255u) == 0u) { if (xb_ld(&(bar)[XB_TMO])) break; if (_sp > XB_SPIN_CAP) { atomicAdd(&(bar)[XB_TMO], 1u); break; } } } } while (0)
struct XcdBarrier { unsigned* bar; unsigned x; volatile LAS unsigned* st; };
__device__ __forceinline__ XcdBarrier xcd_barrier_post(unsigned* bar, volatile LAS unsigned* st) {
  XcdBarrier b; b.bar = bar; b.x = xb_xcc_id(); b.st = st;
  if (threadIdx.x == 0) st[2] = xb_add(&bar[XB_XCNT(b.x)], 1u);
  return b;
}
__device__ __forceinline__ void xcd_barrier_complete(unsigned* bar, unsigned x, unsigned& nloc, unsigned& nx) {
  const unsigned G = gridDim.x * gridDim.y * gridDim.z;
  unsigned sum, cnt, mine, sp = 0u;
  for (;;) {
    sum = 0u; cnt = 0u; mine = 0u;
#pragma unroll
    for (unsigned j = 0; j < 16; ++j) { const unsigned c = xb_ld(&bar[XB_XCNT(j)]); sum += c; cnt += (c > 0u) ? 1u : 0u; mine = (j == x) ? c : mine; }
    if (sum == G) break;
    __builtin_amdgcn_s_sleep(1);
    if ((++sp & 255u) == 0u) { if (xb_ld(&bar[XB_TMO])) break; if (sp > XB_SPIN_CAP) { atomicAdd(&bar[XB_TMO], 1u); break; } }
  }
  nloc = mine > 0u ? mine : 1u; nx = cnt > 0u ? cnt : 1u;
}
__device__ __forceinline__ void xcd_barrier(const XcdBarrier& b) {
  asm volatile("s_waitcnt vmcnt(0)" ::: "memory");
  __syncthreads();
  if (threadIdx.x == 0) {
    unsigned* bar = b.bar;
    __builtin_amdgcn_s_waitcnt(0);
    unsigned nloc = b.st[0], nx = b.st[1];
    if (nloc == 0u) { xcd_barrier_complete(bar, b.x, nloc, nx); b.st[0] = nloc; b.st[1] = nx; }
    const unsigned old = xb_add(&bar[XB_XSUB(b.x)], 1u);
    const unsigned gen = old / nloc;
    if (old + 1u == (gen + 1u) * nloc) {
      __builtin_amdgcn_fence(__ATOMIC_RELEASE, "agent");
      asm volatile("s_waitcnt vmcnt(0)" ::: "memory");
      const unsigned og = xb_add(&bar[XB_TOP], 1u);
      const unsigned tg = og / nx;
      if (og + 1u == (tg + 1u) * nx) xb_add(&bar[XB_TOPGEN], 1u);
      else XB_SPIN(xb_ld(&bar[XB_TOPGEN]) == tg, bar);
      __builtin_amdgcn_fence(__ATOMIC_ACQUIRE, "agent");
      xb_add(&bar[XB_XGEN(b.x)], 1u);
      asm volatile("s_waitcnt vmcnt(0)" ::: "memory");
    } else {
      XB_SPIN(xb_ld(&bar[XB_XGEN(b.x)]) == gen, bar);
      __builtin_amdgcn_fence(__ATOMIC_ACQUIRE, "agent");
      asm volatile("s_waitcnt vmcnt(0)" ::: "memory");
    }
  }
  __syncthreads();
}

__device__ __forceinline__ void phase_mod(const Params& p, int bid, int nblk, unsigned char* smem) {
  float* sil = (float*)smem;
  float* red = sil + 5 * 1024;
  const int tid = opaque_tid();
  for (int i = tid; i < 5 * 1024; i += NT) {
    const int r = i >> 10, k = i & 1023;
    const float v = r < 4 ? p.c[r * 1024 + k] : p.c_ctx[k];
    sil[i] = silu_f(v);
  }
  __syncthreads();
  for (int item = bid; item < 192; item += nblk) {
    const int l = item / 96, j0 = (item % 96) * 64;
    const int cc = tid & 63, kg = tid >> 6;
    float acc[5] = {0.f, 0.f, 0.f, 0.f, 0.f};
    const float* w = p.w_mod + (size_t)l * 1024 * NMOD + j0 + cc;
#pragma unroll 32
    for (int k = kg * 128; k < kg * 128 + 128; ++k) {
      const float wv = w[(size_t)k * NMOD];
#pragma unroll
      for (int r = 0; r < 5; ++r) acc[r] += sil[r * 1024 + k] * wv;
    }
#pragma unroll
    for (int r = 0; r < 5; ++r) red[(kg * 5 + r) * 64 + cc] = acc[r];
    __syncthreads();
    if (tid < 320) {
      const int r = tid >> 6;
      float s = 0.f;
#pragma unroll
      for (int g = 0; g < 8; ++g) s += red[(g * 5 + r) * 64 + cc];
      p.modv[((size_t)l * 5 + r) * NMOD + j0 + cc] = s + p.b_mod[l * NMOD + j0 + cc];
    }
    __syncthreads();
  }
}

__device__ __forceinline__ void transpose_tile(const float* src, int ldsrc, bf16_t* dst, int lddst, int k0, int r0, int nsrc, int glu, float* tile) {
  const int tid = opaque_tid();
  const int j = tid & 63;
  const int r = r0 + j;
  int scol;
  if (glu) {
    const int pn = r >> 8, bj = (r >> 7) & 1, i = r & 127;
    scol = bj * 256 + pn * 128 + i;
  } else {
    scol = r < nsrc ? r : -1;
  }
  float v[32];
#pragma unroll
  for (int it = 0; it < 32; ++it) {
    const int kk = (tid >> 6) + it * 8;
    v[it] = scol >= 0 ? src[(size_t)(k0 + kk) * ldsrc + scol] : 0.f;
  }
#pragma unroll
  for (int it = 0; it < 32; ++it) {
    const int kk = (tid >> 6) + it * 8;
    tile[(kk >> 6) * 4160 + (kk & 63) * 65 + j] = v[it];
  }
  __syncthreads();
  const int kq = tid & 63;
#pragma unroll
  for (int it = 0; it < 32; ++it) {
    const int jj = (tid >> 6) + (it & 7) * 8, sub = it >> 3;
    dst[(size_t)(r0 + jj) * lddst + k0 + sub * 64 + kq] = f2bf(tile[sub * 4160 + kq * 65 + jj]);
  }
  __syncthreads();
}

__device__ __forceinline__ void s5_tables(const Params& p, int id, int part, unsigned char* smem) {
  const int tid = opaque_tid();
  float2* Apow = (float2*)smem;
  float2* Bbs = Apow + 65 * 64;
  float2* Cs = Bbs + 64 * 16;
  __syncthreads();
  if (tid < 64) {
    const int pid = id * 64 + tid;
    double lre = (double)p.lam_re[pid];
    if (lre > -1e-4) lre = -1e-4;
    const double lim = (double)p.lam_im[pid];
    const double dt = exp((double)p.log_step[id]);
    const double mag = exp(lre * dt);
    const double are = mag * cos(lim * dt), aim = mag * sin(lim * dt);
    {
      double pr = 1.0, pi = 0.0;
      for (int n = 0; n <= 64; ++n) {
        Apow[n * 64 + tid] = make_float2((float)pr, (float)pi);
        const double nr = pr * are - pi * aim, ni = pr * aim + pi * are;
        pr = nr; pi = ni;
      }
    }
    const double den = lre * lre + lim * lim;
    const double fre = ((are - 1.0) * lre + aim * lim) / den;
    const double fim = (aim * lre - (are - 1.0) * lim) / den;
    for (int h = 0; h < 16; ++h) {
      const double br = (double)p.b_re[(size_t)pid * 16 + h], bi = (double)p.b_im[(size_t)pid * 16 + h];
      Bbs[tid * 16 + h] = make_float2((float)(fre * br - fim * bi), (float)(fre * bi + fim * br));
    }
  }
  for (int e = tid; e < 1024; e += NT) Cs[e] = make_float2(p.c_re[(size_t)id * 1024 + e], p.c_im[(size_t)id * 1024 + e]);
  __syncthreads();
  bf16_t* Kt = p.s5K + (size_t)id * 16384;
  for (int e = part * 2048 + tid; e < part * 2048 + 2048; e += NT) {
    const int d = e >> 8, hp = (e >> 4) & 15, h = e & 15;
    float acc = 0.f;
    for (int pp = 0; pp < 64; ++pp) {
      const float2 c = Cs[hp * 64 + pp], a = Apow[d * 64 + pp], b = Bbs[pp * 16 + h];
      const float cr = c.x * a.x - c.y * a.y, ci = c.x * a.y + c.y * a.x;
      acc += cr * b.x - ci * b.y;
    }
    Kt[e] = f2bf(acc);
  }
  bf16_t* M1 = p.s5M1 + (size_t)id * 131072;
  for (int e = part * 16384 + tid; e < part * 16384 + 16384; e += NT) {
    const int c = e >> 10, k = e & 1023, ri = c >> 6, pp = c & 63, tau = k >> 4, h = k & 15;
    const float2 a = Apow[(63 - tau) * 64 + pp], b = Bbs[pp * 16 + h];
    M1[e] = f2bf(ri ? (a.x * b.y + a.y * b.x) : (a.x * b.x - a.y * b.y));
  }
  bf16_t* N2 = p.s5N2 + (size_t)id * 131072;
  for (int e = part * 16384 + tid; e < part * 16384 + 16384; e += NT) {
    const int col = e >> 7, kk = e & 127, tau = col >> 4, hp = col & 15, ri = kk >> 6, pp = kk & 63;
    const float2 c = Cs[hp * 64 + pp], a = Apow[(tau + 1) * 64 + pp];
    N2[e] = f2bf(ri ? -(c.x * a.y + c.y * a.x) : (c.x * a.x - c.y * a.y));
  }
  __syncthreads();
}

__device__ __forceinline__ void convert_rows(const Params& p, int it, int tid) {
      const int lane = tid & 63;
      const int row0 = it * 16 + (tid >> 6) * 2;
      const int tab = row0 >> 15, r0 = row0 & 32767;
      const float* s = (tab ? p.exp_v : p.exp_u) + (size_t)r0 * 1024 + lane * 16;
      f32x4 v[2][4];
#pragma unroll
      for (int rr = 0; rr < 2; ++rr)
#pragma unroll
        for (int q = 0; q < 4; ++q) v[rr][q] = *(const f32x4*)(s + rr * 1024 + q * 4);
#pragma unroll
      for (int rr = 0; rr < 2; ++rr) {
        float m = 0.f;
#pragma unroll
        for (int q = 0; q < 4; ++q) m = fmaxf(m, fmaxf(fmaxf(fabsf(v[rr][q][0]), fabsf(v[rr][q][1])), fmaxf(fabsf(v[rr][q][2]), fabsf(v[rr][q][3]))));
#pragma unroll
        for (int o = 32; o > 0; o >>= 1) m = fmaxf(m, __shfl_xor(m, o));
        const float scale = m > 0.f ? m * (1.f / 400.f) : 1.f;
        const float inv = 1.f / scale;
        unsigned wv[4];
#pragma unroll
        for (int q = 0; q < 4; ++q) {
          unsigned w = 0;
          w = __builtin_amdgcn_cvt_pk_fp8_f32(v[rr][q][0] * inv, v[rr][q][1] * inv, w, false);
          w = __builtin_amdgcn_cvt_pk_fp8_f32(v[rr][q][2] * inv, v[rr][q][3] * inv, w, true);
          wv[q] = w;
        }
        *(uint4*)((tab ? p.ev8 : p.eu8) + (size_t)(r0 + rr) * 1024 + lane * 16) = make_uint4(wv[0], wv[1], wv[2], wv[3]);
        if (lane == 0) (tab ? p.sv : p.su)[r0 + rr] = scale;
      }
}

__device__ __forceinline__ void phase_wprep(const Params& p, int bid, int nblk, unsigned char* smem) {
  float* tile = (float*)smem;
  const int tid = opaque_tid();
  const int NT_L = 360;
  const int n_tr = 2 * NT_L;
  const int n_keys = 256 + 64;
  const int n_disc = 8;
  const int n_exp = 2048;
  const int n_s5t = 512;
  const int total = n_tr + n_keys + n_disc + n_exp + n_s5t;
  for (int item0 = bid; item0 < total; item0 += nblk) {
    const int item = item0 - n_s5t;
    if (item0 < n_s5t) {
      s5_tables(p, item0 >> 3, item0 & 7, smem);
    } else if (item < n_tr) {
      const int l = item / NT_L;
      int t = item % NT_L;
      if (t < 160) {
        transpose_tile(p.w_in + (size_t)l * 1024 * INW, INW, p.wt_in + (size_t)l * INWP * 1024, 1024, (t % 4) * 256, (t / 4) * 64, INW, 0, tile);
      } else if (t < 224) {
        t -= 160;
        transpose_tile(p.w_out + (size_t)l * 1024 * 1024, 1024, p.wt_out + (size_t)l * 1024 * 1024, 1024, (t % 4) * 256, (t / 4) * 64, 1024, 0, tile);
      } else if (t < 352) {
        t -= 224;
        transpose_tile(p.w_query + (size_t)l * 1024 * 2048, 2048, p.wt_q + (size_t)l * 2048 * 1024, 1024, (t % 4) * 256, (t / 4) * 64, 2048, 0, tile);
      } else {
        t -= 352;
        transpose_tile(p.w_glu + (size_t)l * 256 * 512, 512, p.wt_glu + (size_t)l * 512 * 256, 256, 0, t * 64, 512, 1, tile);
      }
    } else if (item < n_tr + n_keys) {
      const int ki = item - n_tr;
      if (ki < 256) {
        const int base = ki * 2048;
        for (int i = tid; i < 2048; i += NT) p.keysb[base + i] = f2bf(p.sub_keys[base + i]);
      } else {
        const int base = (ki - 256) * 2048;
        for (int i = tid; i < 2048; i += NT) p.sgu_wb[base + i] = f2bf(p.sgu_w[base + i]);
      }
    } else if (item >= n_tr + n_keys + n_disc) {
      const int j = item - (n_tr + n_keys + n_disc);
      convert_rows(p, (j >> 10) * 2048 + (j & 1023), tid);
    } else {
      const int id = (item - n_tr - n_keys) * NT + tid;
      const int g = (id >> 6) & 15;
      const int ldg = id >> 6;
      double lre = (double)p.lam_re[id];
      if (lre > -1e-4) lre = -1e-4;
      const double lim = (double)p.lam_im[id];
      const double dt = exp((double)p.log_step[ldg]);
      const double mag = exp(lre * dt);
      const double are = mag * cos(lim * dt), aim = mag * sin(lim * dt);
      const double den = lre * lre + lim * lim;
      const double fre = ((are - 1.0) * lre + aim * lim) / den;
      const double fim = (aim * lre - (are - 1.0) * lim) / den;
      p.s5a[id * 2 + 0] = (float)are;
      p.s5a[id * 2 + 1] = (float)aim;
      double pr = are, pi = aim;
      for (int s = 0; s < 6; ++s) { const double nr = pr * pr - pi * pi, ni = 2.0 * pr * pi; pr = nr; pi = ni; }
      p.s5a64[id * 2 + 0] = (float)pr;
      p.s5a64[id * 2 + 1] = (float)pi;
      for (int h = 0; h < 16; ++h) {
        const double br = (double)p.b_re[(size_t)id * 16 + h], bi = (double)p.b_im[(size_t)id * 16 + h];
        p.s5bb[(size_t)id * 32 + h] = (float)(fre * br - fim * bi);
        p.s5bb[(size_t)id * 32 + 16 + h] = (float)(fre * bi + fim * br);
      }
      (void)g;
    }
  }
}

__device__ __forceinline__ void phase_normmod(const Params& p, const float* src_l, const float* src_c, const float* gain, const float* modl, int shift_off, int scale_off,
                              int ntok, int copy, int bid, int nblk) {
  const int tid = opaque_tid(); const int lane = tid & 63, wid = tid >> 6;
  for (int t = bid * NW + wid; t < ntok; t += nblk * NW) {
    const float* row = t < TL ? src_l + (size_t)t * 1024 : src_c + (size_t)(t - TL) * 1024;
    const float* md = modl + (size_t)tok_batch(t) * NMOD;
    f32x4 v[4];
    float ss = 0.f;
#pragma unroll
    for (int j = 0; j < 4; ++j) {
      v[j] = *(const f32x4*)(row + j * 256 + lane * 4);
      ss += v[j][0] * v[j][0] + v[j][1] * v[j][1] + v[j][2] * v[j][2] + v[j][3] * v[j][3];
    }
    ss = wave_sum(ss);
    const float rstd = rsqrtf(ss * (1.f / 1024.f) + EPSV);
#pragma unroll
    for (int j = 0; j < 4; ++j) {
      const int c0 = j * 256 + lane * 4;
      const f32x4 g = *(const f32x4*)(gain + c0);
      const f32x4 sh = *(const f32x4*)(md + shift_off + c0);
      const f32x4 sc = *(const f32x4*)(md + scale_off + c0);
      ushort4 o;
      o.x = f2bf(v[j][0] * rstd * g[0] * (1.f + sc[0]) + sh[0]);
      o.y = f2bf(v[j][1] * rstd * g[1] * (1.f + sc[1]) + sh[1]);
      o.z = f2bf(v[j][2] * rstd * g[2] * (1.f + sc[2]) + sh[2]);
      o.w = f2bf(v[j][3] * rstd * g[3] * (1.f + sc[3]) + sh[3]);
      *(ushort4*)(p.abuf + (size_t)t * 1024 + c0) = o;
      if (copy) *(f32x4*)(p.xres + (size_t)t * 1024 + c0) = v[j];
    }
  }
}

namespace pg8 {
#define PG8_LAS __attribute__((address_space(3)))
typedef unsigned u32x4 __attribute__((ext_vector_type(4)));
constexpr int BM = 256, BK = 64, HALF = 128, HTB = HALF * BK * 2, STAGE_BYTES = 8 * HTB, NXCD = 8, WGM = 8;
__device__ __forceinline__ int lds_byte(int r, int c) { const int st = (r >> 4) * 2 + (c >> 5), rr = r & 15, cc = c & 31, ob = rr * 64 + cc * 2; return st * 1024 + (ob ^ (((ob >> 9) & 1) << 5)); }
__device__ __forceinline__ void stage_rc(int b, int& R, int& C) { const int st = b / 1024, sb = b % 1024, swz = sb ^ (((sb >> 9) & 1) << 5); R = (st >> 1) * 16 + swz / 64; C = (st & 1) * 32 + (swz % 64) / 2; }
__device__ __forceinline__ int perm32(int rho) { const int n = rho >> 4, i = rho & 15; return 8 * (i >> 2) + 4 * n + (i & 3); }
struct Unit { int pm, pn; };
struct Gemm { const bf16_t* A; const bf16_t* Bt; int M, N, K; };
struct StaticOrder {
  int nM, nN, nwg, G, c;
  __device__ void init(int M, int N, int G_, int c_) { nM = M / BM; nN = N / BM; nwg = nM * nN; G = G_; c = c_; }
  __device__ bool next(int i, Unit& u) const {
    const long L = (long)i * G + c; if (L >= nwg) return false;
    int wgid = (int)L; { const int q = nwg / NXCD, r = nwg % NXCD, xcd = wgid % NXCD, off = wgid / NXCD; wgid = (xcd < r ? xcd * (q + 1) : r * (q + 1) + (xcd - r) * q) + off; }
    const int nig = WGM * nN, gid = wgid / nig, fm = gid * WGM, gsz = (nM - fm) < WGM ? (nM - fm) : WGM;
    u.pm = fm + ((wgid % nig) % gsz); u.pn = (wgid % nig) / gsz; return true;
  }
};
__device__ __forceinline__ unsigned cvt_pk_bf16(float lo, float hi) { unsigned r; asm volatile("v_cvt_pk_bf16_f32 %0, %1, %2" : "=v"(r) : "v"(lo), "v"(hi)); return r; }

template <class Epi>
__device__ __forceinline__ void gemm_phase(PG8_LAS unsigned char* lds, const Gemm g, const StaticOrder& S, const Epi& E) {
  const int tid = opaque_tid(), wid = __builtin_amdgcn_readfirstlane(tid >> 6), lane = tid & 63, wr = wid >> 2, wc = wid & 3, fr = lane & 15, fq = lane >> 4;
  const int K = g.K, nt = K / BK;
  unsigned voffA[2], voffB[2];
#pragma unroll
  for (int i = 0; i < 2; ++i) { int R, C; stage_rc(tid * 16 + i * 8192, R, C); const int Rb = Epi::PERM ? ((R & ~31) + perm32(R & 31)) : R;
    voffA[i] = (unsigned)(R * K + C) * 2u; voffB[i] = (unsigned)(Rb * K + C) * 2u; }
  const size_t kstep = (size_t)(BK * 2);
  const size_t hstep = (size_t)HALF * K * 2;
  const size_t tstep = 2 * hstep;
  const unsigned ldsw = (unsigned)wid * 1024u;
  const int aoff = lds_byte(wr * 64 + fr, fq * 8), boff = lds_byte(wc * 32 + fr, fq * 8);
#define PG8_SA(b, h) (((b) * 2 + (h)) * HTB)
#define PG8_SB(b, h) ((4 + (b) * 2 + (h)) * HTB)
#define PG8_STAGE(bufoff, gbase, voff) do { _Pragma("unroll") for (int _i = 0; _i < 2; ++_i) \
    __builtin_amdgcn_global_load_lds((const unsigned*)((const char*)(gbase) + (voff)[_i]), (PG8_LAS unsigned*)(lds + (bufoff) + ldsw + _i * 8192), 16, 0, 0); } while (0)
#define PG8_LDA(dst, b, h) do { _Pragma("unroll") for (int m = 0; m < 4; ++m) _Pragma("unroll") for (int k = 0; k < 2; ++k) dst[m][k] = *(const PG8_LAS bf16x8*)(lds + PG8_SA(b, h) + aoff + m * 2048 + k * 1024); } while (0)
#define PG8_LDB(dst, b, h) do { _Pragma("unroll") for (int n = 0; n < 2; ++n) _Pragma("unroll") for (int k = 0; k < 2; ++k) dst[n][k] = *(const PG8_LAS bf16x8*)(lds + PG8_SB(b, h) + boff + n * 2048 + k * 1024); } while (0)
#define PG8_MMA(ai, bj, At, Bt) do { __builtin_amdgcn_s_setprio(1); _Pragma("unroll") for (int m = 0; m < 4; ++m) _Pragma("unroll") for (int n = 0; n < 2; ++n) _Pragma("unroll") for (int k = 0; k < 2; ++k) \
    acc[ai][bj][m][n] = __builtin_amdgcn_mfma_f32_16x16x32_bf16(Bt[n][k], At[m][k], acc[ai][bj][m][n], 0, 0, 0); __builtin_amdgcn_s_setprio(0); } while (0)
#define PG8_WAIT_V(n) asm volatile("s_waitcnt vmcnt(" #n ")" ::: "memory")
#define PG8_WAIT_L(n) asm volatile("s_waitcnt lgkmcnt(" #n ")" ::: "memory")
#define PG8_BAR __builtin_amdgcn_s_barrier()
#define PG8_SCHED __builtin_amdgcn_sched_barrier(0)
  Unit cur, nxt; int ui = 0;
  if (!S.next(0, cur)) return;
  f32x4 acc[2][2][4][2];
#pragma unroll
  for (int a = 0; a < 2; ++a)
#pragma unroll
    for (int b = 0; b < 2; ++b)
#pragma unroll
      for (int m = 0; m < 4; ++m)
#pragma unroll
        for (int n = 0; n < 2; ++n) acc[a][b][m][n] = (f32x4){0.f, 0.f, 0.f, 0.f};
  bf16x8 At[4][2], B0[2][2], B1[2][2];
  const char* cA = (const char*)g.A + (size_t)cur.pm * tstep; const char* cB = (const char*)g.Bt + (size_t)cur.pn * tstep;
  PG8_STAGE(PG8_SB(0, 0), cB, voffB); PG8_STAGE(PG8_SA(0, 0), cA, voffA); PG8_STAGE(PG8_SB(0, 1), cB + hstep, voffB); PG8_STAGE(PG8_SA(0, 1), cA + hstep, voffA);
  if (wr == 1) PG8_BAR;
  PG8_WAIT_V(4); PG8_BAR;
  PG8_STAGE(PG8_SB(1, 0), cB + kstep, voffB); PG8_STAGE(PG8_SA(1, 0), cA + kstep, voffA); PG8_STAGE(PG8_SB(1, 1), cB + hstep + kstep, voffB);
  PG8_WAIT_V(6); PG8_BAR;
  for (;;) {
    const bool has_next = S.next(ui + 1, nxt);
    const char* nA = has_next ? (const char*)g.A + (size_t)nxt.pm * tstep : cA; const char* nB = has_next ? (const char*)g.Bt + (size_t)nxt.pn * tstep : cB;
#pragma unroll 1
    for (int t = 0; t < nt; t += 2) {
      const bool last = (t == nt - 2);
      const char* a1 = cA + (size_t)(t + 1) * kstep;
      const char* a2 = last ? nA : cA + (size_t)(t + 2) * kstep; const char* b2 = last ? nB : cB + (size_t)(t + 2) * kstep;
      const char* a3 = a2 + kstep; const char* b3 = b2 + kstep;
      PG8_LDB(B0, 0, 0); PG8_SCHED; PG8_LDA(At, 0, 0); PG8_STAGE(PG8_SA(1, 1), a1 + hstep, voffA);
      PG8_WAIT_L(8); PG8_BAR; PG8_WAIT_L(0); PG8_MMA(0, 0, At, B0); PG8_BAR; PG8_SCHED;
      PG8_LDB(B1, 0, 1); PG8_STAGE(PG8_SB(0, 0), b2, voffB);
      PG8_BAR; PG8_WAIT_L(0); PG8_MMA(0, 1, At, B1); PG8_BAR;
      PG8_LDA(At, 0, 1); PG8_STAGE(PG8_SA(0, 0), a2, voffA);
      PG8_BAR; PG8_WAIT_L(0); PG8_MMA(1, 0, At, B0); PG8_BAR; PG8_SCHED;
      PG8_STAGE(PG8_SB(0, 1), b2 + hstep, voffB);
      PG8_WAIT_V(6); PG8_BAR; PG8_MMA(1, 1, At, B1); PG8_BAR;
      PG8_LDB(B0, 1, 0); PG8_SCHED; PG8_LDA(At, 1, 0); PG8_STAGE(PG8_SA(0, 1), a2 + hstep, voffA);
      PG8_WAIT_L(8); PG8_BAR; PG8_WAIT_L(0); PG8_MMA(0, 0, At, B0); PG8_BAR; PG8_SCHED;
      PG8_LDB(B1, 1, 1); PG8_STAGE(PG8_SB(1, 0), b3, voffB);
      PG8_BAR; PG8_WAIT_L(0); PG8_MMA(0, 1, At, B1); PG8_BAR;
      PG8_LDA(At, 1, 1); PG8_STAGE(PG8_SA(1, 0), a3, voffA);
      PG8_BAR; PG8_WAIT_L(0); PG8_MMA(1, 0, At, B0); PG8_BAR; PG8_SCHED;
      PG8_STAGE(PG8_SB(1, 1), b3 + hstep, voffB);
      PG8_WAIT_V(6); PG8_BAR; PG8_MMA(1, 1, At, B1); PG8_BAR;
    }
    E(acc, cur, wr, wc, fr, fq);
    if (!has_next) break;
#pragma unroll
    for (int a = 0; a < 2; ++a)
#pragma unroll
      for (int b = 0; b < 2; ++b)
#pragma unroll
        for (int m = 0; m < 4; ++m)
#pragma unroll
          for (int n = 0; n < 2; ++n) acc[a][b][m][n] = (f32x4){0.f, 0.f, 0.f, 0.f};
    cur = nxt; cA = nA; cB = nB; ++ui;
  }
  PG8_WAIT_V(0);
  if (wr == 0) PG8_BAR;
  PG8_BAR;
#undef PG8_SA
#undef PG8_SB
#undef PG8_STAGE
#undef PG8_LDA
#undef PG8_LDB
#undef PG8_MMA
#undef PG8_WAIT_V
#undef PG8_WAIT_L
#undef PG8_BAR
#undef PG8_SCHED
}

struct EpiBf16 {
  static constexpr bool PERM = true;
  bf16_t* O; int ldc; int ncols;
  __device__ __forceinline__ void operator()(const f32x4 (&acc)[2][2][4][2], const Unit& u, int wr, int wc, int fr, int fq) const {
    const int row0 = u.pm * BM + wr * 64 + fr, col0 = u.pn * BM + wc * 32 + 8 * fq;
#pragma unroll
    for (int ai = 0; ai < 2; ++ai)
#pragma unroll
      for (int m = 0; m < 4; ++m) {
        bf16_t* rowp = O + (size_t)(row0 + ai * HALF + m * 16) * ldc + col0;
#pragma unroll
        for (int bj = 0; bj < 2; ++bj) {
          if (col0 + bj * HALF < ncols) {
            const f32x4 v0 = acc[ai][bj][m][0], v1 = acc[ai][bj][m][1];
            u32x4 w; w.x = cvt_pk_bf16(v0[0], v0[1]); w.y = cvt_pk_bf16(v0[2], v0[3]); w.z = cvt_pk_bf16(v1[0], v1[1]); w.w = cvt_pk_bf16(v1[2], v1[3]);
            *(u32x4*)(rowp + bj * HALF) = w;
          }
        }
      }
  }
};
struct EpiIn {
  static constexpr bool PERM = true;
  bf16_t* O; bf16_t* s5u;
  __device__ __forceinline__ void operator()(const f32x4 (&acc)[2][2][4][2], const Unit& u, int wr, int wc, int fr, int fq) const {
    const int row0 = u.pm * BM + wr * 64 + fr, col0 = u.pn * BM + wc * 32 + 8 * fq;
    const bool s5 = u.pn == 2;
#pragma unroll
    for (int ai = 0; ai < 2; ++ai)
#pragma unroll
      for (int m = 0; m < 4; ++m) {
        const int row = row0 + ai * HALF + m * 16;
#pragma unroll
        for (int bj = 0; bj < 2; ++bj) {
          const int c = col0 + bj * HALF;
          if (c < INW) {
            const f32x4 v0 = acc[ai][bj][m][0], v1 = acc[ai][bj][m][1];
            u32x4 w; w.x = cvt_pk_bf16(v0[0], v0[1]); w.y = cvt_pk_bf16(v0[2], v0[3]); w.z = cvt_pk_bf16(v1[0], v1[1]); w.w = cvt_pk_bf16(v1[2], v1[3]);
            bf16_t* dst = s5 ? s5u + ((size_t)((c - 512) >> 4) * TT + row) * 16 + (c & 8) : O + (size_t)row * INW + c;
            *(u32x4*)dst = w;
          }
        }
      }
  }
};
struct EpiResid {
  static constexpr bool PERM = false;
  float* xres; const float* modl; int gate_off;
  __device__ __forceinline__ void operator()(const f32x4 (&acc)[2][2][4][2], const Unit& u, int wr, int wc, int fr, int fq) const {
    const int row0 = u.pm * BM + wr * 64 + fr, col0 = u.pn * BM + wc * 32 + 4 * fq;
#pragma unroll
    for (int ai = 0; ai < 2; ++ai)
#pragma unroll
      for (int m = 0; m < 4; ++m) {
        const int row = row0 + ai * HALF + m * 16;
        float* rowp = xres + (size_t)row * 1024 + col0;
        const float* md = modl + (size_t)tok_batch(row) * NMOD + gate_off + col0;
#pragma unroll
        for (int bj = 0; bj < 2; ++bj)
#pragma unroll
          for (int n = 0; n < 2; ++n) {
            const f32x4 g = *(const f32x4*)(md + bj * HALF + n * 16);
            f32x4 x = *(const f32x4*)(rowp + bj * HALF + n * 16);
            x += g * acc[ai][bj][m][n];
            *(f32x4*)(rowp + bj * HALF + n * 16) = x;
          }
      }
  }
};
struct EpiGlu {
  static constexpr bool PERM = true;
  bf16_t* mix;
  __device__ __forceinline__ void operator()(const f32x4 (&acc)[2][2][4][2], const Unit& u, int wr, int wc, int fr, int fq) const {
    const int row0 = u.pm * BM + wr * 64 + fr, col0 = 256 + u.pn * HALF + wc * 32 + 8 * fq;
#pragma unroll
    for (int ai = 0; ai < 2; ++ai)
#pragma unroll
      for (int m = 0; m < 4; ++m) {
        float v[8];
#pragma unroll
        for (int n = 0; n < 2; ++n)
#pragma unroll
          for (int j = 0; j < 4; ++j) v[n * 4 + j] = acc[ai][0][m][n][j] * sigmoid_f(acc[ai][1][m][n][j]);
        u32x4 w; w.x = cvt_pk_bf16(v[0], v[1]); w.y = cvt_pk_bf16(v[2], v[3]); w.z = cvt_pk_bf16(v[4], v[5]); w.w = cvt_pk_bf16(v[6], v[7]);
        *(u32x4*)(mix + (size_t)(row0 + ai * HALF + m * 16) * 1024 + col0) = w;
        __builtin_amdgcn_sched_barrier(0);
      }
  }
};
}

#define VNT_STRIDE 136
__device__ __forceinline__ void phase_sgu(const Params& p, int layer, int nchunks, int bid, int nblk, unsigned char* smem) {
  bf16_t* vnT = (bf16_t*)smem;
  const int tid = opaque_tid(); const int lane = tid & 63, wid = tid >> 6;
  const int fr = lane & 15, fq = lane >> 4;
  for (int item = bid; item < nchunks * 4; item += nblk) {
    const int ch = item >> 2, h = item & 3;
    const int tok0 = ch * 128;
    {
      const int s = tid >> 2, q = tid & 3;
      const bf16_t* vrow = p.cols + (size_t)(tok0 + s) * INW + C_SGU_V + h * 64 + q * 16;
      const uint4 r0 = *(const uint4*)vrow, r1 = *(const uint4*)(vrow + 8);
      float gv[16];
      gv[0] = bflo(r0.x); gv[1] = bfhi(r0.x); gv[2] = bflo(r0.y); gv[3] = bfhi(r0.y); gv[4] = bflo(r0.z); gv[5] = bfhi(r0.z); gv[6] = bflo(r0.w); gv[7] = bfhi(r0.w);
      gv[8] = bflo(r1.x); gv[9] = bfhi(r1.x); gv[10] = bflo(r1.y); gv[11] = bfhi(r1.y); gv[12] = bflo(r1.z); gv[13] = bfhi(r1.z); gv[14] = bflo(r1.w); gv[15] = bfhi(r1.w);
      float ss = 0.f;
#pragma unroll
      for (int d = 0; d < 16; ++d) { gv[d] = gelu_f(gv[d]); ss += gv[d] * gv[d]; }
      ss += xor_lane_f<1>(ss);
      ss += xor_lane_f<2>(ss);
      const float rstd = rsqrtf(ss * (1.f / 64.f) + EPSV);
#pragma unroll
      for (int d = 0; d < 16; ++d) vnT[(q * 16 + d) * VNT_STRIDE + s] = f2bf(gv[d] * rstd);
    }
    __syncthreads();
    {
      const bf16_t* wrow = p.sgu_wb + (((size_t)layer * 4 + h) * 128 + wid * 16 + fr) * 128 + fq * 8;
      f32x4 acc[4];
#pragma unroll
      for (int n = 0; n < 4; ++n) acc[n] = (f32x4){0.f, 0.f, 0.f, 0.f};
#pragma unroll
      for (int ks = 0; ks < 4; ++ks) {
        const bf16x8 a = *(const bf16x8*)(wrow + ks * 32);
#pragma unroll
        for (int n = 0; n < 4; ++n) {
          const bf16x8 b = *(const bf16x8*)(vnT + (n * 16 + fr) * VNT_STRIDE + ks * 32 + fq * 8);
          acc[n] = __builtin_amdgcn_mfma_f32_16x16x32_bf16(a, b, acc[n], 0, 0, 0);
        }
      }
#pragma unroll
      for (int j = 0; j < 4; ++j) {
        const int t = wid * 16 + fq * 4 + j;
        const float bs = p.sgu_b[((size_t)layer * 4 + h) * 128 + t];
        const bf16_t* urow = p.cols + (size_t)(tok0 + t) * INW + C_SGU_U + h * 64;
        bf16_t* orow = p.mix + (size_t)(tok0 + t) * 1024 + h * 64;
#pragma unroll
        for (int n = 0; n < 4; ++n) orow[n * 16 + fr] = f2bf(gelu_f(bf2f(urow[n * 16 + fr])) * (acc[n][j] + bs));
      }
    }
    __syncthreads();
  }
}

#define S5A_RS 68
__device__ __forceinline__ void phase_s5a(const Params& p, int layer, int bid, int nblk, unsigned char* smem) {
  const int tid = opaque_tid(); const int lane = tid & 63, wid = tid >> 6, fr = lane & 15, fq = lane >> 4;
  float* red = (float*)smem;
  for (int task = bid; task < 256; task += nblk) {
    const int mq = task & 3, nh = (task >> 2) & 1, g = (task >> 3) & 15, dir = task >> 7;
    const bf16_t* tab = p.s5M1 + (size_t)((layer * 2 + dir) * 16 + g) * 131072 + (size_t)(nh * 64 + fr) * 1024 + wid * 128 + fq * 8;
    bf16x8 b[4][4];
#pragma unroll
    for (int ksl = 0; ksl < 4; ++ksl)
#pragma unroll
      for (int n = 0; n < 4; ++n) b[ksl][n] = *(const bf16x8*)(tab + (size_t)n * 16 * 1024 + ksl * 32);
    f32x4 acc[5][4];
#pragma unroll
    for (int mi = 0; mi < 5; ++mi)
#pragma unroll
      for (int n = 0; n < 4; ++n) acc[mi][n] = (f32x4){0.f, 0.f, 0.f, 0.f};
    const bf16_t* ug = p.s5u + (size_t)g * TT * 16 + (fq & 1) * 8;
#pragma unroll
    for (int mi = 0; mi < 5; ++mi) {
      const int mt = mq + 4 * mi;
      if (mt < 17) {
        const int scr = mt * 16 + fr;
#pragma unroll
        for (int ksl = 0; ksl < 4; ++ksl) {
          const int tau = 8 * wid + 2 * ksl + (fq >> 1);
          const int i = dir ? 63 - tau : tau;
          const bf16x8 a = *(const bf16x8*)(ug + (size_t)s5_tok(scr, i) * 16);
#pragma unroll
          for (int n = 0; n < 4; ++n) acc[mi][n] = __builtin_amdgcn_mfma_f32_16x16x32_bf16(a, b[ksl][n], acc[mi][n], 0, 0, 0);
        }
      }
    }
#pragma unroll
    for (int r = 0; r < 2; ++r) {
      __syncthreads();
#pragma unroll
      for (int ml = 0; ml < 3; ++ml) {
        const int mi = 3 * r + ml;
        if (mi < 5) {
#pragma unroll
          for (int n = 0; n < 4; ++n)
#pragma unroll
            for (int j = 0; j < 4; ++j) red[((wid * 3 + ml) * 16 + fq * 4 + j) * S5A_RS + n * 16 + fr] = acc[mi < 5 ? mi : 0][n][j];
        }
      }
      __syncthreads();
#pragma unroll
      for (int ml = 0; ml < 3; ++ml) {
        const int mi = 3 * r + ml;
        const int mt = mq + 4 * mi;
        if (mi < 5 && mt < 17) {
#pragma unroll
          for (int k = 0; k < 2; ++k) {
            const int e = tid + NT * k, row = e >> 6, col = e & 63;
            float s = 0.f;
#pragma unroll
            for (int w = 0; w < 8; ++w) s += red[((w * 3 + ml) * 16 + row) * S5A_RS + col];
            p.s5S[(((size_t)dir * NSC + mt * 16 + row) * 16 + g) * 128 + nh * 64 + col] = s;
          }
        }
      }
    }
  }
  __syncthreads();
}

__device__ __forceinline__ int scan_sc(int s, int b, int dir) {
  return s < 4 ? 256 + b * 4 + (dir ? 3 - s : s) : b * 64 + (dir ? 63 - (s - 4) : (s - 4));
}
__device__ __forceinline__ void phase_scan(const Params& p, int layer, int bid, int nblk) {
  const int tid = opaque_tid();
  for (int item = bid; item < 16 + 256; item += nblk) {
    if (item < 16) {
      const int id = item * NT + tid;
      const int pp = id & 63, g = (id >> 6) & 15, b = (id >> 10) & 3, dir = id >> 12;
      const int pid = ((layer * 2 + dir) * 16 + g) * 64 + pp;
      const float ar = p.s5a64[pid * 2], ai = p.s5a64[pid * 2 + 1];
      float hr = 0.f, hi = 0.f;
      for (int s0 = 0; s0 < 68; s0 += 17) {
        float sr[17], si[17];
#pragma unroll
        for (int k = 0; k < 17; ++k) {
          const size_t o = (((size_t)dir * NSC + scan_sc(s0 + k, b, dir)) * 16 + g) * 128 + pp;
          sr[k] = p.s5S[o]; si[k] = p.s5S[o + 64];
        }
#pragma unroll
        for (int k = 0; k < 17; ++k) {
          const size_t o = (((size_t)dir * NSC + scan_sc(s0 + k, b, dir)) * 16 + g) * 128 + pp;
          p.s5H[o] = hr; p.s5H[o + 64] = hi;
          const float nr = ar * hr - ai * hi + sr[k];
          const float ni = ar * hi + ai * hr + si[k];
          hr = nr; hi = ni;
        }
      }
    } else {
      const int id = (item - 16) * NT + tid;
      const int e = id & 2047, h = (id >> 11) & 7, b = (id >> 14) & 3, dir = id >> 16;
      const int dk = e & 31;
      float S = 0.f;
      for (int s0 = 0; s0 < 68; s0 += 17) {
        float kv[17], dc[17];
#pragma unroll
        for (int k = 0; k < 17; ++k) {
          const size_t o = (((size_t)dir * NSC + scan_sc(s0 + k, b, dir)) * 8 + h);
          kv[k] = p.gkv[o * 2048 + e]; dc[k] = p.gdec[o * 32 + dk];
        }
#pragma unroll
        for (int k = 0; k < 17; ++k) {
          const size_t o = (((size_t)dir * NSC + scan_sc(s0 + k, b, dir)) * 8 + h);
          p.gkv[o * 2048 + e] = S;
          S = dc[k] * S + kv[k];
        }
      }
    }
  }
}

__device__ __forceinline__ bf16x8 s5_kfrag(const bf16_t* kb, int delta, int sh) {
  const int d = delta - sh;
  bf16x8 r = *(const bf16x8*)(kb + (size_t)(d < 0 ? 0 : d) * 256);
  if (d < 0) r = (bf16x8){0, 0, 0, 0, 0, 0, 0, 0};
  return r;
}
#define S5_UCH 1032
typedef const __attribute__((address_space(3))) bf16_t* lds_bf16_cp;
template <int DIR, bool DIAG>
__device__ __forceinline__ void s5_group8(f32x4 (&acc)[16], bf16x8 (&W)[16], const bf16_t* ul  , const bf16_t* kl  , int ks0, int E, int sh) {
  const bf16x8 zero8 = (bf16x8){0, 0, 0, 0, 0, 0, 0, 0};
#pragma unroll
  for (int j = 0; j < 8; ++j) {
    const int sigma = 2 * (ks0 + j) + sh;
    const bf16x8 a = *(const bf16x8*)(ul + (DIR ? 63 - sigma : sigma) * 16);
    bf16x8 n0 = zero8, n1 = zero8;
    if (!DIAG) {
      if (j + 1 < 8) { n0 = *(const bf16x8*)(kl + (E - 2 * (j + 1) - sh) * 256); n1 = *(const bf16x8*)(kl + (E - 2 * (j + 1) + 1 - sh) * 256); }
      else { n0 = s5_kfrag(kl, E - 16, sh); n1 = s5_kfrag(kl, E - 15, sh); }
    }
#pragma unroll
    for (int i = 0; i < 16; ++i) {
      if (!(DIAG && i < 2 * j)) {
        const int sl = DIR ? 15 - i : i;
        acc[sl] = __builtin_amdgcn_mfma_f32_16x16x32_bf16(a, W[(i - 2 * j) & 15], acc[sl], 0, 0, 0);
      }
    }
    if (!DIAG) { W[(16 - 2 * (j + 1)) & 15] = n0; W[(17 - 2 * (j + 1)) & 15] = n1; }
  }
}
template <int DIR>
__device__ __forceinline__ void s5_dir(f32x4 (&acc)[16], const Params& p, int layer, int g, int scr, int qd, int fr, int fq, const bf16_t* ul, const bf16_t* kl) {
  const int sh = fq >> 1;
  {
    bf16x8 W[16];
#pragma unroll
    for (int i = 0; i < 16; ++i) W[i] = s5_kfrag(kl, 16 * qd + i, sh);
    for (int c = 0; c < qd; ++c) s5_group8<DIR, false>(acc, W, ul, kl, 8 * c, 16 * (qd - c), sh);
    s5_group8<DIR, true>(acc, W, ul, kl, 8 * qd, 0, sh);
  }
  const size_t tb = (size_t)((layer * 2 + DIR) * 16 + g);
  const float* hin = p.s5H + (((size_t)DIR * NSC + scr) * 16 + g) * 128 + fq * 8;
  const bf16_t* n2 = p.s5N2 + tb * 131072 + (size_t)(16 * qd * 16 + fr) * 128 + fq * 8;
  bf16x8 ah[4];
#pragma unroll
  for (int ks = 0; ks < 4; ++ks) {
    const f32x4 h0 = *(const f32x4*)(hin + ks * 32), h1 = *(const f32x4*)(hin + ks * 32 + 4);
    const float h8[8] = {h0[0], h0[1], h0[2], h0[3], h1[0], h1[1], h1[2], h1[3]};
    ah[ks] = pack_bf16x8(h8);
  }
#pragma unroll
  for (int ks = 0; ks < 4; ++ks) {
    bf16x8 b[16];
#pragma unroll
    for (int i = 0; i < 16; ++i) b[i] = *(const bf16x8*)(n2 + (size_t)i * 16 * 128 + ks * 32);
#pragma unroll
    for (int i = 0; i < 16; ++i) {
      const int sl = DIR ? 15 - i : i;
      acc[sl] = __builtin_amdgcn_mfma_f32_16x16x32_bf16(ah[ks], b[i], acc[sl], 0, 0, 0);
    }
    __builtin_amdgcn_sched_barrier(0);
  }
}
__device__ __forceinline__ void phase_s5c(const Params& p, int layer, int nsc, int bid, int nblk, unsigned char* smem) {
  const int tid = opaque_tid(); const int lane = tid & 63, wid = tid >> 6;
  bf16_t* Kl = (bf16_t*)smem;
  bf16_t* Ul = Kl + 2 * 16384;
  const int nmt = nsc / 16, npair = (nmt + 1) / 2;
  const int ntask = 16 * npair;
  for (int task = bid; task < ntask; task += nblk) {
    const int g = task / npair, mt0 = (task % npair) * 2;
    __syncthreads();
    int tid_o = tid; asm volatile("" : "+v"(tid_o));
#pragma unroll
    for (int it = 0; it < 8; ++it) {
      const int e = it * NT + tid_o;
      const int dir = e >> 11, off = (e & 2047) * 8;
      *(uint4*)(Kl + dir * 16384 + off) = *(const uint4*)(p.s5K + (size_t)((layer * 2 + dir) * 16 + g) * 16384 + off);
    }
#pragma unroll
    for (int it = 0; it < 8; ++it) {
      const int e = it * NT + tid_o;
      const int hf = e & 1, tk = (e >> 1) & 63, chk = (e >> 7) & 15, tl = e >> 11;
      const int mt = mt0 + tl;
      uint4 v = make_uint4(0u, 0u, 0u, 0u);
      if (mt < nmt) v = *(const uint4*)(p.s5u + ((size_t)g * TT + s5_tok(mt * 16 + chk, tk)) * 16 + hf * 8);
      *(uint4*)(Ul + (tl * 16 + chk) * S5_UCH + tk * 16 + hf * 8) = v;
    }
    __syncthreads();
    int lane_o = lane; asm volatile("" : "+v"(lane_o));
    const int fr = lane_o & 15, fq = lane_o >> 4;
    const int tl = wid >> 2, q = wid & 3, mt = mt0 + tl;
    if (mt < nmt) {
      const int scr = mt * 16 + fr;
      const bf16_t* ul = Ul + (tl * 16 + fr) * S5_UCH + (fq & 1) * 8;
      f32x4 acc[16];
#pragma unroll
      for (int i = 0; i < 16; ++i) acc[i] = (f32x4){0.f, 0.f, 0.f, 0.f};
      s5_dir<0>(acc, p, layer, g, scr, q, fr, fq, ul, Kl + fr * 16 + (fq & 1) * 8);
      s5_dir<1>(acc, p, layer, g, scr, 3 - q, fr, fq, ul, Kl + 16384 + fr * 16 + (fq & 1) * 8);
      const int ch = g * 16 + fr;
      const float dsk = p.s5_d[layer * 256 + ch];
#pragma unroll
      for (int j = 0; j < 4; ++j) {
        const int chk = fq * 4 + j;
        const size_t tok0 = (size_t)s5_tok(mt * 16 + chk, 16 * q);
        const bf16_t* up = Ul + (tl * 16 + chk) * S5_UCH + (16 * q) * 16 + fr;
        bf16_t* yp = p.yg + tok0 * 256 + ch;
#pragma unroll
        for (int i = 0; i < 16; ++i) {
          const float v = acc[i][j] + dsk * bf2f(up[i * 16]);
          yp[(size_t)i * 256] = f2bf(gelu_f(v));
        }
        __builtin_amdgcn_sched_barrier(0);
      }
    }
  }
  __syncthreads();
}

#define GL_VT_STRIDE 72
#define GL_LB_STRIDE 36
#define GL_HALF_BYTES (64 * 72 * 2 + 64 * 36 * 4 + 64 * 72 * 2)
__device__ __forceinline__ void unpack8(const uint4& r, float* v) {
  v[0] = bflo(r.x); v[1] = bfhi(r.x); v[2] = bflo(r.y); v[3] = bfhi(r.y); v[4] = bflo(r.z); v[5] = bfhi(r.z); v[6] = bflo(r.w); v[7] = bfhi(r.w);
}
__device__ __forceinline__ void gla_store_vT(const uint4& r0, const uint4& r1, bf16_t* vT, int i, int part) {
  const unsigned w[8] = {r0.x, r0.y, r0.z, r0.w, r1.x, r1.y, r1.z, r1.w};
#pragma unroll
  for (int e = 0; e < 8; ++e) {
    vT[(part * 16 + 2 * e) * GL_VT_STRIDE + i] = (bf16_t)(w[e] & 0xffffu);
    vT[(part * 16 + 2 * e + 1) * GL_VT_STRIDE + i] = (bf16_t)(w[e] >> 16);
  }
}
__device__ __forceinline__ void gla_logdecay(int dir, const bf16_t* zs, const float* wgs, float* lb, int ltid) {
  const int lane = ltid & 63;
  const int wu = __builtin_amdgcn_readfirstlane(ltid >> 6);
  float z[16];
  unpack8(*(const uint4*)(zs + lane * 32 + dir * 16), z); unpack8(*(const uint4*)(zs + lane * 32 + dir * 16 + 8), z + 8);
  const float* wg = wgs + dir * 512 + wu * 8;
  float la[8];
  {
    const f32x4 b0 = *(const f32x4*)(wgs + 1024 + dir * 32 + wu * 8), b1 = *(const f32x4*)(wgs + 1024 + dir * 32 + wu * 8 + 4);
    la[0] = b0[0]; la[1] = b0[1]; la[2] = b0[2]; la[3] = b0[3]; la[4] = b1[0]; la[5] = b1[1]; la[6] = b1[2]; la[7] = b1[3];
  }
#pragma unroll
  for (int r = 0; r < 16; ++r) {
    const f32x4 w0 = *(const f32x4*)(wg + r * 32), w1 = *(const f32x4*)(wg + r * 32 + 4);
    la[0] += z[r] * w0[0]; la[1] += z[r] * w0[1]; la[2] += z[r] * w0[2]; la[3] += z[r] * w0[3];
    la[4] += z[r] * w1[0]; la[5] += z[r] * w1[1]; la[6] += z[r] * w1[2]; la[7] += z[r] * w1[3];
  }
#pragma unroll
  for (int c = 0; c < 8; ++c) la[c] = (fminf(la[c], 0.f) - __logf(1.f + __expf(-fabsf(la[c])))) * (1.f / 16.f);
#pragma unroll
  for (int c = 0; c < 8; ++c) {
    float v = la[c];
    if (dir == 0) {
      v += __builtin_bit_cast(float, __builtin_amdgcn_update_dpp(0, __builtin_bit_cast(int, v), 0x111, 0xf, 0xf, true));
      v += __builtin_bit_cast(float, __builtin_amdgcn_update_dpp(0, __builtin_bit_cast(int, v), 0x112, 0xf, 0xf, true));
      v += __builtin_bit_cast(float, __builtin_amdgcn_update_dpp(0, __builtin_bit_cast(int, v), 0x114, 0xf, 0xf, true));
      v += __builtin_bit_cast(float, __builtin_amdgcn_update_dpp(0, __builtin_bit_cast(int, v), 0x118, 0xf, 0xf, true));
      const float t0 = __builtin_bit_cast(float, __builtin_amdgcn_readlane(__builtin_bit_cast(int, v), 15));
      const float t1 = __builtin_bit_cast(float, __builtin_amdgcn_readlane(__builtin_bit_cast(int, v), 31));
      const float t2 = __builtin_bit_cast(float, __builtin_amdgcn_readlane(__builtin_bit_cast(int, v), 47));
      const int row = lane >> 4;
      v += row == 0 ? 0.f : (row == 1 ? t0 : (row == 2 ? t0 + t1 : (t0 + t1) + t2));
    } else {
      v += __builtin_bit_cast(float, __builtin_amdgcn_update_dpp(0, __builtin_bit_cast(int, v), 0x101, 0xf, 0xf, true));
      v += __builtin_bit_cast(float, __builtin_amdgcn_update_dpp(0, __builtin_bit_cast(int, v), 0x102, 0xf, 0xf, true));
      v += __builtin_bit_cast(float, __builtin_amdgcn_update_dpp(0, __builtin_bit_cast(int, v), 0x104, 0xf, 0xf, true));
      v += __builtin_bit_cast(float, __builtin_amdgcn_update_dpp(0, __builtin_bit_cast(int, v), 0x108, 0xf, 0xf, true));
      const float t1 = __builtin_bit_cast(float, __builtin_amdgcn_readlane(__builtin_bit_cast(int, v), 16));
      const float t2 = __builtin_bit_cast(float, __builtin_amdgcn_readlane(__builtin_bit_cast(int, v), 32));
      const float t3 = __builtin_bit_cast(float, __builtin_amdgcn_readlane(__builtin_bit_cast(int, v), 48));
      const int row = lane >> 4;
      v += row == 3 ? 0.f : (row == 2 ? t3 : (row == 1 ? t3 + t2 : (t3 + t2) + t1));
    }
    la[c] = v;
  }
  *(f32x4*)(lb + lane * GL_LB_STRIDE + wu * 8) = (f32x4){la[0], la[1], la[2], la[3]};
  *(f32x4*)(lb + lane * GL_LB_STRIDE + wu * 8 + 4) = (f32x4){la[4], la[5], la[6], la[7]};
}

#define GLA_HALF_BYTES (64 * 72 * 2 + 64 * 36 * 4 + 32 * 72 * 2 + 64 * 32 * 2 + (1024 + 64) * 4)
struct GlaAPre { uint4 v0, v1, z, k; };
__device__ __forceinline__ GlaAPre glaa_prefetch(const Params& p, int item, int ltid) {
  const int sc = item >> 3, h = item & 7;
  const int i = ltid >> 2, pc = ltid & 3;
  const bf16_t* row = p.cols + (size_t)gla_tok(sc, i) * INW;
  GlaAPre r;
  r.v0 = *(const uint4*)(row + C_GV + h * 64 + pc * 16); r.v1 = *(const uint4*)(row + C_GV + h * 64 + pc * 16 + 8);
  r.z = *(const uint4*)(row + C_ZF + pc * 8);
  r.k = *(const uint4*)(row + C_GK + h * 32 + pc * 8);
  return r;
}
__device__ __forceinline__ void phase_glaa(const Params& p, int layer, int bid, int nblk, unsigned char* smem) {
  const int tid = opaque_tid(); const int half = __builtin_amdgcn_readfirstlane(tid >> 8), ltid = tid & 255;
  const int lane = tid & 63, w = ltid >> 6, fr = lane & 15, fq = lane >> 4;
  bf16_t* vT = (bf16_t*)(smem + half * GLA_HALF_BYTES);
  float* lb = (float*)(vT + 64 * GL_VT_STRIDE);
  bf16_t* kT = (bf16_t*)(lb + 64 * GL_LB_STRIDE);
  bf16_t* zs = kT + 32 * GL_VT_STRIDE;
  float* wgs = (float*)(zs + 64 * 32);
  const int nit = NSC * 8 / 2;
  if (bid >= nit) return;
  GlaAPre cur = glaa_prefetch(p, bid * 2 + half, ltid);
  for (int it = bid; it < nit; it += nblk) {
    const int item = it * 2 + half;
    const int sc = item >> 3, h = item & 7;
    const int itn = it + nblk < nit ? it + nblk : it;
    const GlaAPre nxt = glaa_prefetch(p, itn * 2 + half, ltid);
    const int ti = ltid >> 2, pc = ltid & 3;
    gla_store_vT(cur.v0, cur.v1, vT, ti, pc);
    *(uint4*)(zs + ti * 32 + pc * 8) = cur.z;
    {
      const int dir = ltid >> 7, r = (ltid >> 3) & 15, c4 = (ltid & 7) * 4;
      *(f32x4*)(wgs + dir * 512 + r * 32 + c4) = *(const f32x4*)(p.gla_wg + ((size_t)(layer * 2 + dir) * 16 + r) * 256 + h * 32 + c4);
      if (ltid < 16) *(f32x4*)(wgs + 1024 + ltid * 4) = *(const f32x4*)(p.gla_bg + (layer * 2 + (ltid >> 3)) * 256 + h * 32 + (ltid & 7) * 4);
    }
    __syncthreads();
#pragma unroll
    for (int dir = 0; dir < 2; ++dir) {
      gla_logdecay(dir, zs, wgs, lb, ltid);
      __syncthreads();
      const int ilast = dir ? 0 : 63;
      {
        float kv8[8];
        unpack8(cur.k, kv8);
#pragma unroll
        for (int c = 0; c < 8; ++c) {
          const int dk = pc * 8 + c;
          kT[dk * GL_VT_STRIDE + ti] = f2bf(kv8[c] * __expf(lb[ilast * GL_LB_STRIDE + dk] - lb[ti * GL_LB_STRIDE + dk]));
        }
      }
      const size_t o = (((size_t)dir * NSC + sc) * 8 + h);
      if (ltid < 32) p.gdec[o * 32 + ltid] = __expf(lb[ilast * GL_LB_STRIDE + ltid]);
      {
        float* gt = p.glb + o * 2048;
#pragma unroll
        for (int r = 0; r < 2; ++r) {
          const int q = ltid + 256 * r;
          *(f32x4*)(gt + q * 4) = *(const f32x4*)(lb + (q >> 3) * GL_LB_STRIDE + (q & 7) * 4);
        }
      }
      __syncthreads();
      {
        f32x4 acc[2];
        acc[0] = (f32x4){0.f, 0.f, 0.f, 0.f}; acc[1] = acc[0];
#pragma unroll
        for (int ks = 0; ks < 2; ++ks) {
          const bf16x8 b = *(const bf16x8*)(vT + (w * 16 + fr) * GL_VT_STRIDE + ks * 32 + fq * 8);
#pragma unroll
          for (int m = 0; m < 2; ++m) {
            const bf16x8 a = *(const bf16x8*)(kT + (m * 16 + fr) * GL_VT_STRIDE + ks * 32 + fq * 8);
            acc[m] = __builtin_amdgcn_mfma_f32_16x16x32_bf16(a, b, acc[m], 0, 0, 0);
          }
        }
#pragma unroll
        for (int m = 0; m < 2; ++m) *(f32x4*)(p.gkv + o * 2048 + (size_t)(w * 16 + fr) * 32 + m * 16 + fq * 4) = acc[m];
      }
      __syncthreads();
    }
    cur = nxt;
  }
}

__device__ __forceinline__ void gl_load8(const float* g, float* v) {
  const f32x4 a = *(const f32x4*)g, b = *(const f32x4*)(g + 4);
  v[0] = a[0]; v[1] = a[1]; v[2] = a[2]; v[3] = a[3]; v[4] = b[0]; v[5] = b[1]; v[6] = b[2]; v[7] = b[3];
}
#define GLC_KS_STRIDE 40
#define GLC_HALF_BYTES (64 * 72 * 2 + 64 * 72 * 2 + 2 * 64 * 36 * 4 + 2 * 64 * 36 * 4 + 64 * GLC_KS_STRIDE * 2)
struct GlaCPre { uint4 v0, v1, q, k, g[2], lb[2][2], st[2][2]; };
__device__ __forceinline__ GlaCPre glac_prefetch(const Params& p, int item, int ltid, int w, int fr, int fq) {
  const int sc = item >> 3, h = item & 7;
  GlaCPre r;
  {
    const int i = ltid >> 2, pc = ltid & 3;
    const bf16_t* row = p.cols + (size_t)gla_tok(sc, i) * INW;
    r.v0 = *(const uint4*)(row + C_GV + h * 64 + pc * 16); r.v1 = *(const uint4*)(row + C_GV + h * 64 + pc * 16 + 8);
    r.k = *(const uint4*)(row + C_GK + h * 32 + pc * 8);
  }
  r.q = *(const uint4*)(p.cols + (size_t)gla_tok(sc, w * 16 + fr) * INW + C_GQ + h * 32 + fq * 8);
  {
    const int lane = ltid & 63;
#pragma unroll
    for (int e = 0; e < 2; ++e) r.g[e] = *(const uint4*)(p.cols + (size_t)gla_tok(sc, w * 16 + (lane >> 3) + 8 * e) * INW + C_GG + h * 64 + (lane & 7) * 8);
  }
  {
#pragma unroll
    for (int dir = 0; dir < 2; ++dir) {
      const float* g = p.glb + (((size_t)dir * NSC + sc) * 8 + h) * 2048;
      r.lb[dir][0] = *(const uint4*)(g + ltid * 4); r.lb[dir][1] = *(const uint4*)(g + (ltid + 256) * 4);
      const float* s = p.gkv + (((size_t)dir * NSC + sc) * 8 + h) * 2048;
      r.st[dir][0] = *(const uint4*)(s + ltid * 4); r.st[dir][1] = *(const uint4*)(s + (ltid + 256) * 4);
    }
  }
  return r;
}
#define GLC_BONUS 6
__device__ __forceinline__ void phase_glac(const Params& p, int layer, int nsc, int nbusy, int bid, int nblk, unsigned char* smem) {
  const int tid = opaque_tid(); const int half = __builtin_amdgcn_readfirstlane(tid >> 8), ltid = tid & 255;
  const int lane = tid & 63, w = ltid >> 6, fr = lane & 15, fq = lane >> 4;
  bf16_t* vT = (bf16_t*)(smem + half * GLC_HALF_BYTES);
  bf16_t* Pw = vT + 64 * GL_VT_STRIDE + w * 16 * GL_VT_STRIDE;
  float* lbT = (float*)(vT + 2 * 64 * GL_VT_STRIDE);
  float* ST = lbT + 2 * 64 * GL_LB_STRIDE;
  bf16_t* kS = (bf16_t*)(ST + 2 * 64 * GL_LB_STRIDE);
  const int nit = nsc * 4;
  const int nfree = nblk - nbusy;
  const int nbonus = (nbusy > 0 && nfree > 0 && nfree * GLC_BONUS < nit) ? nfree * GLC_BONUS : 0;
  auto itof = [&](int k) -> int {
    if (nbonus == 0) return bid + k * nblk;
    if (bid >= nbusy) return k < GLC_BONUS ? k * nfree + (bid - nbusy) : nbonus + bid + (k - GLC_BONUS) * nblk;
    return nbonus + bid + k * nblk;
  };
  if (itof(0) >= nit) return;
  GlaCPre cur = glac_prefetch(p, itof(0) * 2 + half, ltid, w, fr, fq);
  for (int kk = 0; itof(kk) < nit; ++kk) {
    const int it = itof(kk);
    const int item = it * 2 + half;
    const int sc = item >> 3, h = item & 7;
    __syncthreads();
    gla_store_vT(cur.v0, cur.v1, vT, ltid >> 2, ltid & 3);
    *(uint4*)(kS + (ltid >> 2) * GLC_KS_STRIDE + (ltid & 3) * 8) = cur.k;
    {
#pragma unroll
      for (int dir = 0; dir < 2; ++dir)
#pragma unroll
        for (int r = 0; r < 2; ++r) {
          const int q = ltid + 256 * r;
          *(uint4*)(lbT + (dir * 64 + (q >> 3)) * GL_LB_STRIDE + (q & 7) * 4) = cur.lb[dir][r];
          *(uint4*)(ST + (dir * 64 + (q >> 3)) * GL_LB_STRIDE + (q & 7) * 4) = cur.st[dir][r];
        }
    }
    const int itn = itof(kk + 1) < nit ? itof(kk + 1) : it;
    const GlaCPre nxt = glac_prefetch(p, itn * 2 + half, ltid, w, fr, fq);
    __syncthreads();
    f32x4 o[4];
#pragma unroll
    for (int n = 0; n < 4; ++n) o[n] = (f32x4){0.f, 0.f, 0.f, 0.f};
#pragma unroll
    for (int dir = 0; dir < 2; ++dir) {
      const float* lbd = lbT + dir * 64 * GL_LB_STRIDE + fq * 8;
      float bref[8], bt[8];
      gl_load8(lbd + (dir ? 31 : 32) * GL_LB_STRIDE, bref);
      gl_load8(lbd + (w * 16 + fr) * GL_LB_STRIDE, bt);
      bf16x8 aqs, aqe;
      {
        float q8[8], s8[8], e8[8];
        unpack8(cur.q, q8);
#pragma unroll
        for (int c = 0; c < 8; ++c) {
          const float qx = q8[c] * 0.17677669529663687f;
          s8[c] = qx * __expf(bt[c] - bref[c]);
          e8[c] = qx * __expf(bt[c]);
        }
        aqs = pack_bf16x8(s8); aqe = pack_bf16x8(e8);
      }
#pragma unroll
      for (int n = 0; n < 4; ++n) {
        const int s = n * 16 + fr;
        float k8[8], bs[8];
        unpack8(*(const uint4*)(kS + s * GLC_KS_STRIDE + fq * 8), k8);
        gl_load8(lbd + s * GL_LB_STRIDE, bs);
#pragma unroll
        for (int c = 0; c < 8; ++c) k8[c] *= __expf(bref[c] - bs[c]);
        const bf16x8 bks = pack_bf16x8(k8);
        const f32x4 sa = __builtin_amdgcn_mfma_f32_16x16x32_bf16(aqs, bks, (f32x4){0.f, 0.f, 0.f, 0.f}, 0, 0, 0);
#pragma unroll
        for (int j = 0; j < 4; ++j) {
          const int t = w * 16 + fq * 4 + j;
          const bool ok = dir ? (s >= t) : (s <= t);
          Pw[(fq * 4 + j) * GL_VT_STRIDE + s] = f2bf(ok ? sa[j] : 0.f);
        }
      }
      __builtin_amdgcn_wave_barrier();
#pragma unroll
      for (int ks = 0; ks < 2; ++ks) {
        const bf16x8 ap = *(const bf16x8*)(Pw + fr * GL_VT_STRIDE + ks * 32 + fq * 8);
#pragma unroll
        for (int n = 0; n < 4; ++n) {
          const bf16x8 bv = *(const bf16x8*)(vT + (n * 16 + fr) * GL_VT_STRIDE + ks * 32 + fq * 8);
          o[n] = __builtin_amdgcn_mfma_f32_16x16x32_bf16(ap, bv, o[n], 0, 0, 0);
        }
      }
      __builtin_amdgcn_wave_barrier();
      {
        const float* Sg = ST + dir * 64 * GL_LB_STRIDE + fq * 8;
#pragma unroll
        for (int n = 0; n < 4; ++n) {
          float s8[8];
          gl_load8(Sg + (n * 16 + fr) * GL_LB_STRIDE, s8);
          const bf16x8 bS = pack_bf16x8(s8);
          o[n] = __builtin_amdgcn_mfma_f32_16x16x32_bf16(aqe, bS, o[n], 0, 0, 0);
        }
      }
    }
    __builtin_amdgcn_wave_barrier();
#pragma unroll
    for (int j = 0; j < 4; ++j) {
      float ss = o[0][j] * o[0][j] + o[1][j] * o[1][j] + o[2][j] * o[2][j] + o[3][j] * o[3][j];
      ss += xor_lane_f<1>(ss); ss += xor_lane_f<2>(ss); ss += xor_lane_f<4>(ss); ss += xor_lane_f<8>(ss);
      const float rstd = rsqrtf(ss * (1.f / 64.f) + EPSV);
#pragma unroll
      for (int n = 0; n < 4; ++n) Pw[(fq * 4 + j) * GL_VT_STRIDE + n * 16 + fr] = f2bf(o[n][j] * rstd);
    }
    __builtin_amdgcn_wave_barrier();
    {
      const int pc8 = (lane & 7) * 8;
      const float* ng = p.gla_ng + layer * 512 + h * 64 + pc8;
      const f32x4 n0 = *(const f32x4*)ng, n1 = *(const f32x4*)(ng + 4);
      const float nv[8] = {n0[0], n0[1], n0[2], n0[3], n1[0], n1[1], n1[2], n1[3]};
#pragma unroll
      for (int e = 0; e < 2; ++e) {
        const int tl = (lane >> 3) + 8 * e;
        const int tok = gla_tok(sc, w * 16 + tl);
        float ov[8], gv[8];
        unpack8(*(const uint4*)(Pw + tl * GL_VT_STRIDE + pc8), ov);
        unpack8(cur.g[e], gv);
        unsigned wv[4];
#pragma unroll
        for (int c = 0; c < 4; ++c) {
          const float a = ov[2 * c] * nv[2 * c] * silu_f(gv[2 * c]), b = ov[2 * c + 1] * nv[2 * c + 1] * silu_f(gv[2 * c + 1]);
          wv[c] = (unsigned)f2bf(a) | ((unsigned)f2bf(b) << 16);
        }
        *(uint4*)(p.mix + (size_t)tok * 1024 + 512 + h * 64 + pc8) = make_uint4(wv[0], wv[1], wv[2], wv[3]);
      }
    }
    __builtin_amdgcn_wave_barrier();
    cur = nxt;
  }
  __syncthreads();
}

__device__ __forceinline__ unsigned fkey(float f) { const unsigned u = __float_as_uint(f); return u ^ ((u >> 31) ? 0xFFFFFFFFu : 0x80000000u); }
__device__ __forceinline__ float funkey(unsigned k) { return __uint_as_float((k >> 31) ? (k ^ 0x80000000u) : ~k); }
__device__ __forceinline__ unsigned umax3(unsigned a, unsigned b) { return a > b ? a : b; }
__device__ __forceinline__ unsigned umin3(unsigned a, unsigned b) { return a < b ? a : b; }
__device__ __forceinline__ unsigned umed3(unsigned a, unsigned b, unsigned c) { return umax3(umin3(a, b), umin3(umax3(a, b), c)); }
__device__ __forceinline__ void top16_insert(unsigned (&L)[16], unsigned x) {
#pragma unroll
  for (int q = 15; q >= 1; --q) L[q] = umed3(L[q - 1], L[q], x);
  L[0] = umax3(L[0], x);
}
template <int XM>
__device__ __forceinline__ void top16_merge(unsigned (&L)[16]) {
  unsigned P[16];
#pragma unroll
  for (int i = 0; i < 16; ++i) P[i] = xor_lane_u<XM>(L[i]);
  unsigned M[16];
#pragma unroll
  for (int i = 0; i < 16; ++i) M[i] = umax3(L[i], P[15 - i]);
#pragma unroll
  for (int d = 8; d >= 1; d >>= 1) {
#pragma unroll
    for (int i = 0; i < 16; ++i) {
      if ((i & d) == 0) { const unsigned hi = umax3(M[i], M[i + d]), lo = umin3(M[i], M[i + d]); M[i] = hi; M[i + d] = lo; }
    }
  }
#pragma unroll
  for (int i = 0; i < 16; ++i) L[i] = M[i];
}
#define RT_MAX_ITEMS 5
__device__ __forceinline__ void phase_route(const Params& p, int layer, int ntok, int bid, int nblk, unsigned char* smem) {
  const int tid = opaque_tid(); const int lane = tid & 63, wid = tid >> 6;
  unsigned* lists_w = (unsigned*)smem + wid * (RT_MAX_ITEMS * 2 * 16 * 16);
  const int fr = lane & 15, fq = lane >> 4;
  const bf16_t* qb = p.cols;
  const int nitems = ntok / 16;
  static const unsigned char STAIR[52] = {0, 1, 2, 3, 4, 5, 6, 7, 8, 9, 10, 11, 12, 13, 14, 15, 16, 17, 18, 19, 20, 21, 22, 23, 32, 33, 34, 35, 36, 48, 49, 50, 51, 64, 65, 66, 80, 81, 96, 97, 112, 113, 128, 144, 160, 176, 192, 208, 224, 240, 255, 255};
  for (int item0 = bid; item0 < nitems; item0 += nblk * RT_MAX_ITEMS) {
    for (int ph = 0; ph < 2; ++ph) {
      bf16x8 bk[8][4];
      {
        const bf16_t* kb = p.keysb + ((((size_t)layer * 2 + ph) * 8 + wid) * 128) * 128 + (size_t)fr * 128 + fq * 8;
#pragma unroll
        for (int n = 0; n < 8; ++n)
#pragma unroll
          for (int kt = 0; kt < 4; ++kt) bk[n][kt] = *(const bf16x8*)(kb + (size_t)n * 16 * 128 + kt * 32);
      }
      bf16x8 an[4];
      {
        const bf16_t* qrow = qb + (size_t)(item0 * 16 + fr) * 2048 + wid * 256 + ph * 128 + fq * 8;
#pragma unroll
        for (int kt = 0; kt < 4; ++kt) an[kt] = *(const bf16x8*)(qrow + kt * 32);
      }
      for (int ii = 0; ii < RT_MAX_ITEMS; ++ii) {
        const int item = item0 + ii * nblk;
        if (item >= nitems) break;
        const int tok0 = item * 16;
        bf16x8 a[4];
#pragma unroll
        for (int kt = 0; kt < 4; ++kt) a[kt] = an[kt];
        {
          const int itn = item0 + (ii + 1) * nblk;
          const int tokn = (ii + 1 < RT_MAX_ITEMS && itn < nitems) ? itn * 16 : tok0;
          const bf16_t* qrow = qb + (size_t)(tokn + fr) * 2048 + wid * 256 + ph * 128 + fq * 8;
#pragma unroll
          for (int kt = 0; kt < 4; ++kt) an[kt] = *(const bf16x8*)(qrow + kt * 32);
        }
        unsigned L[16];
#pragma unroll
        for (int i = 0; i < 16; ++i) L[i] = 0u;
#pragma unroll
        for (int n = 0; n < 8; ++n) {
          f32x4 acc = (f32x4){0.f, 0.f, 0.f, 0.f};
#pragma unroll
          for (int kt = 0; kt < 4; ++kt) acc = __builtin_amdgcn_mfma_f32_16x16x32_bf16(bk[n][kt], a[kt], acc, 0, 0, 0);
#pragma unroll
          for (int j = 0; j < 4; ++j) top16_insert(L, (fkey(acc[j]) & 0xFFFFFF80u) | (unsigned)(n * 16 + fq * 4 + j));
        }
        top16_merge<16>(L);
        top16_merge<32>(L);
        if (fq == 0) {
          unsigned* dst = lists_w + ((ii * 2 + ph) * 16 + fr) * 16;
#pragma unroll
          for (int i = 0; i < 4; ++i) *(uint4*)(dst + i * 4) = make_uint4(L[i * 4], L[i * 4 + 1], L[i * 4 + 2], L[i * 4 + 3]);
        }
      }
    }
    __builtin_amdgcn_wave_barrier();
    for (int ii = 0; ii < RT_MAX_ITEMS; ++ii) {
      const int item = item0 + ii * nblk;
      if (item >= nitems) break;
      const int tok0 = item * 16;
      const unsigned* l1 = lists_w + ((ii * 2 + 0) * 16 + fr) * 16;
      const unsigned* l2 = lists_w + ((ii * 2 + 1) * 16 + fr) * 16;
      unsigned T[16];
#pragma unroll
      for (int i = 0; i < 16; ++i) T[i] = 0u;
#pragma unroll
      for (int j = 0; j < 13; ++j) {
        const unsigned c = STAIR[fq + 4 * j];
        const float sa = funkey(l1[(c >> 4) & 15] & 0xFFFFFF80u), sb = funkey(l2[c & 15] & 0xFFFFFF80u);
        const unsigned key = (fkey(sa + sb) & 0xFFFFFF00u) | c;
        top16_insert(T, c == 255u ? 0u : key);
      }
      top16_merge<16>(T);
      top16_merge<32>(T);
      const float mx = funkey(T[0] & 0xFFFFFF00u);
      float ex[16], sum = 0.f;
#pragma unroll
      for (int r = 0; r < 16; ++r) { ex[r] = __expf(funkey(T[r] & 0xFFFFFF00u) - mx); sum += ex[r]; }
      const float inv = 1.f / sum;
      int eid[4]; float gt[4];
#pragma unroll
      for (int r = 0; r < 16; ++r) {
        if ((r >> 2) == fq) {
          const int a = (T[r] >> 4) & 15, b = T[r] & 15;
          eid[r & 3] = (int)(l1[a] & 127u) * 128 + (int)(l2[b] & 127u);
          gt[r & 3] = ex[r] * inv;
        }
      }
      const size_t o = (size_t)(tok0 + fr) * 128 + wid * 16 + fq * 4;
      *(int4*)(p.pidx + o) = make_int4(eid[0], eid[1], eid[2], eid[3]);
      *(f32x4*)(p.pgate + o) = (f32x4){gt[0], gt[1], gt[2], gt[3]};
    }
    __builtin_amdgcn_wave_barrier();
  }
  __syncthreads();
}

typedef float f32x2 __attribute__((ext_vector_type(2)));
__device__ __forceinline__ float dot16_fp8(const uint4& r, const f32x2* h2) {
  const unsigned w[4] = {r.x, r.y, r.z, r.w};
  f32x2 d = {0.f, 0.f};
#pragma unroll
  for (int q = 0; q < 4; ++q) {
    d += __builtin_amdgcn_cvt_pk_f32_fp8(w[q], false) * h2[q * 2];
    d += __builtin_amdgcn_cvt_pk_f32_fp8(w[q], true) * h2[q * 2 + 1];
  }
  return d.x + d.y;
}
__device__ __forceinline__ void fma16_fp8(f32x2* acc2, const uint4& r, float w8) {
  const unsigned w[4] = {r.x, r.y, r.z, r.w};
  const f32x2 ww = {w8, w8};
#pragma unroll
  for (int q = 0; q < 4; ++q) {
    acc2[q * 2] += ww * __builtin_amdgcn_cvt_pk_f32_fp8(w[q], false);
    acc2[q * 2 + 1] += ww * __builtin_amdgcn_cvt_pk_f32_fp8(w[q], true);
  }
}
struct XcdInfo { int rank, nloc, xi, nx; };
__device__ __forceinline__ XcdInfo xcd_info(const XcdBarrier& b) {
  if (threadIdx.x == 0) {
    unsigned xi = 0;
    for (unsigned j = 0; j < 16; ++j) { const unsigned c = xb_ld(&b.bar[XB_XCNT(j)]); if (j < b.x && c > 0u) ++xi; }
    b.st[3] = xi;
  }
  __syncthreads();
  XcdInfo r;
  r.nloc = __builtin_amdgcn_readfirstlane((int)b.st[0]); r.nx = __builtin_amdgcn_readfirstlane((int)b.st[1]);
  r.rank = __builtin_amdgcn_readfirstlane((int)b.st[2]); r.xi = __builtin_amdgcn_readfirstlane((int)b.st[3]);
  return r;
}
__device__ __forceinline__ void gs_issue(uint4 (&buf)[16], const unsigned char* tab, const int* el, int grp) {
#pragma unroll
  for (int k = 0; k < 16; ++k) buf[k] = *(const uint4*)(tab + (size_t)el[k * 8 + grp] * 1024);
}
__device__ __forceinline__ void phase_gather_u(const Params& p, int layer, int ntok, const XcdInfo xin, unsigned char* smem) {
  const int tid = opaque_tid(); const int lane = tid & 63, wid = tid >> 6;
  int* elw = (int*)smem + wid * 256;
  float* pbuf = (float*)p.cols;
  const int sub = lane & 7, grp = lane >> 3;
  const bool b0 = (lane & 1) != 0, b1 = (lane & 2) != 0, b2 = (lane & 4) != 0;
  const int tstep = xin.nloc * NW;
  for (int s = xin.xi; s < 8; s += xin.nx) {
    const unsigned char* EU = p.eu8 + (size_t)layer * 16384 * 1024 + s * 128 + sub * 16;
    const int t0 = xin.rank * NW + wid;
    if (t0 >= ntok) continue;
    const int kslot = ((b0 ? 8 : 0) + (b1 ? 4 : 0) + (b2 ? 2 : 0)) * 8 + grp;
    uint4 bufA[16], bufB[16];
    uint4 hA0, hA1, hB0, hB1;
    int i0n, i1n;
    {
      elw[lane] = p.pidx[(size_t)t0 * 128 + lane]; elw[64 + lane] = p.pidx[(size_t)t0 * 128 + 64 + lane];
      __builtin_amdgcn_wave_barrier();
      gs_issue(bufA, EU, elw, grp);
      hA0 = *(const uint4*)(p.abuf + (size_t)t0 * 1024 + s * 128 + sub * 16); hA1 = *(const uint4*)(p.abuf + (size_t)t0 * 1024 + s * 128 + sub * 16 + 8);
      const int t1 = t0 + tstep < ntok ? t0 + tstep : t0;
      i0n = p.pidx[(size_t)t1 * 128 + lane]; i1n = p.pidx[(size_t)t1 * 128 + 64 + lane];
    }
    int par = 0;
    for (int t = t0; t < ntok; t += 2 * tstep) {
#pragma unroll
      for (int hh = 0; hh < 2; ++hh) {
        const int tc = t + hh * tstep;
        if (tc < ntok) {
          uint4 (&cur)[16] = hh ? bufB : bufA;
          uint4 (&nxt)[16] = hh ? bufA : bufB;
          const uint4 hc0 = hh ? hB0 : hA0, hc1 = hh ? hB1 : hA1;
          const int tn = tc + tstep < ntok ? tc + tstep : tc;
          par ^= 1;
          int* eln = elw + par * 128;
          eln[lane] = i0n; eln[64 + lane] = i1n;
          __builtin_amdgcn_wave_barrier();
          gs_issue(nxt, EU, eln, grp);
          const uint4 hn0 = *(const uint4*)(p.abuf + (size_t)tn * 1024 + s * 128 + sub * 16), hn1 = *(const uint4*)(p.abuf + (size_t)tn * 1024 + s * 128 + sub * 16 + 8);
          const int tnn = tn + tstep < ntok ? tn + tstep : tn;
          i0n = p.pidx[(size_t)tnn * 128 + lane]; i1n = p.pidx[(size_t)tnn * 128 + 64 + lane];
          f32x2 hv2[8];
          {
            float hv[16];
            unpack8(hc0, hv); unpack8(hc1, hv + 8);
#pragma unroll
            for (int q = 0; q < 8; ++q) hv2[q] = (f32x2){hv[2 * q], hv[2 * q + 1]};
          }
          float d[16];
#pragma unroll
          for (int k = 0; k < 16; ++k) d[k] = dot16_fp8(cur[k], hv2);
          float d8[8], d4[4], d2[2];
#pragma unroll
          for (int q = 0; q < 8; ++q) { const float send = b0 ? d[q] : d[q + 8]; const float keep = b0 ? d[q + 8] : d[q]; d8[q] = keep + xor_lane_f<1>(send); }
#pragma unroll
          for (int q = 0; q < 4; ++q) { const float send = b1 ? d8[q] : d8[q + 4]; const float keep = b1 ? d8[q + 4] : d8[q]; d4[q] = keep + xor_lane_f<2>(send); }
#pragma unroll
          for (int q = 0; q < 2; ++q) { const float send = b2 ? d4[q] : d4[q + 2]; const float keep = b2 ? d4[q + 2] : d4[q]; d2[q] = keep + xor_lane_f<4>(send); }
          float* dst = pbuf + ((size_t)s * TT + tc) * 128 + kslot;
          dst[0] = d2[0]; dst[8] = d2[1];
          if (hh) { hA0 = hn0; hA1 = hn1; } else { hB0 = hn0; hB1 = hn1; }
        }
      }
    }
    __builtin_amdgcn_wave_barrier();
  }
}
__device__ __forceinline__ void phase_gather_r(const Params& p, int layer, int ntok, int bid, int nblk) {
  const int tid = opaque_tid();
  const float* pbuf = (const float*)p.cols;
  const size_t n4 = (size_t)ntok * 32;
  for (size_t i = (size_t)bid * NT + tid; i < n4; i += (size_t)nblk * NT) {
    f32x4 z = *(const f32x4*)(pbuf + i * 4);
#pragma unroll
    for (int s = 1; s < 8; ++s) z += *(const f32x4*)(pbuf + (size_t)s * TT * 128 + i * 4);
    const f32x4 g = *(const f32x4*)(p.pgate + i * 4);
    const int4 e = *(const int4*)(p.pidx + i * 4);
    const int ev[4] = {e.x, e.y, e.z, e.w};
    f32x4 w;
#pragma unroll
    for (int j = 0; j < 4; ++j) w[j] = g[j] * gelu_f(z[j] * p.su[layer * 16384 + ev[j]]) * p.sv[layer * 16384 + ev[j]];
    *(f32x4*)(p.wbuf + i * 4) = w;
  }
}
template <bool DUMMY>
__device__ __forceinline__ void phase_gather_v(const Params& p, int layer, int ntok, const XcdInfo xin, unsigned char* smem) {
  float* xout = DUMMY ? (float*)p.cols : p.xres;
  const int tid = opaque_tid(); const int lane = tid & 63, wid = tid >> 6;
  int* elw = (int*)smem + wid * 512;
  float* wlw = (float*)(elw + 256);
  const int sub = lane & 7, grp = lane >> 3;
  const bool b5 = (lane & 32) != 0, b4 = (lane & 16) != 0, b3 = (lane & 8) != 0;
  const int tstep = xin.nloc * NW;
  for (int s = xin.xi; s < 8; s += xin.nx) {
    const unsigned char* EV = p.ev8 + (size_t)layer * 16384 * 1024 + s * 128 + sub * 16;
    const int col = s * 128 + sub * 16 + (b3 ? 8 : 0) + (b4 ? 4 : 0) + (b5 ? 2 : 0);
    const int t0 = xin.rank * NW + wid;
    if (t0 >= ntok) continue;
    uint4 bufA[16], bufB[16];
    int i0n, i1n; float w0n, w1n;
    f32x2 xc, gc, xn, gn;
    {
      elw[lane] = p.pidx[(size_t)t0 * 128 + lane]; elw[64 + lane] = p.pidx[(size_t)t0 * 128 + 64 + lane];
      wlw[lane] = p.wbuf[(size_t)t0 * 128 + lane]; wlw[64 + lane] = p.wbuf[(size_t)t0 * 128 + 64 + lane];
      __builtin_amdgcn_wave_barrier();
      gs_issue(bufA, EV, elw, grp);
      xc = *(const f32x2*)(p.xres + (size_t)t0 * 1024 + col);
      gc = *(const f32x2*)(p.modv + ((size_t)layer * 5 + tok_batch(t0)) * NMOD + 5120 + col);
      const int t1 = t0 + tstep < ntok ? t0 + tstep : t0;
      i0n = p.pidx[(size_t)t1 * 128 + lane]; i1n = p.pidx[(size_t)t1 * 128 + 64 + lane];
      w0n = p.wbuf[(size_t)t1 * 128 + lane]; w1n = p.wbuf[(size_t)t1 * 128 + 64 + lane];
      xn = *(const f32x2*)(p.xres + (size_t)t1 * 1024 + col);
      gn = *(const f32x2*)(p.modv + ((size_t)layer * 5 + tok_batch(t1)) * NMOD + 5120 + col);
    }
    int par = 0;
    for (int t = t0; t < ntok; t += 2 * tstep) {
#pragma unroll
      for (int hh = 0; hh < 2; ++hh) {
        const int tc = t + hh * tstep;
        if (tc < ntok) {
          uint4 (&cur)[16] = hh ? bufB : bufA;
          uint4 (&nxt)[16] = hh ? bufA : bufB;
          const float* wlc = wlw + par * 128;
          const int tn = tc + tstep < ntok ? tc + tstep : tc;
          par ^= 1;
          int* eln = elw + par * 128; float* wln = wlw + par * 128;
          eln[lane] = i0n; eln[64 + lane] = i1n; wln[lane] = w0n; wln[64 + lane] = w1n;
          __builtin_amdgcn_wave_barrier();
          gs_issue(nxt, EV, eln, grp);
          const f32x2 xcur = xc, gcur = gc;
          xc = xn; gc = gn;
          const int tnn = tn + tstep < ntok ? tn + tstep : tn;
          i0n = p.pidx[(size_t)tnn * 128 + lane]; i1n = p.pidx[(size_t)tnn * 128 + 64 + lane];
          w0n = p.wbuf[(size_t)tnn * 128 + lane]; w1n = p.wbuf[(size_t)tnn * 128 + 64 + lane];
          xn = *(const f32x2*)(p.xres + (size_t)tnn * 1024 + col);
          gn = *(const f32x2*)(p.modv + ((size_t)layer * 5 + tok_batch(tnn)) * NMOD + 5120 + col);
          f32x2 acc2[8];
#pragma unroll
          for (int j = 0; j < 8; ++j) acc2[j] = (f32x2){0.f, 0.f};
#pragma unroll
          for (int k = 0; k < 16; ++k) fma16_fp8(acc2, cur[k], wlc[k * 8 + grp]);
          float a16[16];
#pragma unroll
          for (int q = 0; q < 8; ++q) { a16[2 * q] = acc2[q].x; a16[2 * q + 1] = acc2[q].y; }
          float a8[8], a4[4], a2[2];
#pragma unroll
          for (int q = 0; q < 8; ++q) { const float send = b3 ? a16[q] : a16[q + 8]; const float keep = b3 ? a16[q + 8] : a16[q]; a8[q] = keep + xor_lane_f<8>(send); }
#pragma unroll
          for (int q = 0; q < 4; ++q) { const float send = b4 ? a8[q] : a8[q + 4]; const float keep = b4 ? a8[q + 4] : a8[q]; a4[q] = keep + xor_lane_f<16>(send); }
#pragma unroll
          for (int q = 0; q < 2; ++q) { const float send = b5 ? a4[q] : a4[q + 2]; const float keep = b5 ? a4[q + 2] : a4[q]; a2[q] = keep + xor_lane_f<32>(send); }
          f32x2 xv = xcur;
          xv.x += gcur.x * a2[0]; xv.y += gcur.y * a2[1];
          *(f32x2*)(xout + (size_t)tc * 1024 + col) = xv;
        }
      }
    }
    __builtin_amdgcn_wave_barrier();
  }
}
__device__ __forceinline__ void phase_gather_norm(const Params& p, int layer, int ntok, int bid, int nblk) {
  const int tid = opaque_tid(); const int lane = tid & 63, wid = tid >> 6;
  for (int t = bid * NW + wid; t < ntok; t += nblk * NW) {
    f32x4 xv[4];
    float ss = 0.f;
#pragma unroll
    for (int q = 0; q < 4; ++q) {
      xv[q] = *(const f32x4*)(p.xres + (size_t)t * 1024 + lane * 16 + q * 4);
      ss += xv[q][0] * xv[q][0] + xv[q][1] * xv[q][1] + xv[q][2] * xv[q][2] + xv[q][3] * xv[q][3];
    }
    ss = wave_sum(ss);
    const float rstd = rsqrtf(ss * (1.f / 1024.f) + EPSV);
    if (layer == 0) {
      const float* md1 = p.modv + ((size_t)5 + tok_batch(t)) * NMOD;
#pragma unroll
      for (int q = 0; q < 4; ++q) {
        const int c0 = lane * 16 + q * 4;
        const f32x4 g = *(const f32x4*)(p.norm1_g + 1024 + c0);
        const f32x4 sh = *(const f32x4*)(md1 + c0);
        const f32x4 sc = *(const f32x4*)(md1 + 1024 + c0);
        ushort4 o;
        o.x = f2bf(xv[q][0] * rstd * g[0] * (1.f + sc[0]) + sh[0]);
        o.y = f2bf(xv[q][1] * rstd * g[1] * (1.f + sc[1]) + sh[1]);
        o.z = f2bf(xv[q][2] * rstd * g[2] * (1.f + sc[2]) + sh[2]);
        o.w = f2bf(xv[q][3] * rstd * g[3] * (1.f + sc[3]) + sh[3]);
        *(ushort4*)(p.abuf + (size_t)t * 1024 + c0) = o;
      }
    } else {
#pragma unroll
      for (int q = 0; q < 4; ++q) {
        const int c0 = lane * 16 + q * 4;
        const f32x4 g = *(const f32x4*)(p.final_g + c0);
        f32x4 o;
        o[0] = xv[q][0] * rstd * g[0]; o[1] = xv[q][1] * rstd * g[1]; o[2] = xv[q][2] * rstd * g[2]; o[3] = xv[q][3] * rstd * g[3];
        *(f32x4*)(p.out + (size_t)t * 1024 + c0) = o;
      }
    }
  }
}

__device__ __forceinline__ void phase_final(const Params& p, int bid, int nblk) {
  const int tid = opaque_tid(); const int lane = tid & 63, wid = tid >> 6;
  for (int t = bid * 4 + wid; t < TL; t += nblk * 4) {
    const float* row = p.xres + (size_t)t * 1024;
    f32x4 v[4];
    float ss = 0.f;
#pragma unroll
    for (int j = 0; j < 4; ++j) {
      v[j] = *(const f32x4*)(row + j * 256 + lane * 4);
      ss += v[j][0] * v[j][0] + v[j][1] * v[j][1] + v[j][2] * v[j][2] + v[j][3] * v[j][3];
    }
    ss = wave_sum(ss);
    const float rstd = rsqrtf(ss * (1.f / 1024.f) + EPSV);
#pragma unroll
    for (int j = 0; j < 4; ++j) {
      const int c0 = j * 256 + lane * 4;
      const f32x4 g = *(const f32x4*)(p.final_g + c0);
      f32x4 o;
      o[0] = v[j][0] * rstd * g[0]; o[1] = v[j][1] * rstd * g[1]; o[2] = v[j][2] * rstd * g[2]; o[3] = v[j][3] * rstd * g[3];
      *(f32x4*)(p.out + (size_t)t * 1024 + c0) = o;
    }
  }
}

template <class Epi>
__device__ __forceinline__ void run_gemm(const bf16_t* A, const bf16_t* Bt, int M, int N, int K, const Epi& epi, int bid, int nblk, unsigned char* smem) {
  pg8::Gemm g{A, Bt, M, N, K};
  pg8::StaticOrder S; S.init(M, N, nblk, bid);
  pg8::gemm_phase(( PG8_LAS unsigned char*)smem, g, S, epi);
}
__device__ __forceinline__ void phase_gemm_in(const Params& p, int layer, int bid, int nblk, unsigned char* smem) {
  pg8::EpiIn epi{p.cols, p.s5u};
  run_gemm(p.abuf, p.wt_in + (size_t)layer * INWP * 1024, TT, INWP, 1024, epi, bid, nblk, smem);
}
__device__ __forceinline__ void phase_gemm_glu(const Params& p, int layer, int ntok, int bid, int nblk, unsigned char* smem) {
  pg8::EpiGlu epi{p.mix};
  run_gemm(p.yg, p.wt_glu + (size_t)layer * 512 * 256, ntok, 512, 256, epi, bid, nblk, smem);
}
__device__ __forceinline__ void phase_gemm_out(const Params& p, int layer, int ntok, int bid, int nblk, unsigned char* smem) {
  pg8::EpiResid epi{p.xres, p.modv + (size_t)layer * 5 * NMOD, 2048};
  run_gemm(p.mix, p.wt_out + (size_t)layer * 1024 * 1024, ntok, 1024, 1024, epi, bid, nblk, smem);
}
__device__ __forceinline__ void phase_gemm_q(const Params& p, int layer, int ntok, int bid, int nblk, unsigned char* smem) {
  pg8::EpiBf16 epi{p.cols  , 2048, 2048};
  run_gemm(p.abuf, p.wt_q + (size_t)layer * 2048 * 1024, ntok, 2048, 1024, epi, bid, nblk, smem);
}

template <int L>
__device__ __forceinline__ void layer_body(const Params& p, const XcdBarrier& bar, const XcdInfo xin, int bid, int nblk, unsigned char* smem) {
  constexpr int l = L;
  constexpr int ntok = L == 0 ? TT : TL;
  for (int rep = 0; rep < REP_GEMM; ++rep) phase_gemm_in(p, l, bid, nblk, smem);
  xcd_barrier(bar);
  for (int rep = 0; rep < REP_MIX; ++rep) {
    phase_s5a(p, l, bid, nblk, smem);
    if (REP_S5 > 1) phase_s5a(p, l, bid, nblk, smem);
    for (int r2 = 0; r2 < REP_GLA; ++r2) phase_glaa(p, l, bid, nblk, smem);
  }
  xcd_barrier(bar);
  phase_scan(p, l, bid, nblk);
  for (int r2 = 0; r2 < REP_SGU; ++r2) phase_sgu(p, l, ntok / 128, bid, nblk, smem);
  xcd_barrier(bar);
  for (int rep = 0; rep < REP_MIX; ++rep) {
    phase_s5c(p, l, ntok / 64, bid, nblk, smem);
    if (REP_S5 > 1) phase_s5c(p, l, ntok / 64, bid, nblk, smem);
    for (int r2 = 0; r2 < REP_GLA; ++r2) phase_glac(p, l, ntok / 64, 16 * ((ntok / 64 / 16 + 1) / 2), bid, nblk, smem);
  }
  xcd_barrier(bar);
  for (int rep = 0; rep < REP_GEMM; ++rep) phase_gemm_glu(p, l, ntok, bid, nblk, smem);
  xcd_barrier(bar);
  if (REP_GEMM > 1) {
    pg8::EpiBf16 epi{p.abuf, 1024, 1024};
    for (int rep = 1; rep < REP_GEMM; ++rep) run_gemm(p.mix, p.wt_out + (size_t)l * 1024 * 1024, ntok, 1024, 1024, epi, bid, nblk, smem);
  }
  phase_gemm_out(p, l, ntok, bid, nblk, smem);
  if (l == 0 && nblk > 16 && bid >= 16) {
    const int tid = opaque_tid();
    for (int j = bid - 16; j < 2048; j += nblk - 16) convert_rows(p, (j >> 10) * 2048 + 1024 + (j & 1023), tid);
  } else if (l == 0 && nblk <= 16) {
    const int tid = opaque_tid();
    for (int j = bid; j < 2048; j += nblk) convert_rows(p, (j >> 10) * 2048 + 1024 + (j & 1023), tid);
  }
  xcd_barrier(bar);
  for (int rep = 0; rep < REP_PRO; ++rep)
    phase_normmod(p, p.xres, p.xres + (size_t)TL * 1024, p.norm2_g + l * 1024, p.modv + (size_t)l * 5 * NMOD, 3072, 4096, ntok, 0, bid, nblk);
  xcd_barrier(bar);
  for (int rep = 0; rep < REP_GEMM; ++rep) phase_gemm_q(p, l, ntok, bid, nblk, smem);
  xcd_barrier(bar);
  for (int rep = 0; rep < REP_ROUTE; ++rep) phase_route(p, l, ntok, bid, nblk, smem);
  xcd_barrier(bar);
  phase_gather_u(p, l, ntok, xin, smem);
  if (REP_GATHER == 2) phase_gather_u(p, l, ntok, xin, smem);
  xcd_barrier(bar);
  phase_gather_r(p, l, ntok, bid, nblk);
  xcd_barrier(bar);
  if (REP_GATHER > 2) phase_gather_v<true>(p, l, ntok, xin, smem);
  phase_gather_v<false>(p, l, ntok, xin, smem);
  xcd_barrier(bar);
  phase_gather_norm(p, l, ntok, bid, nblk);
  if (l == 0) xcd_barrier(bar);
}

#define SMEM_BYTES (148 * 1024)
__global__ void __launch_bounds__(NT) mega_kernel(Params p) {
  __shared__ __attribute__((aligned(16))) unsigned char smem[SMEM_BYTES + 16];
  const int bid = blockIdx.x, nblk = gridDim.x;
  volatile LAS unsigned* xbw = (volatile LAS unsigned*)(smem + SMEM_BYTES);
  if (threadIdx.x == 0) { xbw[0] = 0u; xbw[1] = 0u; xbw[2] = 0u; xbw[3] = 0u; }
  __syncthreads();
  XcdBarrier bar = xcd_barrier_post(p.bar, xbw);
  for (int rep = 0; rep < REP_PRO; ++rep) {
    phase_mod(p, bid, nblk, smem);
    phase_wprep(p, bid, nblk, smem);
  }
  xcd_barrier(bar);
  for (int rep = 0; rep < REP_PRO; ++rep) phase_normmod(p, p.x, p.ctx, p.norm1_g, p.modv, 0, 1024, TT, 1, bid, nblk);
  xcd_barrier(bar);
  const XcdInfo xin = xcd_info(bar);
  layer_body<0>(p, bar, xin, bid, nblk, smem);
  layer_body<1>(p, bar, xin, bid, nblk, smem);
}

static inline size_t align_up(size_t v, size_t a) { return (v + a - 1) / a * a; }

extern "C" void kernel_launch(void* const* d_in, const int* in_sizes, int n_in, void* d_out, int out_size, void* d_ws, size_t ws_size,
                              hipStream_t stream) {
  Params p{};
  const float* const* in = (const float* const*)d_in;
  p.x = in[0]; p.c = in[1]; p.ctx = in[2]; p.c_ctx = in[3]; p.w_mod = in[4]; p.b_mod = in[5]; p.norm1_g = in[6]; p.norm2_g = in[7];
  p.w_in = in[8]; p.w_out = in[9]; p.sgu_w = in[10]; p.sgu_b = in[11]; p.lam_re = in[12]; p.lam_im = in[13]; p.b_re = in[14]; p.b_im = in[15];
  p.c_re = in[16]; p.c_im = in[17]; p.log_step = in[18]; p.s5_d = in[19]; p.w_glu = in[20]; p.gla_wg = in[21]; p.gla_bg = in[22]; p.gla_ng = in[23];
  p.w_query = in[24]; p.sub_keys = in[25]; p.exp_u = in[26]; p.exp_v = in[27]; p.final_g = in[28];
  p.out = (float*)d_out;
  unsigned char* w = (unsigned char*)d_ws;
  size_t off = 0;
  auto take = [&](size_t bytes) { void* r = w + off; off = align_up(off + bytes, 256); return r; };
  p.bar = (unsigned*)take(16384);
  p.xres = (float*)take((size_t)TT * 1024 * 4);
  p.modv = (float*)take((size_t)2 * 5 * NMOD * 4);
  p.abuf = (bf16_t*)take((size_t)TT * 1024 * 2);
  p.cols = (bf16_t*)take((size_t)TT * INW * 2);
  p.mix = (bf16_t*)take((size_t)TT * 1024 * 2);
  p.yg = (bf16_t*)take((size_t)TT * 256 * 2);
  p.s5u = (bf16_t*)take((size_t)16 * TT * 16 * 2);
  p.wt_in = (bf16_t*)take((size_t)2 * INWP * 1024 * 2);
  p.wt_out = (bf16_t*)take((size_t)2 * 1024 * 1024 * 2);
  p.wt_q = (bf16_t*)take((size_t)2 * 2048 * 1024 * 2);
  p.wt_glu = (bf16_t*)take((size_t)2 * 512 * 256 * 2);
  p.keysb = (bf16_t*)take((size_t)2 * 2 * 8 * 128 * 128 * 2);
  p.sgu_wb = (bf16_t*)take((size_t)2 * 4 * 128 * 128 * 2);
  p.s5a = (float*)take((size_t)4096 * 2 * 4);
  p.s5a64 = (float*)take((size_t)4096 * 2 * 4);
  p.s5bb = (float*)take((size_t)4096 * 32 * 4);
  p.s5K = (bf16_t*)take((size_t)64 * 16384 * 2);
  p.s5M1 = (bf16_t*)take((size_t)64 * 131072 * 2);
  p.s5N2 = (bf16_t*)take((size_t)64 * 131072 * 2);
  p.s5S = (float*)take((size_t)2 * NSC * 16 * 64 * 2 * 4);
  p.s5H = (float*)take((size_t)2 * NSC * 16 * 64 * 2 * 4);
  p.gkv = (float*)take((size_t)2 * NSC * 8 * 2048 * 4);
  p.gdec = (float*)take((size_t)2 * NSC * 8 * 32 * 4);
  p.eu8 = (unsigned char*)take((size_t)2 * 16384 * 1024);
  p.ev8 = (unsigned char*)take((size_t)2 * 16384 * 1024);
  p.su = (float*)take((size_t)2 * 16384 * 4);
  p.sv = (float*)take((size_t)2 * 16384 * 4);
  p.glb = (float*)take((size_t)2 * TT * 256 * 4);
  p.wbuf = (float*)take((size_t)TT * 128 * 4);
  p.ssbuf = (float*)take((size_t)TT * 8 * 4);
  p.pidx = (int*)take((size_t)TT * 128 * 4);
  p.pgate = (float*)take((size_t)TT * 128 * 4);
  if (off > ws_size) { fprintf(stderr, "workspace too small: need %zu have %zu\n", off, ws_size); return; }

  (void)hipMemsetAsync(p.bar, 0, XCD_BAR_WORDS * 4, stream);
  static int grid_blocks = 0;
  if (!grid_blocks) {
    int dev = 0, cus = 0, per_cu = 0;
    (void)hipGetDevice(&dev);
    (void)hipDeviceGetAttribute(&cus, hipDeviceAttributeMultiprocessorCount, dev);
    (void)hipOccupancyMaxActiveBlocksPerMultiprocessor(&per_cu, (const void*)mega_kernel, NT, 0);
    if (per_cu < 1) { fprintf(stderr, "occupancy query says 0 blocks/CU\n"); per_cu = 1; }
    grid_blocks = cus;
  }
  void* args[] = {&p};
  hipError_t e = hipLaunchCooperativeKernel((const void*)mega_kernel, dim3(grid_blocks), dim3(NT), args, 0, stream);
  if (e != hipSuccess) fprintf(stderr, "cooperative launch failed: %s (grid %d)\n", hipGetErrorString(e), grid_blocks);
}
```

```cpp
#include <hip/hip_runtime.h>
#include <cstdio>
#include <cstdint>
#include <cmath>

typedef unsigned short bf16_t;
typedef short bf16x8 __attribute__((ext_vector_type(8)));
typedef float f32x4 __attribute__((ext_vector_type(4)));

#define DM 1024
#define NBATCH 4
#define SEQ 4096
#define CTXL 256
#define TL (NBATCH * SEQ)
#define TC (NBATCH * CTXL)
#define TT (TL + TC)
#define INW 2336
#define INWP 2560
#define NMOD 6144
#define NSC 272
#define EPSV 1e-6f
#define NT 512
#define NW 8
#ifndef REP_GATHER
#define REP_GATHER 1
#endif
#ifndef REP_ROUTE
#define REP_ROUTE 1
#endif
#ifndef REP_GEMM
#define REP_GEMM 1
#endif
#ifndef REP_MIX
#define REP_MIX 1
#endif
#ifndef REP_PRO
#define REP_PRO 1
#endif
#ifndef REP_SGU
#define REP_SGU 1
#endif
#ifndef REP_S5
#define REP_S5 1
#endif
#ifndef REP_GLA
#define REP_GLA 1
#endif

#define C_SGU_U 0
#define C_SGU_V 256
#define C_S5 512
#define C_GQ 768
#define C_GK 1024
#define C_GV 1280
#define C_GG 1792
#define C_ZF 2304

struct Params {
  const float *x, *c, *ctx, *c_ctx, *w_mod, *b_mod, *norm1_g, *norm2_g, *w_in, *w_out, *sgu_w, *sgu_b;
  const float *lam_re, *lam_im, *b_re, *b_im, *c_re, *c_im, *log_step, *s5_d, *w_glu, *gla_wg, *gla_bg, *gla_ng;
  const float *w_query, *sub_keys, *exp_u, *exp_v, *final_g;
  float* out;
  unsigned* bar;
  float* xres;
  float* modv;
  bf16_t* abuf;
  bf16_t* cols;
  bf16_t* mix;
  bf16_t* yg;
  bf16_t* s5u;
  bf16_t *wt_in, *wt_out, *wt_q, *wt_glu, *keysb, *sgu_wb;
  float *s5a, *s5a64, *s5bb;
  bf16_t *s5K, *s5M1, *s5N2;
  float *s5S, *s5H;
  float *gkv, *gdec;
  unsigned char *eu8, *ev8;
  float *su, *sv;
  bf16_t* gksc;
  float* glb;
  float *wbuf, *ssbuf;
  int* pidx;
  float* pgate;
};

typedef const __attribute__((address_space(4))) Params& PRef;
__device__ __forceinline__ const __attribute__((address_space(4))) Params* kp_launder(const __attribute__((address_space(4))) Params* q) { asm volatile("" : "+s"(q)); return q; }
typedef float f32x2_t __attribute__((ext_vector_type(2)));
typedef float f32x2 __attribute__((ext_vector_type(2)));
typedef __bf16 hbf16x2_t __attribute__((ext_vector_type(2)));
typedef _Float16 f16x2_t __attribute__((ext_vector_type(2)));
__device__ __forceinline__ unsigned pk_f16(float lo, float hi) { const f32x2_t v = {lo, hi}; return __builtin_bit_cast(unsigned, __builtin_convertvector(v, f16x2_t)); }
__device__ __forceinline__ f32x2_t unpk_f16(unsigned u) { return __builtin_convertvector(__builtin_bit_cast(f16x2_t, u), f32x2_t); }
typedef unsigned u32x4_t __attribute__((ext_vector_type(4)));
__device__ __forceinline__ unsigned pk_bf16(float lo, float hi) { const f32x2_t v = {lo, hi}; return __builtin_bit_cast(unsigned, __builtin_convertvector(v, hbf16x2_t)); }
__device__ __forceinline__ bf16_t f2bf(float f) { return __builtin_bit_cast(unsigned short, (__bf16)f); }
__device__ __forceinline__ float bf2f(bf16_t h) { return __uint_as_float(((unsigned)h) << 16); }
__device__ __forceinline__ bf16x8 pack_bf16x8(const float* v) {
  const u32x4_t w = {pk_bf16(v[0], v[1]), pk_bf16(v[2], v[3]), pk_bf16(v[4], v[5]), pk_bf16(v[6], v[7])};
  return __builtin_bit_cast(bf16x8, w);
}

__device__ __forceinline__ float bflo(unsigned u) { return __uint_as_float(u << 16); }
__device__ __forceinline__ float bfhi(unsigned u) { return __uint_as_float(u & 0xffff0000u); }
__device__ __forceinline__ float gelu_f(float x) {
  const float y2 = x * (1.5957691216057308f + 0.07135481627260025f * x * x);
  return x * __builtin_amdgcn_rcpf(1.f + __expf(-y2));
}
__device__ __forceinline__ float sigmoid_f(float x) { return __builtin_amdgcn_rcpf(1.f + __expf(-x)); }
__device__ __forceinline__ float silu_f(float x) { return x * sigmoid_f(x); }
__device__ __forceinline__ float logsigmoid_f(float x) { return fminf(x, 0.f) - log1pf(__expf(-fabsf(x))); }
template <int M>
__device__ __forceinline__ unsigned xor_lane_u(unsigned x) {
  if constexpr (M == 1) return (unsigned)__builtin_amdgcn_mov_dpp((int)x, 0xB1, 0xf, 0xf, true);
  else if constexpr (M == 2) return (unsigned)__builtin_amdgcn_mov_dpp((int)x, 0x4E, 0xf, 0xf, true);
  else if constexpr (M == 4) {
    const int a = __builtin_amdgcn_update_dpp((int)x, (int)x, 0x104, 0xf, 0x5, false);
    return (unsigned)__builtin_amdgcn_update_dpp(a, (int)x, 0x114, 0xf, 0xa, false);
  } else if constexpr (M == 8) return (unsigned)__builtin_amdgcn_mov_dpp((int)x, 0x128, 0xf, 0xf, true);
  else if constexpr (M == 16) {
    const auto r = __builtin_amdgcn_permlane16_swap(x, x, false, false);
    return ((threadIdx.x >> 4) & 1) ? r[0] : r[1];
  } else if constexpr (M == 32) {
    const auto r = __builtin_amdgcn_permlane32_swap(x, x, false, false);
    return (threadIdx.x & 32) ? r[0] : r[1];
  } else return (unsigned)__shfl_xor((int)x, M);
}
template <int M>
__device__ __forceinline__ float xor_lane_f(float x) { return __uint_as_float(xor_lane_u<M>(__float_as_uint(x))); }
__device__ __forceinline__ float wave_sum(float v) {
  v += xor_lane_f<32>(v); v += xor_lane_f<16>(v); v += xor_lane_f<8>(v); v += xor_lane_f<4>(v); v += xor_lane_f<2>(v); v += xor_lane_f<1>(v);
  return v;
}
__device__ __forceinline__ void lds_barrier() {
  asm volatile("s_waitcnt lgkmcnt(0)" ::: "memory");
  __builtin_amdgcn_s_barrier();
  asm volatile("" ::: "memory");
}
__device__ __forceinline__ int opaque_tid() { int t = threadIdx.x; asm volatile("" : "+v"(t)); return t; }
__device__ __forceinline__ int tok_batch(int t) { return t < TL ? (t >> 12) : 4; }
__device__ __forceinline__ int s5_tok(int sc, int i) { return sc < 256 ? ((sc >> 6) * SEQ + (sc & 63) * 64 + i) : (TL + (sc - 256) * 64 + i); }
__device__ __forceinline__ int gla_tok(int sc, int i) { return sc < 256 ? ((sc >> 6) * SEQ + i * 64 + (sc & 63)) : (TL + (sc - 256) * 64 + i); }


#define XB_TMO      128
#define XB_XCNT(j)  (256  + 64 * (j))
#define XB_XSUB(j)  (1280 + 64 * (j))
#define XB_XGEN(j)  (2304 + 64 * (j))
#define XB_TOP      3328
#define XB_TOPGEN   3392
#define XCD_BAR_WORDS 3456
#define XB_SPIN_CAP (1u << 22)
#define LAS __attribute__((address_space(3)))
__device__ __forceinline__ unsigned xb_ld(unsigned* p)              { return __hip_atomic_load(p, __ATOMIC_RELAXED, __HIP_MEMORY_SCOPE_AGENT); }
__device__ __forceinline__ unsigned xb_add(unsigned* p, unsigned v) { return __hip_atomic_fetch_add(p, v, __ATOMIC_RELAXED, __HIP_MEMORY_SCOPE_AGENT); }
__device__ __forceinline__ unsigned xb_xcc_id() { return (unsigned)__builtin_amdgcn_s_getreg((3 << 11) | 20) & 0xFu; }
#define XB_SPIN(cond, bar) do { unsigned _sp = 0; while (cond) { __builtin_amdgcn_s_sleep(1); \
    if ((++_sp & 255u) == 0u) { if (xb_ld(&(bar)[XB_TMO])) break; if (_sp > XB_SPIN_CAP) { atomicAdd(&(bar)[XB_TMO], 1u); break; } } } } while (0)
struct XcdBarrier { unsigned* bar; unsigned x; volatile LAS unsigned* st; };
__device__ __forceinline__ XcdBarrier xcd_barrier_post(unsigned* bar, volatile LAS unsigned* st) {
  XcdBarrier b; b.bar = bar; b.x = xb_xcc_id(); b.st = st;
  if (threadIdx.x == 0) st[2] = xb_add(&bar[XB_XCNT(b.x)], 1u);
  return b;
}
__device__ __forceinline__ void xcd_barrier_complete(unsigned* bar, unsigned x, unsigned& nloc, unsigned& nx) {
  const unsigned G = gridDim.x * gridDim.y * gridDim.z;
  unsigned sum, cnt, mine, sp = 0u;
  for (;;) {
    sum = 0u; cnt = 0u; mine = 0u;
#pragma unroll
    for (unsigned j = 0; j < 16; ++j) { const unsigned c = xb_ld(&bar[XB_XCNT(j)]); sum += c; cnt += (c > 0u) ? 1u : 0u; mine = (j == x) ? c : mine; }
    if (sum == G) break;
    __builtin_amdgcn_s_sleep(1);
    if ((++sp & 255u) == 0u) { if (xb_ld(&bar[XB_TMO])) break; if (sp > XB_SPIN_CAP) { atomicAdd(&bar[XB_TMO], 1u); break; } }
  }
  nloc = mine > 0u ? mine : 1u; nx = cnt > 0u ? cnt : 1u;
}
__device__ __forceinline__ void xcd_barrier(const XcdBarrier& b) {
  asm volatile("s_waitcnt vmcnt(0)" ::: "memory");
  __syncthreads();
  if (threadIdx.x == 0) {
    unsigned* bar = b.bar;
    __builtin_amdgcn_s_waitcnt(0);
    unsigned nloc = b.st[0], nx = b.st[1];
    if (nloc == 0u) { xcd_barrier_complete(bar, b.x, nloc, nx); b.st[0] = nloc; b.st[1] = nx; }
    const unsigned old = xb_add(&bar[XB_XSUB(b.x)], 1u);
    const unsigned gen = old / nloc;
    if (old + 1u == (gen + 1u) * nloc) {
      __builtin_amdgcn_fence(__ATOMIC_RELEASE, "agent");
      asm volatile("s_waitcnt vmcnt(0)" ::: "memory");
      const unsigned og = xb_add(&bar[XB_TOP], 1u);
      const unsigned tg = og / nx;
      if (og + 1u == (tg + 1u) * nx) xb_add(&bar[XB_TOPGEN], 1u);
      else XB_SPIN(xb_ld(&bar[XB_TOPGEN]) == tg, bar);
      __builtin_amdgcn_fence(__ATOMIC_ACQUIRE, "agent");
      xb_add(&bar[XB_XGEN(b.x)], 1u);
      asm volatile("s_waitcnt vmcnt(0)" ::: "memory");
    } else {
      XB_SPIN(xb_ld(&bar[XB_XGEN(b.x)]) == gen, bar);
      __builtin_amdgcn_fence(__ATOMIC_ACQUIRE, "agent");
      asm volatile("s_waitcnt vmcnt(0)" ::: "memory");
    }
  }
  __syncthreads();
}

__device__ __forceinline__ void phase_mod(PRef p, int bid, int nblk, unsigned char* smem) {
  float* sil = (float*)smem;
  float* red = sil + 5 * 1024;
  const int tid = opaque_tid();
  if (bid < 192) {
    float v[10];
#pragma unroll
    for (int j = 0; j < 10; ++j) { const int i = tid + j * NT, r = i >> 10, k = i & 1023; v[j] = r < 4 ? p.c[r * 1024 + k] : p.c_ctx[k]; }
#pragma unroll
    for (int j = 0; j < 10; ++j) sil[tid + j * NT] = silu_f(v[j]);
  }
  __syncthreads();
  for (int item = bid; item < 192; item += nblk) {
    const int l = item / 96, j0 = (item % 96) * 64;
    const int lane = tid & 63, kg = tid >> 6, c4 = (lane & 15) * 4, rsub = lane >> 4;
    f32x4 acc[5];
#pragma unroll
    for (int r = 0; r < 5; ++r) acc[r] = (f32x4){0.f, 0.f, 0.f, 0.f};
    const float* w = p.w_mod + (size_t)l * 1024 * NMOD + j0 + c4;
#pragma unroll 1
    for (int jb = 0; jb < 4; ++jb) {
      f32x4 wv[8];
#pragma unroll
      for (int j = 0; j < 8; ++j) wv[j] = *(const f32x4*)(w + (size_t)(kg * 128 + rsub + 4 * (jb * 8 + j)) * NMOD);
#pragma unroll
      for (int j = 0; j < 8; ++j) {
        const int k = kg * 128 + rsub + 4 * (jb * 8 + j);
#pragma unroll
        for (int r = 0; r < 5; ++r) acc[r] += sil[r * 1024 + k] * wv[j];
      }
    }
#pragma unroll
    for (int r = 0; r < 5; ++r)
#pragma unroll
      for (int q = 0; q < 4; ++q) { float v = acc[r][q]; v += xor_lane_f<16>(v); v += xor_lane_f<32>(v); acc[r][q] = v; }
    if (rsub == 0) {
#pragma unroll
      for (int r = 0; r < 5; ++r) *(f32x4*)(red + (kg * 5 + r) * 64 + c4) = acc[r];
    }
    __syncthreads();
    if (tid < 320) {
      const int r = tid >> 6, cc = tid & 63;
      float s = 0.f;
#pragma unroll
      for (int g = 0; g < 8; ++g) s += red[(g * 5 + r) * 64 + cc];
      p.modv[((size_t)l * 5 + r) * NMOD + j0 + cc] = s + p.b_mod[l * NMOD + j0 + cc];
    }
    __syncthreads();
  }
}

__device__ __forceinline__ void transpose_tile(const float* src, int ldsrc, bf16_t* dst, int lddst, int k0, int r0, int nsrc, int glu, float* tile) {
  const int tid = opaque_tid();
  const int j = tid & 63;
  const int r = r0 + j;
  int scol;
  if (glu) {
    const int pn = r >> 8, bj = (r >> 7) & 1, i = r & 127;
    scol = bj * 256 + pn * 128 + i;
  } else {
    scol = r < nsrc ? r : -1;
  }
  float v[32];
#pragma unroll
  for (int it = 0; it < 32; ++it) {
    const int kk = (tid >> 6) + it * 8;
    v[it] = scol >= 0 ? src[(size_t)(k0 + kk) * ldsrc + scol] : 0.f;
  }
#pragma unroll
  for (int it = 0; it < 32; ++it) {
    const int kk = (tid >> 6) + it * 8;
    tile[(kk >> 6) * 4160 + (kk & 63) * 65 + j] = v[it];
  }
  __syncthreads();
  const int kq = tid & 63;
#pragma unroll
  for (int it = 0; it < 32; ++it) {
    const int jj = (tid >> 6) + (it & 7) * 8, sub = it >> 3;
    dst[(size_t)(r0 + jj) * lddst + k0 + sub * 64 + kq] = f2bf(tile[sub * 4160 + kq * 65 + jj]);
  }
  __syncthreads();
}

__device__ __forceinline__ void s5_tables(PRef p, int id, int part, unsigned char* smem) {
  const int tid = opaque_tid();
  float2* Apow = (float2*)smem;
  float2* Bbs = Apow + 65 * 64;
  float2* Cs = Bbs + 64 * 16;
  __syncthreads();
  if (tid < 64) {
    const int pid = id * 64 + tid;
    float lre = p.lam_re[pid];
    if (lre > -1e-4f) lre = -1e-4f;
    const float lim = p.lam_im[pid];
    const float dt = expf(p.log_step[id]);
    const float x = lre * dt, th = lim * dt;
    const float em1 = expm1f(x), mag = em1 + 1.f;
    const float cs = cosf(th), sn = sinf(th), sh = sinf(0.5f * th);
    const float are = mag * cs, aim = mag * sn;
    const float am1 = em1 * cs - 2.f * sh * sh;
    {
      float pr = 1.f, pi = 0.f;
      for (int n = 0; n <= 64; ++n) {
        Apow[n * 64 + tid] = make_float2(pr, pi);
        const float nr = pr * are - pi * aim, ni = pr * aim + pi * are;
        pr = nr; pi = ni;
      }
    }
    const float den = lre * lre + lim * lim;
    const float fre = (am1 * lre + aim * lim) / den;
    const float fim = (aim * lre - am1 * lim) / den;
    const f32x4* brp = (const f32x4*)(p.b_re + (size_t)pid * 16);
    const f32x4* bip = (const f32x4*)(p.b_im + (size_t)pid * 16);
    f32x4 brv[4], biv[4];
#pragma unroll
    for (int q = 0; q < 4; ++q) { brv[q] = brp[q]; biv[q] = bip[q]; }
#pragma unroll
    for (int h = 0; h < 16; ++h) {
      const float br = brv[h >> 2][h & 3], bi = biv[h >> 2][h & 3];
      Bbs[tid * 16 + h] = make_float2(fre * br - fim * bi, fre * bi + fim * br);
    }
  }
  for (int e = tid; e < 1024; e += NT) Cs[(e >> 6) * 65 + (e & 63)] = make_float2(p.c_re[(size_t)id * 1024 + e], p.c_im[(size_t)id * 1024 + e]);
  __syncthreads();
  {
    bf16_t* Kt = p.s5K + (size_t)id * 16384;
#pragma unroll 1
    for (int dh = 0; dh < 2; ++dh) {
    const int d = part * 16 + dh * 8 + (tid >> 6), hp = (tid >> 2) & 15, hq = tid & 3;
    float acc[4] = {0.f, 0.f, 0.f, 0.f};
#pragma unroll 4
    for (int pp = 0; pp < 64; ++pp) {
      const float2 c = Cs[hp * 65 + pp], a = Apow[d * 64 + pp];
      const float cr = c.x * a.x - c.y * a.y, ci = c.x * a.y + c.y * a.x;
      const f32x4 b01 = *(const f32x4*)(Bbs + pp * 16 + hq * 4), b23 = *(const f32x4*)(Bbs + pp * 16 + hq * 4 + 2);
      acc[0] += cr * b01[0] - ci * b01[1]; acc[1] += cr * b01[2] - ci * b01[3];
      acc[2] += cr * b23[0] - ci * b23[1]; acc[3] += cr * b23[2] - ci * b23[3];
    }
    *(uint2*)(Kt + d * 256 + hp * 16 + hq * 4) = make_uint2(pk_bf16(acc[0], acc[1]), pk_bf16(acc[2], acc[3]));
    }
  }
  bf16_t* M1 = p.s5M1 + (size_t)id * 131072;
  bf16_t* N2 = p.s5N2 + (size_t)id * 131072;
#pragma unroll 1
  for (int it = 0; it < 8; ++it) {
    const int e0 = (part * 4096 + it * NT + tid) * 8;
    const int fl = (e0 >> 3) & 63;
    {
      const int frag = e0 >> 9, c = (frag >> 5) * 16 + (fl & 15), k0 = (frag & 31) * 32 + (fl >> 4) * 8;
      const int ri = c >> 6, pp = c & 63, tau = k0 >> 4, h0 = k0 & 15;
      const float2 av = Apow[(63 - tau) * 64 + pp];
      float o[8];
#pragma unroll
      for (int j = 0; j < 8; ++j) { const float2 bv = Bbs[pp * 16 + h0 + j]; o[j] = ri ? (av.x * bv.y + av.y * bv.x) : (av.x * bv.x - av.y * bv.y); }
      *(bf16x8*)(M1 + e0) = pack_bf16x8(o);
    }
    {
      const int frag = e0 >> 9, col = (frag >> 2) * 16 + (fl & 15), kk0 = (frag & 3) * 32 + (fl >> 4) * 8;
      const int tau = col >> 4, hp = col & 15, ri = kk0 >> 6, pp0 = kk0 & 63;
      float o[8];
#pragma unroll
      for (int j = 0; j < 8; ++j) {
        const float2 c = Cs[hp * 65 + pp0 + j], av = Apow[(tau + 1) * 64 + pp0 + j];
        o[j] = ri ? -(c.x * av.y + c.y * av.x) : (c.x * av.x - c.y * av.y);
      }
      *(bf16x8*)(N2 + e0) = pack_bf16x8(o);
    }
  }
  __syncthreads();
}

__device__ __forceinline__ unsigned pack_i8x4(float a, float b, float c, float d) {
  const int ia = __float2int_rn(a), ib = __float2int_rn(b), ic = __float2int_rn(c), id = __float2int_rn(d);
  return ((unsigned)ia & 255u) | (((unsigned)ib & 255u) << 8) | (((unsigned)ic & 255u) << 16) | ((unsigned)id << 24);
}
__device__ __forceinline__ unsigned pack_i8x4_scaled(float a, float b, float c, float d, float s) {
  const unsigned ua = __float_as_uint(fmaf(a, s, 12582912.f)), ub = __float_as_uint(fmaf(b, s, 12582912.f));
  const unsigned uc = __float_as_uint(fmaf(c, s, 12582912.f)), ud = __float_as_uint(fmaf(d, s, 12582912.f));
  const unsigned lo = __builtin_amdgcn_perm(ub, ua, 0x0c0c0400u), hi = __builtin_amdgcn_perm(ud, uc, 0x0c0c0400u);
  return __builtin_amdgcn_perm(hi, lo, 0x05040100u);
}
__device__ __forceinline__ void convert_rows(PRef p, int it, int tid) {
      const int lane = tid & 63;
      const int row0 = it * 16 + (tid >> 6) * 2;
      const int tab = row0 >> 15, r0 = row0 & 32767;
      const float* s = (tab ? p.exp_v : p.exp_u) + (size_t)r0 * 1024 + lane * 16;
      f32x4 v[2][4];
#pragma unroll
      for (int rr = 0; rr < 2; ++rr)
#pragma unroll
        for (int q = 0; q < 4; ++q) v[rr][q] = *(const f32x4*)(s + rr * 1024 + q * 4);
#pragma unroll
      for (int rr = 0; rr < 2; ++rr) {
        float m = 0.f;
#pragma unroll
        for (int q = 0; q < 4; ++q) m = fmaxf(m, fmaxf(fmaxf(fabsf(v[rr][q][0]), fabsf(v[rr][q][1])), fmaxf(fabsf(v[rr][q][2]), fabsf(v[rr][q][3]))));
#pragma unroll
        for (int o = 32; o > 0; o >>= 1) m = fmaxf(m, __shfl_xor(m, o));
        const float scale = m > 0.f ? m * (tab ? 1.f / 400.f : 1.f / 127.f) : 1.f;
        const float inv = 1.f / scale;
        unsigned wv[4];
#pragma unroll
        for (int q = 0; q < 4; ++q) {
          unsigned w = 0;
          if (tab) {
            w = __builtin_amdgcn_cvt_pk_fp8_f32(v[rr][q][0] * inv, v[rr][q][1] * inv, w, false);
            w = __builtin_amdgcn_cvt_pk_fp8_f32(v[rr][q][2] * inv, v[rr][q][3] * inv, w, true);
          } else {
            w = pack_i8x4(v[rr][q][0] * inv, v[rr][q][1] * inv, v[rr][q][2] * inv, v[rr][q][3] * inv);
          }
          wv[q] = w;
        }
        *(uint4*)((tab ? p.ev8 : p.eu8) + (size_t)(r0 + rr) * 1024 + lane * 16) = make_uint4(wv[0], wv[1], wv[2], wv[3]);
        if (lane == 0) (tab ? p.sv : p.su)[r0 + rr] = scale;
      }
}

__device__ __forceinline__ void phase_wprep(PRef p, int bid, int nblk, unsigned char* smem) {
  float* tile = (float*)smem;
  const int tid = opaque_tid();
  const int NT_L = 360;
  const int n_tr = 2 * NT_L;
  const int n_keys = 256 + 64;
  const int n_disc = 8;
  const int n_exp = 2048;
  const int n_s5t = 256;
  const int total = n_tr + n_keys + n_disc + n_exp + n_s5t;
  for (int item0 = bid; item0 < total; item0 += nblk) {
    const int item = item0 - n_s5t;
    if (item0 < n_s5t) {
      s5_tables(p, item0 >> 2, item0 & 3, smem);
    } else if (item < n_tr) {
      const int l = item / NT_L;
      int t = item % NT_L;
      if (t < 160) {
        transpose_tile(p.w_in + (size_t)l * 1024 * INW, INW, p.wt_in + (size_t)l * INWP * 1024, 1024, (t % 4) * 256, (t / 4) * 64, INW, 0, tile);
      } else if (t < 224) {
        t -= 160;
        transpose_tile(p.w_out + (size_t)l * 1024 * 1024, 1024, p.wt_out + (size_t)l * 1024 * 1024, 1024, (t % 4) * 256, (t / 4) * 64, 1024, 0, tile);
      } else if (t < 352) {
        t -= 224;
        transpose_tile(p.w_query + (size_t)l * 1024 * 2048, 2048, p.wt_q + (size_t)l * 2048 * 1024, 1024, (t % 4) * 256, (t / 4) * 64, 2048, 0, tile);
      } else {
        t -= 352;
        transpose_tile(p.w_glu + (size_t)l * 256 * 512, 512, p.wt_glu + (size_t)l * 512 * 256, 256, 0, t * 64, 512, 1, tile);
      }
    } else if (item < n_tr + n_keys) {
      const int ki = item - n_tr;
      if (ki < 256) {
        const int base = ki * 2048;
        for (int i = tid; i < 2048; i += NT) p.keysb[base + i] = f2bf(p.sub_keys[base + i]);
      } else {
        const int base = (ki - 256) * 2048;
        for (int i = tid; i < 2048; i += NT) p.sgu_wb[base + i] = f2bf(p.sgu_w[base + i]);
      }
    } else if (item >= n_tr + n_keys + n_disc) {
      const int j = item - (n_tr + n_keys + n_disc);
      convert_rows(p, (j >> 10) * 2048 + (j & 1023), tid);
    } else {
      const int id = (item - n_tr - n_keys) * NT + tid;
      const int g = (id >> 6) & 15;
      const int ldg = id >> 6;
      double lre = (double)p.lam_re[id];
      if (lre > -1e-4) lre = -1e-4;
      const double lim = (double)p.lam_im[id];
      const double dt = exp((double)p.log_step[ldg]);
      const double mag = exp(lre * dt);
      const double are = mag * cos(lim * dt), aim = mag * sin(lim * dt);
      const double den = lre * lre + lim * lim;
      const double fre = ((are - 1.0) * lre + aim * lim) / den;
      const double fim = (aim * lre - (are - 1.0) * lim) / den;
      p.s5a[id * 2 + 0] = (float)are;
      p.s5a[id * 2 + 1] = (float)aim;
      double pr = are, pi = aim;
      for (int s = 0; s < 6; ++s) { const double nr = pr * pr - pi * pi, ni = 2.0 * pr * pi; pr = nr; pi = ni; }
      p.s5a64[id * 2 + 0] = (float)pr;
      p.s5a64[id * 2 + 1] = (float)pi;
      for (int h = 0; h < 16; ++h) {
        const double br = (double)p.b_re[(size_t)id * 16 + h], bi = (double)p.b_im[(size_t)id * 16 + h];
        p.s5bb[(size_t)id * 32 + h] = (float)(fre * br - fim * bi);
        p.s5bb[(size_t)id * 32 + 16 + h] = (float)(fre * bi + fim * br);
      }
      (void)g;
    }
  }
}

__device__ __forceinline__ void phase_normmod(PRef p, const float* src_l, const float* src_c, const float* gain, const float* modl, int shift_off, int scale_off,
                              int ntok, int copy, int bid, int nblk) {
  const int tid = opaque_tid(); const int lane = tid & 63, wid = tid >> 6;
  for (int t = bid * NW + wid; t < ntok; t += nblk * NW) {
    const float* row = t < TL ? src_l + (size_t)t * 1024 : src_c + (size_t)(t - TL) * 1024;
    const float* md = modl + (size_t)tok_batch(t) * NMOD;
    f32x4 v[4];
    float ss = 0.f;
#pragma unroll
    for (int j = 0; j < 4; ++j) {
      v[j] = *(const f32x4*)(row + j * 256 + lane * 4);
      ss += v[j][0] * v[j][0] + v[j][1] * v[j][1] + v[j][2] * v[j][2] + v[j][3] * v[j][3];
    }
    ss = wave_sum(ss);
    const float rstd = rsqrtf(ss * (1.f / 1024.f) + EPSV);
#pragma unroll
    for (int j = 0; j < 4; ++j) {
      const int c0 = j * 256 + lane * 4;
      const f32x4 g = *(const f32x4*)(gain + c0);
      const f32x4 sh = *(const f32x4*)(md + shift_off + c0);
      const f32x4 sc = *(const f32x4*)(md + scale_off + c0);
      ushort4 o;
      o.x = f2bf(v[j][0] * rstd * g[0] * (1.f + sc[0]) + sh[0]);
      o.y = f2bf(v[j][1] * rstd * g[1] * (1.f + sc[1]) + sh[1]);
      o.z = f2bf(v[j][2] * rstd * g[2] * (1.f + sc[2]) + sh[2]);
      o.w = f2bf(v[j][3] * rstd * g[3] * (1.f + sc[3]) + sh[3]);
      *(ushort4*)(p.abuf + (size_t)t * 1024 + c0) = o;
      if (copy) *(f32x4*)(p.xres + (size_t)t * 1024 + c0) = v[j];
    }
  }
}

namespace pg8 {
#define PG8_LAS __attribute__((address_space(3)))
typedef unsigned u32x4 __attribute__((ext_vector_type(4)));
constexpr int BM = 256, BK = 64, HALF = 128, HTB = HALF * BK * 2, STAGE_BYTES = 8 * HTB, NXCD = 8, WGM = 8;
__device__ __forceinline__ int lds_byte(int r, int c) { const int st = (r >> 4) * 2 + (c >> 5), rr = r & 15, cc = c & 31, ob = rr * 64 + cc * 2; return st * 1024 + (ob ^ (((ob >> 9) & 1) << 5)); }
__device__ __forceinline__ void stage_rc(int b, int& R, int& C) { const int st = b / 1024, sb = b % 1024, swz = sb ^ (((sb >> 9) & 1) << 5); R = (st >> 1) * 16 + swz / 64; C = (st & 1) * 32 + (swz % 64) / 2; }
__device__ __forceinline__ int perm32(int rho) { const int n = rho >> 4, i = rho & 15; return 8 * (i >> 2) + 4 * n + (i & 3); }
struct Unit { int pm, pn; };
struct Gemm { const bf16_t* A; const bf16_t* Bt; int M, N, K; };
struct StaticOrder {
  int nM, nN, nwg, G, c;
  __device__ void init(int M, int N, int G_, int c_) { nM = M / BM; nN = N / BM; nwg = nM * nN; G = G_; c = c_; }
  __device__ bool next(int i, Unit& u) const {
    const long L = (long)i * G + c; if (L >= nwg) return false;
    int wgid = (int)L; { const int q = nwg / NXCD, r = nwg % NXCD, xcd = wgid % NXCD, off = wgid / NXCD; wgid = (xcd < r ? xcd * (q + 1) : r * (q + 1) + (xcd - r) * q) + off; }
    const int nig = WGM * nN, gid = wgid / nig, fm = gid * WGM, gsz = (nM - fm) < WGM ? (nM - fm) : WGM;
    u.pm = fm + ((wgid % nig) % gsz); u.pn = (wgid % nig) / gsz; return true;
  }
};
__device__ __forceinline__ unsigned cvt_pk_bf16(float lo, float hi) { unsigned r; asm volatile("v_cvt_pk_bf16_f32 %0, %1, %2" : "=v"(r) : "v"(lo), "v"(hi)); return r; }

template <class Epi>
__device__ __forceinline__ void gemm_phase(PG8_LAS unsigned char* lds, const Gemm g, const StaticOrder& S, const Epi& E) {
  const int tid = opaque_tid(), wid = __builtin_amdgcn_readfirstlane(tid >> 6), lane = tid & 63, wr = wid >> 2, wc = wid & 3, fr = lane & 15, fq = lane >> 4;
  const int K = g.K, nt = K / BK;
  unsigned voffA[2], voffB[2];
#pragma unroll
  for (int i = 0; i < 2; ++i) { int R, C; stage_rc(tid * 16 + i * 8192, R, C); const int Rb = Epi::PERM ? ((R & ~31) + perm32(R & 31)) : R;
    voffA[i] = (unsigned)(R * K + C) * 2u; voffB[i] = (unsigned)(Rb * K + C) * 2u; }
  const size_t kstep = (size_t)(BK * 2);
  const size_t hstep = (size_t)HALF * K * 2;
  const size_t tstep = 2 * hstep;
  const unsigned ldsw = (unsigned)wid * 1024u;
  const int aoff = lds_byte(wr * 64 + fr, fq * 8), boff = lds_byte(wc * 32 + fr, fq * 8);
#define PG8_SA(b, h) (((b) * 2 + (h)) * HTB)
#define PG8_SB(b, h) ((4 + (b) * 2 + (h)) * HTB)
#define PG8_STAGE(bufoff, gbase, voff) do { _Pragma("unroll") for (int _i = 0; _i < 2; ++_i) \
    __builtin_amdgcn_global_load_lds((const unsigned*)((const char*)(gbase) + (voff)[_i]), (PG8_LAS unsigned*)(lds + (bufoff) + ldsw + _i * 8192), 16, 0, 0); } while (0)
#define PG8_LDA(dst, b, h) do { _Pragma("unroll") for (int m = 0; m < 4; ++m) _Pragma("unroll") for (int k = 0; k < 2; ++k) dst[m][k] = *(const PG8_LAS bf16x8*)(lds + PG8_SA(b, h) + aoff + m * 2048 + k * 1024); } while (0)
#define PG8_LDB(dst, b, h) do { _Pragma("unroll") for (int n = 0; n < 2; ++n) _Pragma("unroll") for (int k = 0; k < 2; ++k) dst[n][k] = *(const PG8_LAS bf16x8*)(lds + PG8_SB(b, h) + boff + n * 2048 + k * 1024); } while (0)
#define PG8_MMA(ai, bj, At, Bt) do { __builtin_amdgcn_s_setprio(1); _Pragma("unroll") for (int m = 0; m < 4; ++m) _Pragma("unroll") for (int n = 0; n < 2; ++n) _Pragma("unroll") for (int k = 0; k < 2; ++k) \
    acc[ai][bj][m][n] = __builtin_amdgcn_mfma_f32_16x16x32_bf16(Bt[n][k], At[m][k], acc[ai][bj][m][n], 0, 0, 0); __builtin_amdgcn_s_setprio(0); } while (0)
#define PG8_WAIT_V(n) asm volatile("s_waitcnt vmcnt(" #n ")" ::: "memory")
#define PG8_WAIT_L(n) asm volatile("s_waitcnt lgkmcnt(" #n ")" ::: "memory")
#define PG8_BAR __builtin_amdgcn_s_barrier()
#define PG8_SCHED __builtin_amdgcn_sched_barrier(0)
  Unit cur, nxt; int ui = 0;
  if (!S.next(0, cur)) return;
  f32x4 acc[2][2][4][2];
#pragma unroll
  for (int a = 0; a < 2; ++a)
#pragma unroll
    for (int b = 0; b < 2; ++b)
#pragma unroll
      for (int m = 0; m < 4; ++m)
#pragma unroll
        for (int n = 0; n < 2; ++n) acc[a][b][m][n] = (f32x4){0.f, 0.f, 0.f, 0.f};
  bf16x8 At[4][2], B0[2][2], B1[2][2];
  const char* cA = (const char*)g.A + (size_t)cur.pm * tstep; const char* cB = (const char*)g.Bt + (size_t)cur.pn * tstep;
  PG8_STAGE(PG8_SB(0, 0), cB, voffB); PG8_STAGE(PG8_SA(0, 0), cA, voffA); PG8_STAGE(PG8_SB(0, 1), cB + hstep, voffB); PG8_STAGE(PG8_SA(0, 1), cA + hstep, voffA);
  if (wr == 1) PG8_BAR;
  PG8_WAIT_V(4); PG8_BAR;
  PG8_STAGE(PG8_SB(1, 0), cB + kstep, voffB); PG8_STAGE(PG8_SA(1, 0), cA + kstep, voffA); PG8_STAGE(PG8_SB(1, 1), cB + hstep + kstep, voffB);
  PG8_WAIT_V(6); PG8_BAR;
  for (;;) {
    const bool has_next = S.next(ui + 1, nxt);
    const char* nA = has_next ? (const char*)g.A + (size_t)nxt.pm * tstep : cA; const char* nB = has_next ? (const char*)g.Bt + (size_t)nxt.pn * tstep : cB;
#pragma unroll 1
    for (int t = 0; t < nt; t += 2) {
      const bool last = (t == nt - 2);
      const char* a1 = cA + (size_t)(t + 1) * kstep;
      const char* a2 = last ? nA : cA + (size_t)(t + 2) * kstep; const char* b2 = last ? nB : cB + (size_t)(t + 2) * kstep;
      const char* a3 = a2 + kstep; const char* b3 = b2 + kstep;
      PG8_LDB(B0, 0, 0); PG8_SCHED; PG8_LDA(At, 0, 0); PG8_STAGE(PG8_SA(1, 1), a1 + hstep, voffA);
      PG8_WAIT_L(8); PG8_BAR; PG8_WAIT_L(0); PG8_MMA(0, 0, At, B0); PG8_BAR; PG8_SCHED;
      PG8_LDB(B1, 0, 1); PG8_STAGE(PG8_SB(0, 0), b2, voffB);
      PG8_BAR; PG8_WAIT_L(0); PG8_MMA(0, 1, At, B1); PG8_BAR;
      PG8_LDA(At, 0, 1); PG8_STAGE(PG8_SA(0, 0), a2, voffA);
      PG8_BAR; PG8_WAIT_L(0); PG8_MMA(1, 0, At, B0); PG8_BAR; PG8_SCHED;
      PG8_STAGE(PG8_SB(0, 1), b2 + hstep, voffB);
      PG8_WAIT_V(6); PG8_BAR; PG8_MMA(1, 1, At, B1); PG8_BAR;
      PG8_LDB(B0, 1, 0); PG8_SCHED; PG8_LDA(At, 1, 0); PG8_STAGE(PG8_SA(0, 1), a2 + hstep, voffA);
      PG8_WAIT_L(8); PG8_BAR; PG8_WAIT_L(0); PG8_MMA(0, 0, At, B0); PG8_BAR; PG8_SCHED;
      PG8_LDB(B1, 1, 1); PG8_STAGE(PG8_SB(1, 0), b3, voffB);
      PG8_BAR; PG8_WAIT_L(0); PG8_MMA(0, 1, At, B1); PG8_BAR;
      PG8_LDA(At, 1, 1); PG8_STAGE(PG8_SA(1, 0), a3, voffA);
      PG8_BAR; PG8_WAIT_L(0); PG8_MMA(1, 0, At, B0); PG8_BAR; PG8_SCHED;
      PG8_STAGE(PG8_SB(1, 1), b3 + hstep, voffB);
      PG8_WAIT_V(6); PG8_BAR; PG8_MMA(1, 1, At, B1); PG8_BAR;
    }
    E(acc, cur, wr, wc, fr, fq);
    if (!has_next) break;
#pragma unroll
    for (int a = 0; a < 2; ++a)
#pragma unroll
      for (int b = 0; b < 2; ++b)
#pragma unroll
        for (int m = 0; m < 4; ++m)
#pragma unroll
          for (int n = 0; n < 2; ++n) acc[a][b][m][n] = (f32x4){0.f, 0.f, 0.f, 0.f};
    cur = nxt; cA = nA; cB = nB; ++ui;
  }
  PG8_WAIT_V(0);
  if (wr == 0) PG8_BAR;
  PG8_BAR;
#undef PG8_SA
#undef PG8_SB
#undef PG8_STAGE
#undef PG8_LDA
#undef PG8_LDB
#undef PG8_MMA
#undef PG8_WAIT_V
#undef PG8_WAIT_L
#undef PG8_BAR
#undef PG8_SCHED
}

struct EpiBf16 {
  static constexpr bool PERM = true;
  bf16_t* O; int ldc; int ncols;
  __device__ __forceinline__ void operator()(const f32x4 (&acc)[2][2][4][2], const Unit& u, int wr, int wc, int fr, int fq) const {
    const int row0 = u.pm * BM + wr * 64 + fr, col0 = u.pn * BM + wc * 32 + 8 * fq;
#pragma unroll
    for (int ai = 0; ai < 2; ++ai)
#pragma unroll
      for (int m = 0; m < 4; ++m) {
        bf16_t* rowp = O + (size_t)(row0 + ai * HALF + m * 16) * ldc + col0;
#pragma unroll
        for (int bj = 0; bj < 2; ++bj) {
          if (col0 + bj * HALF < ncols) {
            const f32x4 v0 = acc[ai][bj][m][0], v1 = acc[ai][bj][m][1];
            u32x4 w; w.x = cvt_pk_bf16(v0[0], v0[1]); w.y = cvt_pk_bf16(v0[2], v0[3]); w.z = cvt_pk_bf16(v1[0], v1[1]); w.w = cvt_pk_bf16(v1[2], v1[3]);
            *(u32x4*)(rowp + bj * HALF) = w;
          }
        }
      }
  }
};
struct EpiIn {
  static constexpr bool PERM = true;
  bf16_t* O; bf16_t* s5u;
  __device__ __forceinline__ void operator()(const f32x4 (&acc)[2][2][4][2], const Unit& u, int wr, int wc, int fr, int fq) const {
    const int row0 = u.pm * BM + wr * 64 + fr, col0 = u.pn * BM + wc * 32 + 8 * fq;
    const bool s5 = u.pn == 2;
#pragma unroll
    for (int ai = 0; ai < 2; ++ai)
#pragma unroll
      for (int m = 0; m < 4; ++m) {
        const int row = row0 + ai * HALF + m * 16;
#pragma unroll
        for (int bj = 0; bj < 2; ++bj) {
          const int c = col0 + bj * HALF;
          if (c < INW) {
            const f32x4 v0 = acc[ai][bj][m][0], v1 = acc[ai][bj][m][1];
            u32x4 w; w.x = cvt_pk_bf16(v0[0], v0[1]); w.y = cvt_pk_bf16(v0[2], v0[3]); w.z = cvt_pk_bf16(v1[0], v1[1]); w.w = cvt_pk_bf16(v1[2], v1[3]);
            bf16_t* dst = s5 ? s5u + ((size_t)((c - 512) >> 4) * TT + row) * 16 + (c & 8) : O + (size_t)row * INW + c;
            *(u32x4*)dst = w;
          }
        }
      }
  }
};
struct EpiResid {
  static constexpr bool PERM = false;
  float* xres; const float* res_lat; const float* res_ctx; const float* modl; int gate_off;
  __device__ __forceinline__ void operator()(const f32x4 (&acc)[2][2][4][2], const Unit& u, int wr, int wc, int fr, int fq) const {
    const int row0 = u.pm * BM + wr * 64 + fr, col0 = u.pn * BM + wc * 32 + 4 * fq;
#pragma unroll
    for (int ai = 0; ai < 2; ++ai)
#pragma unroll
      for (int m = 0; m < 4; ++m) {
        const int row = row0 + ai * HALF + m * 16;
        float* rowp = xres + (size_t)row * 1024 + col0;
        const float* resp = (row < TL ? res_lat + (size_t)row * 1024 : res_ctx + (size_t)(row - TL) * 1024) + col0;
        const float* md = modl + (size_t)tok_batch(row) * NMOD + gate_off + col0;
#pragma unroll
        for (int bj = 0; bj < 2; ++bj)
#pragma unroll
          for (int n = 0; n < 2; ++n) {
            const f32x4 g = *(const f32x4*)(md + bj * HALF + n * 16);
            f32x4 x = *(const f32x4*)(resp + bj * HALF + n * 16);
            x += g * acc[ai][bj][m][n];
            *(f32x4*)(rowp + bj * HALF + n * 16) = x;
          }
      }
  }
};
struct EpiGlu {
  static constexpr bool PERM = true;
  bf16_t* mix;
  __device__ __forceinline__ void operator()(const f32x4 (&acc)[2][2][4][2], const Unit& u, int wr, int wc, int fr, int fq) const {
    const int row0 = u.pm * BM + wr * 64 + fr, col0 = 256 + u.pn * HALF + wc * 32 + 8 * fq;
#pragma unroll
    for (int ai = 0; ai < 2; ++ai)
#pragma unroll
      for (int m = 0; m < 4; ++m) {
        float v[8];
#pragma unroll
        for (int n = 0; n < 2; ++n)
#pragma unroll
          for (int j = 0; j < 4; ++j) v[n * 4 + j] = acc[ai][0][m][n][j] * sigmoid_f(acc[ai][1][m][n][j]);
        u32x4 w; w.x = cvt_pk_bf16(v[0], v[1]); w.y = cvt_pk_bf16(v[2], v[3]); w.z = cvt_pk_bf16(v[4], v[5]); w.w = cvt_pk_bf16(v[6], v[7]);
        *(u32x4*)(mix + (size_t)(row0 + ai * HALF + m * 16) * 1024 + col0) = w;
        __builtin_amdgcn_sched_barrier(0);
      }
  }
};
}

#define VNT_STRIDE 136
__device__ __forceinline__ void phase_sgu(PRef p, int layer, int nchunks, int bid, int nblk, unsigned char* smem) {
  bf16_t* vnT = (bf16_t*)smem;
  const int tid = opaque_tid(); const int lane = tid & 63, wid = tid >> 6;
  const int fr = lane & 15, fq = lane >> 4;
  for (int item = bid; item < nchunks * 4; item += nblk) {
    const int ch = item >> 2, h = item & 3;
    const int tok0 = ch * 128;
    {
      const int s = tid >> 2, q = tid & 3;
      const bf16_t* vrow = p.cols + (size_t)(tok0 + s) * INW + C_SGU_V + h * 64 + q * 16;
      const uint4 r0 = *(const uint4*)vrow, r1 = *(const uint4*)(vrow + 8);
      float gv[16];
      gv[0] = bflo(r0.x); gv[1] = bfhi(r0.x); gv[2] = bflo(r0.y); gv[3] = bfhi(r0.y); gv[4] = bflo(r0.z); gv[5] = bfhi(r0.z); gv[6] = bflo(r0.w); gv[7] = bfhi(r0.w);
      gv[8] = bflo(r1.x); gv[9] = bfhi(r1.x); gv[10] = bflo(r1.y); gv[11] = bfhi(r1.y); gv[12] = bflo(r1.z); gv[13] = bfhi(r1.z); gv[14] = bflo(r1.w); gv[15] = bfhi(r1.w);
      float ss = 0.f;
#pragma unroll
      for (int d = 0; d < 16; ++d) { gv[d] = gelu_f(gv[d]); ss += gv[d] * gv[d]; }
      ss += xor_lane_f<1>(ss);
      ss += xor_lane_f<2>(ss);
      const float rstd = rsqrtf(ss * (1.f / 64.f) + EPSV);
#pragma unroll
      for (int d = 0; d < 16; ++d) vnT[(q * 16 + d) * VNT_STRIDE + s] = f2bf(gv[d] * rstd);
    }
    __syncthreads();
    {
      const bf16_t* wrow = p.sgu_wb + (((size_t)layer * 4 + h) * 128 + wid * 16 + fr) * 128 + fq * 8;
      f32x4 acc[4];
#pragma unroll
      for (int n = 0; n < 4; ++n) acc[n] = (f32x4){0.f, 0.f, 0.f, 0.f};
#pragma unroll
      for (int ks = 0; ks < 4; ++ks) {
        const bf16x8 a = *(const bf16x8*)(wrow + ks * 32);
#pragma unroll
        for (int n = 0; n < 4; ++n) {
          const bf16x8 b = *(const bf16x8*)(vnT + (n * 16 + fr) * VNT_STRIDE + ks * 32 + fq * 8);
          acc[n] = __builtin_amdgcn_mfma_f32_16x16x32_bf16(a, b, acc[n], 0, 0, 0);
        }
      }
#pragma unroll
      for (int j = 0; j < 4; ++j) {
        const int t = wid * 16 + fq * 4 + j;
        const float bs = p.sgu_b[((size_t)layer * 4 + h) * 128 + t];
        const bf16_t* urow = p.cols + (size_t)(tok0 + t) * INW + C_SGU_U + h * 64;
        bf16_t* orow = p.mix + (size_t)(tok0 + t) * 1024 + h * 64;
#pragma unroll
        for (int n = 0; n < 4; ++n) orow[n * 16 + fr] = f2bf(gelu_f(bf2f(urow[n * 16 + fr])) * (acc[n][j] + bs));
      }
    }
    __syncthreads();
  }
}

#define S5A_RS 68
__device__ __forceinline__ void phase_s5a(PRef p, int layer, int bid, int nblk, unsigned char* smem) {
  const int tid = opaque_tid(); const int lane = tid & 63, wid = tid >> 6, fr = lane & 15, fq = lane >> 4;
  float* red = (float*)smem;
  for (int task = bid; task < 256; task += nblk) {
    const int mq = task & 3, nh = (task >> 2) & 1, g = (task >> 3) & 15, dir = task >> 7;
    const bf16_t* tab = p.s5M1 + (size_t)((layer * 2 + dir) * 16 + g) * 131072 + (size_t)(nh * 4 * 32 + wid * 4) * 512 + lane * 8;
    bf16x8 b[4][4];
#pragma unroll
    for (int ksl = 0; ksl < 4; ++ksl)
#pragma unroll
      for (int n = 0; n < 4; ++n) b[ksl][n] = *(const bf16x8*)(tab + (size_t)(n * 32 + ksl) * 512);
    f32x4 acc[5][4];
#pragma unroll
    for (int mi = 0; mi < 5; ++mi)
#pragma unroll
      for (int n = 0; n < 4; ++n) acc[mi][n] = (f32x4){0.f, 0.f, 0.f, 0.f};
    const bf16_t* ug = p.s5u + (size_t)g * TT * 16 + (fq & 1) * 8;
#pragma unroll
    for (int mi = 0; mi < 5; ++mi) {
      const int mt = mq + 4 * mi;
      if (mt < 17) {
        const int scr = mt * 16 + fr;
#pragma unroll
        for (int ksl = 0; ksl < 4; ++ksl) {
          const int tau = 8 * wid + 2 * ksl + (fq >> 1);
          const int i = dir ? 63 - tau : tau;
          const bf16x8 a = *(const bf16x8*)(ug + (size_t)s5_tok(scr, i) * 16);
#pragma unroll
          for (int n = 0; n < 4; ++n) acc[mi][n] = __builtin_amdgcn_mfma_f32_16x16x32_bf16(a, b[ksl][n], acc[mi][n], 0, 0, 0);
        }
      }
    }
#pragma unroll
    for (int r = 0; r < 2; ++r) {
      __syncthreads();
#pragma unroll
      for (int ml = 0; ml < 3; ++ml) {
        const int mi = 3 * r + ml;
        if (mi < 5) {
#pragma unroll
          for (int n = 0; n < 4; ++n)
#pragma unroll
            for (int j = 0; j < 4; ++j) red[((wid * 3 + ml) * 16 + fq * 4 + j) * S5A_RS + n * 16 + fr] = acc[mi < 5 ? mi : 0][n][j];
        }
      }
      __syncthreads();
#pragma unroll
      for (int ml = 0; ml < 3; ++ml) {
        const int mi = 3 * r + ml;
        const int mt = mq + 4 * mi;
        if (mi < 5 && mt < 17) {
#pragma unroll
          for (int k = 0; k < 2; ++k) {
            const int e = tid + NT * k, row = e >> 6, col = e & 63;
            float s = 0.f;
#pragma unroll
            for (int w = 0; w < 8; ++w) s += red[((w * 3 + ml) * 16 + row) * S5A_RS + col];
            p.s5S[(((size_t)dir * NSC + mt * 16 + row) * 16 + g) * 128 + nh * 64 + col] = s;
          }
        }
      }
    }
  }
  __syncthreads();
}

__device__ __forceinline__ int scan_sc(int s, int b, int dir) {
  return s < 4 ? 256 + b * 4 + (dir ? 3 - s : s) : b * 64 + (dir ? 63 - (s - 4) : (s - 4));
}
__device__ __forceinline__ void phase_scan(PRef p, int layer, int bid, int nblk) {
  const int tid = opaque_tid();
  for (int item = bid; item < 16 + 256; item += nblk) {
    if (item < 16) {
      const int id = item * NT + tid;
      const int pp = id & 63, g = (id >> 6) & 15, b = (id >> 10) & 3, dir = id >> 12;
      const int pid = ((layer * 2 + dir) * 16 + g) * 64 + pp;
      const float ar = p.s5a64[pid * 2], ai = p.s5a64[pid * 2 + 1];
      float hr = 0.f, hi = 0.f;
      for (int s0 = 0; s0 < 68; s0 += 17) {
        float sr[17], si[17];
#pragma unroll
        for (int k = 0; k < 17; ++k) {
          const size_t o = (((size_t)dir * NSC + scan_sc(s0 + k, b, dir)) * 16 + g) * 128 + pp;
          sr[k] = p.s5S[o]; si[k] = p.s5S[o + 64];
        }
#pragma unroll
        for (int k = 0; k < 17; ++k) {
          const size_t o = (((size_t)dir * NSC + scan_sc(s0 + k, b, dir)) * 16 + g) * 128 + pp;
          p.s5H[o] = hr; p.s5H[o + 64] = hi;
          const float nr = ar * hr - ai * hi + sr[k];
          const float ni = ar * hi + ai * hr + si[k];
          hr = nr; hi = ni;
        }
      }
    } else {
      const int id = (item - 16) * NT + tid;
      const int e = id & 2047, h = (id >> 11) & 7, b = (id >> 14) & 3, dir = id >> 16;
      const int dk = e & 31;
      float S = 0.f;
      for (int s0 = 0; s0 < 68; s0 += 17) {
        float kv[17], dc[17];
#pragma unroll
        for (int k = 0; k < 17; ++k) {
          const size_t o = (((size_t)dir * NSC + scan_sc(s0 + k, b, dir)) * 8 + h);
          kv[k] = p.gkv[o * 2048 + e]; dc[k] = p.gdec[o * 32 + dk];
        }
#pragma unroll
        for (int k = 0; k < 17; ++k) {
          const size_t o = (((size_t)dir * NSC + scan_sc(s0 + k, b, dir)) * 8 + h);
          p.gkv[o * 2048 + e] = S;
          S = dc[k] * S + kv[k];
        }
      }
    }
  }
}

__device__ __forceinline__ bf16x8 s5_kfrag(const bf16_t* kb, int delta, int sh) {
  const int d = delta - sh;
  bf16x8 r = *(const bf16x8*)(kb + (size_t)(d < 0 ? 0 : d) * 256);
  if (d < 0) r = (bf16x8){0, 0, 0, 0, 0, 0, 0, 0};
  return r;
}
#define S5_UCH 1032
typedef const __attribute__((address_space(3))) bf16_t* lds_bf16_cp;
template <int DIR, bool DIAG>
__device__ __forceinline__ void s5_group8(f32x4 (&acc)[16], bf16x8 (&W)[16], const bf16_t* ul  , const bf16_t* kl  , int ks0, int E, int sh) {
  const bf16x8 zero8 = (bf16x8){0, 0, 0, 0, 0, 0, 0, 0};
#pragma unroll
  for (int j = 0; j < 8; ++j) {
    const int sigma = 2 * (ks0 + j) + sh;
    const bf16x8 a = *(const bf16x8*)(ul + (DIR ? 63 - sigma : sigma) * 16);
    bf16x8 n0 = zero8, n1 = zero8;
    if (!DIAG) {
      if (j + 1 < 8) { n0 = *(const bf16x8*)(kl + (E - 2 * (j + 1) - sh) * 256); n1 = *(const bf16x8*)(kl + (E - 2 * (j + 1) + 1 - sh) * 256); }
      else { n0 = s5_kfrag(kl, E - 16, sh); n1 = s5_kfrag(kl, E - 15, sh); }
    }
#pragma unroll
    for (int i = 0; i < 16; ++i) {
      if (!(DIAG && i < 2 * j)) {
        const int sl = DIR ? 15 - i : i;
        acc[sl] = __builtin_amdgcn_mfma_f32_16x16x32_bf16(a, W[(i - 2 * j) & 15], acc[sl], 0, 0, 0);
      }
    }
    if (!DIAG) { W[(16 - 2 * (j + 1)) & 15] = n0; W[(17 - 2 * (j + 1)) & 15] = n1; }
  }
}
template <int DIR>
__device__ __forceinline__ void s5_dir(f32x4 (&acc)[16], PRef p, int layer, int g, int scr, int qd, int fr, int fq, const bf16_t* ul, const bf16_t* kl) {
  const int sh = fq >> 1;
  {
    bf16x8 W[16];
#pragma unroll
    for (int i = 0; i < 16; ++i) W[i] = s5_kfrag(kl, 16 * qd + i, sh);
    for (int c = 0; c < qd; ++c) s5_group8<DIR, false>(acc, W, ul, kl, 8 * c, 16 * (qd - c), sh);
    s5_group8<DIR, true>(acc, W, ul, kl, 8 * qd, 0, sh);
  }
  const size_t tb = (size_t)((layer * 2 + DIR) * 16 + g);
  const bf16_t* n2 = p.s5N2 + tb * 131072 + (size_t)(16 * qd * 4) * 512 + (fq * 16 + fr) * 8;
  bf16x8 b[16];
#pragma unroll
  for (int i = 0; i < 16; ++i) b[i] = *(const bf16x8*)(n2 + (size_t)(i * 4 + 0) * 512);
  bf16x8 ah[4];
  {
    const float* hin = p.s5H + (((size_t)DIR * NSC + scr) * 16 + g) * 128 + fq * 8;
#pragma unroll
    for (int ks = 0; ks < 4; ++ks) {
      const f32x4 h0 = *(const f32x4*)(hin + ks * 32), h1 = *(const f32x4*)(hin + ks * 32 + 4);
      const float h8[8] = {h0[0], h0[1], h0[2], h0[3], h1[0], h1[1], h1[2], h1[3]};
      ah[ks] = pack_bf16x8(h8);
    }
  }
  __builtin_amdgcn_sched_barrier(0);
#pragma unroll
  for (int ks = 0; ks < 4; ++ks) {
#pragma unroll
    for (int i = 0; i < 16; ++i) {
      const int sl = DIR ? 15 - i : i;
      acc[sl] = __builtin_amdgcn_mfma_f32_16x16x32_bf16(ah[ks], b[i], acc[sl], 0, 0, 0);
      if (ks < 3) b[i] = *(const bf16x8*)(n2 + (size_t)(i * 4 + ks + 1) * 512);
      __builtin_amdgcn_sched_barrier(0);
    }
  }
}
__device__ __forceinline__ void phase_s5c(PRef p, int layer, int nsc, int bid, int nblk, unsigned char* smem) {
  const int tid = opaque_tid(); const int lane = tid & 63, wid = tid >> 6;
  bf16_t* Kl = (bf16_t*)smem;
  bf16_t* Ul = Kl + 2 * 16384;
  const int nmt = nsc / 16, npair = (nmt + 1) / 2;
  const int ntask = 16 * npair;
  for (int task = bid; task < ntask; task += nblk) {
    const int g = task / npair, mt0 = (task % npair) * 2;
    __syncthreads();
    int tid_o = tid; asm volatile("" : "+v"(tid_o));
#pragma unroll
    for (int it = 0; it < 8; ++it) {
      const int e = it * NT + tid_o;
      const int dir = e >> 11, off = (e & 2047) * 8;
      *(uint4*)(Kl + dir * 16384 + off) = *(const uint4*)(p.s5K + (size_t)((layer * 2 + dir) * 16 + g) * 16384 + off);
    }
#pragma unroll
    for (int it = 0; it < 8; ++it) {
      const int e = it * NT + tid_o;
      const int hf = e & 1, tk = (e >> 1) & 63, chk = (e >> 7) & 15, tl = e >> 11;
      const int mt = mt0 + tl;
      uint4 v = make_uint4(0u, 0u, 0u, 0u);
      if (mt < nmt) v = *(const uint4*)(p.s5u + ((size_t)g * TT + s5_tok(mt * 16 + chk, tk)) * 16 + hf * 8);
      *(uint4*)(Ul + (tl * 16 + chk) * S5_UCH + tk * 16 + hf * 8) = v;
    }
    __syncthreads();
    int lane_o = lane; asm volatile("" : "+v"(lane_o));
    const int fr = lane_o & 15, fq = lane_o >> 4;
    const int tl = wid >> 2, q = wid & 3, mt = mt0 + tl;
    if (mt < nmt) {
      const int scr = mt * 16 + fr;
      const bf16_t* ul = Ul + (tl * 16 + fr) * S5_UCH + (fq & 1) * 8;
      f32x4 acc[16];
#pragma unroll
      for (int i = 0; i < 16; ++i) acc[i] = (f32x4){0.f, 0.f, 0.f, 0.f};
      s5_dir<0>(acc, p, layer, g, scr, q, fr, fq, ul, Kl + fr * 16 + (fq & 1) * 8);
      s5_dir<1>(acc, p, layer, g, scr, 3 - q, fr, fq, ul, Kl + 16384 + fr * 16 + (fq & 1) * 8);
      const int ch = g * 16 + fr;
      const float dsk = p.s5_d[layer * 256 + ch];
#pragma unroll
      for (int j = 0; j < 4; ++j) {
        const int chk = fq * 4 + j;
        const size_t tok0 = (size_t)s5_tok(mt * 16 + chk, 16 * q);
        const bf16_t* up = Ul + (tl * 16 + chk) * S5_UCH + (16 * q) * 16 + fr;
        bf16_t* yp = p.yg + tok0 * 256 + ch;
#pragma unroll
        for (int i = 0; i < 16; ++i) {
          const float v = acc[i][j] + dsk * bf2f(up[i * 16]);
          yp[(size_t)i * 256] = f2bf(gelu_f(v));
        }
        __builtin_amdgcn_sched_barrier(0);
      }
    }
  }
  __syncthreads();
}

#define GL_VT_STRIDE 72
#define GL_LB_STRIDE 36
#define GL_HALF_BYTES (64 * 72 * 2 + 64 * 36 * 4 + 64 * 72 * 2)
__device__ __forceinline__ void unpack8(const uint4& r, float* v) {
  v[0] = bflo(r.x); v[1] = bfhi(r.x); v[2] = bflo(r.y); v[3] = bfhi(r.y); v[4] = bflo(r.z); v[5] = bfhi(r.z); v[6] = bflo(r.w); v[7] = bfhi(r.w);
}
__device__ __forceinline__ void gla_store_vT(const uint4& r0, const uint4& r1, bf16_t* vT, int i, int part) {
  const unsigned w[8] = {r0.x, r0.y, r0.z, r0.w, r1.x, r1.y, r1.z, r1.w};
#pragma unroll
  for (int e = 0; e < 8; ++e) {
    vT[(part * 16 + 2 * e) * GL_VT_STRIDE + i] = (bf16_t)(w[e] & 0xffffu);
    vT[(part * 16 + 2 * e + 1) * GL_VT_STRIDE + i] = (bf16_t)(w[e] >> 16);
  }
}
__device__ __forceinline__ void gla_logdecay(int dir, const bf16_t* zs, const float* wgs, float* lb, int ltid) {
  const int lane = ltid & 63;
  const int wu = __builtin_amdgcn_readfirstlane(ltid >> 6);
  float z[16];
  unpack8(*(const uint4*)(zs + lane * 32 + dir * 16), z); unpack8(*(const uint4*)(zs + lane * 32 + dir * 16 + 8), z + 8);
  const float* wg = wgs + dir * 512 + wu * 8;
  f32x2 la2[4];
  {
    const f32x4 b0 = *(const f32x4*)(wgs + 1024 + dir * 32 + wu * 8), b1 = *(const f32x4*)(wgs + 1024 + dir * 32 + wu * 8 + 4);
    la2[0] = (f32x2){b0[0], b0[1]}; la2[1] = (f32x2){b0[2], b0[3]}; la2[2] = (f32x2){b1[0], b1[1]}; la2[3] = (f32x2){b1[2], b1[3]};
  }
#pragma unroll
  for (int r = 0; r < 16; ++r) {
    const f32x4 w0 = *(const f32x4*)(wg + r * 32), w1 = *(const f32x4*)(wg + r * 32 + 4);
    const f32x2 zz = {z[r], z[r]};
    la2[0] += zz * (f32x2){w0[0], w0[1]}; la2[1] += zz * (f32x2){w0[2], w0[3]};
    la2[2] += zz * (f32x2){w1[0], w1[1]}; la2[3] += zz * (f32x2){w1[2], w1[3]};
  }
  float la[8] = {la2[0].x, la2[0].y, la2[1].x, la2[1].y, la2[2].x, la2[2].y, la2[3].x, la2[3].y};
#pragma unroll
  for (int c = 0; c < 8; ++c) {
    const float e = __builtin_amdgcn_exp2f(-fabsf(la[c]) * 1.4426950408889634f);
    la[c] = fminf(la[c], 0.f) * (1.f / 16.f) - __builtin_amdgcn_logf(1.f + e) * (0.6931471805599453f / 16.f);
  }
  const int row = lane >> 4;
  const float m1 = dir == 0 ? (row >= 1 ? 1.f : 0.f) : (row < 1 ? 1.f : 0.f);
  const float m2 = dir == 0 ? (row >= 2 ? 1.f : 0.f) : (row < 2 ? 1.f : 0.f);
  const float m3 = dir == 0 ? (row >= 3 ? 1.f : 0.f) : (row < 3 ? 1.f : 0.f);
#pragma unroll
  for (int c = 0; c < 8; ++c) {
    float v = la[c];
    if (dir == 0) {
      v += __builtin_bit_cast(float, __builtin_amdgcn_update_dpp(0, __builtin_bit_cast(int, v), 0x111, 0xf, 0xf, true));
      v += __builtin_bit_cast(float, __builtin_amdgcn_update_dpp(0, __builtin_bit_cast(int, v), 0x112, 0xf, 0xf, true));
      v += __builtin_bit_cast(float, __builtin_amdgcn_update_dpp(0, __builtin_bit_cast(int, v), 0x114, 0xf, 0xf, true));
      v += __builtin_bit_cast(float, __builtin_amdgcn_update_dpp(0, __builtin_bit_cast(int, v), 0x118, 0xf, 0xf, true));
      const float t0 = __builtin_bit_cast(float, __builtin_amdgcn_readlane(__builtin_bit_cast(int, v), 15));
      const float t1 = __builtin_bit_cast(float, __builtin_amdgcn_readlane(__builtin_bit_cast(int, v), 31));
      const float t2 = __builtin_bit_cast(float, __builtin_amdgcn_readlane(__builtin_bit_cast(int, v), 47));
      v += m1 * t0 + m2 * t1 + m3 * t2;
    } else {
      v += __builtin_bit_cast(float, __builtin_amdgcn_update_dpp(0, __builtin_bit_cast(int, v), 0x101, 0xf, 0xf, true));
      v += __builtin_bit_cast(float, __builtin_amdgcn_update_dpp(0, __builtin_bit_cast(int, v), 0x102, 0xf, 0xf, true));
      v += __builtin_bit_cast(float, __builtin_amdgcn_update_dpp(0, __builtin_bit_cast(int, v), 0x104, 0xf, 0xf, true));
      v += __builtin_bit_cast(float, __builtin_amdgcn_update_dpp(0, __builtin_bit_cast(int, v), 0x108, 0xf, 0xf, true));
      const float t1 = __builtin_bit_cast(float, __builtin_amdgcn_readlane(__builtin_bit_cast(int, v), 16));
      const float t2 = __builtin_bit_cast(float, __builtin_amdgcn_readlane(__builtin_bit_cast(int, v), 32));
      const float t3 = __builtin_bit_cast(float, __builtin_amdgcn_readlane(__builtin_bit_cast(int, v), 48));
      v += m3 * t3 + m2 * t2 + m1 * t1;
    }
    la[c] = v;
  }
  *(f32x4*)(lb + lane * GL_LB_STRIDE + wu * 8) = (f32x4){la[0], la[1], la[2], la[3]};
  *(f32x4*)(lb + lane * GL_LB_STRIDE + wu * 8 + 4) = (f32x4){la[4], la[5], la[6], la[7]};
}

#define GLA_HALF_BYTES (64 * 72 * 2 + 2 * 64 * 36 * 4 + 2 * 32 * 72 * 2 + 64 * 32 * 2 + (1024 + 64) * 4)
struct GlaAPre { uint4 v0, v1, z, k, wg, bg; };
__device__ __forceinline__ GlaAPre glaa_prefetch(PRef p, int layer, int item, int ltid) {
  const int sc = item >> 3, h = item & 7;
  const int i = ltid >> 2, pc = ltid & 3;
  const bf16_t* row = p.cols + (size_t)gla_tok(sc, i) * INW;
  GlaAPre r;
  r.v0 = *(const uint4*)(row + C_GV + h * 64 + pc * 16); r.v1 = *(const uint4*)(row + C_GV + h * 64 + pc * 16 + 8);
  r.z = *(const uint4*)(row + C_ZF + pc * 8);
  r.k = *(const uint4*)(row + C_GK + h * 32 + pc * 8);
  {
    const int dir = ltid >> 7, rr = (ltid >> 3) & 15, c4 = (ltid & 7) * 4;
    r.wg = *(const uint4*)(p.gla_wg + ((size_t)(layer * 2 + dir) * 16 + rr) * 256 + h * 32 + c4);
    r.bg = *(const uint4*)(p.gla_bg + (layer * 2 + ((ltid >> 3) & 1)) * 256 + h * 32 + (ltid & 7) * 4);
  }
  return r;
}
__device__ __forceinline__ void phase_glaa(PRef p, int layer, int bid, int nblk, unsigned char* smem) {
  const int tid = opaque_tid(); const int half = __builtin_amdgcn_readfirstlane(tid >> 8), ltid = tid & 255;
  const int lane = tid & 63, w = ltid >> 6, fr = lane & 15, fq = lane >> 4;
  bf16_t* vT = (bf16_t*)(smem + half * GLA_HALF_BYTES);
  float* lb = (float*)(vT + 64 * GL_VT_STRIDE);
  bf16_t* kT = (bf16_t*)(lb + 2 * 64 * GL_LB_STRIDE);
  bf16_t* zs = kT + 2 * 32 * GL_VT_STRIDE;
  float* wgs = (float*)(zs + 64 * 32);
  const int nit = NSC * 8 / 2;
  if (bid >= nit) return;
  GlaAPre cur = glaa_prefetch(p, layer, bid * 2 + half, ltid);
  for (int it = bid; it < nit; it += nblk) {
    const int item = it * 2 + half;
    const int sc = item >> 3, h = item & 7;
    const int itn = it + nblk < nit ? it + nblk : it;
    const GlaAPre nxt = glaa_prefetch(p, layer, itn * 2 + half, ltid);
    const int ti = ltid >> 2, pc = ltid & 3;
    gla_store_vT(cur.v0, cur.v1, vT, ti, pc);
    *(uint4*)(zs + ti * 32 + pc * 8) = cur.z;
    *(uint4*)(wgs + ltid * 4) = cur.wg;
    if (ltid < 16) *(uint4*)(wgs + 1024 + ltid * 4) = cur.bg;
    __syncthreads();
    gla_logdecay(0, zs, wgs, lb, ltid);
    gla_logdecay(1, zs, wgs, lb + 64 * GL_LB_STRIDE, ltid);
    __syncthreads();
    float kv8[8];
    unpack8(cur.k, kv8);
#pragma unroll
    for (int dir = 0; dir < 2; ++dir) {
      const float* lbd = lb + dir * 64 * GL_LB_STRIDE;
      bf16_t* kTd = kT + dir * 32 * GL_VT_STRIDE;
      const int ilast = dir ? 0 : 63, iref = dir ? 31 : 32;
      const size_t o = (((size_t)dir * NSC + sc) * 8 + h);
      float s8[8];
#pragma unroll
      for (int c = 0; c < 8; ++c) {
        const int dk = pc * 8 + c;
        const float bi = lbd[ti * GL_LB_STRIDE + dk];
        kTd[dk * GL_VT_STRIDE + ti] = f2bf(kv8[c] * __expf(lbd[ilast * GL_LB_STRIDE + dk] - bi));
        s8[c] = kv8[c] * __expf(lbd[iref * GL_LB_STRIDE + dk] - bi);
      }
      *(bf16x8*)(p.gksc + o * 2048 + ltid * 8) = pack_bf16x8(s8);
      if (ltid < 32) p.gdec[o * 32 + ltid] = __expf(lbd[ilast * GL_LB_STRIDE + ltid]);
      {
        float* gt = p.glb + o * 2048;
#pragma unroll
        for (int r = 0; r < 2; ++r) {
          const int q = ltid + 256 * r;
          *(f32x4*)(gt + q * 4) = *(const f32x4*)(lbd + (q >> 3) * GL_LB_STRIDE + (q & 7) * 4);
        }
      }
    }
    __syncthreads();
    {
      bf16x8 bv[2];
#pragma unroll
      for (int ks = 0; ks < 2; ++ks) bv[ks] = *(const bf16x8*)(vT + (w * 16 + fr) * GL_VT_STRIDE + ks * 32 + fq * 8);
#pragma unroll
      for (int dir = 0; dir < 2; ++dir) {
        const bf16_t* kTd = kT + dir * 32 * GL_VT_STRIDE;
        const size_t o = (((size_t)dir * NSC + sc) * 8 + h);
        f32x4 acc[2];
        acc[0] = (f32x4){0.f, 0.f, 0.f, 0.f}; acc[1] = acc[0];
#pragma unroll
        for (int ks = 0; ks < 2; ++ks)
#pragma unroll
          for (int m = 0; m < 2; ++m) {
            const bf16x8 a = *(const bf16x8*)(kTd + (m * 16 + fr) * GL_VT_STRIDE + ks * 32 + fq * 8);
            acc[m] = __builtin_amdgcn_mfma_f32_16x16x32_bf16(a, bv[ks], acc[m], 0, 0, 0);
          }
#pragma unroll
        for (int m = 0; m < 2; ++m) *(f32x4*)(p.gkv + o * 2048 + (size_t)(w * 16 + fr) * 32 + m * 16 + fq * 4) = acc[m];
      }
    }
    __syncthreads();
    cur = nxt;
  }
}

__device__ __forceinline__ void gl_load8(const float* g, float* v) {
  const f32x4 a = *(const f32x4*)g, b = *(const f32x4*)(g + 4);
  v[0] = a[0]; v[1] = a[1]; v[2] = a[2]; v[3] = a[3]; v[4] = b[0]; v[5] = b[1]; v[6] = b[2]; v[7] = b[3];
}
#define GLC_KS_STRIDE 40
#define GLC_HALF_BYTES (64 * 72 * 2 + 64 * 72 * 2 + 2 * 64 * 36 * 4 + 2 * 64 * 36 * 4 + 2 * 64 * GLC_KS_STRIDE * 2)
struct GlaCPre { uint4 v0, v1, q, ks[2], g[2], lb[2][2], st[2][2]; };
__device__ __forceinline__ GlaCPre glac_prefetch(PRef p, int item, int ltid, int w, int fr, int fq) {
  const int sc = item >> 3, h = item & 7;
  GlaCPre r;
  {
    const int i = ltid >> 2, pc = ltid & 3;
    const bf16_t* row = p.cols + (size_t)gla_tok(sc, i) * INW;
    r.v0 = *(const uint4*)(row + C_GV + h * 64 + pc * 16); r.v1 = *(const uint4*)(row + C_GV + h * 64 + pc * 16 + 8);
  }
  r.q = *(const uint4*)(p.cols + (size_t)gla_tok(sc, w * 16 + fr) * INW + C_GQ + h * 32 + fq * 8);
  {
    const int lane = ltid & 63;
#pragma unroll
    for (int e = 0; e < 2; ++e) r.g[e] = *(const uint4*)(p.cols + (size_t)gla_tok(sc, w * 16 + (lane >> 3) + 8 * e) * INW + C_GG + h * 64 + (lane & 7) * 8);
  }
  {
#pragma unroll
    for (int dir = 0; dir < 2; ++dir) {
      const float* g = p.glb + (((size_t)dir * NSC + sc) * 8 + h) * 2048;
      r.lb[dir][0] = *(const uint4*)(g + ltid * 4); r.lb[dir][1] = *(const uint4*)(g + (ltid + 256) * 4);
      r.ks[dir] = *(const uint4*)(p.gksc + (((size_t)dir * NSC + sc) * 8 + h) * 2048 + ltid * 8);
      const float* s = p.gkv + (((size_t)dir * NSC + sc) * 8 + h) * 2048;
      r.st[dir][0] = *(const uint4*)(s + ltid * 4); r.st[dir][1] = *(const uint4*)(s + (ltid + 256) * 4);
    }
  }
  return r;
}
#define GLC_BONUS 4
__device__ __forceinline__ void phase_glac(PRef p, int layer, int nsc, int nbusy, int bid, int nblk, unsigned char* smem) {
  const int tid = opaque_tid(); const int half = __builtin_amdgcn_readfirstlane(tid >> 8), ltid = tid & 255;
  const int lane = tid & 63, w = ltid >> 6, fr = lane & 15, fq = lane >> 4;
  bf16_t* vT = (bf16_t*)(smem + half * GLC_HALF_BYTES);
  bf16_t* Pw = vT + 64 * GL_VT_STRIDE + w * 16 * GL_VT_STRIDE;
  float* lbT = (float*)(vT + 2 * 64 * GL_VT_STRIDE);
  float* ST = lbT + 2 * 64 * GL_LB_STRIDE;
  bf16_t* kS = (bf16_t*)(ST + 2 * 64 * GL_LB_STRIDE);
  const int nit = nsc * 4;
  const int nfree = nblk - nbusy;
  const int nbonus = (nbusy > 0 && nfree > 0 && nfree * GLC_BONUS < nit) ? nfree * GLC_BONUS : 0;
  auto itof = [&](int k) -> int {
    if (nbonus == 0) return bid + k * nblk;
    if (bid >= nbusy) return k < GLC_BONUS ? k * nfree + (bid - nbusy) : nbonus + bid + (k - GLC_BONUS) * nblk;
    return nbonus + bid + k * nblk;
  };
  if (itof(0) >= nit) return;
  GlaCPre cur = glac_prefetch(p, itof(0) * 2 + half, ltid, w, fr, fq);
  for (int kk = 0; itof(kk) < nit; ++kk) {
    const int it = itof(kk);
    const int item = it * 2 + half;
    const int sc = item >> 3, h = item & 7;
    __syncthreads();
    gla_store_vT(cur.v0, cur.v1, vT, ltid >> 2, ltid & 3);
#pragma unroll
    for (int dir = 0; dir < 2; ++dir) *(uint4*)(kS + (dir * 64 + (ltid >> 2)) * GLC_KS_STRIDE + (ltid & 3) * 8) = cur.ks[dir];
    {
#pragma unroll
      for (int dir = 0; dir < 2; ++dir)
#pragma unroll
        for (int r = 0; r < 2; ++r) {
          const int q = ltid + 256 * r;
          *(uint4*)(lbT + (dir * 64 + (q >> 3)) * GL_LB_STRIDE + (q & 7) * 4) = cur.lb[dir][r];
          *(uint4*)(ST + (dir * 64 + (q >> 3)) * GL_LB_STRIDE + (q & 7) * 4) = cur.st[dir][r];
        }
    }
    const int itn = itof(kk + 1) < nit ? itof(kk + 1) : it;
    const GlaCPre nxt = glac_prefetch(p, itn * 2 + half, ltid, w, fr, fq);
    __syncthreads();
    f32x4 o[4];
#pragma unroll
    for (int n = 0; n < 4; ++n) o[n] = (f32x4){0.f, 0.f, 0.f, 0.f};
#pragma unroll
    for (int dir = 0; dir < 2; ++dir) {
      const float* lbd = lbT + dir * 64 * GL_LB_STRIDE + fq * 8;
      float bref[8], bt[8];
      gl_load8(lbd + (dir ? 31 : 32) * GL_LB_STRIDE, bref);
      gl_load8(lbd + (w * 16 + fr) * GL_LB_STRIDE, bt);
      bf16x8 aqs, aqe;
      {
        float q8[8], s8[8], e8[8];
        unpack8(cur.q, q8);
#pragma unroll
        for (int c = 0; c < 8; ++c) {
          const float qx = q8[c] * 0.17677669529663687f;
          s8[c] = qx * __expf(bt[c] - bref[c]);
          e8[c] = qx * __expf(bt[c]);
        }
        aqs = pack_bf16x8(s8); aqe = pack_bf16x8(e8);
      }
#pragma unroll
      for (int n = 0; n < 4; ++n) {
        const int s = n * 16 + fr;
        const bf16x8 bks = *(const bf16x8*)(kS + (dir * 64 + s) * GLC_KS_STRIDE + fq * 8);
        const f32x4 sa = __builtin_amdgcn_mfma_f32_16x16x32_bf16(bks, aqs, (f32x4){0.f, 0.f, 0.f, 0.f}, 0, 0, 0);
        const int t = w * 16 + fr, sk = n * 16 + fq * 4;
        float m4[4];
#pragma unroll
        for (int j = 0; j < 4; ++j) m4[j] = (dir ? (sk + j >= t) : (sk + j <= t)) ? sa[j] : 0.f;
        *(uint2*)(Pw + fr * GL_VT_STRIDE + sk) = make_uint2(pk_bf16(m4[0], m4[1]), pk_bf16(m4[2], m4[3]));
      }
      __builtin_amdgcn_wave_barrier();
#pragma unroll
      for (int ks = 0; ks < 2; ++ks) {
        const bf16x8 ap = *(const bf16x8*)(Pw + fr * GL_VT_STRIDE + ks * 32 + fq * 8);
#pragma unroll
        for (int n = 0; n < 4; ++n) {
          const bf16x8 bv = *(const bf16x8*)(vT + (n * 16 + fr) * GL_VT_STRIDE + ks * 32 + fq * 8);
          o[n] = __builtin_amdgcn_mfma_f32_16x16x32_bf16(bv, ap, o[n], 0, 0, 0);
        }
      }
      __builtin_amdgcn_wave_barrier();
      {
        const float* Sg = ST + dir * 64 * GL_LB_STRIDE + fq * 8;
#pragma unroll
        for (int n = 0; n < 4; ++n) {
          float s8[8];
          gl_load8(Sg + (n * 16 + fr) * GL_LB_STRIDE, s8);
          const bf16x8 bS = pack_bf16x8(s8);
          o[n] = __builtin_amdgcn_mfma_f32_16x16x32_bf16(bS, aqe, o[n], 0, 0, 0);
        }
      }
    }
    __builtin_amdgcn_wave_barrier();
    {
      float ss = 0.f;
#pragma unroll
      for (int n = 0; n < 4; ++n) ss += o[n][0] * o[n][0] + o[n][1] * o[n][1] + o[n][2] * o[n][2] + o[n][3] * o[n][3];
      ss += xor_lane_f<16>(ss); ss += xor_lane_f<32>(ss);
      const float rstd = rsqrtf(ss * (1.f / 64.f) + EPSV);
#pragma unroll
      for (int n = 0; n < 4; ++n)
        *(uint2*)(Pw + fr * GL_VT_STRIDE + n * 16 + fq * 4) = make_uint2(pk_bf16(o[n][0] * rstd, o[n][1] * rstd), pk_bf16(o[n][2] * rstd, o[n][3] * rstd));
    }
    __builtin_amdgcn_wave_barrier();
    {
      const int pc8 = (lane & 7) * 8;
      const float* ng = p.gla_ng + layer * 512 + h * 64 + pc8;
      const f32x4 n0 = *(const f32x4*)ng, n1 = *(const f32x4*)(ng + 4);
      const float nv[8] = {n0[0], n0[1], n0[2], n0[3], n1[0], n1[1], n1[2], n1[3]};
#pragma unroll
      for (int e = 0; e < 2; ++e) {
        const int tl = (lane >> 3) + 8 * e;
        const int tok = gla_tok(sc, w * 16 + tl);
        float ov[8], gv[8];
        unpack8(*(const uint4*)(Pw + tl * GL_VT_STRIDE + pc8), ov);
        unpack8(cur.g[e], gv);
        unsigned wv[4];
#pragma unroll
        for (int c = 0; c < 4; ++c) {
          const float a = ov[2 * c] * nv[2 * c] * silu_f(gv[2 * c]), b = ov[2 * c + 1] * nv[2 * c + 1] * silu_f(gv[2 * c + 1]);
          wv[c] = pk_bf16(a, b);
        }
        *(uint4*)(p.mix + (size_t)tok * 1024 + 512 + h * 64 + pc8) = make_uint4(wv[0], wv[1], wv[2], wv[3]);
      }
    }
    __builtin_amdgcn_wave_barrier();
    cur = nxt;
  }
  __syncthreads();
}

__device__ __forceinline__ unsigned fkey(float f) { const unsigned u = __float_as_uint(f); return u ^ ((u >> 31) ? 0xFFFFFFFFu : 0x80000000u); }
__device__ __forceinline__ float funkey(unsigned k) { return __uint_as_float((k >> 31) ? (k ^ 0x80000000u) : ~k); }
__device__ __forceinline__ unsigned umax3(unsigned a, unsigned b) { return a > b ? a : b; }
__device__ __forceinline__ unsigned umin3(unsigned a, unsigned b) { return a < b ? a : b; }
__device__ __forceinline__ unsigned umed3(unsigned a, unsigned b, unsigned c) { return umax3(umin3(a, b), umin3(umax3(a, b), c)); }
__device__ __forceinline__ void top16_insert(unsigned (&L)[16], unsigned x) {
#pragma unroll
  for (int q = 15; q >= 1; --q) L[q] = umed3(L[q - 1], L[q], x);
  L[0] = umax3(L[0], x);
}
template <int XM>
__device__ __forceinline__ void top16_merge(unsigned (&L)[16]) {
  unsigned P[16];
#pragma unroll
  for (int i = 0; i < 16; ++i) P[i] = xor_lane_u<XM>(L[i]);
  unsigned M[16];
#pragma unroll
  for (int i = 0; i < 16; ++i) M[i] = umax3(L[i], P[15 - i]);
#pragma unroll
  for (int d = 8; d >= 1; d >>= 1) {
#pragma unroll
    for (int i = 0; i < 16; ++i) {
      if ((i & d) == 0) { const unsigned hi = umax3(M[i], M[i + d]), lo = umin3(M[i], M[i + d]); M[i] = hi; M[i + d] = lo; }
    }
  }
#pragma unroll
  for (int i = 0; i < 16; ++i) L[i] = M[i];
}
#define RT_MAX_ITEMS 5
__device__ __forceinline__ void phase_route(PRef p, int layer, int ntok, int bid, int nblk, unsigned char* smem) {
  const int tid = opaque_tid(); const int lane = tid & 63, wid = tid >> 6;
  unsigned* lists_w = (unsigned*)smem + wid * (RT_MAX_ITEMS * 2 * 16 * 16);
  const int fr = lane & 15, fq = lane >> 4;
  const bf16_t* qb = p.cols;
  const int nitems = ntok / 16;
  static const unsigned char STAIR[52] = {0, 1, 2, 3, 4, 5, 6, 7, 8, 9, 10, 11, 12, 13, 14, 15, 16, 17, 18, 19, 20, 21, 22, 23, 32, 33, 34, 35, 36, 48, 49, 50, 51, 64, 65, 66, 80, 81, 96, 97, 112, 113, 128, 144, 160, 176, 192, 208, 224, 240, 255, 255};
  for (int item0 = bid; item0 < nitems; item0 += nblk * RT_MAX_ITEMS) {
    for (int ph = 0; ph < 2; ++ph) {
      bf16x8 bk[8][4];
      {
        const bf16_t* kb = p.keysb + ((((size_t)layer * 2 + ph) * 8 + wid) * 128) * 128 + (size_t)fr * 128 + fq * 8;
#pragma unroll
        for (int n = 0; n < 8; ++n)
#pragma unroll
          for (int kt = 0; kt < 4; ++kt) bk[n][kt] = *(const bf16x8*)(kb + (size_t)n * 16 * 128 + kt * 32);
      }
      bf16x8 an[4];
      {
        const bf16_t* qrow = qb + (size_t)(item0 * 16 + fr) * 2048 + wid * 256 + ph * 128 + fq * 8;
#pragma unroll
        for (int kt = 0; kt < 4; ++kt) an[kt] = *(const bf16x8*)(qrow + kt * 32);
      }
      for (int ii = 0; ii < RT_MAX_ITEMS; ++ii) {
        const int item = item0 + ii * nblk;
        if (item >= nitems) break;
        const int tok0 = item * 16;
        bf16x8 a[4];
#pragma unroll
        for (int kt = 0; kt < 4; ++kt) a[kt] = an[kt];
        {
          const int itn = item0 + (ii + 1) * nblk;
          const int tokn = (ii + 1 < RT_MAX_ITEMS && itn < nitems) ? itn * 16 : tok0;
          const bf16_t* qrow = qb + (size_t)(tokn + fr) * 2048 + wid * 256 + ph * 128 + fq * 8;
#pragma unroll
          for (int kt = 0; kt < 4; ++kt) an[kt] = *(const bf16x8*)(qrow + kt * 32);
        }
        unsigned L[16];
#pragma unroll
        for (int i = 0; i < 16; ++i) L[i] = 0u;
#pragma unroll
        for (int n = 0; n < 8; ++n) {
          f32x4 acc = (f32x4){0.f, 0.f, 0.f, 0.f};
#pragma unroll
          for (int kt = 0; kt < 4; ++kt) acc = __builtin_amdgcn_mfma_f32_16x16x32_bf16(bk[n][kt], a[kt], acc, 0, 0, 0);
#pragma unroll
          for (int j = 0; j < 4; ++j) top16_insert(L, (fkey(acc[j]) & 0xFFFFFF80u) | (unsigned)(n * 16 + fq * 4 + j));
        }
        top16_merge<16>(L);
        top16_merge<32>(L);
        if (fq == 0) {
          unsigned* dst = lists_w + ((ii * 2 + ph) * 16 + fr) * 16;
#pragma unroll
          for (int i = 0; i < 4; ++i) *(uint4*)(dst + i * 4) = make_uint4(L[i * 4], L[i * 4 + 1], L[i * 4 + 2], L[i * 4 + 3]);
        }
      }
    }
    __builtin_amdgcn_wave_barrier();
    for (int ii = 0; ii < RT_MAX_ITEMS; ++ii) {
      const int item = item0 + ii * nblk;
      if (item >= nitems) break;
      const int tok0 = item * 16;
      const unsigned* l1 = lists_w + ((ii * 2 + 0) * 16 + fr) * 16;
      const unsigned* l2 = lists_w + ((ii * 2 + 1) * 16 + fr) * 16;
      unsigned T[16];
#pragma unroll
      for (int i = 0; i < 16; ++i) T[i] = 0u;
#pragma unroll
      for (int j = 0; j < 13; ++j) {
        const unsigned c = STAIR[fq + 4 * j];
        const float sa = funkey(l1[(c >> 4) & 15] & 0xFFFFFF80u), sb = funkey(l2[c & 15] & 0xFFFFFF80u);
        const unsigned key = (fkey(sa + sb) & 0xFFFFFF00u) | c;
        top16_insert(T, c == 255u ? 0u : key);
      }
      top16_merge<16>(T);
      top16_merge<32>(T);
      const float mx = funkey(T[0] & 0xFFFFFF00u);
      float ex[16], sum = 0.f;
#pragma unroll
      for (int r = 0; r < 16; ++r) { ex[r] = __expf(funkey(T[r] & 0xFFFFFF00u) - mx); sum += ex[r]; }
      const float inv = 1.f / sum;
      int eid[4]; float gt[4];
#pragma unroll
      for (int r = 0; r < 16; ++r) {
        if ((r >> 2) == fq) {
          const int a = (T[r] >> 4) & 15, b = T[r] & 15;
          eid[r & 3] = (int)(l1[a] & 127u) * 128 + (int)(l2[b] & 127u);
          gt[r & 3] = ex[r] * inv;
        }
      }
      const size_t o = (size_t)(tok0 + fr) * 128 + wid * 16 + fq * 4;
      *(int4*)(p.pidx + o) = make_int4(eid[0], eid[1], eid[2], eid[3]);
      *(f32x4*)(p.pgate + o) = (f32x4){gt[0], gt[1], gt[2], gt[3]};
    }
    __builtin_amdgcn_wave_barrier();
  }
  __syncthreads();
}

__device__ __forceinline__ float dot16_fp8(const uint4& r, const f32x2* h2) {
  const unsigned w[4] = {r.x, r.y, r.z, r.w};
  f32x2 d = {0.f, 0.f};
#pragma unroll
  for (int q = 0; q < 4; ++q) {
    d += __builtin_amdgcn_cvt_pk_f32_fp8(w[q], false) * h2[q * 2];
    d += __builtin_amdgcn_cvt_pk_f32_fp8(w[q], true) * h2[q * 2 + 1];
  }
  return d.x + d.y;
}
__device__ __forceinline__ void fma16_fp8(f32x2* acc2, const uint4& r, float w8) {
  const unsigned w[4] = {r.x, r.y, r.z, r.w};
  const f32x2 ww = {w8, w8};
#pragma unroll
  for (int q = 0; q < 4; ++q) {
    acc2[q * 2] += ww * __builtin_amdgcn_cvt_pk_f32_fp8(w[q], false);
    acc2[q * 2 + 1] += ww * __builtin_amdgcn_cvt_pk_f32_fp8(w[q], true);
  }
}
struct XcdInfo { int rank, nloc, xi, nx; };
__device__ __forceinline__ XcdInfo xcd_info(const XcdBarrier& b) {
  if (threadIdx.x == 0) {
    unsigned xi = 0;
    for (unsigned j = 0; j < 16; ++j) { const unsigned c = xb_ld(&b.bar[XB_XCNT(j)]); if (j < b.x && c > 0u) ++xi; }
    b.st[3] = xi;
  }
  __syncthreads();
  XcdInfo r;
  r.nloc = __builtin_amdgcn_readfirstlane((int)b.st[0]); r.nx = __builtin_amdgcn_readfirstlane((int)b.st[1]);
  r.rank = __builtin_amdgcn_readfirstlane((int)b.st[2]); r.xi = __builtin_amdgcn_readfirstlane((int)b.st[3]);
  return r;
}
__device__ __forceinline__ void gs_issue(uint4 (&buf)[16], const unsigned char* tab  , int sub16, const int* el  , int grp) {
#pragma unroll
  for (int k = 0; k < 16; ++k) buf[k] = *(const uint4*)(tab + (unsigned)(el[k * 8 + grp] + sub16));
}
__device__ __forceinline__ void phase_gather_u(PRef p, int layer, int ntok, const XcdInfo xin, unsigned char* smem) {
  const int tid = opaque_tid(); const int lane = tid & 63, wid = tid >> 6;
  int* elw = (int*)smem + wid * 256;
  unsigned* pbuf = (unsigned*)p.cols;
  const int sub = lane & 7, grp = lane >> 3;
  const bool b0 = (lane & 1) != 0, b1 = (lane & 2) != 0, b2 = (lane & 4) != 0;
  const int tstep = xin.nloc * NW;
  for (int s = xin.xi; s < 8; s += xin.nx) {
    const unsigned char* EU = p.eu8 + (size_t)layer * 16384 * 1024 + __builtin_amdgcn_readfirstlane(s) * 128;
    const int t0 = xin.rank * NW + wid;
    if (t0 >= ntok) continue;
    const int kslot = ((b0 ? 8 : 0) + (b1 ? 4 : 0) + (b2 ? 2 : 0)) * 8 + grp;
    uint4 bufA[16], bufB[16];
    uint4 hA0, hA1, hB0, hB1;
    int i0n, i1n;
    {
      elw[lane] = p.pidx[(size_t)t0 * 128 + lane] << 10; elw[64 + lane] = p.pidx[(size_t)t0 * 128 + 64 + lane] << 10;
      __builtin_amdgcn_wave_barrier();
      gs_issue(bufA, EU, sub * 16, elw, grp);
      hA0 = *(const uint4*)(p.abuf + (size_t)t0 * 1024 + s * 128 + sub * 16); hA1 = *(const uint4*)(p.abuf + (size_t)t0 * 1024 + s * 128 + sub * 16 + 8);
      const int t1 = t0 + tstep < ntok ? t0 + tstep : t0;
      i0n = p.pidx[(size_t)t1 * 128 + lane]; i1n = p.pidx[(size_t)t1 * 128 + 64 + lane];
    }
    int par = 0;
    for (int t = t0; t < ntok; t += 2 * tstep) {
#pragma unroll
      for (int hh = 0; hh < 2; ++hh) {
        const int tc = t + hh * tstep;
        if (tc < ntok) {
          uint4 (&cur)[16] = hh ? bufB : bufA;
          uint4 (&nxt)[16] = hh ? bufA : bufB;
          const uint4 hc0 = hh ? hB0 : hA0, hc1 = hh ? hB1 : hA1;
          const int tn = tc + tstep < ntok ? tc + tstep : tc;
          par ^= 1;
          int* eln = elw + par * 128;
          eln[lane] = i0n << 10; eln[64 + lane] = i1n << 10;
          __builtin_amdgcn_wave_barrier();
          gs_issue(nxt, EU, sub * 16, eln, grp);
          const uint4 hn0 = *(const uint4*)(p.abuf + (size_t)tn * 1024 + s * 128 + sub * 16), hn1 = *(const uint4*)(p.abuf + (size_t)tn * 1024 + s * 128 + sub * 16 + 8);
          const int tnn = tn + tstep < ntok ? tn + tstep : tn;
          i0n = p.pidx[(size_t)tnn * 128 + lane]; i1n = p.pidx[(size_t)tnn * 128 + 64 + lane];
          float hsc;
          int hq[4];
          {
            float hv[16];
            unpack8(hc0, hv); unpack8(hc1, hv + 8);
            float m = 0.f;
#pragma unroll
            for (int q = 0; q < 16; ++q) m = fmaxf(m, fabsf(hv[q]));
            m = fmaxf(m, xor_lane_f<1>(m)); m = fmaxf(m, xor_lane_f<2>(m)); m = fmaxf(m, xor_lane_f<4>(m));
            const float hs = m > 0.f ? 127.f * __builtin_amdgcn_rcpf(m) : 0.f;
            hsc = m * (1.f / 127.f) * 0.0625f;
#pragma unroll
            for (int q = 0; q < 4; ++q) hq[q] = (int)pack_i8x4_scaled(hv[4 * q], hv[4 * q + 1], hv[4 * q + 2], hv[4 * q + 3], hs);
          }
          int d[16];
#pragma unroll
          for (int k = 0; k < 16; ++k) {
            int a = __builtin_amdgcn_sdot4((int)cur[k].x, hq[0], 0, false);
            a = __builtin_amdgcn_sdot4((int)cur[k].y, hq[1], a, false);
            a = __builtin_amdgcn_sdot4((int)cur[k].z, hq[2], a, false);
            d[k] = __builtin_amdgcn_sdot4((int)cur[k].w, hq[3], a, false);
          }
          int d8[8], d4[4], d2[2];
#pragma unroll
          for (int q = 0; q < 8; ++q) { const int send = b0 ? d[q] : d[q + 8]; const int keep = b0 ? d[q + 8] : d[q]; d8[q] = keep + (int)xor_lane_u<1>((unsigned)send); }
#pragma unroll
          for (int q = 0; q < 4; ++q) { const int send = b1 ? d8[q] : d8[q + 4]; const int keep = b1 ? d8[q + 4] : d8[q]; d4[q] = keep + (int)xor_lane_u<2>((unsigned)send); }
#pragma unroll
          for (int q = 0; q < 2; ++q) { const int send = b2 ? d4[q] : d4[q + 2]; const int keep = b2 ? d4[q + 2] : d4[q]; d2[q] = keep + (int)xor_lane_u<4>((unsigned)send); }
          pbuf[((size_t)s * TT + tc) * 64 + ((kslot >> 4) << 3) + (kslot & 7)] = pk_f16((float)d2[0] * hsc, (float)d2[1] * hsc);
          if (hh) { hA0 = hn0; hA1 = hn1; } else { hB0 = hn0; hB1 = hn1; }
        }
      }
    }
    __builtin_amdgcn_wave_barrier();
  }
}
__device__ __forceinline__ void phase_gather_r(PRef p, int layer, int ntok, int bid, int nblk) {
  const int tid = opaque_tid();
  const unsigned* pbuf = (const unsigned*)p.cols;
  const size_t n8 = (size_t)ntok * 16;
  for (size_t it = (size_t)bid * NT + tid; it < n8; it += (size_t)nblk * NT) {
    const size_t t = it >> 4;
    const int j = (int)(it & 15), m0 = ((j >> 1) << 2) + (j & 1);
    f32x4 z0 = (f32x4){0.f, 0.f, 0.f, 0.f}, z1 = z0;
#pragma unroll
    for (int s = 0; s < 8; ++s) {
      const uint4 q = *(const uint4*)(pbuf + ((size_t)s * TT + t) * 64 + ((m0 >> 2) << 3) + (m0 & 1) * 4);
      const f32x2_t a = unpk_f16(q.x), b = unpk_f16(q.y), c = unpk_f16(q.z), d = unpk_f16(q.w);
      z0[0] += a.x; z1[0] += a.y; z0[1] += b.x; z1[1] += b.y; z0[2] += c.x; z1[2] += c.y; z0[3] += d.x; z1[3] += d.y;
    }
#pragma unroll
    for (int hf = 0; hf < 2; ++hf) {
      const size_t i4 = t * 128 + (size_t)(m0 + 2 * hf) * 4;
      const f32x4 z = (hf ? z1 : z0) * 16.f;
      const f32x4 g = *(const f32x4*)(p.pgate + i4);
      const int4 e = *(const int4*)(p.pidx + i4);
      const int ev[4] = {e.x, e.y, e.z, e.w};
      f32x4 w;
#pragma unroll
      for (int jj = 0; jj < 4; ++jj) w[jj] = g[jj] * gelu_f(z[jj] * p.su[layer * 16384 + ev[jj]]) * p.sv[layer * 16384 + ev[jj]];
      *(f32x4*)(p.wbuf + i4) = w;
    }
  }
}
template <bool DUMMY>
__device__ __forceinline__ void phase_gather_v(PRef p, int layer, int ntok, const XcdInfo xin, unsigned char* smem) {
  float* xout = DUMMY ? (float*)p.cols : p.xres;
  const int tid = opaque_tid(); const int lane = tid & 63, wid = tid >> 6;
  int* elw = (int*)smem + wid * 512;
  float* wlw = (float*)(elw + 256);
  const int sub = lane & 7, grp = lane >> 3;
  const bool b5 = (lane & 32) != 0, b4 = (lane & 16) != 0, b3 = (lane & 8) != 0;
  const int tstep = xin.nloc * NW;
  for (int s = xin.xi; s < 8; s += xin.nx) {
    const unsigned char* EV = p.ev8 + (size_t)layer * 16384 * 1024 + __builtin_amdgcn_readfirstlane(s) * 128;
    const int col = s * 128 + sub * 16 + (b3 ? 8 : 0) + (b4 ? 4 : 0) + (b5 ? 2 : 0);
    const int t0 = xin.rank * NW + wid;
    if (t0 >= ntok) continue;
    uint4 bufA[16], bufB[16];
    int i0n, i1n; float w0n, w1n;
    f32x2 xc, gc, xn, gn;
    {
      elw[lane] = p.pidx[(size_t)t0 * 128 + lane] << 10; elw[64 + lane] = p.pidx[(size_t)t0 * 128 + 64 + lane] << 10;
      wlw[lane] = p.wbuf[(size_t)t0 * 128 + lane]; wlw[64 + lane] = p.wbuf[(size_t)t0 * 128 + 64 + lane];
      __builtin_amdgcn_wave_barrier();
      gs_issue(bufA, EV, sub * 16, elw, grp);
      xc = *(const f32x2*)(p.xres + (size_t)t0 * 1024 + col);
      gc = *(const f32x2*)(p.modv + ((size_t)layer * 5 + tok_batch(t0)) * NMOD + 5120 + col);
      const int t1 = t0 + tstep < ntok ? t0 + tstep : t0;
      i0n = p.pidx[(size_t)t1 * 128 + lane]; i1n = p.pidx[(size_t)t1 * 128 + 64 + lane];
      w0n = p.wbuf[(size_t)t1 * 128 + lane]; w1n = p.wbuf[(size_t)t1 * 128 + 64 + lane];
      xn = *(const f32x2*)(p.xres + (size_t)t1 * 1024 + col);
      gn = *(const f32x2*)(p.modv + ((size_t)layer * 5 + tok_batch(t1)) * NMOD + 5120 + col);
    }
    int par = 0;
    for (int t = t0; t < ntok; t += 2 * tstep) {
#pragma unroll
      for (int hh = 0; hh < 2; ++hh) {
        const int tc = t + hh * tstep;
        if (tc < ntok) {
          uint4 (&cur)[16] = hh ? bufB : bufA;
          uint4 (&nxt)[16] = hh ? bufA : bufB;
          const float* wlc = wlw + par * 128;
          const int tn = tc + tstep < ntok ? tc + tstep : tc;
          par ^= 1;
          int* eln = elw + par * 128; float* wln = wlw + par * 128;
          eln[lane] = i0n << 10; eln[64 + lane] = i1n << 10; wln[lane] = w0n; wln[64 + lane] = w1n;
          __builtin_amdgcn_wave_barrier();
          gs_issue(nxt, EV, sub * 16, eln, grp);
          const f32x2 xcur = xc, gcur = gc;
          xc = xn; gc = gn;
          const int tnn = tn + tstep < ntok ? tn + tstep : tn;
          i0n = p.pidx[(size_t)tnn * 128 + lane]; i1n = p.pidx[(size_t)tnn * 128 + 64 + lane];
          w0n = p.wbuf[(size_t)tnn * 128 + lane]; w1n = p.wbuf[(size_t)tnn * 128 + 64 + lane];
          xn = *(const f32x2*)(p.xres + (size_t)tnn * 1024 + col);
          gn = *(const f32x2*)(p.modv + ((size_t)layer * 5 + tok_batch(tnn)) * NMOD + 5120 + col);
          f32x2 acc2[8];
#pragma unroll
          for (int j = 0; j < 8; ++j) acc2[j] = (f32x2){0.f, 0.f};
#pragma unroll
          for (int k = 0; k < 16; ++k) fma16_fp8(acc2, cur[k], wlc[k * 8 + grp]);
          float a16[16];
#pragma unroll
          for (int q = 0; q < 8; ++q) { a16[2 * q] = acc2[q].x; a16[2 * q + 1] = acc2[q].y; }
          float a8[8], a4[4], a2[2];
#pragma unroll
          for (int q = 0; q < 8; ++q) { const float send = b3 ? a16[q] : a16[q + 8]; const float keep = b3 ? a16[q + 8] : a16[q]; a8[q] = keep + xor_lane_f<8>(send); }
#pragma unroll
          for (int q = 0; q < 4; ++q) {
            const auto r = __builtin_amdgcn_permlane16_swap(__float_as_uint(a8[q]), __float_as_uint(a8[q + 4]), false, false);
            a4[q] = __uint_as_float(r[0]) + __uint_as_float(r[1]);
          }
#pragma unroll
          for (int q = 0; q < 2; ++q) {
            const auto r = __builtin_amdgcn_permlane32_swap(__float_as_uint(a4[q]), __float_as_uint(a4[q + 2]), false, false);
            a2[q] = __uint_as_float(r[0]) + __uint_as_float(r[1]);
          }
          f32x2 xv = xcur;
          xv.x += gcur.x * a2[0]; xv.y += gcur.y * a2[1];
          *(f32x2*)(xout + (size_t)tc * 1024 + col) = xv;
        }
      }
    }
    __builtin_amdgcn_wave_barrier();
  }
}
__device__ __forceinline__ void phase_gather_norm(PRef p, int layer, int ntok, int bid, int nblk) {
  const int tid = opaque_tid(); const int lane = tid & 63, wid = tid >> 6;
  for (int t = bid * NW + wid; t < ntok; t += nblk * NW) {
    f32x4 xv[4];
    float ss = 0.f;
#pragma unroll
    for (int q = 0; q < 4; ++q) {
      xv[q] = *(const f32x4*)(p.xres + (size_t)t * 1024 + lane * 16 + q * 4);
      ss += xv[q][0] * xv[q][0] + xv[q][1] * xv[q][1] + xv[q][2] * xv[q][2] + xv[q][3] * xv[q][3];
    }
    ss = wave_sum(ss);
    const float rstd = rsqrtf(ss * (1.f / 1024.f) + EPSV);
    if (layer == 0) {
      const float* md1 = p.modv + ((size_t)5 + tok_batch(t)) * NMOD;
#pragma unroll
      for (int q = 0; q < 4; ++q) {
        const int c0 = lane * 16 + q * 4;
        const f32x4 g = *(const f32x4*)(p.norm1_g + 1024 + c0);
        const f32x4 sh = *(const f32x4*)(md1 + c0);
        const f32x4 sc = *(const f32x4*)(md1 + 1024 + c0);
        ushort4 o;
        o.x = f2bf(xv[q][0] * rstd * g[0] * (1.f + sc[0]) + sh[0]);
        o.y = f2bf(xv[q][1] * rstd * g[1] * (1.f + sc[1]) + sh[1]);
        o.z = f2bf(xv[q][2] * rstd * g[2] * (1.f + sc[2]) + sh[2]);
        o.w = f2bf(xv[q][3] * rstd * g[3] * (1.f + sc[3]) + sh[3]);
        *(ushort4*)(p.abuf + (size_t)t * 1024 + c0) = o;
      }
    } else {
#pragma unroll
      for (int q = 0; q < 4; ++q) {
        const int c0 = lane * 16 + q * 4;
        const f32x4 g = *(const f32x4*)(p.final_g + c0);
        f32x4 o;
        o[0] = xv[q][0] * rstd * g[0]; o[1] = xv[q][1] * rstd * g[1]; o[2] = xv[q][2] * rstd * g[2]; o[3] = xv[q][3] * rstd * g[3];
        *(f32x4*)(p.out + (size_t)t * 1024 + c0) = o;
      }
    }
  }
}

__device__ __forceinline__ void phase_final(PRef p, int bid, int nblk) {
  const int tid = opaque_tid(); const int lane = tid & 63, wid = tid >> 6;
  for (int t = bid * 4 + wid; t < TL; t += nblk * 4) {
    const float* row = p.xres + (size_t)t * 1024;
    f32x4 v[4];
    float ss = 0.f;
#pragma unroll
    for (int j = 0; j < 4; ++j) {
      v[j] = *(const f32x4*)(row + j * 256 + lane * 4);
      ss += v[j][0] * v[j][0] + v[j][1] * v[j][1] + v[j][2] * v[j][2] + v[j][3] * v[j][3];
    }
    ss = wave_sum(ss);
    const float rstd = rsqrtf(ss * (1.f / 1024.f) + EPSV);
#pragma unroll
    for (int j = 0; j < 4; ++j) {
      const int c0 = j * 256 + lane * 4;
      const f32x4 g = *(const f32x4*)(p.final_g + c0);
      f32x4 o;
      o[0] = v[j][0] * rstd * g[0]; o[1] = v[j][1] * rstd * g[1]; o[2] = v[j][2] * rstd * g[2]; o[3] = v[j][3] * rstd * g[3];
      *(f32x4*)(p.out + (size_t)t * 1024 + c0) = o;
    }
  }
}

template <class Epi>
__device__ __forceinline__ void run_gemm(const bf16_t* A, const bf16_t* Bt, int M, int N, int K, const Epi& epi, int bid, int nblk, unsigned char* smem) {
  pg8::Gemm g{A, Bt, M, N, K};
  pg8::StaticOrder S; S.init(M, N, nblk, bid);
  pg8::gemm_phase(( PG8_LAS unsigned char*)smem, g, S, epi);
}
__device__ __forceinline__ void phase_gemm_in(PRef p, int layer, int bid, int nblk, unsigned char* smem) {
  pg8::EpiIn epi{p.cols, p.s5u};
  run_gemm(p.abuf, p.wt_in + (size_t)layer * INWP * 1024, TT, INWP, 1024, epi, bid, nblk, smem);
}
__device__ __forceinline__ void phase_gemm_glu(PRef p, int layer, int ntok, int bid, int nblk, unsigned char* smem) {
  pg8::EpiGlu epi{p.mix};
  run_gemm(p.yg, p.wt_glu + (size_t)layer * 512 * 256, ntok, 512, 256, epi, bid, nblk, smem);
}
__device__ __forceinline__ void phase_gemm_out(PRef p, int layer, int ntok, int bid, int nblk, unsigned char* smem) {
  pg8::EpiResid epi{p.xres, layer == 0 ? p.x : p.xres, layer == 0 ? p.ctx : p.xres + (size_t)TL * 1024, p.modv + (size_t)layer * 5 * NMOD, 2048};
  run_gemm(p.mix, p.wt_out + (size_t)layer * 1024 * 1024, ntok, 1024, 1024, epi, bid, nblk, smem);
}
__device__ __forceinline__ void phase_gemm_q(PRef p, int layer, int ntok, int bid, int nblk, unsigned char* smem) {
  pg8::EpiBf16 epi{p.cols  , 2048, 2048};
  run_gemm(p.abuf, p.wt_q + (size_t)layer * 2048 * 1024, ntok, 2048, 1024, epi, bid, nblk, smem);
}

#define LP(q) (*kp_launder(&(q)))
template <int L>
__device__ __forceinline__ void layer_body(PRef p, const XcdBarrier& bar, const XcdInfo xin, int bid, int nblk, unsigned char* smem) {
  constexpr int l = L;
  constexpr int ntok = L == 0 ? TT : TL;
  for (int rep = 0; rep < REP_GEMM; ++rep) phase_gemm_in(LP(p), l, bid, nblk, smem);
  xcd_barrier(bar);
  for (int rep = 0; rep < REP_MIX; ++rep) {
    phase_s5a(LP(p), l, bid, nblk, smem);
    if (REP_S5 > 1) phase_s5a(LP(p), l, bid, nblk, smem);
    for (int r2 = 0; r2 < REP_GLA; ++r2) phase_glaa(LP(p), l, bid, nblk, smem);
  }
  xcd_barrier(bar);
  phase_scan(LP(p), l, bid, nblk);
  for (int r2 = 0; r2 < REP_SGU; ++r2) phase_sgu(LP(p), l, ntok / 128, bid, nblk, smem);
  xcd_barrier(bar);
  for (int rep = 0; rep < REP_MIX; ++rep) {
    phase_s5c(LP(p), l, ntok / 64, bid, nblk, smem);
    if (REP_S5 > 1) phase_s5c(LP(p), l, ntok / 64, bid, nblk, smem);
    for (int r2 = 0; r2 < REP_GLA; ++r2) phase_glac(LP(p), l, ntok / 64, 16 * ((ntok / 64 / 16 + 1) / 2), bid, nblk, smem);
  }
  xcd_barrier(bar);
  for (int rep = 0; rep < REP_GEMM; ++rep) phase_gemm_glu(LP(p), l, ntok, bid, nblk, smem);
  xcd_barrier(bar);
  if (REP_GEMM > 1) {
    pg8::EpiBf16 epi{p.abuf, 1024, 1024};
    for (int rep = 1; rep < REP_GEMM; ++rep) run_gemm(LP(p).mix, p.wt_out + (size_t)l * 1024 * 1024, ntok, 1024, 1024, epi, bid, nblk, smem);
  }
  phase_gemm_out(LP(p), l, ntok, bid, nblk, smem);
  if (l == 0 && nblk > 16 && bid >= 16) {
    const int tid = opaque_tid();
    for (int j = bid - 16; j < 2048; j += nblk - 16) convert_rows(LP(p), (j >> 10) * 2048 + 1024 + (j & 1023), tid);
  } else if (l == 0 && nblk <= 16) {
    const int tid = opaque_tid();
    for (int j = bid; j < 2048; j += nblk) convert_rows(LP(p), (j >> 10) * 2048 + 1024 + (j & 1023), tid);
  }
  xcd_barrier(bar);
  for (int rep = 0; rep < REP_PRO; ++rep)
    phase_normmod(LP(p), p.xres, p.xres + (size_t)TL * 1024, p.norm2_g + l * 1024, p.modv + (size_t)l * 5 * NMOD, 3072, 4096, ntok, 0, bid, nblk);
  xcd_barrier(bar);
  for (int rep = 0; rep < REP_GEMM; ++rep) phase_gemm_q(LP(p), l, ntok, bid, nblk, smem);
  xcd_barrier(bar);
  for (int rep = 0; rep < REP_ROUTE; ++rep) phase_route(LP(p), l, ntok, bid, nblk, smem);
  xcd_barrier(bar);
  phase_gather_u(LP(p), l, ntok, xin, smem);
  if (REP_GATHER == 2) phase_gather_u(LP(p), l, ntok, xin, smem);
  xcd_barrier(bar);
  phase_gather_r(LP(p), l, ntok, bid, nblk);
  xcd_barrier(bar);
  if (REP_GATHER > 2) phase_gather_v<true>(LP(p), l, ntok, xin, smem);
  phase_gather_v<false>(LP(p), l, ntok, xin, smem);
  xcd_barrier(bar);
  phase_gather_norm(LP(p), l, ntok, bid, nblk);
  if (l == 0) xcd_barrier(bar);
}

#define SMEM_BYTES (148 * 1024)
__global__ void __launch_bounds__(NT) mega_kernel(Params p_unused) {
  const __attribute__((address_space(4))) Params* pk = (const __attribute__((address_space(4))) Params*)__builtin_amdgcn_kernarg_segment_ptr();
#define p (*kp_launder(pk))
  __shared__ __attribute__((aligned(16))) unsigned char smem[SMEM_BYTES + 16];
  const int bid = blockIdx.x, nblk = gridDim.x;
  volatile LAS unsigned* xbw = (volatile LAS unsigned*)(smem + SMEM_BYTES);
  if (threadIdx.x == 0) { xbw[0] = 0u; xbw[1] = 0u; xbw[2] = 0u; xbw[3] = 0u; }
  __syncthreads();
  XcdBarrier bar = xcd_barrier_post(p.bar, xbw);
  for (int rep = 0; rep < REP_PRO; ++rep) {
    phase_mod(p, bid, nblk, smem);
    phase_wprep(p, bid, nblk, smem);
  }
  xcd_barrier(bar);
  for (int rep = 0; rep < REP_PRO; ++rep) phase_normmod(p, p.x, p.ctx, p.norm1_g, p.modv, 0, 1024, TT, 0, bid, nblk);
  xcd_barrier(bar);
  const XcdInfo xin = xcd_info(bar);
  layer_body<0>(p, bar, xin, bid, nblk, smem);
  layer_body<1>(p, bar, xin, bid, nblk, smem);
}
#undef p

static inline size_t align_up(size_t v, size_t a) { return (v + a - 1) / a * a; }

extern "C" void kernel_launch(void* const* d_in, const int* in_sizes, int n_in, void* d_out, int out_size, void* d_ws, size_t ws_size,
                              hipStream_t stream) {
  Params p{};
  const float* const* in = (const float* const*)d_in;
  p.x = in[0]; p.c = in[1]; p.ctx = in[2]; p.c_ctx = in[3]; p.w_mod = in[4]; p.b_mod = in[5]; p.norm1_g = in[6]; p.norm2_g = in[7];
  p.w_in = in[8]; p.w_out = in[9]; p.sgu_w = in[10]; p.sgu_b = in[11]; p.lam_re = in[12]; p.lam_im = in[13]; p.b_re = in[14]; p.b_im = in[15];
  p.c_re = in[16]; p.c_im = in[17]; p.log_step = in[18]; p.s5_d = in[19]; p.w_glu = in[20]; p.gla_wg = in[21]; p.gla_bg = in[22]; p.gla_ng = in[23];
  p.w_query = in[24]; p.sub_keys = in[25]; p.exp_u = in[26]; p.exp_v = in[27]; p.final_g = in[28];
  p.out = (float*)d_out;
  unsigned char* w = (unsigned char*)d_ws;
  size_t off = 0;
  auto take = [&](size_t bytes) { void* r = w + off; off = align_up(off + bytes, 256); return r; };
  p.bar = (unsigned*)take(16384);
  p.xres = (float*)take((size_t)TT * 1024 * 4);
  p.modv = (float*)take((size_t)2 * 5 * NMOD * 4);
  p.abuf = (bf16_t*)take((size_t)TT * 1024 * 2);
  p.cols = (bf16_t*)take((size_t)TT * INW * 2);
  p.mix = (bf16_t*)take((size_t)TT * 1024 * 2);
  p.yg = (bf16_t*)take((size_t)TT * 256 * 2);
  p.s5u = (bf16_t*)take((size_t)16 * TT * 16 * 2);
  p.wt_in = (bf16_t*)take((size_t)2 * INWP * 1024 * 2);
  p.wt_out = (bf16_t*)take((size_t)2 * 1024 * 1024 * 2);
  p.wt_q = (bf16_t*)take((size_t)2 * 2048 * 1024 * 2);
  p.wt_glu = (bf16_t*)take((size_t)2 * 512 * 256 * 2);
  p.keysb = (bf16_t*)take((size_t)2 * 2 * 8 * 128 * 128 * 2);
  p.sgu_wb = (bf16_t*)take((size_t)2 * 4 * 128 * 128 * 2);
  p.s5a = (float*)take((size_t)4096 * 2 * 4);
  p.s5a64 = (float*)take((size_t)4096 * 2 * 4);
  p.s5bb = (float*)take((size_t)4096 * 32 * 4);
  p.s5K = (bf16_t*)take((size_t)64 * 16384 * 2);
  p.s5M1 = (bf16_t*)take((size_t)64 * 131072 * 2);
  p.s5N2 = (bf16_t*)take((size_t)64 * 131072 * 2);
  p.s5S = (float*)take((size_t)2 * NSC * 16 * 64 * 2 * 4);
  p.s5H = (float*)take((size_t)2 * NSC * 16 * 64 * 2 * 4);
  p.gkv = (float*)take((size_t)2 * NSC * 8 * 2048 * 4);
  p.gdec = (float*)take((size_t)2 * NSC * 8 * 32 * 4);
  p.eu8 = (unsigned char*)take((size_t)2 * 16384 * 1024);
  p.ev8 = (unsigned char*)take((size_t)2 * 16384 * 1024);
  p.su = (float*)take((size_t)2 * 16384 * 4);
  p.sv = (float*)take((size_t)2 * 16384 * 4);
  p.glb = (float*)take((size_t)2 * TT * 256 * 4);
  p.gksc = (bf16_t*)take((size_t)2 * NSC * 8 * 2048 * 2);
  p.wbuf = (float*)take((size_t)TT * 128 * 4);
  p.ssbuf = (float*)take((size_t)TT * 8 * 4);
  p.pidx = (int*)take((size_t)TT * 128 * 4);
  p.pgate = (float*)take((size_t)TT * 128 * 4);
  if (off > ws_size) { fprintf(stderr, "workspace too small: need %zu have %zu\n", off, ws_size); return; }

  (void)hipMemsetAsync(p.bar, 0, XCD_BAR_WORDS * 4, stream);
  static int grid_blocks = 0;
  if (!grid_blocks) {
    int dev = 0, cus = 0, per_cu = 0;
    (void)hipGetDevice(&dev);
    (void)hipDeviceGetAttribute(&cus, hipDeviceAttributeMultiprocessorCount, dev);
    (void)hipOccupancyMaxActiveBlocksPerMultiprocessor(&per_cu, (const void*)mega_kernel, NT, 0);
    if (per_cu < 1) { fprintf(stderr, "occupancy query says 0 blocks/CU\n"); per_cu = 1; }
    grid_blocks = cus;
  }
  void* args[] = {&p};
  hipError_t e = hipLaunchCooperativeKernel((const void*)mega_kernel, dim3(grid_blocks), dim3(NT), args, 0, stream);
  if (e != hipSuccess) fprintf(stderr, "cooperative launch failed: %s (grid %d)\n", hipGetErrorString(e), grid_blocks);
}
```
